# Optimizing an MI355X kernel written in HIP

```python
import numpy as np
import jax
import jax.numpy as jnp
from jax import lax

D_MODEL = 2048
BATCH = 2
SEQ = 4096
DEPTH = 1

HEAD_DIM = 128
N_MIX_HEADS = D_MODEL // HEAD_DIM
FOX_HEADS = N_MIX_HEADS // 2
NSA_HEADS = N_MIX_HEADS - FOX_HEADS
NSA_KV_HEADS = 2
NSA_GROUP = NSA_HEADS // NSA_KV_HEADS
N_BRANCH = 3
D_FF = 4 * D_MODEL
ROPE_THETA = 10000.0
Q_BLOCK = 128
CMP_LEN = 32
CMP_STRIDE = 16
CMP_HIDDEN = 2 * HEAD_DIM
SEL_BLOCK = 64
SEL_TOPK = 16
WINDOW = 512
NORM_EPS = 1e-6
ATTN_SCALE = HEAD_DIM ** -0.5
FOX_W = FOX_HEADS * HEAD_DIM
NSA_W = NSA_HEADS * HEAD_DIM
KV_W = NSA_KV_HEADS * HEAD_DIM
IN_SIZES = (FOX_W, FOX_W, FOX_W, FOX_HEADS, NSA_W, KV_W, KV_W, KV_W, KV_W, KV_W, KV_W, N_BRANCH * NSA_HEADS)
D_IN = 3 * FOX_W + FOX_HEADS + NSA_W + 6 * KV_W + N_BRANCH * NSA_HEADS

kernel_name = 'hybrid_fox_nsa_block'


def _rms_norm(x, gain):
    xf = x.astype(jnp.float32)
    y = xf * lax.rsqrt(jnp.mean(xf * xf, axis=-1, keepdims=True) + NORM_EPS)
    return (y * gain.astype(jnp.float32)).astype(x.dtype)


def _modulate(h, shift, scale):
    return h * (1.0 + scale[:, None, :]) + shift[:, None, :]


def _heads(a, n):
    return a.reshape(a.shape[0], a.shape[1], n, HEAD_DIM)


def _rope(x, pos):
    half = HEAD_DIM // 2
    inv_freq = ROPE_THETA ** (-jnp.arange(half, dtype=jnp.float32) / half)
    ang = pos.astype(jnp.float32)[:, None] * inv_freq[None, :]
    cos = jnp.cos(ang)[None, :, None, :]
    sin = jnp.sin(ang)[None, :, None, :]
    xf = x.astype(jnp.float32)
    x1, x2 = xf[..., :half], xf[..., half:]
    return jnp.concatenate([x1 * cos - x2 * sin, x2 * cos + x1 * sin], axis=-1).astype(x.dtype)


def _masked_softmax(s, mask):
    s = jnp.where(mask, s, -jnp.inf)
    m = jnp.max(s, axis=-1, keepdims=True)
    m = jnp.where(jnp.isfinite(m), m, 0.0)
    e = jnp.exp(s - m)
    return e / jnp.maximum(jnp.sum(e, axis=-1, keepdims=True), 1e-30)


def _fox_attention(q, k, v, log_f):
    B, T, H, D = q.shape
    nb = T // Q_BLOCK
    cum = jnp.cumsum(log_f, axis=1)
    q_blocks = q.reshape(B, nb, Q_BLOCK, H, D).transpose(1, 0, 3, 2, 4)
    c_blocks = cum.reshape(B, nb, Q_BLOCK, H).transpose(1, 0, 3, 2)
    k_t = k.transpose(0, 2, 1, 3)
    v_t = v.transpose(0, 2, 1, 3)
    c_k = cum.transpose(0, 2, 1)
    k_pos = jnp.arange(T)

    def block(args):
        q_i, c_i, i = args
        q_pos = i * Q_BLOCK + jnp.arange(Q_BLOCK)
        s = jnp.einsum('bhqd,bhkd->bhqk', q_i, k_t).astype(jnp.float32) * ATTN_SCALE
        s = s + (c_i[..., :, None] - c_k[:, :, None, :])
        p = _masked_softmax(s, k_pos[None, :] <= q_pos[:, None])
        return jnp.einsum('bhqk,bhkd->bhqd', p.astype(v_t.dtype), v_t)

    o = lax.map(block, (q_blocks, c_blocks, jnp.arange(nb)))
    return o.transpose(1, 0, 3, 2, 4).reshape(B, T, H * D)


def _compress(x, pe, w1, w2):
    B, T, G, D = x.shape
    n_cmp = (T - CMP_LEN) // CMP_STRIDE + 1
    idx = np.arange(n_cmp)[:, None] * CMP_STRIDE + np.arange(CMP_LEN)[None, :]
    xb = x[:, idx] + pe[None, None, :, None, :]
    xb = xb.transpose(0, 1, 3, 2, 4).reshape(B, n_cmp, G, CMP_LEN * D)
    return jax.nn.silu(xb @ w1) @ w2


def _nsa_attention(q, k_cmp, v_cmp, k_slc, v_slc, k_win, v_win, gates):
    B, T, H, D = q.shape
    G, hg = NSA_KV_HEADS, NSA_GROUP
    nb = T // Q_BLOCK
    t_pos = jnp.arange(T)
    n_cmp = k_cmp.shape[1]

    q_g = q.reshape(B, T, G, hg, D)
    s = jnp.einsum('btghd,bngd->bghtn', q_g, k_cmp).astype(jnp.float32) * ATTN_SCALE
    cmp_end = jnp.arange(n_cmp) * CMP_STRIDE + CMP_LEN - 1
    p_cmp = _masked_softmax(s, cmp_end[None, :] <= t_pos[:, None])
    o_cmp = jnp.einsum('bghtn,bngd->btghd', p_cmp.astype(v_cmp.dtype), v_cmp)

    n_sel = T // SEL_BLOCK
    c0 = np.arange(n_cmp) * CMP_STRIDE
    s0 = np.arange(n_sel) * SEL_BLOCK
    overlap = np.clip(np.minimum(c0[:, None] + CMP_LEN, s0[None, :] + SEL_BLOCK)
                      - np.maximum(c0[:, None], s0[None, :]), 0, None).astype(np.float32) / CMP_LEN
    imp = jnp.einsum('bghtn,nj->bgtj', p_cmp, jnp.asarray(overlap))
    q_blk = t_pos // SEL_BLOCK
    blk = jnp.arange(n_sel)
    causal = blk[None, :] <= q_blk[:, None]
    forced = (blk[None, :] == 0) | (blk[None, :] == q_blk[:, None]) | (blk[None, :] == q_blk[:, None] - 1)
    imp = jnp.where(forced, jnp.inf, jnp.where(causal, imp, -jnp.inf))
    n_top = min(SEL_TOPK, n_sel)
    _, sel_idx = lax.top_k(imp, n_top)

    q_r = _rope(q, t_pos).reshape(B, T, G, hg, D)
    k_s = k_slc.reshape(B, n_sel, SEL_BLOCK, G, D).transpose(0, 3, 1, 2, 4)
    v_s = v_slc.reshape(B, n_sel, SEL_BLOCK, G, D).transpose(0, 3, 1, 2, 4)
    q_blocks = q_r.reshape(B, nb, Q_BLOCK, G, hg, D).transpose(1, 0, 2, 3, 4, 5)
    i_blocks = sel_idx.reshape(B, G, nb, Q_BLOCK, n_top).transpose(2, 0, 1, 3, 4)
    b_ix = jnp.arange(B)[:, None, None, None]
    g_ix = jnp.arange(G)[None, :, None, None]
    m_keys = n_top * SEL_BLOCK

    def sel_block(args):
        q_i, idx_i, i = args
        q_pos = i * Q_BLOCK + jnp.arange(Q_BLOCK)
        k_g = k_s[b_ix, g_ix, idx_i].reshape(B, G, Q_BLOCK, m_keys, D)
        v_g = v_s[b_ix, g_ix, idx_i].reshape(B, G, Q_BLOCK, m_keys, D)
        k_pos = (idx_i[..., None] * SEL_BLOCK + jnp.arange(SEL_BLOCK)).reshape(B, G, Q_BLOCK, m_keys)
        mask = (k_pos <= q_pos[None, None, :, None])[:, :, None]
        s_i = jnp.einsum('bqghd,bgqmd->bghqm', q_i, k_g).astype(jnp.float32) * ATTN_SCALE
        p = _masked_softmax(s_i, mask)
        return jnp.einsum('bghqm,bgqmd->bqghd', p.astype(v_g.dtype), v_g)

    o_slc = lax.map(sel_block, (q_blocks, i_blocks, jnp.arange(nb)))
    o_slc = o_slc.transpose(1, 0, 2, 3, 4, 5).reshape(B, T, G, hg, D)

    k_wp = jnp.pad(k_win, ((0, 0), (WINDOW, 0), (0, 0), (0, 0)))
    v_wp = jnp.pad(v_win, ((0, 0), (WINDOW, 0), (0, 0), (0, 0)))

    def win_block(args):
        q_i, i = args
        start = i * Q_BLOCK
        k_b = lax.dynamic_slice_in_dim(k_wp, start, Q_BLOCK + WINDOW, axis=1)
        v_b = lax.dynamic_slice_in_dim(v_wp, start, Q_BLOCK + WINDOW, axis=1)
        q_pos = start + jnp.arange(Q_BLOCK)
        k_pos = start - WINDOW + jnp.arange(Q_BLOCK + WINDOW)
        diff = q_pos[:, None] - k_pos[None, :]
        mask = (k_pos[None, :] >= 0) & (diff >= 0) & (diff < WINDOW)
        s_i = jnp.einsum('bqghd,bkgd->bghqk', q_i, k_b).astype(jnp.float32) * ATTN_SCALE
        p = _masked_softmax(s_i, mask)
        return jnp.einsum('bghqk,bkgd->bqghd', p.astype(v_b.dtype), v_b)

    o_win = lax.map(win_block, (q_blocks, jnp.arange(nb)))
    o_win = o_win.transpose(1, 0, 2, 3, 4, 5).reshape(B, T, G, hg, D)

    g = gates.reshape(B, T, G, hg, N_BRANCH)
    o = g[..., 0:1] * o_cmp + g[..., 1:2] * o_slc + g[..., 2:3] * o_win
    return o.reshape(B, T, H * D)


def setup_inputs(seed: int = 0) -> dict:
    key = jax.random.key(seed)
    ks = jax.random.split(key, 24)
    L = DEPTH
    f32 = jnp.float32

    def nrm(k, shape, scale):
        return jax.random.normal(k, shape, f32) * scale

    return {
        'x': nrm(ks[0], (BATCH, SEQ, D_MODEL), 1.0),
        'c': nrm(ks[1], (BATCH, D_MODEL), 1.0),
        'w_ada': nrm(ks[2], (L, D_MODEL, 6 * D_MODEL), D_MODEL ** -0.5),
        'b_ada': nrm(ks[3], (L, 6 * D_MODEL), 0.02),
        'norm1_g': 1.0 + nrm(ks[4], (L, D_MODEL), 0.05),
        'w_in': nrm(ks[5], (L, D_MODEL, D_IN), D_MODEL ** -0.5),
        'b_forget': jax.random.uniform(ks[6], (L, FOX_HEADS), f32, 1.0, 4.0),
        'fox_q_norm': 1.0 + nrm(ks[7], (L, HEAD_DIM), 0.05),
        'fox_k_norm': 1.0 + nrm(ks[8], (L, HEAD_DIM), 0.05),
        'nsa_q_norm': 1.0 + nrm(ks[9], (L, HEAD_DIM), 0.05),
        'cmp_k_norm': 1.0 + nrm(ks[10], (L, HEAD_DIM), 0.05),
        'slc_k_norm': 1.0 + nrm(ks[11], (L, HEAD_DIM), 0.05),
        'win_k_norm': 1.0 + nrm(ks[12], (L, HEAD_DIM), 0.05),
        'cmp_pe_k': nrm(ks[13], (L, CMP_LEN, HEAD_DIM), 0.2),
        'cmp_w1_k': nrm(ks[14], (L, CMP_LEN * HEAD_DIM, CMP_HIDDEN), (CMP_LEN * HEAD_DIM) ** -0.5),
        'cmp_w2_k': nrm(ks[15], (L, CMP_HIDDEN, HEAD_DIM), CMP_HIDDEN ** -0.5),
        'cmp_pe_v': nrm(ks[16], (L, CMP_LEN, HEAD_DIM), 0.2),
        'cmp_w1_v': nrm(ks[17], (L, CMP_LEN * HEAD_DIM, CMP_HIDDEN), (CMP_LEN * HEAD_DIM) ** -0.5),
        'cmp_w2_v': nrm(ks[18], (L, CMP_HIDDEN, HEAD_DIM), CMP_HIDDEN ** -0.5),
        'w_out': nrm(ks[19], (L, D_MODEL, D_MODEL), D_MODEL ** -0.5),
        'norm2_g': 1.0 + nrm(ks[20], (L, D_MODEL), 0.05),
        'w_up': nrm(ks[21], (L, D_MODEL, D_FF), D_MODEL ** -0.5),
        'w_down': nrm(ks[22], (L, D_FF, D_MODEL), D_FF ** -0.5),
    }


def reference(x, c, w_ada, b_ada, norm1_g, w_in, b_forget, fox_q_norm, fox_k_norm, nsa_q_norm,
              cmp_k_norm, slc_k_norm, win_k_norm, cmp_pe_k, cmp_w1_k, cmp_w2_k, cmp_pe_v, cmp_w1_v,
              cmp_w2_v, w_out, norm2_g, w_up, w_down):
    B, T, _ = x.shape
    t_pos = jnp.arange(T)
    split_at = np.cumsum(IN_SIZES)[:-1].tolist()
    c_act = jax.nn.silu(c)
    for l in range(DEPTH):
        mod = c_act @ w_ada[l] + b_ada[l]
        shift1, scale1, gate1, shift2, scale2, gate2 = jnp.split(mod, 6, axis=-1)

        h = _modulate(_rms_norm(x, norm1_g[l]), shift1, scale1)
        proj = h @ w_in[l]
        fq, fk, fv, fz, nq, kc, vc, ksl, vsl, kw, vw, gz = jnp.split(proj, split_at, axis=-1)

        fq = _rms_norm(_heads(fq, FOX_HEADS), fox_q_norm[l])
        fk = _rms_norm(_heads(fk, FOX_HEADS), fox_k_norm[l])
        log_f = jax.nn.log_sigmoid(fz.astype(jnp.float32) + b_forget[l].astype(jnp.float32))
        o_fox = _fox_attention(fq, fk, _heads(fv, FOX_HEADS), log_f)

        nq = _rms_norm(_heads(nq, NSA_HEADS), nsa_q_norm[l])
        k_cmp = _rms_norm(_compress(_heads(kc, NSA_KV_HEADS), cmp_pe_k[l], cmp_w1_k[l], cmp_w2_k[l]), cmp_k_norm[l])
        v_cmp = _compress(_heads(vc, NSA_KV_HEADS), cmp_pe_v[l], cmp_w1_v[l], cmp_w2_v[l])
        k_slc = _rope(_rms_norm(_heads(ksl, NSA_KV_HEADS), slc_k_norm[l]), t_pos)
        k_win = _rope(_rms_norm(_heads(kw, NSA_KV_HEADS), win_k_norm[l]), t_pos)
        gates = jax.nn.sigmoid(gz).reshape(B, T, NSA_HEADS, N_BRANCH)
        o_nsa = _nsa_attention(nq, k_cmp, v_cmp, k_slc, _heads(vsl, NSA_KV_HEADS),
                               k_win, _heads(vw, NSA_KV_HEADS), gates)

        mix = jnp.concatenate([o_fox, o_nsa], axis=-1) @ w_out[l]
        x = x + gate1[:, None, :] * mix

        h = _modulate(_rms_norm(x, norm2_g[l]), shift2, scale2)
        x = x + gate2[:, None, :] * (jnp.square(jax.nn.relu(h @ w_up[l])) @ w_down[l])
    return x
```

```cpp
#include <hip/hip_runtime.h>
#include <stdint.h>
#include <math.h>

constexpr int DM = 2048, NB = 2, T = 4096, M = NB * T, HD = 128;
constexpr int DIN = 5664, DFF = 8192;
constexpr int C_FQ = 0, C_FK = 1024, C_FV = 2048, C_FZ = 3072, C_NQ = 3080, C_KC = 4104, C_VC = 4360, C_KSL = 4616, C_VSL = 4872,
              C_KW = 5128, C_VW = 5384, C_GZ = 5640;
constexpr int NCMP = 255, NSELB = 64;
constexpr float SCALE = 0.08838834764831845f;
constexpr float EPS = 1e-6f;

__device__ __forceinline__ float wave_sum(float v) {
#pragma unroll
    for (int o = 1; o < 64; o <<= 1) v += __shfl_xor(v, o);
    return v;
}
__device__ __forceinline__ float wave_max(float v) {
#pragma unroll
    for (int o = 1; o < 64; o <<= 1) v = fmaxf(v, __shfl_xor(v, o));
    return v;
}

__global__ __launch_bounds__(256) void adaln_kernel(const float* __restrict__ c, const float* __restrict__ w, const float* __restrict__ bias, float* __restrict__ mod) {
    __shared__ float ca[2][DM];
    for (int i = threadIdx.x; i < 2 * DM; i += 256) { float v = c[i]; ca[i / DM][i % DM] = v / (1.f + expf(-v)); }
    __syncthreads();
    const int j = blockIdx.x * 256 + threadIdx.x;
    float a0 = 0.f, a1 = 0.f;
#pragma unroll 8
    for (int k = 0; k < DM; ++k) { const float wv = w[(size_t)k * (6 * DM) + j]; a0 += ca[0][k] * wv; a1 += ca[1][k] * wv; }
    mod[j] = a0 + bias[j]; mod[6 * DM + j] = a1 + bias[j];
}

__global__ __launch_bounds__(256) void norm_mod_kernel(const float* __restrict__ x, const float* __restrict__ g, const float* __restrict__ mod, int shift_off, int scale_off, float* __restrict__ h) {
    __shared__ float red[4];
    const int row = blockIdx.x, b = row / T;
    const float* xr = x + (size_t)row * DM;
    float v[8]; float ss = 0.f;
#pragma unroll
    for (int i = 0; i < 8; ++i) { v[i] = xr[threadIdx.x + 256 * i]; ss += v[i] * v[i]; }
    ss = wave_sum(ss);
    if ((threadIdx.x & 63) == 0) red[threadIdx.x >> 6] = ss;
    __syncthreads();
    const float tot = red[0] + red[1] + red[2] + red[3];
    const float rstd = 1.0f / sqrtf(tot / DM + EPS);
#pragma unroll
    for (int i = 0; i < 8; ++i) { const int d = threadIdx.x + 256 * i;
        h[(size_t)row * DM + d] = v[i] * rstd * g[d] * (1.f + mod[b * 6 * DM + scale_off + d]) + mod[b * 6 * DM + shift_off + d]; }
}

template <int EPI>
__global__ __launch_bounds__(256) void gemm_f32(const float* __restrict__ A, int lda, const float* __restrict__ B, int ldb, float* __restrict__ C, int ldc,
                                                int Mr, int N, int K, const float* __restrict__ base, const float* __restrict__ gate, int rows_per_batch, int batch0) {
    __shared__ float As[16][68];
    __shared__ float Bs[16][68];
    const int tid = threadIdx.x, tx = tid & 15, ty = tid >> 4;
    const int m0 = blockIdx.y * 64, n0 = blockIdx.x * 64;
    float acc[4][4] = {};
    const int ar = tid >> 2, ak = (tid & 3) * 4;
    const int bk = tid >> 4, bn = (tid & 15) * 4;
    for (int k0 = 0; k0 < K; k0 += 16) {
        float4 av = make_float4(0.f, 0.f, 0.f, 0.f), bv = make_float4(0.f, 0.f, 0.f, 0.f);
        if (m0 + ar < Mr) av = *(const float4*)(A + (size_t)(m0 + ar) * lda + k0 + ak);
        if (n0 + bn < N) bv = *(const float4*)(B + (size_t)(k0 + bk) * ldb + n0 + bn);
        __syncthreads();
        As[ak + 0][ar] = av.x; As[ak + 1][ar] = av.y; As[ak + 2][ar] = av.z; As[ak + 3][ar] = av.w;
        *(float4*)&Bs[bk][bn] = bv;
        __syncthreads();
#pragma unroll
        for (int k = 0; k < 16; ++k) {
            const float4 a4 = *(const float4*)&As[k][ty * 4];
            const float4 b4 = *(const float4*)&Bs[k][tx * 4];
            const float a[4] = {a4.x, a4.y, a4.z, a4.w}, b[4] = {b4.x, b4.y, b4.z, b4.w};
#pragma unroll
            for (int i = 0; i < 4; ++i)
#pragma unroll
                for (int j = 0; j < 4; ++j) acc[i][j] += a[i] * b[j];
        }
    }
#pragma unroll
    for (int i = 0; i < 4; ++i) {
        const int m = m0 + ty * 4 + i; if (m >= Mr) continue;
#pragma unroll
        for (int j = 0; j < 4; ++j) {
            const int n = n0 + tx * 4 + j; if (n >= N) continue;
            float v = acc[i][j];
            if (EPI == 1) { v = v > 0.f ? v * v : 0.f; }
            if (EPI == 2) { v = v / (1.f + expf(-v)); }
            if (EPI == 3) { const int b = batch0 + m / rows_per_batch; v = base[(size_t)m * ldc + n] + gate[b * 6 * DM + n] * v; }
            C[(size_t)m * ldc + n] = v;
        }
    }
}

__global__ __launch_bounds__(256) void postproj_kernel(float* __restrict__ proj, float* __restrict__ qr, const float* __restrict__ b_forget,
                                                       const float* __restrict__ g_fq, const float* __restrict__ g_fk, const float* __restrict__ g_nq,
                                                       const float* __restrict__ g_slc, const float* __restrict__ g_win) {
    const int row = blockIdx.x, t = row % T, wave = threadIdx.x >> 6, lane = threadIdx.x & 63;
    float* pr = proj + (size_t)row * DIN;
    const float inv_freq = (float)pow(10000.0, -(double)lane / 64.0);
    const float ang = (float)t * inv_freq;
    const float cs = (float)cos((double)ang), sn = (float)sin((double)ang);
    for (int hh = wave; hh < 28; hh += 4) {
        int col; const float* g; bool rope = false; bool isq = false;
        if (hh < 8) { col = C_FQ + hh * 128; g = g_fq; }
        else if (hh < 16) { col = C_FK + (hh - 8) * 128; g = g_fk; }
        else if (hh < 24) { col = C_NQ + (hh - 16) * 128; g = g_nq; isq = true; }
        else if (hh < 26) { col = C_KSL + (hh - 24) * 128; g = g_slc; rope = true; }
        else { col = C_KW + (hh - 26) * 128; g = g_win; rope = true; }
        const float v0 = pr[col + lane], v1 = pr[col + 64 + lane];
        const float ss = wave_sum(v0 * v0 + v1 * v1);
        const float rstd = 1.0f / sqrtf(ss / 128.f + EPS);
        const float y0 = v0 * rstd * g[lane], y1 = v1 * rstd * g[64 + lane];
        const float r0 = y0 * cs - y1 * sn, r1 = y1 * cs + y0 * sn;
        if (rope) { pr[col + lane] = r0; pr[col + 64 + lane] = r1; }
        else { pr[col + lane] = y0; pr[col + 64 + lane] = y1; }
        if (isq) { float* q = qr + (size_t)row * 1024 + (hh - 16) * 128; q[lane] = r0; q[64 + lane] = r1; }
    }
    if (threadIdx.x < 8) { const float z = pr[C_FZ + threadIdx.x] + b_forget[threadIdx.x];
        pr[C_FZ + threadIdx.x] = fminf(z, 0.f) - log1pf(expf(-fabsf(z))); }
    if (threadIdx.x >= 64 && threadIdx.x < 88) { const int i = threadIdx.x - 64; const float z = pr[C_GZ + i]; pr[C_GZ + i] = 1.f / (1.f + expf(-z)); }
}

__global__ void cumsum_kernel(const float* __restrict__ proj, float* __restrict__ cum) {
    const int i = threadIdx.x; if (i >= 16) return;
    const int b = i / 8, h = i % 8; float s = 0.f;
    for (int t = 0; t < T; ++t) { s += proj[(size_t)(b * T + t) * DIN + C_FZ + h]; cum[(size_t)i * T + t] = s; }
}

template <class F>
__device__ __forceinline__ void attend_wave(const float* qs, float* sc, int nk, F keyfn, int lane, float& o0, float& o1, float* inv_sum_out) {
    float mx = -INFINITY;
    for (int i = lane; i < nk; i += 64) {
        const float* kp; const float* vp; float bias;
        float s = -INFINITY;
        if (keyfn(i, kp, vp, bias)) {
            float a = 0.f;
#pragma unroll 8
            for (int d = 0; d < 128; d += 4) { const float4 kv = *(const float4*)(kp + d); const float4 qv = *(const float4*)(qs + d);
                a += kv.x * qv.x + kv.y * qv.y + kv.z * qv.z + kv.w * qv.w; }
            s = a * SCALE + bias;
        }
        sc[i] = s; mx = fmaxf(mx, s);
    }
    mx = wave_max(mx);
    if (mx == -INFINITY) mx = 0.f;
    float sum = 0.f;
    for (int i = lane; i < nk; i += 64) { const float s = sc[i]; const float e = (s == -INFINITY) ? 0.f : expf(s - mx); sc[i] = e; sum += e; }
    sum = wave_sum(sum);
    const float inv = 1.0f / fmaxf(sum, 1e-30f);
    __builtin_amdgcn_s_waitcnt(0);
    float a0 = 0.f, a1 = 0.f;
    for (int i = 0; i < nk; ++i) {
        const float p = sc[i];
        if (p != 0.f) { const float* kp; const float* vp; float bias; keyfn(i, kp, vp, bias); a0 += p * vp[lane]; a1 += p * vp[64 + lane]; }
    }
    o0 = a0 * inv; o1 = a1 * inv; *inv_sum_out = inv;
}

__global__ __launch_bounds__(128) void fox_attn_kernel(const float* __restrict__ proj, const float* __restrict__ cum, float* __restrict__ ao) {
    __shared__ __attribute__((aligned(16))) float qs[2][128];
    __shared__ float sc[2][T];
    const int wave = threadIdx.x >> 6, lane = threadIdx.x & 63;
    const int gw = blockIdx.x * 2 + wave;
    const int t = gw % T, bh = gw / T, b = bh / 8, h = bh % 8;
    const float* qrow = proj + (size_t)(b * T + t) * DIN + C_FQ + h * 128;
    qs[wave][lane] = qrow[lane]; qs[wave][64 + lane] = qrow[64 + lane];
    const float* cu = cum + (size_t)bh * T; const float ct = cu[t];
    const float* Kb = proj + (size_t)(b * T) * DIN + C_FK + h * 128;
    const float* Vb = proj + (size_t)(b * T) * DIN + C_FV + h * 128;
    float o0, o1, inv;
    attend_wave(qs[wave], sc[wave], t + 1, [&](int i, const float*& kp, const float*& vp, float& bias) {
        kp = Kb + (size_t)i * DIN; vp = Vb + (size_t)i * DIN; bias = ct - cu[i]; return true; }, lane, o0, o1, &inv);
    float* orow = ao + (size_t)(b * T + t) * DM + h * 128;
    orow[lane] = o0; orow[64 + lane] = o1;
}

__global__ __launch_bounds__(128) void nsa_attn_kernel(const float* __restrict__ proj, const float* __restrict__ qr, const float* __restrict__ kcmp, const float* __restrict__ vcmp,
                                                       float* __restrict__ ao) {
    __shared__ __attribute__((aligned(16))) float qs[2][128];
    __shared__ float sc[2][1024];
    __shared__ float psum[2][256];
    __shared__ float impv[2][64];
    const int wave = threadIdx.x >> 6, lane = threadIdx.x & 63;
    const int gw = blockIdx.x * 2 + wave;
    const int g = gw & 1, row = gw >> 1, t = row % T, b = row / T;
    const float* prow = proj + (size_t)row * DIN;
    float* ps = psum[wave];
    for (int i = lane; i < 256; i += 64) ps[i] = 0.f;
    float oc[4][2], osl[4][2], ow[4][2];
    const float* KC = kcmp + (size_t)((b * 2 + g) * NCMP) * 128;
    const float* VC = vcmp + (size_t)((b * 2 + g) * NCMP) * 128;
    for (int hh = 0; hh < 4; ++hh) {
        const float* qrow = prow + C_NQ + (g * 4 + hh) * 128;
        qs[wave][lane] = qrow[lane]; qs[wave][64 + lane] = qrow[64 + lane];
        float inv;
        attend_wave(qs[wave], sc[wave], NCMP, [&](int i, const float*& kp, const float*& vp, float& bias) {
            kp = KC + (size_t)i * 128; vp = VC + (size_t)i * 128; bias = 0.f; return (16 * i + 31) <= t; }, lane, oc[hh][0], oc[hh][1], &inv);
        for (int i = lane; i < NCMP; i += 64) ps[i] += sc[wave][i] * inv;
    }
    const int qblk = t / 64;
    {
        const int j = lane;
        float im = 0.f;
        for (int n = 4 * j - 1; n <= 4 * j + 3; ++n) { if (n < 0 || n >= NCMP) continue;
            const int lo = max(16 * n, 64 * j), hi = min(16 * n + 32, 64 * j + 64); const int ov = hi - lo;
            if (ov > 0) im += ps[n] * ((float)ov / 32.f); }
        const bool forced = (j == 0) || (j == qblk) || (j == qblk - 1);
        const bool causal = j <= qblk;
        const float v = forced ? INFINITY : (causal ? im : -INFINITY);
        impv[wave][j] = v;
    }
    unsigned long long selmask;
    {
        const int j = lane; const float v = impv[wave][j]; int rank = 0;
        for (int jj = 0; jj < 64; ++jj) { const float u = impv[wave][jj]; rank += (u > v || (u == v && jj < j)) ? 1 : 0; }
        selmask = __ballot(rank < 16 && j <= qblk);
    }
    const int nsel = __popcll(selmask);
    const float* KS = proj + (size_t)(b * T) * DIN + C_KSL + g * 128;
    const float* VS = proj + (size_t)(b * T) * DIN + C_VSL + g * 128;
    const float* KW = proj + (size_t)(b * T) * DIN + C_KW + g * 128;
    const float* VW = proj + (size_t)(b * T) * DIN + C_VW + g * 128;
    for (int hh = 0; hh < 4; ++hh) {
        const float* qrow = qr + (size_t)row * 1024 + (g * 4 + hh) * 128;
        qs[wave][lane] = qrow[lane]; qs[wave][64 + lane] = qrow[64 + lane];
        float inv;
        attend_wave(qs[wave], sc[wave], nsel * 64, [&](int i, const float*& kp, const float*& vp, float& bias) {
            int bi = i >> 6; unsigned long long mm = selmask; for (int z = 0; z < bi; ++z) mm &= mm - 1; const int blk = __ffsll((long long)mm) - 1;
            const int kpos = blk * 64 + (i & 63);
            kp = KS + (size_t)kpos * DIN; vp = VS + (size_t)kpos * DIN; bias = 0.f; return kpos <= t; }, lane, osl[hh][0], osl[hh][1], &inv);
        const int w0 = max(0, t - 511);
        attend_wave(qs[wave], sc[wave], t - w0 + 1, [&](int i, const float*& kp, const float*& vp, float& bias) {
            const int kpos = w0 + i; kp = KW + (size_t)kpos * DIN; vp = VW + (size_t)kpos * DIN; bias = 0.f; return true; }, lane, ow[hh][0], ow[hh][1], &inv);
    }
    for (int hh = 0; hh < 4; ++hh) {
        const int head = g * 4 + hh;
        const float g0 = prow[C_GZ + head * 3 + 0], g1 = prow[C_GZ + head * 3 + 1], g2 = prow[C_GZ + head * 3 + 2];
        float* orow = ao + (size_t)row * DM + 1024 + head * 128;
        orow[lane] = g0 * oc[hh][0] + g1 * osl[hh][0] + g2 * ow[hh][0];
        orow[64 + lane] = g0 * oc[hh][1] + g1 * osl[hh][1] + g2 * ow[hh][1];
    }
}

__global__ __launch_bounds__(256) void build_xb_kernel(const float* __restrict__ proj, int col0, const float* __restrict__ pe, float* __restrict__ xb) {
    const int r = blockIdx.x, n = r % NCMP, bg = r / NCMP, g = bg & 1, b = bg >> 1;
    for (int i = threadIdx.x; i < 4096; i += 256) { const int l = i >> 7, d = i & 127;
        xb[(size_t)r * 4096 + i] = proj[(size_t)(b * T + 16 * n + l) * DIN + col0 + g * 128 + d] + pe[l * 128 + d]; }
}
__global__ __launch_bounds__(64) void rownorm128_kernel(float* __restrict__ x, const float* __restrict__ g) {
    const int r = blockIdx.x, lane = threadIdx.x; float* p = x + (size_t)r * 128;
    const float v0 = p[lane], v1 = p[64 + lane]; const float ss = wave_sum(v0 * v0 + v1 * v1); const float rstd = 1.0f / sqrtf(ss / 128.f + EPS);
    p[lane] = v0 * rstd * g[lane]; p[64 + lane] = v1 * rstd * g[64 + lane];
}

extern "C" void kernel_launch(void* const* d_in, const int* in_sizes, int n_in, void* d_out, int out_size, void* d_ws, size_t ws_size, hipStream_t stream) {
    const float* x = (const float*)d_in[0]; const float* c = (const float*)d_in[1]; const float* w_ada = (const float*)d_in[2]; const float* b_ada = (const float*)d_in[3];
    const float* norm1_g = (const float*)d_in[4]; const float* w_in = (const float*)d_in[5]; const float* b_forget = (const float*)d_in[6];
    const float* fox_q_norm = (const float*)d_in[7]; const float* fox_k_norm = (const float*)d_in[8]; const float* nsa_q_norm = (const float*)d_in[9];
    const float* cmp_k_norm = (const float*)d_in[10]; const float* slc_k_norm = (const float*)d_in[11]; const float* win_k_norm = (const float*)d_in[12];
    const float* cmp_pe_k = (const float*)d_in[13]; const float* cmp_w1_k = (const float*)d_in[14]; const float* cmp_w2_k = (const float*)d_in[15];
    const float* cmp_pe_v = (const float*)d_in[16]; const float* cmp_w1_v = (const float*)d_in[17]; const float* cmp_w2_v = (const float*)d_in[18];
    const float* w_out = (const float*)d_in[19]; const float* norm2_g = (const float*)d_in[20]; const float* w_up = (const float*)d_in[21]; const float* w_down = (const float*)d_in[22];
    float* out = (float*)d_out;
    char* ws = (char*)d_ws;
    constexpr size_t MiB = 1u << 20;
    float* mod = (float*)(ws);
    float* cum = (float*)(ws + 1 * MiB);
    float* kcmp = (float*)(ws + 2 * MiB);
    float* vcmp = (float*)(ws + 3 * MiB);
    float* hid = (float*)(ws + 4 * MiB);
    float* hbuf = (float*)(ws + 8 * MiB);
    float* proj = (float*)(ws + 72 * MiB);
    float* qr = (float*)(ws + 250 * MiB);
    float* xb = (float*)(ws + 282 * MiB);

    adaln_kernel<<<6 * DM / 256, 256, 0, stream>>>(c, w_ada, b_ada, mod);
    norm_mod_kernel<<<M, 256, 0, stream>>>(x, norm1_g, mod, 0, DM, hbuf);
    gemm_f32<0><<<dim3((DIN + 63) / 64, M / 64), 256, 0, stream>>>(hbuf, DM, w_in, DIN, proj, DIN, M, DIN, DM, nullptr, nullptr, T, 0);
    build_xb_kernel<<<4 * NCMP, 256, 0, stream>>>(proj, C_KC, cmp_pe_k, xb);
    gemm_f32<2><<<dim3(256 / 64, (4 * NCMP + 63) / 64), 256, 0, stream>>>(xb, 4096, cmp_w1_k, 256, hid, 256, 4 * NCMP, 256, 4096, nullptr, nullptr, T, 0);
    gemm_f32<0><<<dim3(128 / 64, (4 * NCMP + 63) / 64), 256, 0, stream>>>(hid, 256, cmp_w2_k, 128, kcmp, 128, 4 * NCMP, 128, 256, nullptr, nullptr, T, 0);
    rownorm128_kernel<<<4 * NCMP, 64, 0, stream>>>(kcmp, cmp_k_norm);
    build_xb_kernel<<<4 * NCMP, 256, 0, stream>>>(proj, C_VC, cmp_pe_v, xb);
    gemm_f32<2><<<dim3(256 / 64, (4 * NCMP + 63) / 64), 256, 0, stream>>>(xb, 4096, cmp_w1_v, 256, hid, 256, 4 * NCMP, 256, 4096, nullptr, nullptr, T, 0);
    gemm_f32<0><<<dim3(128 / 64, (4 * NCMP + 63) / 64), 256, 0, stream>>>(hid, 256, cmp_w2_v, 128, vcmp, 128, 4 * NCMP, 128, 256, nullptr, nullptr, T, 0);
    postproj_kernel<<<M, 256, 0, stream>>>(proj, qr, b_forget, fox_q_norm, fox_k_norm, nsa_q_norm, slc_k_norm, win_k_norm);
    cumsum_kernel<<<1, 64, 0, stream>>>(proj, cum);
    fox_attn_kernel<<<NB * 8 * T / 2, 128, 0, stream>>>(proj, cum, hbuf);
    nsa_attn_kernel<<<M * 2 / 2, 128, 0, stream>>>(proj, qr, kcmp, vcmp, hbuf);
    gemm_f32<3><<<dim3(DM / 64, M / 64), 256, 0, stream>>>(hbuf, DM, w_out, DM, out, DM, M, DM, DM, x, mod + 2 * DM, T, 0);
    norm_mod_kernel<<<M, 256, 0, stream>>>(out, norm2_g, mod, 3 * DM, 4 * DM, hbuf);
    for (int half = 0; half < 2; ++half) {
        float* u = proj;
        gemm_f32<1><<<dim3(DFF / 64, T / 64), 256, 0, stream>>>(hbuf + (size_t)half * T * DM, DM, w_up, DFF, u, DFF, T, DFF, DM, nullptr, nullptr, T, 0);
        gemm_f32<3><<<dim3(DM / 64, T / 64), 256, 0, stream>>>(u, DFF, w_down, DM, out + (size_t)half * T * DM, DM, T, DM, DFF, out + (size_t)half * T * DM, mod + 5 * DM, T, half);
    }
}
```

```cpp
#include <hip/hip_runtime.h>
#include <hip/hip_cooperative_groups.h>
#include <stdint.h>
#include <math.h>
#include <cstdio>
namespace cg = cooperative_groups;

constexpr int DM = 2048, NB = 2, T = 4096, M = NB * T, HD = 128;
constexpr int DIN = 5664, DFF = 8192, NPAD = 5888;
constexpr int C_FQ = 0, C_FK = 1024, C_FV = 2048, C_FZ = 3072, C_NQ = 3080, C_KC = 4104, C_VC = 4360, C_KSL = 4616, C_VSL = 4872,
              C_KW = 5128, C_VW = 5384, C_GZ = 5640;
constexpr int NCMP = 255;
constexpr float SCALE = 0.08838834764831845f;
constexpr float EPS = 1e-6f;
constexpr int NWAVES = 8, NTHR = 512;

constexpr size_t MiB = 1u << 20;
constexpr size_t WS_CTL = 0;
constexpr size_t WS_MODP = 256 * 1024;
constexpr size_t WS_MOD = 2 * MiB;
constexpr size_t WS_ROPE = 3 * MiB;
constexpr size_t WS_PEBP = 5 * MiB;
constexpr size_t WS_PEB = 5 * MiB + 256 * 1024;
constexpr size_t WS_LOGF = 5 * MiB + 320 * 1024;
constexpr size_t WS_KBIAS = 5 * MiB + 640 * 1024;
constexpr size_t WS_GATES = 6 * MiB;
constexpr size_t WS_W2T = 7 * MiB;
constexpr size_t WS_W1T = 8 * MiB;
constexpr size_t WS_WIN = 12 * MiB;
constexpr size_t WS_WOUT = 36 * MiB;
constexpr size_t WS_WUP = 44 * MiB;
constexpr size_t WS_WDN = 76 * MiB;
constexpr size_t WS_XN = 108 * MiB;
constexpr size_t WS_FQ = 140 * MiB, WS_FK = 156 * MiB, WS_FV = 172 * MiB, WS_NQ = 188 * MiB, WS_NQR = 204 * MiB;
constexpr size_t WS_KC = 220 * MiB, WS_VC = 224 * MiB, WS_KSL = 228 * MiB, WS_VSL = 232 * MiB, WS_KW = 236 * MiB, WS_VW = 240 * MiB;
constexpr size_t WS_KCMP = 244 * MiB, WS_VCMP = 244 * MiB + 512 * 1024;
constexpr size_t WS_PART = 245 * MiB;
constexpr size_t WS_NSAO = 277 * MiB;
constexpr size_t WS_AO = 309 * MiB;
constexpr size_t WS_U = 140 * MiB;
constexpr size_t WS_END = 341 * MiB;
constexpr size_t WS_DEV_CUM = 341 * MiB;
constexpr size_t WS_DEV_XB = 342 * MiB;
constexpr size_t WS_DEV_HID = 358 * MiB;
constexpr size_t WS_DEV_KC = 360 * MiB;

constexpr int LDS_STATS = 131072;
constexpr int LDS_BYTES = 155648;

#define LAS __attribute__((address_space(3)))
typedef unsigned short bf16_t;
typedef short bf16x8 __attribute__((ext_vector_type(8)));
typedef float f32x4 __attribute__((ext_vector_type(4)));
typedef float f32x2 __attribute__((ext_vector_type(2)));
typedef unsigned u32x4 __attribute__((ext_vector_type(4)));
typedef unsigned u32x2 __attribute__((ext_vector_type(2)));

__device__ __forceinline__ unsigned cvt_pk_bf16(float lo, float hi) { unsigned r; asm volatile("v_cvt_pk_bf16_f32 %0, %1, %2" : "=v"(r) : "v"(lo), "v"(hi)); return r; }
__device__ __forceinline__ float bf2f(bf16_t v) { return __uint_as_float(((unsigned)v) << 16); }
__device__ __forceinline__ float wave_sum(float v) {
#pragma unroll
    for (int o = 1; o < 64; o <<= 1) v += __shfl_xor(v, o);
    return v;
}
__device__ __forceinline__ float wave_max(float v) {
#pragma unroll
    for (int o = 1; o < 64; o <<= 1) v = fmaxf(v, __shfl_xor(v, o));
    return v;
}

namespace pg8 {
constexpr int BM = 256, BK = 64, HALF = 128, HTB = HALF * BK * 2, STAGE_BYTES = 8 * HTB, NXCD = 8, WGM = 8;
__host__ __device__ __forceinline__ int lds_byte(int r, int c) { const int st = (r >> 4) * 2 + (c >> 5), rr = r & 15, cc = c & 31, ob = rr * 64 + cc * 2; return st * 1024 + (ob ^ (((ob >> 9) & 1) << 5)); }
__host__ __device__ __forceinline__ void stage_rc(int b, int& R, int& C) { const int st = b / 1024, sb = b % 1024, swz = sb ^ (((sb >> 9) & 1) << 5); R = (st >> 1) * 16 + swz / 64; C = (st & 1) * 32 + (swz % 64) / 2; }
__host__ __device__ __forceinline__ int perm32(int rho) { const int n = rho >> 4, i = rho & 15; return 8 * (i >> 2) + 4 * n + (i & 3); }

struct Unit { int pm, pn, aux; };

struct StaticOrder {
    int nM, nN, nwg, G, c; const char* A; const char* Bt; size_t tsA, tsB;
    __device__ void init(int M_, int N_, int G_, int c_, const void* A_, const void* Bt_, int lda, int ldb) { nM = M_ / BM; nN = N_ / BM; nwg = nM * nN; G = G_; c = c_; A = (const char*)A_; Bt = (const char*)Bt_; tsA = (size_t)BM * lda * 2; tsB = (size_t)BM * ldb * 2; }
    __device__ bool next(int i, Unit& u) const {
        const long L = (long)i * G + c; if (L >= nwg) return false;
        int wgid = (int)L; { const int q = nwg / NXCD, r = nwg % NXCD, xcd = wgid % NXCD, off = wgid / NXCD; wgid = (xcd < r ? xcd * (q + 1) : r * (q + 1) + (xcd - r) * q) + off; }
        const int nig = WGM * nN, gid = wgid / nig, fm = gid * WGM, gsz = (nM - fm) < WGM ? (nM - fm) : WGM;
        u.pm = fm + ((wgid % nig) % gsz); u.pn = (wgid % nig) / gsz; u.aux = 0; return true;
    }
    __device__ __forceinline__ void ptrs(const Unit& u, const char*& a, const char*& b) const { a = A + (size_t)u.pm * tsA; b = Bt + (size_t)u.pn * tsB; }
};

template <class Epi, class Sched>
__device__ __forceinline__ void gemm_phase(LAS unsigned char* lds, const int lda, const int ldb, const int K, const Sched& S, const Epi& E) {
    const int tid = threadIdx.x, wid = __builtin_amdgcn_readfirstlane(tid >> 6), lane = tid & 63, wr = wid >> 2, wc = wid & 3, fr = lane & 15, fq = lane >> 4;
    const int nt = K / BK;
    unsigned voffA[2], voffB[2];
#pragma unroll
    for (int i = 0; i < 2; ++i) { int R, C; stage_rc(tid * 16 + i * 8192, R, C); const int Rb = Epi::PERM ? ((R & ~31) + perm32(R & 31)) : R;
        voffA[i] = (unsigned)(R * lda + C) * 2u; voffB[i] = (unsigned)(Rb * ldb + C) * 2u; }
    const size_t kstep = (size_t)(BK * 2);
    const size_t hsA = (size_t)HALF * lda * 2, hsB = (size_t)HALF * ldb * 2;
    const unsigned ldsw = (unsigned)wid * 1024u;
    const int aoff = lds_byte(wr * 64 + fr, fq * 8), boff = lds_byte(wc * 32 + fr, fq * 8);
#define PG8_SA(b, h) (((b) * 2 + (h)) * HTB)
#define PG8_SB(b, h) ((4 + (b) * 2 + (h)) * HTB)
#define PG8_STAGE(bufoff, gbase, voff) do { _Pragma("unroll") for (int _i = 0; _i < 2; ++_i) \
        __builtin_amdgcn_global_load_lds((const unsigned*)((const char*)(gbase) + (voff)[_i]), (LAS unsigned*)(lds + (bufoff) + ldsw + _i * 8192), 16, 0, 0); } while (0)
#define PG8_LDA(dst, b, h) do { _Pragma("unroll") for (int m = 0; m < 4; ++m) _Pragma("unroll") for (int k = 0; k < 2; ++k) dst[m][k] = *(const LAS bf16x8*)(lds + PG8_SA(b, h) + aoff + m * 2048 + k * 1024); } while (0)
#define PG8_LDB(dst, b, h) do { _Pragma("unroll") for (int n = 0; n < 2; ++n) _Pragma("unroll") for (int k = 0; k < 2; ++k) dst[n][k] = *(const LAS bf16x8*)(lds + PG8_SB(b, h) + boff + n * 2048 + k * 1024); } while (0)
#define PG8_MMA(ai, bj, At, Bt) do { __builtin_amdgcn_s_setprio(1); _Pragma("unroll") for (int m = 0; m < 4; ++m) _Pragma("unroll") for (int n = 0; n < 2; ++n) _Pragma("unroll") for (int k = 0; k < 2; ++k) \
        acc[ai][bj][m][n] = __builtin_amdgcn_mfma_f32_16x16x32_bf16(Bt[n][k], At[m][k], acc[ai][bj][m][n], 0, 0, 0); __builtin_amdgcn_s_setprio(0); } while (0)
#define PG8_WAIT_V(n) asm volatile("s_waitcnt vmcnt(" #n ")" ::: "memory")
#define PG8_WAIT_L(n) asm volatile("s_waitcnt lgkmcnt(" #n ")" ::: "memory")
#define PG8_BAR __builtin_amdgcn_s_barrier()
#define PG8_SCHED __builtin_amdgcn_sched_barrier(0)
    Unit cur, nxt; int ui = 0;
    if (!S.next(0, cur)) return;
    f32x4 acc[2][2][4][2];
#pragma unroll
    for (int a = 0; a < 2; ++a)
#pragma unroll
        for (int b = 0; b < 2; ++b)
#pragma unroll
            for (int m = 0; m < 4; ++m)
#pragma unroll
                for (int n = 0; n < 2; ++n) acc[a][b][m][n] = (f32x4){0.f, 0.f, 0.f, 0.f};
    bf16x8 At[4][2], B0[2][2], B1[2][2];
    const char* cA; const char* cB; S.ptrs(cur, cA, cB);
    PG8_STAGE(PG8_SB(0, 0), cB, voffB); PG8_STAGE(PG8_SB(0, 1), cB + hsB, voffB); PG8_STAGE(PG8_SA(0, 0), cA, voffA); PG8_STAGE(PG8_SA(0, 1), cA + hsA, voffA);
    if (wr == 1) PG8_BAR;
    PG8_WAIT_V(2); PG8_BAR;
    PG8_STAGE(PG8_SB(1, 0), cB + kstep, voffB); PG8_STAGE(PG8_SA(1, 0), cA + kstep, voffA); PG8_STAGE(PG8_SB(1, 1), cB + hsB + kstep, voffB);
    PG8_WAIT_V(6); PG8_BAR;
    for (;;) {
        const bool has_next = S.next(ui + 1, nxt);
        const char* nA = cA; const char* nB = cB; if (has_next) S.ptrs(nxt, nA, nB);
        for (int t = 0; t < nt; t += 2) {
            const bool last = (t == nt - 2);
            const char* a1 = cA + (size_t)(t + 1) * kstep;
            const char* a2 = last ? nA : cA + (size_t)(t + 2) * kstep; const char* b2 = last ? nB : cB + (size_t)(t + 2) * kstep;
            const char* a3 = a2 + kstep; const char* b3 = b2 + kstep;
            PG8_LDB(B0, 0, 0); PG8_LDB(B1, 0, 1); PG8_SCHED; PG8_LDA(At, 0, 0); PG8_STAGE(PG8_SA(1, 1), a1 + hsA, voffA);
            PG8_WAIT_V(8); PG8_WAIT_L(0); PG8_BAR; PG8_MMA(0, 0, At, B0); PG8_MMA(0, 1, At, B1); PG8_BAR; PG8_SCHED;
            PG8_LDA(At, 0, 1); PG8_STAGE(PG8_SB(0, 0), b2, voffB); PG8_STAGE(PG8_SB(0, 1), b2 + hsB, voffB); PG8_STAGE(PG8_SA(0, 0), a2, voffA);
            PG8_WAIT_V(8); PG8_WAIT_L(0); PG8_BAR; PG8_MMA(1, 0, At, B0); PG8_MMA(1, 1, At, B1); PG8_BAR; PG8_SCHED;
            PG8_LDB(B0, 1, 0); PG8_LDB(B1, 1, 1); PG8_SCHED; PG8_LDA(At, 1, 0); PG8_STAGE(PG8_SA(0, 1), a2 + hsA, voffA);
            PG8_WAIT_V(8); PG8_WAIT_L(0); PG8_BAR; PG8_MMA(0, 0, At, B0); PG8_MMA(0, 1, At, B1); PG8_BAR; PG8_SCHED;
            PG8_LDA(At, 1, 1); PG8_STAGE(PG8_SB(1, 0), b3, voffB); PG8_STAGE(PG8_SB(1, 1), b3 + hsB, voffB); PG8_STAGE(PG8_SA(1, 0), a3, voffA);
            PG8_WAIT_V(8); PG8_WAIT_L(0); PG8_BAR; PG8_MMA(1, 0, At, B0); PG8_MMA(1, 1, At, B1); PG8_BAR; PG8_SCHED;
        }
        if (wr == 0) PG8_BAR;
        E(acc, cur, wr, wc, fr, fq);
        if (!has_next) break;
#pragma unroll
        for (int a = 0; a < 2; ++a)
#pragma unroll
            for (int b = 0; b < 2; ++b)
#pragma unroll
                for (int m = 0; m < 4; ++m)
#pragma unroll
                    for (int n = 0; n < 2; ++n) acc[a][b][m][n] = (f32x4){0.f, 0.f, 0.f, 0.f};
        cur = nxt; cA = nA; cB = nB; ++ui;
        if (wr == 1) PG8_BAR;
    }
    PG8_WAIT_V(0);
    PG8_BAR;
#undef PG8_SA
#undef PG8_SB
#undef PG8_STAGE
#undef PG8_LDA
#undef PG8_LDB
#undef PG8_MMA
#undef PG8_WAIT_V
#undef PG8_WAIT_L
#undef PG8_BAR
#undef PG8_SCHED
}


struct EpiRes {
    static constexpr bool PERM = true;
    const float* base; float* out; const float* gate;
    __device__ __forceinline__ void operator()(const f32x4 (&acc)[2][2][4][2], const Unit& u, int wr, int wc, int fr, int fq) const {
        const int row0 = u.pm * BM + wr * 64 + fr, col0 = u.pn * BM + wc * 32 + 8 * fq;
        const int b = (u.pm * BM) / T;
        f32x4 gv[2][2];
#pragma unroll
        for (int bj = 0; bj < 2; ++bj)
#pragma unroll
            for (int n = 0; n < 2; ++n) gv[bj][n] = *(const f32x4*)(gate + (size_t)b * 6 * DM + col0 + bj * HALF + 4 * n);
#pragma unroll
        for (int ai = 0; ai < 2; ++ai)
#pragma unroll
            for (int m = 0; m < 4; ++m) { const size_t off = (size_t)(row0 + ai * HALF + m * 16) * DM + col0;
#pragma unroll
                for (int bj = 0; bj < 2; ++bj)
#pragma unroll
                    for (int n = 0; n < 2; ++n) { const f32x4 bs = *(const f32x4*)(base + off + bj * HALF + 4 * n);
                        *(f32x4*)(out + off + bj * HALF + 4 * n) = bs + gv[bj][n] * acc[ai][bj][m][n]; } }
    }
};
struct EpiUp {
    static constexpr bool PERM = true;
    bf16_t* O; int ldc;
    __device__ __forceinline__ void operator()(const f32x4 (&acc)[2][2][4][2], const Unit& u, int wr, int wc, int fr, int fq) const {
        const int row0 = u.pm * BM + wr * 64 + fr, col0 = u.pn * BM + wc * 32 + 8 * fq;
#pragma unroll
        for (int ai = 0; ai < 2; ++ai)
#pragma unroll
            for (int m = 0; m < 4; ++m) { bf16_t* rowp = O + (size_t)(row0 + ai * HALF + m * 16) * ldc + col0;
#pragma unroll
                for (int bj = 0; bj < 2; ++bj) { f32x4 v0 = acc[ai][bj][m][0], v1 = acc[ai][bj][m][1];
                    v0 = __builtin_elementwise_max(v0, (f32x4){0.f, 0.f, 0.f, 0.f}); v1 = __builtin_elementwise_max(v1, (f32x4){0.f, 0.f, 0.f, 0.f}); v0 = v0 * v0; v1 = v1 * v1;
                    u32x4 w; w.x = cvt_pk_bf16(v0[0], v0[1]); w.y = cvt_pk_bf16(v0[2], v0[3]); w.z = cvt_pk_bf16(v1[0], v1[1]); w.w = cvt_pk_bf16(v1[2], v1[3]);
                    *(u32x4*)(rowp + bj * HALF) = w; } }
    }
};
struct EpiIn {
    static constexpr bool PERM = true;
    bf16_t *FQ, *FK, *FV, *NQ, *NQR, *KC, *VC, *KSL, *VSL, *KW, *VW; float* LOGF; float* GATES;
    const float *g_fq, *g_fk, *g_nq, *g_slc, *g_win, *b_forget; const float* rope; LAS float* stats;
    __device__ __forceinline__ void operator()(const f32x4 (&acc)[2][2][4][2], const Unit& u, int wr, int wc, int fr, int fq) const {
        const int pn = u.pn;
        const int b = u.pm >> 4, t0 = (u.pm & 15) * BM + wr * 64 + fr;
        if (pn == 22) {
            if (wc == 0) {
#pragma unroll
                for (int ai = 0; ai < 2; ++ai)
#pragma unroll
                    for (int m = 0; m < 4; ++m) { const int t = t0 + ai * HALF + m * 16;
#pragma unroll
                        for (int n = 0; n < 2; ++n)
#pragma unroll
                            for (int e = 0; e < 4; ++e) { const int p = 8 * fq + 4 * n + e; const float v = acc[ai][0][m][n][e];
                                if (p < 8) { const float z = v + b_forget[p]; LOGF[((size_t)b * 8 + p) * T + t] = fminf(z, 0.f) - log1pf(__expf(-fabsf(z))); }
                                else { GATES[((size_t)b * T + t) * 24 + (p - 8)] = 1.f / (1.f + __expf(-v)); } } }
            }
            return;
        }
        bf16_t* d1 = nullptr; bf16_t* d2 = nullptr; const float* gain = nullptr; int nh = 8, h0 = 0;
        if (pn < 4) { d1 = FQ; gain = g_fq; h0 = 2 * pn; }
        else if (pn < 8) { d1 = FK; gain = g_fk; h0 = 2 * (pn - 4); }
        else if (pn < 12) { d1 = FV; h0 = 2 * (pn - 8); }
        else if (pn < 16) { d1 = NQ; d2 = NQR; gain = g_nq; h0 = 2 * (pn - 12); }
        else { nh = 2; h0 = 0;
            if (pn == 16) d1 = KC; else if (pn == 17) d1 = VC; else if (pn == 18) { d2 = KSL; gain = g_slc; } else if (pn == 19) d1 = VSL;
            else if (pn == 20) { d2 = KW; gain = g_win; } else d1 = VW; }
        const int dlo = 16 * wc + 4 * fq;
        f32x4 g0 = (f32x4){1.f, 1.f, 1.f, 1.f}, g1 = g0;
        if (gain) {
#pragma unroll
            for (int ai = 0; ai < 2; ++ai)
#pragma unroll
                for (int m = 0; m < 4; ++m)
#pragma unroll
                    for (int bj = 0; bj < 2; ++bj) { const f32x4 a = acc[ai][bj][m][0], c = acc[ai][bj][m][1];
                        float s = (a[0] * a[0] + a[1] * a[1]) + (a[2] * a[2] + a[3] * a[3]) + (c[0] * c[0] + c[1] * c[1]) + (c[2] * c[2] + c[3] * c[3]);
                        s += __shfl_xor(s, 16); s += __shfl_xor(s, 32);
                        if (fq == 0) stats[(ai * HALF + wr * 64 + m * 16 + fr) * 8 + bj * 4 + wc] = s; }
            asm volatile("s_waitcnt lgkmcnt(0)" ::: "memory"); __builtin_amdgcn_s_barrier(); asm volatile("" ::: "memory");
            g0 = *(const f32x4*)(gain + dlo); g1 = *(const f32x4*)(gain + 64 + dlo);
        }
#pragma unroll
        for (int ai = 0; ai < 2; ++ai)
#pragma unroll
            for (int m = 0; m < 4; ++m) { const int t = t0 + ai * HALF + m * 16;
                f32x4 cs0 = (f32x4){0.f, 0.f, 0.f, 0.f}, cs1 = cs0;
                if (d2) { const float* rp = rope + ((size_t)t * 64 + dlo) * 2; cs0 = *(const f32x4*)rp; cs1 = *(const f32x4*)(rp + 4); }
                float rsv[2] = {1.f, 1.f};
                if (gain) {
#pragma unroll
                    for (int bj = 0; bj < 2; ++bj) { const f32x4 q = *(const LAS f32x4*)(stats + (ai * HALF + wr * 64 + m * 16 + fr) * 8 + bj * 4);
                        rsv[bj] = 1.0f / sqrtf(((q[0] + q[1]) + (q[2] + q[3])) * (1.f / 128.f) + EPS); } }
#pragma unroll
                for (int bj = 0; bj < 2; ++bj) { f32x4 v0 = acc[ai][bj][m][0], v1 = acc[ai][bj][m][1];
                    if (gain) { const float r = rsv[bj]; v0 = v0 * r * g0; v1 = v1 * r * g1; }
                    const size_t off = (((size_t)b * nh + h0 + bj) * T + t) * 128 + dlo;
                    if (d1) { u32x2 w0, w1; w0.x = cvt_pk_bf16(v0[0], v0[1]); w0.y = cvt_pk_bf16(v0[2], v0[3]); w1.x = cvt_pk_bf16(v1[0], v1[1]); w1.y = cvt_pk_bf16(v1[2], v1[3]);
                        *(u32x2*)(d1 + off) = w0; *(u32x2*)(d1 + off + 64) = w1; }
                    if (d2) { const f32x4 c = (f32x4){cs0[0], cs0[2], cs1[0], cs1[2]}, s = (f32x4){cs0[1], cs0[3], cs1[1], cs1[3]};
                        const f32x4 r0 = v0 * c - v1 * s, r1 = v1 * c + v0 * s;
                        u32x2 w0, w1; w0.x = cvt_pk_bf16(r0[0], r0[1]); w0.y = cvt_pk_bf16(r0[2], r0[3]); w1.x = cvt_pk_bf16(r1[0], r1[1]); w1.y = cvt_pk_bf16(r1[2], r1[3]);
                        *(u32x2*)(d2 + off) = w0; *(u32x2*)(d2 + off + 64) = w1; } }
                asm volatile("" ::: "memory"); }
    }
};
}

struct Args {
    const float *x, *c, *w_ada, *b_ada, *norm1_g, *w_in, *b_forget, *fox_q_norm, *fox_k_norm, *nsa_q_norm, *cmp_k_norm, *slc_k_norm, *win_k_norm,
        *cmp_pe_k, *cmp_w1_k, *cmp_w2_k, *cmp_pe_v, *cmp_w1_v, *cmp_w2_v, *w_out, *norm2_g, *w_up, *w_down;
    float* out; unsigned char* ws; int ph_lo, ph_hi;
};

__device__ __forceinline__ int win_src_col(int pg) {
    const int pn = pg >> 8, p = pg & 255;
    if (pn == 22) { if (p < 8) return C_FZ + p; if (p < 32) return C_GZ + p - 8; return -1; }
    const int bj = p >> 7, q = p & 127;
    const int d = 16 * (q >> 5) + 4 * ((q >> 3) & 3) + (q & 3) + 64 * ((q >> 2) & 1);
    int base;
    if (pn < 4) base = C_FQ + pn * 256; else if (pn < 8) base = C_FK + (pn - 4) * 256; else if (pn < 12) base = C_FV + (pn - 8) * 256;
    else if (pn < 16) base = C_NQ + (pn - 12) * 256; else base = C_KC + (pn - 16) * 256;
    return base + bj * 128 + d;
}
template <int SRC>
__device__ __forceinline__ void transpose_item(const float* W, int K, int N, bf16_t* WT, LAS float* scr, int item, int nblk, int lane) {
    const int kb = item / nblk, nb = item % nblk, k0 = 64 * kb, n0 = 32 * nb;
    int sc = n0 + (lane & 31); if (SRC == 1) sc = win_src_col(sc);
#pragma unroll 8
    for (int i = 0; i < 32; ++i) { const int kk = 2 * i + (lane >> 5); scr[kk * 33 + (lane & 31)] = sc >= 0 ? W[(size_t)(k0 + kk) * N + sc] : 0.f; }
    asm volatile("s_waitcnt lgkmcnt(0)" ::: "memory");
    const int cch = lane & 7;
#pragma unroll
    for (int j = 0; j < 4; ++j) { const int n = (lane >> 3) + 8 * j; const LAS float* s = scr + (8 * cch) * 33 + n;
        u32x4 o; o.x = cvt_pk_bf16(s[0 * 33], s[1 * 33]); o.y = cvt_pk_bf16(s[2 * 33], s[3 * 33]); o.z = cvt_pk_bf16(s[4 * 33], s[5 * 33]); o.w = cvt_pk_bf16(s[6 * 33], s[7 * 33]);
        *(u32x4*)(WT + (size_t)(n0 + n) * K + k0 + 8 * cch) = o; }
    asm volatile("s_waitcnt lgkmcnt(0)" ::: "memory");
}

__device__ __forceinline__ void p0_prologue(const Args& a, LAS unsigned char* lds, int wave, int lane, int vcu, int G) {
    const int tid = threadIdx.x;
    LAS float* ca = (LAS float*)lds;
    for (int i = tid; i < 2 * DM; i += NTHR) { const float v = a.c[i]; ca[i] = v / (1.f + __expf(-v)); }
    __syncthreads();
    const int gw = vcu * NWAVES + wave, NGW = G * NWAVES;
    float* modp = (float*)(a.ws + WS_MODP);
    if (wave < 3) { const int it = vcu * 3 + wave;
        if (it < 16 * 48) { const int kc = it / 48, cq = (it % 48) * 64 + lane;
            f32x4 a0 = (f32x4){0.f, 0.f, 0.f, 0.f}, a1 = a0;
            const float* wp = a.w_ada + (size_t)(kc * 128) * (6 * DM) + 4 * cq;
#pragma unroll 16
            for (int k = 0; k < 128; ++k) { const f32x4 w = *(const f32x4*)(wp + (size_t)k * (6 * DM)); a0 += w * ca[kc * 128 + k]; a1 += w * ca[DM + kc * 128 + k]; }
            *(f32x4*)(modp + ((size_t)kc * 2 + 0) * (6 * DM) + 4 * cq) = a0; *(f32x4*)(modp + ((size_t)kc * 2 + 1) * (6 * DM) + 4 * cq) = a1; } }
    LAS float* scr = (LAS float*)(lds + 16384 + wave * 16384);
    constexpr int I_IN = 32 * (NPAD / 32), I_OUT = 32 * 64, I_UP = 32 * 256, I_DN = 128 * 64, I_W1 = 64 * 8, I_W2 = 4 * 4;
    constexpr int NIT = I_IN + I_OUT + I_UP + I_DN + 2 * I_W1 + 2 * I_W2;
    unsigned* qctr = (unsigned*)(a.ws + WS_CTL);
    for (;;) { int it; { unsigned v = 0; if (lane == 0) v = atomicAdd(qctr, 1u); it = __builtin_amdgcn_readfirstlane((int)v); }
        if (it >= NIT) break; int r = it;
        if (r < I_IN) { transpose_item<1>(a.w_in, DM, DIN, (bf16_t*)(a.ws + WS_WIN), scr, r, NPAD / 32, lane); continue; } r -= I_IN;
        if (r < I_OUT) { transpose_item<0>(a.w_out, DM, DM, (bf16_t*)(a.ws + WS_WOUT), scr, r, 64, lane); continue; } r -= I_OUT;
        if (r < I_UP) { transpose_item<0>(a.w_up, DM, DFF, (bf16_t*)(a.ws + WS_WUP), scr, r, 256, lane); continue; } r -= I_UP;
        if (r < I_DN) { transpose_item<0>(a.w_down, DFF, DM, (bf16_t*)(a.ws + WS_WDN), scr, r, 64, lane); continue; } r -= I_DN;
        if (r < I_W1) { transpose_item<0>(a.cmp_w1_k, 4096, 256, (bf16_t*)(a.ws + WS_W1T), scr, r, 8, lane); continue; } r -= I_W1;
        if (r < I_W1) { transpose_item<0>(a.cmp_w1_v, 4096, 256, (bf16_t*)(a.ws + WS_W1T) + 256 * 4096, scr, r, 8, lane); continue; } r -= I_W1;
        if (r < I_W2) { transpose_item<0>(a.cmp_w2_k, 256, 128, (bf16_t*)(a.ws + WS_W2T), scr, r, 4, lane); continue; } r -= I_W2;
        transpose_item<0>(a.cmp_w2_v, 256, 128, (bf16_t*)(a.ws + WS_W2T) + 128 * 256, scr, r, 4, lane);
    }
    float* rope = (float*)(a.ws + WS_ROPE);
    for (int e = (vcu * NTHR + tid); e < T * 64; e += G * NTHR) { const int t = e >> 6, i = e & 63;
        const float inv_freq = (float)pow(10000.0, -(double)i / 64.0); const float ang = (float)t * inv_freq;
        rope[2 * e] = (float)cos((double)ang); rope[2 * e + 1] = (float)sin((double)ang); }
    float* pebp = (float*)(a.ws + WS_PEBP);
    for (int it = gw; it < 2 * 4 * 64; it += NGW) { const int kv = it >> 8, cg_ = (it >> 6) & 3, ch = it & 63, col = cg_ * 64 + lane;
        const float* pe = kv ? a.cmp_pe_v : a.cmp_pe_k; const float* w1 = kv ? a.cmp_w1_v : a.cmp_w1_k; float s = 0.f;
#pragma unroll 8
        for (int i = 0; i < 64; ++i) s += pe[ch * 64 + i] * w1[(size_t)(ch * 64 + i) * 256 + col];
        pebp[((size_t)kv * 64 + ch) * 256 + col] = s; }
}

template <bool FIRST>
__device__ __forceinline__ void norm_phase(const Args& a, LAS unsigned char* lds, const float* xsrc, const float* gain, int shift_off, int scale_off, int wave, int lane, int bid, int G) {
    const int tid = threadIdx.x;
    LAS float* AS = (LAS float*)lds; LAS float* SH = AS + DM;
    const float* modp = (const float*)(a.ws + WS_MODP); float* mod = (float*)(a.ws + WS_MOD);
    const int rows_per = M / G, b = (bid * rows_per) / T;
    for (int d = tid; d < DM; d += NTHR) { float sc, sh;
        if (FIRST) { sc = a.b_ada[scale_off + d]; sh = a.b_ada[shift_off + d];
#pragma unroll
            for (int kc = 0; kc < 16; ++kc) { sc += modp[((size_t)kc * 2 + b) * (6 * DM) + scale_off + d]; sh += modp[((size_t)kc * 2 + b) * (6 * DM) + shift_off + d]; } }
        else { sc = mod[b * 6 * DM + scale_off + d]; sh = mod[b * 6 * DM + shift_off + d]; }
        AS[d] = gain[d] * (1.f + sc); SH[d] = sh; }
    if (FIRST) {
        for (int e = bid * NTHR + tid; e < 2 * 6 * DM; e += G * NTHR) { const int bb = e / (6 * DM), j = e % (6 * DM); float s = a.b_ada[j];
#pragma unroll
            for (int kc = 0; kc < 16; ++kc) s += modp[((size_t)kc * 2 + bb) * (6 * DM) + j];
            mod[e] = s; }
        if (bid == 0) { const float* pebp = (const float*)(a.ws + WS_PEBP); float* peb = (float*)(a.ws + WS_PEB); const int kv = tid >> 8, j = tid & 255; float s = 0.f;
            for (int ch = 0; ch < 64; ++ch) s += pebp[((size_t)kv * 64 + ch) * 256 + j];
            peb[kv * 256 + j] = s; }
    }
    __syncthreads();
    bf16_t* XN = (bf16_t*)(a.ws + WS_XN);
    for (int r = wave; r < rows_per; r += NWAVES) { const int row = bid * rows_per + r;
        const f32x4* xr = (const f32x4*)(xsrc + (size_t)row * DM) + lane;
        f32x4 v[8]; float ss = 0.f;
#pragma unroll
        for (int j = 0; j < 8; ++j) { v[j] = xr[64 * j]; ss += (v[j][0] * v[j][0] + v[j][1] * v[j][1]) + (v[j][2] * v[j][2] + v[j][3] * v[j][3]); }
        const float rstd = 1.0f / sqrtf(wave_sum(ss) * (1.f / DM) + EPS);
        u32x2* o8 = (u32x2*)(XN + (size_t)row * DM) + lane;
#pragma unroll
        for (int j = 0; j < 8; ++j) { const f32x4 as = *(const LAS f32x4*)(AS + 4 * lane + 256 * j), sh = *(const LAS f32x4*)(SH + 4 * lane + 256 * j);
            const f32x4 h = v[j] * rstd * as + sh; u32x2 w; w.x = cvt_pk_bf16(h[0], h[1]); w.y = cvt_pk_bf16(h[2], h[3]); o8[64 * j] = w; }
    }
    __syncthreads();
}

enum { PH_PRO = 0, PH_NORM1 = 1, PH_INPROJ = 2, PH_CMP1 = 3, PH_CMP2 = 4, PH_ATTN = 5, PH_OUTPROJ = 6, PH_NORM2 = 7, PH_UP = 8, PH_DOWN = 9, PH_END = 10 };

__global__ void __launch_bounds__(NTHR, 2) mega_kernel(Args a) {
    extern __shared__ __attribute__((aligned(16))) unsigned char lds_raw[];
    LAS unsigned char* lds = (LAS unsigned char*)lds_raw;
    const int tid = threadIdx.x, lane = tid & 63, wave = __builtin_amdgcn_readfirstlane(tid >> 6);
    const int G = gridDim.x, bid = blockIdx.x;
    const int vcu = (G % 8 == 0) ? (bid % 8) * (G / 8) + bid / 8 : bid;
    cg::grid_group grid = cg::this_grid();
    unsigned char* ws = a.ws;
#ifndef PHMASK
#define PHMASK 0xffff
#endif
#define IN(k) (((PHMASK >> (k)) & 1) && a.ph_lo <= (k) && (k) < a.ph_hi)
#define SEAM(k) do { if (IN(k) && IN((k) + 1)) grid.sync(); } while (0)
    if (IN(PH_PRO)) { p0_prologue(a, lds, wave, lane, vcu, G); } SEAM(PH_PRO);
    if (IN(PH_NORM1)) { norm_phase<true>(a, lds, a.x, a.norm1_g, 0, DM, wave, lane, bid, G); } SEAM(PH_NORM1);
    if (IN(PH_INPROJ)) {
        pg8::StaticOrder S; S.init(M, NPAD, G, bid, ws + WS_XN, ws + WS_WIN, DM, DM);
        pg8::EpiIn E{(bf16_t*)(ws + WS_FQ), (bf16_t*)(ws + WS_FK), (bf16_t*)(ws + WS_FV), (bf16_t*)(ws + WS_NQ), (bf16_t*)(ws + WS_NQR), (bf16_t*)(ws + WS_KC), (bf16_t*)(ws + WS_VC),
                     (bf16_t*)(ws + WS_KSL), (bf16_t*)(ws + WS_VSL), (bf16_t*)(ws + WS_KW), (bf16_t*)(ws + WS_VW), (float*)(ws + WS_LOGF), (float*)(ws + WS_GATES),
                     a.fox_q_norm, a.fox_k_norm, a.nsa_q_norm, a.slc_k_norm, a.win_k_norm, a.b_forget, (const float*)(ws + WS_ROPE), (LAS float*)(lds + LDS_STATS)};
        pg8::gemm_phase(lds, DM, DM, DM, S, E);
    } SEAM(PH_INPROJ);
    SEAM(PH_CMP1); SEAM(PH_CMP2); SEAM(PH_ATTN);
    if (IN(PH_OUTPROJ)) {
        pg8::StaticOrder S; S.init(M, DM, G, bid, ws + WS_AO, ws + WS_WOUT, DM, DM);
        pg8::EpiRes E{a.x, a.out, (const float*)(ws + WS_MOD) + 2 * DM};
        pg8::gemm_phase(lds, DM, DM, DM, S, E);
    } SEAM(PH_OUTPROJ);
    if (IN(PH_NORM2)) { norm_phase<false>(a, lds, a.out, a.norm2_g, 3 * DM, 4 * DM, wave, lane, bid, G); } SEAM(PH_NORM2);
    if (IN(PH_UP)) {
        pg8::StaticOrder S; S.init(M, DFF, G, bid, ws + WS_XN, ws + WS_WUP, DM, DM);
        pg8::EpiUp E{(bf16_t*)(ws + WS_U), DFF};
        pg8::gemm_phase(lds, DM, DM, DM, S, E);
    } SEAM(PH_UP);
    if (IN(PH_DOWN)) {
        pg8::StaticOrder S; S.init(M, DM, G, bid, ws + WS_U, ws + WS_WDN, DFF, DFF);
        pg8::EpiRes E{a.out, a.out, (const float*)(ws + WS_MOD) + 5 * DM};
        pg8::gemm_phase(lds, DFF, DFF, DFF, S, E);
    }
#undef IN
#undef SEAM
}

__global__ void dev_cumsum_kernel(const float* __restrict__ logf, float* __restrict__ cum) {
    const int i = threadIdx.x; if (i >= 16) return; float s = 0.f;
    for (int t = 0; t < T; ++t) { s += logf[(size_t)i * T + t]; cum[(size_t)i * T + t] = s; }
}
template <class F>
__device__ __forceinline__ void attend_wave(const float* qs, float* sc, int nk, F keyfn, int lane, float& o0, float& o1, float* inv_sum_out) {
    float mx = -INFINITY;
    for (int i = lane; i < nk; i += 64) {
        const bf16_t* kp; const bf16_t* vp; float bias; float s = -INFINITY;
        if (keyfn(i, kp, vp, bias)) { float acc = 0.f;
#pragma unroll 4
            for (int d = 0; d < 128; d += 8) { const u32x4 kv = *(const u32x4*)(kp + d);
                acc += __uint_as_float(kv.x << 16) * qs[d] + __uint_as_float(kv.x & 0xffff0000u) * qs[d + 1] + __uint_as_float(kv.y << 16) * qs[d + 2] + __uint_as_float(kv.y & 0xffff0000u) * qs[d + 3]
                     + __uint_as_float(kv.z << 16) * qs[d + 4] + __uint_as_float(kv.z & 0xffff0000u) * qs[d + 5] + __uint_as_float(kv.w << 16) * qs[d + 6] + __uint_as_float(kv.w & 0xffff0000u) * qs[d + 7]; }
            s = acc * SCALE + bias; }
        sc[i] = s; mx = fmaxf(mx, s);
    }
    mx = wave_max(mx); if (mx == -INFINITY) mx = 0.f;
    float sum = 0.f;
    for (int i = lane; i < nk; i += 64) { const float s = sc[i]; const float e = (s == -INFINITY) ? 0.f : expf(s - mx); sc[i] = e; sum += e; }
    sum = wave_sum(sum);
    const float inv = 1.0f / fmaxf(sum, 1e-30f);
    __builtin_amdgcn_s_waitcnt(0);
    float a0 = 0.f, a1 = 0.f;
    for (int i = 0; i < nk; ++i) { const float p = sc[i];
        if (p != 0.f) { const bf16_t* kp; const bf16_t* vp; float bias; keyfn(i, kp, vp, bias); a0 += p * bf2f(vp[lane]); a1 += p * bf2f(vp[64 + lane]); } }
    o0 = a0 * inv; o1 = a1 * inv; *inv_sum_out = inv;
}
__global__ __launch_bounds__(128) void dev_fox_kernel(const bf16_t* __restrict__ FQ, const bf16_t* __restrict__ FK, const bf16_t* __restrict__ FV, const float* __restrict__ cum, bf16_t* __restrict__ AO) {
    __shared__ __attribute__((aligned(16))) float qs[2][128];
    __shared__ float sc[2][T];
    const int wave = threadIdx.x >> 6, lane = threadIdx.x & 63;
    const int gw = blockIdx.x * 2 + wave; const int t = gw % T, bh = gw / T, b = bh / 8, h = bh % 8;
    const bf16_t* qrow = FQ + ((size_t)bh * T + t) * 128;
    qs[wave][lane] = bf2f(qrow[lane]); qs[wave][64 + lane] = bf2f(qrow[64 + lane]);
    const float* cu = cum + (size_t)bh * T; const float ct = cu[t];
    const bf16_t* Kb = FK + (size_t)bh * T * 128; const bf16_t* Vb = FV + (size_t)bh * T * 128;
    float o0, o1, inv;
    attend_wave(qs[wave], sc[wave], t + 1, [&](int i, const bf16_t*& kp, const bf16_t*& vp, float& bias) { kp = Kb + (size_t)i * 128; vp = Vb + (size_t)i * 128; bias = ct - cu[i]; return true; }, lane, o0, o1, &inv);
    bf16_t* orow = AO + (size_t)(b * T + t) * DM + h * 128;
    orow[lane] = (bf16_t)(cvt_pk_bf16(o0, 0.f) & 0xffff); orow[64 + lane] = (bf16_t)(cvt_pk_bf16(o1, 0.f) & 0xffff);
}
__global__ __launch_bounds__(128) void dev_nsa_kernel(const bf16_t* __restrict__ NQ, const bf16_t* __restrict__ NQR, const bf16_t* __restrict__ KCMP, const bf16_t* __restrict__ VCMP,
                                                      const bf16_t* __restrict__ KSL, const bf16_t* __restrict__ VSL, const bf16_t* __restrict__ KW, const bf16_t* __restrict__ VW,
                                                      const float* __restrict__ GATES, bf16_t* __restrict__ AO) {
    __shared__ __attribute__((aligned(16))) float qs[2][128];
    __shared__ float sc[2][1024];
    __shared__ float psum[2][256];
    __shared__ float impv[2][64];
    const int wave = threadIdx.x >> 6, lane = threadIdx.x & 63;
    const int gw = blockIdx.x * 2 + wave; const int g = gw & 1, row = gw >> 1, t = row % T, b = row / T;
    float* ps = psum[wave];
    for (int i = lane; i < 256; i += 64) ps[i] = 0.f;
    float oc[4][2], osl[4][2], ow[4][2];
    const bf16_t* KC = KCMP + (size_t)(b * 2 + g) * 256 * 128; const bf16_t* VC = VCMP + (size_t)(b * 2 + g) * 256 * 128;
#pragma unroll
    for (int hh = 0; hh < 4; ++hh) {
        const bf16_t* qrow = NQ + (((size_t)b * 8 + g * 4 + hh) * T + t) * 128;
        qs[wave][lane] = bf2f(qrow[lane]); qs[wave][64 + lane] = bf2f(qrow[64 + lane]);
        float inv;
        attend_wave(qs[wave], sc[wave], NCMP, [&](int i, const bf16_t*& kp, const bf16_t*& vp, float& bias) { kp = KC + (size_t)i * 128; vp = VC + (size_t)i * 128; bias = 0.f; return (16 * i + 31) <= t; }, lane, oc[hh][0], oc[hh][1], &inv);
        for (int i = lane; i < NCMP; i += 64) ps[i] += sc[wave][i] * inv;
    }
    const int qblk = t / 64;
    { const int j = lane; float im = 0.f;
      for (int n = 4 * j - 1; n <= 4 * j + 3; ++n) { if (n < 0 || n >= NCMP) continue; const int lo = max(16 * n, 64 * j), hi = min(16 * n + 32, 64 * j + 64); const int ov = hi - lo; if (ov > 0) im += ps[n] * ((float)ov / 32.f); }
      const bool forced = (j == 0) || (j == qblk) || (j == qblk - 1); const bool causal = j <= qblk;
      impv[wave][j] = forced ? INFINITY : (causal ? im : -INFINITY); }
    unsigned long long selmask;
    { const int j = lane; const float v = impv[wave][j]; int rank = 0;
      for (int jj = 0; jj < 64; ++jj) { const float u = impv[wave][jj]; rank += (u > v || (u == v && jj < j)) ? 1 : 0; }
      selmask = __ballot(rank < 16 && j <= qblk); }
    const int nsel = __popcll(selmask);
    const bf16_t* KS = KSL + (size_t)(b * 2 + g) * T * 128; const bf16_t* VS = VSL + (size_t)(b * 2 + g) * T * 128;
    const bf16_t* KWp = KW + (size_t)(b * 2 + g) * T * 128; const bf16_t* VWp = VW + (size_t)(b * 2 + g) * T * 128;
#pragma unroll
    for (int hh = 0; hh < 4; ++hh) {
        const bf16_t* qrow = NQR + (((size_t)b * 8 + g * 4 + hh) * T + t) * 128;
        qs[wave][lane] = bf2f(qrow[lane]); qs[wave][64 + lane] = bf2f(qrow[64 + lane]);
        float inv;
        attend_wave(qs[wave], sc[wave], nsel * 64, [&](int i, const bf16_t*& kp, const bf16_t*& vp, float& bias) {
            int bi = i >> 6; unsigned long long mm = selmask; for (int z = 0; z < bi; ++z) mm &= mm - 1; const int blk = __ffsll((long long)mm) - 1;
            const int kpos = blk * 64 + (i & 63); kp = KS + (size_t)kpos * 128; vp = VS + (size_t)kpos * 128; bias = 0.f; return kpos <= t; }, lane, osl[hh][0], osl[hh][1], &inv);
        const int w0 = max(0, t - 511);
        attend_wave(qs[wave], sc[wave], t - w0 + 1, [&](int i, const bf16_t*& kp, const bf16_t*& vp, float& bias) { const int kpos = w0 + i; kp = KWp + (size_t)kpos * 128; vp = VWp + (size_t)kpos * 128; bias = 0.f; return true; }, lane, ow[hh][0], ow[hh][1], &inv);
    }
#pragma unroll
    for (int hh = 0; hh < 4; ++hh) { const int head = g * 4 + hh; const float* gp = GATES + (size_t)row * 24 + head * 3; const float g0 = gp[0], g1 = gp[1], g2 = gp[2];
        bf16_t* orow = AO + (size_t)row * DM + 1024 + head * 128;
        orow[lane] = (bf16_t)(cvt_pk_bf16(g0 * oc[hh][0] + g1 * osl[hh][0] + g2 * ow[hh][0], 0.f) & 0xffff);
        orow[64 + lane] = (bf16_t)(cvt_pk_bf16(g0 * oc[hh][1] + g1 * osl[hh][1] + g2 * ow[hh][1], 0.f) & 0xffff); }
}
__global__ __launch_bounds__(256) void dev_build_xb_kernel(const bf16_t* __restrict__ src, const float* __restrict__ pe, float* __restrict__ xb) {
    const int r = blockIdx.x, n = r % NCMP, bg = r / NCMP;
    for (int i = threadIdx.x; i < 4096; i += 256) xb[(size_t)r * 4096 + i] = bf2f(src[((size_t)bg * T + 16 * n) * 128 + i]) + pe[i];
}
template <int EPI>
__global__ __launch_bounds__(256) void dev_gemm_f32(const float* __restrict__ A, int lda, const float* __restrict__ B, int ldb, float* __restrict__ C, int ldc, int Mr, int N, int K) {
    __shared__ float As[16][68]; __shared__ float Bs[16][68];
    const int tid = threadIdx.x, tx = tid & 15, ty = tid >> 4; const int m0 = blockIdx.y * 64, n0 = blockIdx.x * 64;
    float acc[4][4] = {}; const int ar = tid >> 2, ak = (tid & 3) * 4; const int bk = tid >> 4, bn = (tid & 15) * 4;
    for (int k0 = 0; k0 < K; k0 += 16) {
        float4 av = make_float4(0.f, 0.f, 0.f, 0.f), bv = make_float4(0.f, 0.f, 0.f, 0.f);
        if (m0 + ar < Mr) av = *(const float4*)(A + (size_t)(m0 + ar) * lda + k0 + ak);
        if (n0 + bn < N) bv = *(const float4*)(B + (size_t)(k0 + bk) * ldb + n0 + bn);
        __syncthreads();
        As[ak + 0][ar] = av.x; As[ak + 1][ar] = av.y; As[ak + 2][ar] = av.z; As[ak + 3][ar] = av.w; *(float4*)&Bs[bk][bn] = bv;
        __syncthreads();
#pragma unroll
        for (int k = 0; k < 16; ++k) { const float4 a4 = *(const float4*)&As[k][ty * 4]; const float4 b4 = *(const float4*)&Bs[k][tx * 4];
            const float aa[4] = {a4.x, a4.y, a4.z, a4.w}, bb[4] = {b4.x, b4.y, b4.z, b4.w};
#pragma unroll
            for (int i = 0; i < 4; ++i)
#pragma unroll
                for (int j = 0; j < 4; ++j) acc[i][j] += aa[i] * bb[j]; }
    }
#pragma unroll
    for (int i = 0; i < 4; ++i) { const int m = m0 + ty * 4 + i; if (m >= Mr) continue;
#pragma unroll
        for (int j = 0; j < 4; ++j) { const int n = n0 + tx * 4 + j; if (n >= N) continue; float v = acc[i][j]; if (EPI == 2) v = v / (1.f + expf(-v)); C[(size_t)m * ldc + n] = v; } }
}
__global__ __launch_bounds__(64) void dev_cmp_out_kernel(const float* __restrict__ kc, const float* __restrict__ g, bf16_t* __restrict__ dst) {
    const int r = blockIdx.x, n = r & 255, bg = r >> 8, lane = threadIdx.x; bf16_t* o = dst + (size_t)r * 128;
    if (n == 255) { o[lane] = 0; o[64 + lane] = 0; return; }
    const float* p = kc + ((size_t)bg * NCMP + n) * 128; float v0 = p[lane], v1 = p[64 + lane];
    if (g) { const float ss = wave_sum(v0 * v0 + v1 * v1); const float rstd = 1.0f / sqrtf(ss / 128.f + EPS); v0 = v0 * rstd * g[lane]; v1 = v1 * rstd * g[64 + lane]; }
    o[lane] = (bf16_t)(cvt_pk_bf16(v0, 0.f) & 0xffff); o[64 + lane] = (bf16_t)(cvt_pk_bf16(v1, 0.f) & 0xffff);
}

static void launch_phases(const Args& a0, int lo, int hi, int grid, hipStream_t stream) {
    Args a = a0; a.ph_lo = lo; a.ph_hi = hi; void* args[] = {&a};
    hipError_t e = hipLaunchCooperativeKernel((void*)mega_kernel, dim3(grid), dim3(NTHR), args, LDS_BYTES, stream);
    if (e != hipSuccess) fprintf(stderr, "cooperative launch failed: %s (grid %d)\n", hipGetErrorString(e), grid);
}

extern "C" void kernel_launch(void* const* d_in, const int* in_sizes, int n_in, void* d_out, int out_size, void* d_ws, size_t ws_size, hipStream_t stream) {
    static int grid = 0;
    if (grid == 0) {
        int dev = 0, cus = 0, per_cu = 0; hipGetDevice(&dev); hipDeviceGetAttribute(&cus, hipDeviceAttributeMultiprocessorCount, dev);
        hipFuncSetAttribute((const void*)mega_kernel, hipFuncAttributeMaxDynamicSharedMemorySize, LDS_BYTES);
        hipOccupancyMaxActiveBlocksPerMultiprocessor(&per_cu, (const void*)mega_kernel, NTHR, LDS_BYTES);
        if (per_cu < 1) { fprintf(stderr, "occupancy query says %d blocks/CU\n", per_cu); per_cu = 1; }
        grid = cus;
        if (ws_size < WS_END + 24 * MiB) fprintf(stderr, "workspace too small: %zu\n", ws_size);
    }
    hipMemsetAsync((char*)d_ws + WS_CTL, 0, 4096, stream);
    Args a{};
    const float** ap = (const float**)&a;
    for (int i = 0; i < 23; ++i) ap[i] = (const float*)d_in[i];
    a.out = (float*)d_out; a.ws = (unsigned char*)d_ws;
    unsigned char* ws = a.ws;
    launch_phases(a, PH_PRO, PH_INPROJ + 1, grid, stream);
    float* xb = (float*)(ws + WS_DEV_XB); float* hid = (float*)(ws + WS_DEV_HID); float* kc = (float*)(ws + WS_DEV_KC); float* cum = (float*)(ws + WS_DEV_CUM);
    for (int kv = 0; kv < 2; ++kv) {
        dev_build_xb_kernel<<<4 * NCMP, 256, 0, stream>>>((const bf16_t*)(ws + (kv ? WS_VC : WS_KC)), kv ? a.cmp_pe_v : a.cmp_pe_k, xb);
        dev_gemm_f32<2><<<dim3(4, 16), 256, 0, stream>>>(xb, 4096, kv ? a.cmp_w1_v : a.cmp_w1_k, 256, hid, 256, 4 * NCMP, 256, 4096);
        dev_gemm_f32<0><<<dim3(2, 16), 256, 0, stream>>>(hid, 256, kv ? a.cmp_w2_v : a.cmp_w2_k, 128, kc, 128, 4 * NCMP, 128, 256);
        dev_cmp_out_kernel<<<1024, 64, 0, stream>>>(kc, kv ? nullptr : a.cmp_k_norm, (bf16_t*)(ws + (kv ? WS_VCMP : WS_KCMP)));
    }
    dev_cumsum_kernel<<<1, 64, 0, stream>>>((const float*)(ws + WS_LOGF), cum);
    dev_fox_kernel<<<NB * 8 * T / 2, 128, 0, stream>>>((const bf16_t*)(ws + WS_FQ), (const bf16_t*)(ws + WS_FK), (const bf16_t*)(ws + WS_FV), cum, (bf16_t*)(ws + WS_AO));
    dev_nsa_kernel<<<M, 128, 0, stream>>>((const bf16_t*)(ws + WS_NQ), (const bf16_t*)(ws + WS_NQR), (const bf16_t*)(ws + WS_KCMP), (const bf16_t*)(ws + WS_VCMP),
                                           (const bf16_t*)(ws + WS_KSL), (const bf16_t*)(ws + WS_VSL), (const bf16_t*)(ws + WS_KW), (const bf16_t*)(ws + WS_VW), (const float*)(ws + WS_GATES), (bf16_t*)(ws + WS_AO));
    launch_phases(a, PH_OUTPROJ, PH_END, grid, stream);
}
```

```cpp
#include <hip/hip_runtime.h>
#include <hip/hip_cooperative_groups.h>
#include <stdint.h>
#include <math.h>
#include <cstdio>
namespace cg = cooperative_groups;

constexpr int DM = 2048, NB = 2, T = 4096, M = NB * T, HD = 128;
constexpr int DIN = 5664, DFF = 8192, NPAD = 5888;
constexpr int C_FQ = 0, C_FK = 1024, C_FV = 2048, C_FZ = 3072, C_NQ = 3080, C_KC = 4104, C_VC = 4360, C_KSL = 4616, C_VSL = 4872,
              C_KW = 5128, C_VW = 5384, C_GZ = 5640;
constexpr int NCMP = 255;
constexpr float SCALE = 0.08838834764831845f;
constexpr float EPS = 1e-6f;
constexpr int NWAVES = 8, NTHR = 512;

constexpr size_t MiB = 1u << 20;
constexpr size_t WS_CTL = 0;
constexpr size_t WS_MODP = 256 * 1024;
constexpr size_t WS_MOD = 2 * MiB;
constexpr size_t WS_ROPE = 3 * MiB;
constexpr size_t WS_PEBP = 5 * MiB;
constexpr size_t WS_PEB = 5 * MiB + 256 * 1024;
constexpr size_t WS_LOGF = 5 * MiB + 320 * 1024;
constexpr size_t WS_KBIAS = 5 * MiB + 640 * 1024;
constexpr size_t WS_GATES = 6 * MiB;
constexpr size_t WS_W2T = 7 * MiB;
constexpr size_t WS_W1T = 8 * MiB;
constexpr size_t WS_WIN = 12 * MiB;
constexpr size_t WS_WOUT = 36 * MiB;
constexpr size_t WS_WUP = 44 * MiB;
constexpr size_t WS_WDN = 76 * MiB;
constexpr size_t WS_XN = 108 * MiB;
constexpr size_t WS_FQ = 140 * MiB, WS_FK = 156 * MiB, WS_FV = 172 * MiB, WS_NQ = 188 * MiB, WS_NQR = 204 * MiB;
constexpr size_t WS_KC = 220 * MiB, WS_VC = 224 * MiB, WS_KSL = 228 * MiB, WS_VSL = 232 * MiB, WS_KW = 236 * MiB, WS_VW = 240 * MiB;
constexpr size_t WS_KCMP = 244 * MiB, WS_VCMP = 244 * MiB + 512 * 1024;
constexpr size_t WS_PART = 245 * MiB;
constexpr size_t WS_NSAO = 277 * MiB;
constexpr size_t WS_AO = 309 * MiB;
constexpr size_t WS_U = 140 * MiB;
constexpr size_t WS_END = 341 * MiB;
constexpr size_t WS_DEV_CUM = 341 * MiB;
constexpr size_t WS_DEV_XB = 342 * MiB;
constexpr size_t WS_DEV_HID = 358 * MiB;
constexpr size_t WS_DEV_KC = 360 * MiB;

constexpr int LDS_STATS = 131072;
constexpr int LDS_BYTES = 155648;

#define LAS __attribute__((address_space(3)))
typedef unsigned short bf16_t;
typedef short bf16x8 __attribute__((ext_vector_type(8)));
typedef float f32x4 __attribute__((ext_vector_type(4)));
typedef float f32x2 __attribute__((ext_vector_type(2)));
typedef unsigned u32x4 __attribute__((ext_vector_type(4)));
typedef unsigned u32x2 __attribute__((ext_vector_type(2)));

typedef __bf16 bf16x2_t __attribute__((ext_vector_type(2)));
__device__ __forceinline__ unsigned cvt_pk_bf16(float lo, float hi) { f32x2 v = {lo, hi}; bf16x2_t b = __builtin_convertvector(v, bf16x2_t); return __builtin_bit_cast(unsigned, b); }
__device__ __forceinline__ float bf2f(bf16_t v) { return __uint_as_float(((unsigned)v) << 16); }
__device__ __forceinline__ float wave_sum(float v) {
#pragma unroll
    for (int o = 1; o < 64; o <<= 1) v += __shfl_xor(v, o);
    return v;
}
__device__ __forceinline__ float wave_max(float v) {
#pragma unroll
    for (int o = 1; o < 64; o <<= 1) v = fmaxf(v, __shfl_xor(v, o));
    return v;
}

namespace pg8 {
constexpr int BM = 256, BK = 64, HALF = 128, HTB = HALF * BK * 2, STAGE_BYTES = 8 * HTB, NXCD = 8, WGM = 8;
__host__ __device__ __forceinline__ int lds_byte(int r, int c) { const int st = (r >> 4) * 2 + (c >> 5), rr = r & 15, cc = c & 31, ob = rr * 64 + cc * 2; return st * 1024 + (ob ^ (((ob >> 9) & 1) << 5)); }
__host__ __device__ __forceinline__ void stage_rc(int b, int& R, int& C) { const int st = b / 1024, sb = b % 1024, swz = sb ^ (((sb >> 9) & 1) << 5); R = (st >> 1) * 16 + swz / 64; C = (st & 1) * 32 + (swz % 64) / 2; }
__host__ __device__ __forceinline__ int perm32(int rho) { const int n = rho >> 4, i = rho & 15; return 8 * (i >> 2) + 4 * n + (i & 3); }

struct Unit { int pm, pn, aux; };

struct StaticOrder {
    int nM, nN, nwg, G, c; const char* A; const char* Bt; size_t tsA, tsB;
    __device__ void init(int M_, int N_, int G_, int c_, const void* A_, const void* Bt_, int lda, int ldb) { nM = M_ / BM; nN = N_ / BM; nwg = nM * nN; G = G_; c = c_; A = (const char*)A_; Bt = (const char*)Bt_; tsA = (size_t)BM * lda * 2; tsB = (size_t)BM * ldb * 2; }
    __device__ bool next(int i, Unit& u) const {
        const long L = (long)i * G + c; if (L >= nwg) return false;
        int wgid = (int)L; { const int q = nwg / NXCD, r = nwg % NXCD, xcd = wgid % NXCD, off = wgid / NXCD; wgid = (xcd < r ? xcd * (q + 1) : r * (q + 1) + (xcd - r) * q) + off; }
        const int nig = WGM * nN, gid = wgid / nig, fm = gid * WGM, gsz = (nM - fm) < WGM ? (nM - fm) : WGM;
        u.pm = fm + ((wgid % nig) % gsz); u.pn = (wgid % nig) / gsz; u.aux = 0; return true;
    }
    __device__ __forceinline__ void ptrs(const Unit& u, const char*& a, const char*& b) const { a = A + (size_t)u.pm * tsA; b = Bt + (size_t)u.pn * tsB; }
};

template <class Epi, class Sched>
__device__ __forceinline__ void gemm_phase(LAS unsigned char* lds, const int lda, const int ldb, const int K, const Sched& S, const Epi& E) {
    int tid = threadIdx.x; asm volatile("" : "+v"(tid));
    const int wid = __builtin_amdgcn_readfirstlane(tid >> 6), lane = tid & 63, wr = wid >> 2, wc = wid & 3, fr = lane & 15, fq = lane >> 4;
    const int nt = K / BK;
    unsigned voffA[2], voffB[2];
#pragma unroll
    for (int i = 0; i < 2; ++i) { int R, C; stage_rc(tid * 16 + i * 8192, R, C); const int Rb = Epi::PERM ? ((R & ~31) + perm32(R & 31)) : R;
        voffA[i] = (unsigned)(R * lda + C) * 2u; voffB[i] = (unsigned)(Rb * ldb + C) * 2u; }
    const size_t kstep = (size_t)(BK * 2);
    const size_t hsA = (size_t)HALF * lda * 2, hsB = (size_t)HALF * ldb * 2;
    const unsigned ldsw = (unsigned)wid * 1024u;
    const int aoff = lds_byte(wr * 64 + fr, fq * 8), boff = lds_byte(wc * 32 + fr, fq * 8);
#define PG8_SA(b, h) (((b) * 2 + (h)) * HTB)
#define PG8_SB(b, h) ((4 + (b) * 2 + (h)) * HTB)
#define PG8_STAGE(bufoff, gbase, voff) do { _Pragma("unroll") for (int _i = 0; _i < 2; ++_i) \
        __builtin_amdgcn_global_load_lds((const unsigned*)((const char*)(gbase) + (voff)[_i]), (LAS unsigned*)(lds + (bufoff) + ldsw + _i * 8192), 16, 0, 0); } while (0)
#define PG8_LDA(dst, b, h) do { _Pragma("unroll") for (int m = 0; m < 4; ++m) _Pragma("unroll") for (int k = 0; k < 2; ++k) dst[m][k] = *(const LAS bf16x8*)(lds + PG8_SA(b, h) + aoff + m * 2048 + k * 1024); } while (0)
#define PG8_LDB(dst, b, h) do { _Pragma("unroll") for (int n = 0; n < 2; ++n) _Pragma("unroll") for (int k = 0; k < 2; ++k) dst[n][k] = *(const LAS bf16x8*)(lds + PG8_SB(b, h) + boff + n * 2048 + k * 1024); } while (0)
#define PG8_MMA(ai, bj, At, Bt) do { __builtin_amdgcn_s_setprio(1); _Pragma("unroll") for (int m = 0; m < 4; ++m) _Pragma("unroll") for (int n = 0; n < 2; ++n) _Pragma("unroll") for (int k = 0; k < 2; ++k) \
        acc[ai][bj][m][n] = __builtin_amdgcn_mfma_f32_16x16x32_bf16(Bt[n][k], At[m][k], acc[ai][bj][m][n], 0, 0, 0); __builtin_amdgcn_s_setprio(0); } while (0)
#define PG8_WAIT_V(n) asm volatile("s_waitcnt vmcnt(" #n ")" ::: "memory")
#define PG8_WAIT_L(n) asm volatile("s_waitcnt lgkmcnt(" #n ")" ::: "memory")
#define PG8_BAR __builtin_amdgcn_s_barrier()
#define PG8_SCHED __builtin_amdgcn_sched_barrier(0)
    Unit cur, nxt; int ui = 0;
    if (!S.next(0, cur)) return;
    f32x4 acc[2][2][4][2];
#pragma unroll
    for (int a = 0; a < 2; ++a)
#pragma unroll
        for (int b = 0; b < 2; ++b)
#pragma unroll
            for (int m = 0; m < 4; ++m)
#pragma unroll
                for (int n = 0; n < 2; ++n) acc[a][b][m][n] = (f32x4){0.f, 0.f, 0.f, 0.f};
    bf16x8 At[4][2], B0[2][2], B1[2][2];
    const char* cA; const char* cB; S.ptrs(cur, cA, cB);
    PG8_STAGE(PG8_SB(0, 0), cB, voffB); PG8_STAGE(PG8_SB(0, 1), cB + hsB, voffB); PG8_STAGE(PG8_SA(0, 0), cA, voffA); PG8_STAGE(PG8_SA(0, 1), cA + hsA, voffA);
    if (wr == 1) PG8_BAR;
    PG8_WAIT_V(2); PG8_BAR;
    PG8_STAGE(PG8_SB(1, 0), cB + kstep, voffB); PG8_STAGE(PG8_SA(1, 0), cA + kstep, voffA); PG8_STAGE(PG8_SB(1, 1), cB + hsB + kstep, voffB);
    PG8_WAIT_V(6); PG8_BAR;
    for (;;) {
        const bool has_next = S.next(ui + 1, nxt);
        const char* nA = cA; const char* nB = cB; if (has_next) S.ptrs(nxt, nA, nB);
#pragma nounroll
        for (int t = 0; t < nt; t += 2) {
            const bool last = (t == nt - 2);
            const char* a1 = cA + (size_t)(t + 1) * kstep;
            const char* a2 = last ? nA : cA + (size_t)(t + 2) * kstep; const char* b2 = last ? nB : cB + (size_t)(t + 2) * kstep;
            const char* a3 = a2 + kstep; const char* b3 = b2 + kstep;
            PG8_LDB(B0, 0, 0); PG8_LDB(B1, 0, 1); PG8_SCHED; PG8_LDA(At, 0, 0); PG8_STAGE(PG8_SA(1, 1), a1 + hsA, voffA);
            PG8_WAIT_V(8); PG8_WAIT_L(0); PG8_BAR; PG8_MMA(0, 0, At, B0); PG8_MMA(0, 1, At, B1); PG8_BAR; PG8_SCHED;
            PG8_LDA(At, 0, 1); PG8_STAGE(PG8_SB(0, 0), b2, voffB); PG8_STAGE(PG8_SB(0, 1), b2 + hsB, voffB); PG8_STAGE(PG8_SA(0, 0), a2, voffA);
            PG8_WAIT_V(8); PG8_WAIT_L(0); PG8_BAR; PG8_MMA(1, 0, At, B0); PG8_MMA(1, 1, At, B1); PG8_BAR; PG8_SCHED;
            PG8_LDB(B0, 1, 0); PG8_LDB(B1, 1, 1); PG8_SCHED; PG8_LDA(At, 1, 0); PG8_STAGE(PG8_SA(0, 1), a2 + hsA, voffA);
            PG8_WAIT_V(8); PG8_WAIT_L(0); PG8_BAR; PG8_MMA(0, 0, At, B0); PG8_MMA(0, 1, At, B1); PG8_BAR; PG8_SCHED;
            PG8_LDA(At, 1, 1); PG8_STAGE(PG8_SB(1, 0), b3, voffB); PG8_STAGE(PG8_SB(1, 1), b3 + hsB, voffB); PG8_STAGE(PG8_SA(1, 0), a3, voffA);
            PG8_WAIT_V(8); PG8_WAIT_L(0); PG8_BAR; PG8_MMA(1, 0, At, B0); PG8_MMA(1, 1, At, B1); PG8_BAR; PG8_SCHED;
        }
        if (wr == 0) PG8_BAR;
        E(acc, cur, wr, wc, fr, fq);
        if (!has_next) break;
#pragma unroll
        for (int a = 0; a < 2; ++a)
#pragma unroll
            for (int b = 0; b < 2; ++b)
#pragma unroll
                for (int m = 0; m < 4; ++m)
#pragma unroll
                    for (int n = 0; n < 2; ++n) acc[a][b][m][n] = (f32x4){0.f, 0.f, 0.f, 0.f};
        cur = nxt; cA = nA; cB = nB; ++ui;
        if (wr == 1) PG8_BAR;
    }
    PG8_WAIT_V(0);
    PG8_BAR;
#undef PG8_SA
#undef PG8_SB
#undef PG8_STAGE
#undef PG8_LDA
#undef PG8_LDB
#undef PG8_MMA
#undef PG8_WAIT_V
#undef PG8_WAIT_L
#undef PG8_BAR
#undef PG8_SCHED
}


struct EpiRes {
    static constexpr bool PERM = true;
    const float* base; float* out; const float* gate;
    __device__ __forceinline__ void operator()(const f32x4 (&acc)[2][2][4][2], const Unit& u, int wr, int wc, int fr, int fq) const {
        const int row0 = u.pm * BM + wr * 64 + fr, col0 = u.pn * BM + wc * 32 + 8 * fq;
        const int b = (u.pm * BM) / T;
        f32x4 gv[2][2];
#pragma unroll
        for (int bj = 0; bj < 2; ++bj)
#pragma unroll
            for (int n = 0; n < 2; ++n) gv[bj][n] = *(const f32x4*)(gate + (size_t)b * 6 * DM + col0 + bj * HALF + 4 * n);
#pragma unroll
        for (int ai = 0; ai < 2; ++ai)
#pragma unroll
            for (int m = 0; m < 4; ++m) { const size_t off = (size_t)(row0 + ai * HALF + m * 16) * DM + col0;
#pragma unroll
                for (int bj = 0; bj < 2; ++bj)
#pragma unroll
                    for (int n = 0; n < 2; ++n) { const f32x4 bs = *(const f32x4*)(base + off + bj * HALF + 4 * n);
                        *(f32x4*)(out + off + bj * HALF + 4 * n) = bs + gv[bj][n] * acc[ai][bj][m][n]; } }
    }
};
struct EpiUp {
    static constexpr bool PERM = true;
    bf16_t* O; int ldc;
    __device__ __forceinline__ void operator()(const f32x4 (&acc)[2][2][4][2], const Unit& u, int wr, int wc, int fr, int fq) const {
        const int row0 = u.pm * BM + wr * 64 + fr, col0 = u.pn * BM + wc * 32 + 8 * fq;
#pragma unroll
        for (int ai = 0; ai < 2; ++ai)
#pragma unroll
            for (int m = 0; m < 4; ++m) { bf16_t* rowp = O + (size_t)(row0 + ai * HALF + m * 16) * ldc + col0;
#pragma unroll
                for (int bj = 0; bj < 2; ++bj) { f32x4 v0 = acc[ai][bj][m][0], v1 = acc[ai][bj][m][1];
                    v0 = __builtin_elementwise_max(v0, (f32x4){0.f, 0.f, 0.f, 0.f}); v1 = __builtin_elementwise_max(v1, (f32x4){0.f, 0.f, 0.f, 0.f}); v0 = v0 * v0; v1 = v1 * v1;
                    u32x4 w; w.x = cvt_pk_bf16(v0[0], v0[1]); w.y = cvt_pk_bf16(v0[2], v0[3]); w.z = cvt_pk_bf16(v1[0], v1[1]); w.w = cvt_pk_bf16(v1[2], v1[3]);
                    *(u32x4*)(rowp + bj * HALF) = w; } }
    }
};
struct EpiIn {
    static constexpr bool PERM = true;
    bf16_t *FQ, *FK, *FV, *NQ, *NQR, *KC, *VC, *KSL, *VSL, *KW, *VW; float* LOGF; float* GATES;
    const float *g_fq, *g_fk, *g_nq, *g_slc, *g_win, *b_forget; const float* rope; LAS float* stats;
    __device__ __forceinline__ void operator()(const f32x4 (&acc)[2][2][4][2], const Unit& u, int wr, int wc, int fr, int fq) const {
        const int pn = u.pn;
        const int b = u.pm >> 4, t0 = (u.pm & 15) * BM + wr * 64 + fr;
        if (pn == 22) {
            if (wc == 0) {
#pragma unroll
                for (int ai = 0; ai < 2; ++ai)
#pragma unroll
                    for (int m = 0; m < 4; ++m) { const int t = t0 + ai * HALF + m * 16;
#pragma unroll
                        for (int n = 0; n < 2; ++n)
#pragma unroll
                            for (int e = 0; e < 4; ++e) { const int p = 8 * fq + 4 * n + e; const float v = acc[ai][0][m][n][e];
                                if (p < 8) { const float z = v + b_forget[p]; LOGF[((size_t)b * 8 + p) * T + t] = fminf(z, 0.f) - log1pf(__expf(-fabsf(z))); }
                                else { GATES[((size_t)b * T + t) * 24 + (p - 8)] = 1.f / (1.f + __expf(-v)); } } }
            }
            return;
        }
        bf16_t* d1 = nullptr; bf16_t* d2 = nullptr; const float* gain = nullptr; int nh = 8, h0 = 0;
        if (pn < 4) { d1 = FQ; gain = g_fq; h0 = 2 * pn; }
        else if (pn < 8) { d1 = FK; gain = g_fk; h0 = 2 * (pn - 4); }
        else if (pn < 12) { d1 = FV; h0 = 2 * (pn - 8); }
        else if (pn < 16) { d1 = NQ; d2 = NQR; gain = g_nq; h0 = 2 * (pn - 12); }
        else { nh = 2; h0 = 0;
            if (pn == 16) d1 = KC; else if (pn == 17) d1 = VC; else if (pn == 18) { d2 = KSL; gain = g_slc; } else if (pn == 19) d1 = VSL;
            else if (pn == 20) { d2 = KW; gain = g_win; } else d1 = VW; }
        const int dlo = 16 * wc + 4 * fq;
        f32x4 g0 = (f32x4){1.f, 1.f, 1.f, 1.f}, g1 = g0;
        if (gain) {
#pragma unroll
            for (int ai = 0; ai < 2; ++ai)
#pragma unroll
                for (int m = 0; m < 4; ++m)
#pragma unroll
                    for (int bj = 0; bj < 2; ++bj) { const f32x4 a = acc[ai][bj][m][0], c = acc[ai][bj][m][1];
                        float s = (a[0] * a[0] + a[1] * a[1]) + (a[2] * a[2] + a[3] * a[3]) + (c[0] * c[0] + c[1] * c[1]) + (c[2] * c[2] + c[3] * c[3]);
                        s += __shfl_xor(s, 16); s += __shfl_xor(s, 32);
                        if (fq == 0) stats[(ai * HALF + wr * 64 + m * 16 + fr) * 8 + bj * 4 + wc] = s; }
            asm volatile("s_waitcnt lgkmcnt(0)" ::: "memory"); __builtin_amdgcn_s_barrier(); asm volatile("" ::: "memory");
            g0 = *(const f32x4*)(gain + dlo); g1 = *(const f32x4*)(gain + 64 + dlo);
        }
#pragma unroll
        for (int ai = 0; ai < 2; ++ai)
#pragma unroll
            for (int m = 0; m < 4; ++m) { const int t = t0 + ai * HALF + m * 16;
                f32x4 cs0 = (f32x4){0.f, 0.f, 0.f, 0.f}, cs1 = cs0;
                if (d2) { const float* rp = rope + ((size_t)t * 64 + dlo) * 2; cs0 = *(const f32x4*)rp; cs1 = *(const f32x4*)(rp + 4); }
                float rsv[2] = {1.f, 1.f};
                if (gain) {
#pragma unroll
                    for (int bj = 0; bj < 2; ++bj) { const f32x4 q = *(const LAS f32x4*)(stats + (ai * HALF + wr * 64 + m * 16 + fr) * 8 + bj * 4);
                        rsv[bj] = 1.0f / sqrtf(((q[0] + q[1]) + (q[2] + q[3])) * (1.f / 128.f) + EPS); } }
#pragma unroll
                for (int bj = 0; bj < 2; ++bj) { f32x4 v0 = acc[ai][bj][m][0], v1 = acc[ai][bj][m][1];
                    if (gain) { const float r = rsv[bj]; v0 = v0 * r * g0; v1 = v1 * r * g1; }
                    const size_t off = (((size_t)b * nh + h0 + bj) * T + t) * 128 + dlo;
                    if (d1) { u32x2 w0, w1; w0.x = cvt_pk_bf16(v0[0], v0[1]); w0.y = cvt_pk_bf16(v0[2], v0[3]); w1.x = cvt_pk_bf16(v1[0], v1[1]); w1.y = cvt_pk_bf16(v1[2], v1[3]);
                        *(u32x2*)(d1 + off) = w0; *(u32x2*)(d1 + off + 64) = w1; }
                    if (d2) { const f32x4 c = (f32x4){cs0[0], cs0[2], cs1[0], cs1[2]}, s = (f32x4){cs0[1], cs0[3], cs1[1], cs1[3]};
                        const f32x4 r0 = v0 * c - v1 * s, r1 = v1 * c + v0 * s;
                        u32x2 w0, w1; w0.x = cvt_pk_bf16(r0[0], r0[1]); w0.y = cvt_pk_bf16(r0[2], r0[3]); w1.x = cvt_pk_bf16(r1[0], r1[1]); w1.y = cvt_pk_bf16(r1[2], r1[3]);
                        *(u32x2*)(d2 + off) = w0; *(u32x2*)(d2 + off + 64) = w1; } }
                asm volatile("" ::: "memory"); }
    }
};

struct EpiPart {
    static constexpr bool PERM = true;
    float* P;
    __device__ __forceinline__ void operator()(const f32x4 (&acc)[2][2][4][2], const Unit& u, int wr, int wc, int fr, int fq) const {
        float* base = P + (size_t)u.aux * 65536 + (size_t)(wr * 64 + fr) * 256 + wc * 32 + 8 * fq;
#pragma unroll
        for (int ai = 0; ai < 2; ++ai)
#pragma unroll
            for (int m = 0; m < 4; ++m) { float* rp = base + (size_t)(ai * HALF + m * 16) * 256;
#pragma unroll
                for (int bj = 0; bj < 2; ++bj)
#pragma unroll
                    for (int n = 0; n < 2; ++n) *(f32x4*)(rp + bj * HALF + 4 * n) = acc[ai][bj][m][n];
                asm volatile("" ::: "memory"); }
    }
};
struct CmpOrder {
    int G, c; const char* KC; const char* VC; const char* W1T;
    __device__ bool next(int i, Unit& u) const { const int L = i * G + c; if (L >= 128) return false; u.pm = 0; u.pn = 0; u.aux = L; return true; }
    __device__ __forceinline__ void ptrs(const Unit& u, const char*& a, const char*& b) const { const int L = u.aux, kv = L >> 6, bg = (L >> 4) & 3, ks = L & 15;
        a = (kv ? VC : KC) + ((size_t)bg * T * 128 + ks * 256) * 2; b = W1T + ((size_t)kv * 256 * 4096 + ks * 256) * 2; }
};
}


struct Args {
    const float *x, *c, *w_ada, *b_ada, *norm1_g, *w_in, *b_forget, *fox_q_norm, *fox_k_norm, *nsa_q_norm, *cmp_k_norm, *slc_k_norm, *win_k_norm,
        *cmp_pe_k, *cmp_w1_k, *cmp_w2_k, *cmp_pe_v, *cmp_w1_v, *cmp_w2_v, *w_out, *norm2_g, *w_up, *w_down;
    float* out; unsigned char* ws; int ph_lo, ph_hi;
};

#ifndef DEV_ATT
#define DEV_ATT 3
#endif
namespace att {
typedef float f32x16 __attribute__((ext_vector_type(16)));
typedef short s16x4 __attribute__((ext_vector_type(4)));
constexpr int NW = 8, QBLK = 32, KVBLK = 64, D = 128;
constexpr int SHM_V = KVBLK * D * 2, SHM_K = KVBLK * D * 2;
constexpr int L_V = 0, L_K = 2 * SHM_V, L_WS = 2 * SHM_V + 2 * SHM_K, L_Q = L_WS + 2048;
constexpr int LC_V = 0, LC_K = 65536, LC_WS = 131072, LC_IMP = 133120;
constexpr int L_SEL = 149504;
constexpr float THR = 8.f;
constexpr float C2 = 1.4426950408889634f * SCALE;
enum { M_FOX = 0, M_WIN = 1, M_SLC = 2 };
#define KSWZ(row, colB) ((row) * 256 + ((colB) ^ (((row) & 7) << 4)))
#define SBAR() __builtin_amdgcn_sched_barrier(0)
__device__ __forceinline__ int v_st(int k, int c) { const int kk = (k & ~0xC) | ((k & 4) << 1) | ((k & 8) >> 1); return ((kk >> 3) * 4 + (c >> 5)) * 512 + ((kk & 7) * 32 + (c & 31)) * 2; }
__device__ __forceinline__ int v_rd_base(int lane) { return ((lane & 3) << 3) | (((lane >> 2) & 3) << 6) | (((lane >> 4) & 1) << 5) | (((lane >> 5) & 1) << 8); }
constexpr int v_rd_off(int d0, int ks, int half) { return d0 * 512 + ks * 4096 + half * 2048; }
__device__ __forceinline__ int crow(int r, int hi) { return (r & 3) + 8 * (r >> 2) + 4 * hi; }
__device__ __forceinline__ bf16x8 load8(const bf16_t* p) { return *reinterpret_cast<const bf16x8*>(p); }
__device__ __forceinline__ void mask_tile(f32x16& p0, f32x16& p1, int dq, unsigned W) {
    const float NEG = -__builtin_inff();
#pragma unroll
    for (int r = 0; r < 16; ++r) { const int c = (r & 3) + 8 * (r >> 2);
        if ((unsigned)(dq - c) >= W) p0[r] = NEG;
        if ((unsigned)(dq - c - 32) >= W) p1[r] = NEG; }
}
__device__ __forceinline__ void partialSM(f32x16& p0, f32x16& p1, float& m_reg, float& mn, float& alpha) {
    float pmax = p0[0];
#pragma unroll
    for (int r = 1; r < 16; ++r) pmax = fmaxf(pmax, p0[r]);
#pragma unroll
    for (int r = 0; r < 16; ++r) pmax = fmaxf(pmax, p1[r]);
    { auto rr = __builtin_amdgcn_permlane32_swap(__float_as_uint(pmax), __float_as_uint(pmax), false, false);
      pmax = fmaxf(__uint_as_float(rr[0]), __uint_as_float(rr[1])); }
    if (__builtin_expect(__all((pmax - m_reg) * SCALE <= THR), 1)) { mn = m_reg; alpha = 1.f; }
    else { mn = fmaxf(m_reg, pmax); alpha = __builtin_amdgcn_exp2f((m_reg - mn) * C2); m_reg = mn; }
    const float mnL = -mn * C2;
#pragma unroll
    for (int r = 0; r < 16; ++r) p0[r] = fmaf(p0[r], C2, mnL);
#pragma unroll
    for (int r = 0; r < 16; ++r) p1[r] = fmaf(p1[r], C2, mnL);
#pragma unroll
    for (int r = 0; r < 16; ++r) p0[r] = __builtin_amdgcn_exp2f(p0[r]);
}
#define PK4(P, B_, OUT) do { unsigned a0 = cvt_pk_bf16(P[B_+0], P[B_+1]), a1 = cvt_pk_bf16(P[B_+2], P[B_+3]);                          \
        unsigned b0 = cvt_pk_bf16(P[B_+4], P[B_+5]), b1 = cvt_pk_bf16(P[B_+6], P[B_+7]);                                             \
        auto r0 = __builtin_amdgcn_permlane32_swap(a0, b0, false, false); auto r1 = __builtin_amdgcn_permlane32_swap(a1, b1, false, false); \
        u32x4 w = {r0[0], r1[0], r0[1], r1[1]}; OUT = *reinterpret_cast<bf16x8*>(&w); } while (0)
__device__ __forceinline__ void finishSM(f32x16& p0, f32x16& p1, float alpha, float& l_reg, bf16x8& pa0, bf16x8& pa1, bf16x8& pa2, bf16x8& pa3) {
#pragma unroll
    for (int r = 0; r < 16; ++r) p1[r] = __builtin_amdgcn_exp2f(p1[r]);
    float ps = 0;
#pragma unroll
    for (int r = 0; r < 16; ++r) ps += p0[r];
#pragma unroll
    for (int r = 0; r < 16; ++r) ps += p1[r];
    { auto rr = __builtin_amdgcn_permlane32_swap(__float_as_uint(ps), __float_as_uint(ps), false, false);
      ps = __uint_as_float(rr[0]) + __uint_as_float(rr[1]); }
    l_reg = l_reg * alpha + ps;
    PK4(p0, 0, pa0); PK4(p0, 8, pa1); PK4(p1, 0, pa2); PK4(p1, 8, pa3);
}
template <int KB>
__device__ __forceinline__ void qkt(f32x16& p0, f32x16& p1, const LAS char* K_lds, int r32, int hi, const LAS char* qs) {
    const LAS char* kb[4];
#pragma unroll
    for (int dd = 0; dd < 4; ++dd) kb[dd] = K_lds + KB * SHM_K + KSWZ(r32, (dd * 16 + hi * 8) * 2);
#pragma unroll
    for (int d0 = 0; d0 < 8; ++d0) { const LAS char* a = kb[d0 & 3] + (d0 >> 2) * 128;
        const bf16x8 q = *reinterpret_cast<const LAS bf16x8*>(qs + d0 * 1024);
        bf16x8 b0 = *reinterpret_cast<const LAS bf16x8*>(a);
        bf16x8 b1 = *reinterpret_cast<const LAS bf16x8*>(a + 32 * 256);
        p0 = __builtin_amdgcn_mfma_f32_32x32x16_bf16(b0, q, p0, 0, 0, 0);
        p1 = __builtin_amdgcn_mfma_f32_32x32x16_bf16(b1, q, p1, 0, 0, 0); }
}
template <int KB>
__device__ __forceinline__ void qkt_r(f32x16& p0, f32x16& p1, const LAS char* K_lds, int r32, int hi, const bf16x8* qr) {
    const LAS char* kb[4];
#pragma unroll
    for (int dd = 0; dd < 4; ++dd) kb[dd] = K_lds + KB * SHM_K + KSWZ(r32, (dd * 16 + hi * 8) * 2);
#pragma unroll
    for (int d0 = 0; d0 < 8; ++d0) { const LAS char* a = kb[d0 & 3] + (d0 >> 2) * 128;
        bf16x8 b0 = *reinterpret_cast<const LAS bf16x8*>(a);
        bf16x8 b1 = *reinterpret_cast<const LAS bf16x8*>(a + 32 * 256);
        p0 = __builtin_amdgcn_mfma_f32_32x32x16_bf16(b0, qr[d0], p0, 0, 0, 0);
        p1 = __builtin_amdgcn_mfma_f32_32x32x16_bf16(b1, qr[d0], p1, 0, 0, 0); }
}
template <int VB>
__device__ __forceinline__ void pv_tile(f32x16* o, int vb0, bf16x8 pa0, bf16x8 pa1, bf16x8 pa2, bf16x8 pa3) {
#define TRRD(dst, off) asm volatile("ds_read_b64_tr_b16 %0, %1 offset:%2" : "=&v"(dst) : "v"(vb0), "i"(off) : "memory")
#define PV_D0(d0) do { s16x4 l0, l1, l2, l3, h0, h1, h2, h3; constexpr int b_ = VB * SHM_V + v_rd_off(d0, 0, 0); \
        TRRD(l0, b_); TRRD(h0, b_ + 2048); TRRD(l1, b_ + 4096); TRRD(h1, b_ + 6144); TRRD(l2, b_ + 8192); TRRD(h2, b_ + 10240); TRRD(l3, b_ + 12288); TRRD(h3, b_ + 14336); \
        asm volatile("s_waitcnt lgkmcnt(0)" ::: "memory"); SBAR(); \
        o[d0] = __builtin_amdgcn_mfma_f32_32x32x16_bf16(pa0, (bf16x8){l0[0], l0[1], l0[2], l0[3], h0[0], h0[1], h0[2], h0[3]}, o[d0], 0, 0, 0);   \
        o[d0] = __builtin_amdgcn_mfma_f32_32x32x16_bf16(pa1, (bf16x8){l1[0], l1[1], l1[2], l1[3], h1[0], h1[1], h1[2], h1[3]}, o[d0], 0, 0, 0);   \
        o[d0] = __builtin_amdgcn_mfma_f32_32x32x16_bf16(pa2, (bf16x8){l2[0], l2[1], l2[2], l2[3], h2[0], h2[1], h2[2], h2[3]}, o[d0], 0, 0, 0);   \
        o[d0] = __builtin_amdgcn_mfma_f32_32x32x16_bf16(pa3, (bf16x8){l3[0], l3[1], l3[2], l3[3], h3[0], h3[1], h3[2], h3[3]}, o[d0], 0, 0, 0); } while (0)
    PV_D0(0); PV_D0(1); PV_D0(2); PV_D0(3);
#undef PV_D0
#undef TRRD
}

struct Blk {
    const bf16_t* Q;
    const bf16_t* K; const bf16_t* V;
    const float* KB;
    int mode, P0, j_lo, j_hi, b, hb;
};
struct Seam { bf16x8 st_v0, st_v1, st_k0, st_k1; };
__device__ __forceinline__ int q_lane_off(int mode, int wid, int r32) { return mode == M_FOX ? (wid * 32 + r32) * 128 : ((r32 >> 3) * T + wid * 8 + (r32 & 7)) * 128; }
#define ROW(p, k0, rr) ((p) + (size_t)((k0) + (rr)) * D + sc)
#define VMW() asm volatile("s_waitcnt vmcnt(0)" ::: "memory")
#define VMWN(n) asm volatile("s_waitcnt vmcnt(%0)" :: "i"(n) : "memory")
#define SLOAD_H(Kp, Vp, k0) do { S.st_v0 = load8(ROW(Vp, k0, sr)); S.st_v1 = load8(ROW(Vp, k0, 32 + sr)); S.st_k0 = load8(ROW(Kp, k0, sr)); S.st_k1 = load8(ROW(Kp, k0, 32 + sr)); } while (0)
#define SWRITE_HK(bf) do { *(LAS bf16x8*)(K_lds + (bf) * SHM_K + kws) = S.st_k0; *(LAS bf16x8*)(K_lds + (bf) * SHM_K + kws + 32 * 256) = S.st_k1; } while (0)
#define SWRITE_HV(bf) do { *(LAS bf16x8*)(V_lds + (bf) * SHM_V + vst0) = S.st_v0; *(LAS bf16x8*)(V_lds + (bf) * SHM_V + vst1) = S.st_v1; } while (0)
#define SWRITE_H(bf) do { SWRITE_HV(bf); SWRITE_HK(bf); } while (0)
__device__ __forceinline__ void attn_prime(const Blk& cur, LAS char* lds, Seam& S) {
    const int tid = threadIdx.x;
    const int sr = tid >> 4, sc = (tid & 15) * 8, kws = KSWZ(sr, sc * 2); LAS char* K_lds = lds + L_K;
    const int kb0 = cur.j_lo * KVBLK;
    SLOAD_H(cur.K, cur.V, kb0); VMW(); SWRITE_HK(0);
    __syncthreads();
}
struct EpiCtx { bf16_t* AO; float* NSAO; const float* GATES; };
__device__ __forceinline__ void attn_block(const Blk& cur, const Blk& nxt, LAS char* lds, Seam& S, const EpiCtx& ec) {
    int tid = threadIdx.x; asm volatile("" : "+v"(tid));
    const int wid = __builtin_amdgcn_readfirstlane(tid >> 6), lane = tid & 63, r32 = lane & 31, hi = lane >> 5;
    const int mode = cur.mode;
    const int j_lo = cur.j_lo, NT = cur.j_hi - cur.j_lo;
    const int kbn = nxt.j_lo * KVBLK;
    const bool fox = mode == M_FOX;
    const int wlo = cur.P0 + (fox ? wid * 32 : wid * 8), whi = wlo + (fox ? 31 : 7);
    const int pos = cur.P0 + (fox ? wid * 32 + r32 : wid * 8 + (r32 & 7)), qm = pos - 4 * hi;
    const unsigned Wu = (mode == M_WIN) ? 512u : (1u << 30);
    LAS char* V_lds = lds + L_V; LAS char* K_lds = lds + L_K;
    LAS float* ws = (LAS float*)(lds + L_WS) + wid * 64; LAS float* li_l = ws; LAS float* al_l = ws + 32;
    float m_reg = -1e30f, l_reg = 0; f32x16 o[4] = {};
    const int sr = tid >> 4, sc = (tid & 15) * 8, vst0 = v_st(sr, sc), vst1 = v_st(32 + sr, sc), kws = KSWZ(sr, sc * 2);
    const int vb0 = (int)(unsigned)(uintptr_t)V_lds + v_rd_base(lane);
    const bf16_t* Kh = cur.K; const bf16_t* Vh = cur.V;
    unsigned long long sel = ~0ull;
    if (mode == M_SLC) sel = *(const LAS unsigned long long*)(lds + L_SEL + (wid * 8 + (r32 & 7)) * 8);
#define RESC(a_) do { if (__any((a_) < 1.f)) { if (hi == 0) al_l[r32] = (a_); asm volatile("s_waitcnt lgkmcnt(0)" ::: "memory");              \
                     _Pragma("unroll") for (int d_ = 0; d_ < 4; ++d_) _Pragma("unroll") for (int r = 0; r < 16; ++r) o[d_][r] *= al_l[crow(r, hi)]; } } while (0)
#define KBASE(t) ((j_lo + (t)) * KVBLK)
#define PRELOAD(P0_, P1_, t) do { if (fox) { const float* kbp_ = cur.KB + KBASE(t) + 4 * hi; \
            _Pragma("unroll") for (int q_ = 0; q_ < 4; ++q_) { const f32x4 a_ = *(const f32x4*)(kbp_ + 8 * q_), b_ = *(const f32x4*)(kbp_ + 32 + 8 * q_); \
                P0_[4*q_] = a_[0]; P0_[4*q_+1] = a_[1]; P0_[4*q_+2] = a_[2]; P0_[4*q_+3] = a_[3]; P1_[4*q_] = b_[0]; P1_[4*q_+1] = b_[1]; P1_[4*q_+2] = b_[2]; P1_[4*q_+3] = b_[3]; } } \
        else { P0_ = f32x16{}; P1_ = f32x16{}; } } while (0)
#define MASKT(P0_, P1_, t) do { const int kb_ = KBASE(t); \
        if (mode == M_SLC) { const unsigned wl_ = ((sel >> (j_lo + (t))) & 1ull) ? (1u << 30) : 0u; mask_tile(P0_, P1_, qm - kb_, wl_); } \
        else if (kb_ + KVBLK - 1 > wlo || kb_ + (int)Wu <= whi) mask_tile(P0_, P1_, qm - kb_, Wu); } while (0)
    f32x16 pA0, pA1, pB0, pB1; float mnA, mnB, alA, alB; bf16x8 pa0, pa1, pa2, pa3;
    LAS char* qs = lds + L_Q + wid * 8192 + lane * 16;
    { const bf16_t* qp = cur.Q + q_lane_off(mode, wid, r32) + hi * 8; bf16x8 tq[8];
#pragma unroll
      for (int d0 = 0; d0 < 8; ++d0) tq[d0] = load8(qp + d0 * 16);
#pragma unroll
      for (int d0 = 0; d0 < 8; ++d0) *(LAS bf16x8*)(qs + d0 * 1024) = tq[d0]; }
    PRELOAD(pA0, pA1, 0);
    SWRITE_HV(0); SBAR();
    if (NT > 1) SLOAD_H(Kh, Vh, KBASE(1));
    SBAR(); qkt<0>(pA0, pA1, K_lds, r32, hi, qs);
    if (NT > 1) PRELOAD(pB0, pB1, 1); else { pB0 = f32x16{}; pB1 = f32x16{}; }
    MASKT(pA0, pA1, 0); partialSM(pA0, pA1, m_reg, mnA, alA);
    if (NT > 1) { VMW(); SWRITE_H(1); }
    __syncthreads();
#define HALF_STEP(PX0, PX1, mnX, alX, PY0, PY1, alY, t, KB_, VB_, SB_) do {                                                      \
        SBAR(); qkt<KB_>(PX0, PX1, K_lds, r32, hi, qs);                                             \
        finishSM(PY0, PY1, alY, l_reg, pa0, pa1, pa2, pa3); SBAR();                                                           \
        if ((t) + 1 < NT) { PRELOAD(PY0, PY1, (t) + 1); SLOAD_H(Kh, Vh, KBASE((t) + 1)); SBAR(); }                                               \
        pv_tile<VB_>(o, vb0, pa0, pa1, pa2, pa3); MASKT(PX0, PX1, (t)); partialSM(PX0, PX1, m_reg, mnX, alX);                                        \
        __syncthreads();                                                                                                      \
        if ((t) + 1 < NT) { VMW(); SWRITE_H(SB_); }                                                                          \
        RESC(alX); __syncthreads(); } while (0)
    for (int t = 1; t + 1 < NT; t += 2) {
        HALF_STEP(pB0, pB1, mnB, alB, pA0, pA1, alA, t, 1, 0, 0);
        HALF_STEP(pA0, pA1, mnA, alA, pB0, pB1, alB, t + 1, 0, 1, 1);
    }
    const bool even = (NT & 1) == 0;
    if (even) { SBAR(); qkt<1>(pB0, pB1, K_lds, r32, hi, qs); SBAR(); }
    SLOAD_H(nxt.K, nxt.V, kbn); SBAR();
    SBAR();
    finishSM(pA0, pA1, alA, l_reg, pa0, pa1, pa2, pa3); SBAR();
    pv_tile<0>(o, vb0, pa0, pa1, pa2, pa3);
    if (even) { MASKT(pB0, pB1, NT - 1); partialSM(pB0, pB1, m_reg, mnB, alB); __syncthreads(); RESC(alB);
        finishSM(pB0, pB1, alB, l_reg, pa0, pa1, pa2, pa3); SBAR(); pv_tile<1>(o, vb0, pa0, pa1, pa2, pa3); }
    SBAR(); VMW(); SWRITE_HK(0); SBAR();
    if (hi == 0) li_l[r32] = l_reg; asm volatile("s_waitcnt lgkmcnt(0)" ::: "memory");
    if (fox) {
        bf16_t* Ow = ec.AO + ((size_t)cur.b * T + cur.P0 + wid * QBLK) * DM + cur.hb * 128;
#pragma unroll
        for (int r = 0; r < 16; ++r) { const int orow = crow(r, hi); const float li = li_l[orow]; const float rl = li > 0.f ? __builtin_amdgcn_rcpf(li) : 0.f;
#pragma unroll
            for (int d0 = 0; d0 < 4; ++d0) { const float v = o[d0][r] * rl; const float vn = __shfl_xor(v, 1);
                if ((r32 & 1) == 0) *(unsigned*)(Ow + (size_t)orow * DM + d0 * 32 + r32) = cvt_pk_bf16(v, vn); } }
    } else {
        const int br = (mode == M_WIN) ? 2 : 1;
#pragma unroll
        for (int r = 0; r < 16; ++r) { const int rho = crow(r, hi); const float li = li_l[rho]; const float rl = li > 0.f ? __builtin_amdgcn_rcpf(li) : 0.f;
            const int tok = cur.P0 + wid * 8 + (rho & 7), head = cur.hb + (rho >> 3);
            const size_t trow = (size_t)cur.b * T + tok;
            const float gt = ec.GATES[trow * 24 + head * 3 + br] * rl;
            float* np = ec.NSAO + trow * 1024 + head * 128 + r32;
            float* np2 = np + (ptrdiff_t)((WS_PART - WS_NSAO) / 4);
#pragma unroll
            for (int d0 = 0; d0 < 4; ++d0) {
                if (mode == M_WIN) np2[d0 * 32] = gt * o[d0][r];
                else { const float v = np[d0 * 32] + np2[d0 * 32] + gt * o[d0][r]; const float vn = __shfl_xor(v, 1); if ((r32 & 1) == 0) *(unsigned*)(ec.AO + trow * DM + 1024 + head * 128 + d0 * 32 + r32) = cvt_pk_bf16(v, vn); } }
            asm volatile("" ::: "memory"); }
    }
    __syncthreads();
#undef RESC
#undef KBASE
#undef PRELOAD
#undef MASKT
#undef HALF_STEP
}
#undef ROW
#undef SLOAD_H
#undef SWRITE_HK
#undef SWRITE_HV
#undef SWRITE_H

__device__ __forceinline__ bf16x8 ovfrag(int n0, int J) {
    asm volatile("" : "+v"(n0));
    unsigned w[4];
#pragma unroll
    for (int q = 0; q < 4; ++q) { unsigned lohi[2];
#pragma unroll
        for (int e = 0; e < 2; ++e) { const int dl = n0 + 2 * q + e - 4 * J; lohi[e] = (dl >= 0 && dl <= 2) ? 0x3F80u : ((dl == 3 || dl == -1) ? 0x3F00u : 0u); }
        w[q] = lohi[0] | (lohi[1] << 16); }
    u32x4 v = {w[0], w[1], w[2], w[3]}; return *reinterpret_cast<bf16x8*>(&v);
}
__device__ __forceinline__ void nsa_cmp_item(int b, int g, int qb, const bf16_t* NQ, const bf16_t* KCMP, const bf16_t* VCMP, const float* GATES, float* NSAO, LAS char* lds) {
    int tid = threadIdx.x; asm volatile("" : "+v"(tid));
    const int wid = __builtin_amdgcn_readfirstlane(tid >> 6), lane = tid & 63, r32 = lane & 31, hi = lane >> 5;
    LAS char* V_lds = lds + LC_V; LAS char* K_lds = lds + LC_K;
    LAS float* ws = (LAS float*)(lds + LC_WS) + wid * 64; LAS float* li_l = ws;
    LAS float* impL = (LAS float*)(lds + LC_IMP);
    const int sr = tid >> 4, sc = (tid & 15) * 8, vst0 = v_st(sr, sc), vst1 = v_st(32 + sr, sc), kws = KSWZ(sr, sc * 2);
    const bf16_t* Kc = KCMP + (size_t)(b * 2 + g) * 256 * 128; const bf16_t* Vc = VCMP + (size_t)(b * 2 + g) * 256 * 128;
    {
        bf16x8 kk[4][2];
#pragma unroll
        for (int tl = 0; tl < 4; ++tl) { kk[tl][0] = load8(Kc + (size_t)(tl * 64 + sr) * 128 + sc); kk[tl][1] = load8(Kc + (size_t)(tl * 64 + 32 + sr) * 128 + sc); }
#pragma unroll
        for (int tl = 0; tl < 4; ++tl) { *(LAS bf16x8*)(K_lds + tl * SHM_K + kws) = kk[tl][0]; *(LAS bf16x8*)(K_lds + tl * SHM_K + kws + 32 * 256) = kk[tl][1]; }
        asm volatile("" ::: "memory");
#pragma unroll
        for (int tl = 0; tl < 4; ++tl) { kk[tl][0] = load8(Vc + (size_t)(tl * 64 + sr) * 128 + sc); kk[tl][1] = load8(Vc + (size_t)(tl * 64 + 32 + sr) * 128 + sc); }
#pragma unroll
        for (int tl = 0; tl < 4; ++tl) { *(LAS bf16x8*)(V_lds + tl * SHM_V + vst0) = kk[tl][0]; *(LAS bf16x8*)(V_lds + tl * SHM_V + vst1) = kk[tl][1]; }
        asm volatile("" ::: "memory");
    }
    bf16x8 qr[8];
    { const bf16_t* qp = NQ + (((size_t)b * 8 + g * 4) * T + qb * 64) * 128 + q_lane_off(M_WIN, wid, r32) + hi * 8;
#pragma unroll
      for (int d0 = 0; d0 < 8; ++d0) qr[d0] = load8(qp + d0 * 16); }
    __syncthreads();
    const int pos = qb * 64 + wid * 8 + (r32 & 7);
    const int nmax = (pos - 31) >> 4;
    const float NEG = -__builtin_inff();
#define CMASK(P0_, P1_, tl) do { _Pragma("unroll") for (int r = 0; r < 16; ++r) { const int n_ = (tl) * 64 + crow(r, hi); if (n_ > nmax) P0_[r] = NEG; if (n_ + 32 > nmax) P1_[r] = NEG; } } while (0)
    float m = -1e30f;
#define PASS1(tl) do { f32x16 p0 = f32x16{}, p1 = f32x16{}; qkt_r<tl>(p0, p1, K_lds, r32, hi, qr); CMASK(p0, p1, tl); \
        _Pragma("unroll") for (int r = 0; r < 16; ++r) m = fmaxf(m, fmaxf(p0[r], p1[r])); } while (0)
    PASS1(0); PASS1(1); PASS1(2); PASS1(3);
#undef PASS1
    { auto rr = __builtin_amdgcn_permlane32_swap(__float_as_uint(m), __float_as_uint(m), false, false); m = fmaxf(__uint_as_float(rr[0]), __uint_as_float(rr[1])); }
    const float mL = -m * C2;
    float l_reg = 0.f;
    const int vb0 = (int)(unsigned)(uintptr_t)V_lds + v_rd_base(lane);
    {
        f32x16 o[4] = {};
#define PASS2(tl) do { f32x16 p0 = f32x16{}, p1 = f32x16{}; qkt_r<tl>(p0, p1, K_lds, r32, hi, qr); CMASK(p0, p1, tl); \
        float ps = 0.f; \
        _Pragma("unroll") for (int r = 0; r < 16; ++r) { p0[r] = __builtin_amdgcn_exp2f(fmaf(p0[r], C2, mL)); p1[r] = __builtin_amdgcn_exp2f(fmaf(p1[r], C2, mL)); ps += p0[r] + p1[r]; } \
        l_reg += ps; bf16x8 pa0, pa1, pa2, pa3; PK4(p0, 0, pa0); PK4(p0, 8, pa1); PK4(p1, 0, pa2); PK4(p1, 8, pa3); \
        pv_tile<tl>(o, vb0, pa0, pa1, pa2, pa3); SBAR(); } while (0)
        PASS2(0); PASS2(1); PASS2(2); PASS2(3);
#undef PASS2
        { auto rr = __builtin_amdgcn_permlane32_swap(__float_as_uint(l_reg), __float_as_uint(l_reg), false, false); l_reg = __uint_as_float(rr[0]) + __uint_as_float(rr[1]); }
        if (hi == 0) li_l[r32] = l_reg; asm volatile("s_waitcnt lgkmcnt(0)" ::: "memory");
#pragma unroll
        for (int r = 0; r < 16; ++r) { const int rho = crow(r, hi); const float li = li_l[rho]; const float rl = li > 0.f ? __builtin_amdgcn_rcpf(li) : 0.f;
            const int tok = qb * 64 + wid * 8 + (rho & 7), head = g * 4 + (rho >> 3);
            const size_t trow = (size_t)b * T + tok;
            const float gt = GATES[trow * 24 + head * 3 + 0] * rl;
            float* np = NSAO + trow * 1024 + head * 128 + r32;
#pragma unroll
            for (int d0 = 0; d0 < 4; ++d0) np[d0 * 32] = gt * o[d0][r];
            asm volatile("" ::: "memory"); }
    }
    SBAR();
    {
        f32x16 io[2] = {};
#define PASS3(tl) do { f32x16 p0 = f32x16{}, p1 = f32x16{}; qkt_r<tl>(p0, p1, K_lds, r32, hi, qr); CMASK(p0, p1, tl); \
        _Pragma("unroll") for (int r = 0; r < 16; ++r) { p0[r] = __builtin_amdgcn_exp2f(fmaf(p0[r], C2, mL)); p1[r] = __builtin_amdgcn_exp2f(fmaf(p1[r], C2, mL)); } \
        bf16x8 pa0, pa1, pa2, pa3; PK4(p0, 0, pa0); PK4(p0, 8, pa1); PK4(p1, 0, pa2); PK4(p1, 8, pa3); \
        _Pragma("unroll") for (int d0 = 0; d0 < 2; ++d0) { const int J = d0 * 32 + r32; \
            io[d0] = __builtin_amdgcn_mfma_f32_32x32x16_bf16(pa0, ovfrag((tl) * 64 + 0 + 8 * hi, J), io[d0], 0, 0, 0); \
            io[d0] = __builtin_amdgcn_mfma_f32_32x32x16_bf16(pa1, ovfrag((tl) * 64 + 16 + 8 * hi, J), io[d0], 0, 0, 0); \
            io[d0] = __builtin_amdgcn_mfma_f32_32x32x16_bf16(pa2, ovfrag((tl) * 64 + 32 + 8 * hi, J), io[d0], 0, 0, 0); \
            io[d0] = __builtin_amdgcn_mfma_f32_32x32x16_bf16(pa3, ovfrag((tl) * 64 + 48 + 8 * hi, J), io[d0], 0, 0, 0); } SBAR(); } while (0)
        PASS3(0); PASS3(1); PASS3(2); PASS3(3);
#undef PASS3
        float imps[2][4] = {};
#pragma unroll
        for (int r = 0; r < 16; ++r) { const int rho = crow(r, hi); const float li = li_l[rho]; const float rl = li > 0.f ? __builtin_amdgcn_rcpf(li) : 0.f;
            imps[0][r & 3] += io[0][r] * rl; imps[1][r & 3] += io[1][r] * rl; }
#pragma unroll
        for (int d0 = 0; d0 < 2; ++d0)
#pragma unroll
            for (int e = 0; e < 4; ++e) impL[(wid * 8 + e + 4 * hi) * 64 + d0 * 32 + r32] = imps[d0][e];
    }
#undef CMASK
    __syncthreads();
    for (int tk = 0; tk < 8; ++tk) { const int tl = wid * 8 + tk; const int J = lane;
        const float im = impL[tl * 64 + J];
        const bool forced = (J == 0) || (J == qb) || (J == qb - 1);
        const float v = forced ? __builtin_inff() : (J <= qb ? im : NEG);
        impL[tl * 64 + J] = v; asm volatile("s_waitcnt lgkmcnt(0)" ::: "memory");
        int rank = 0;
        for (int jj = 0; jj < 64; ++jj) { const float u = impL[tl * 64 + jj]; rank += (u > v || (u == v && jj < J)) ? 1 : 0; }
        const unsigned long long mk = __ballot(rank < 16 && J <= qb);
        if (lane == 0) *(LAS unsigned long long*)(lds + L_SEL + tl * 8) = mk; }
    __syncthreads();
}
#undef PK4
#undef VMW
#undef VMWN

template <class P> __device__ __forceinline__ P* uptr(P* p) { const unsigned long long v = (unsigned long long)p;
    const unsigned lo = __builtin_amdgcn_readfirstlane((unsigned)v), hi = __builtin_amdgcn_readfirstlane((unsigned)(v >> 32)); return (P*)(((unsigned long long)hi << 32) | lo); }
__device__ __forceinline__ Blk make_blk(unsigned char* ws, int i, int st) {
    const int bg = i >> 6, qb = i & 63, b = bg >> 1, g = bg & 1; Blk k;
    if (st < 2) {
        k.Q = uptr((const bf16_t*)(ws + WS_NQR) + (((size_t)b * 8 + g * 4) * T + qb * 64) * 128);
        k.K = uptr((const bf16_t*)(ws + (st == 0 ? WS_KW : WS_KSL)) + (size_t)bg * T * 128); k.V = uptr((const bf16_t*)(ws + (st == 0 ? WS_VW : WS_VSL)) + (size_t)bg * T * 128);
        k.KB = nullptr; k.mode = st == 0 ? M_WIN : M_SLC; k.P0 = qb * 64; k.j_lo = (st == 0 && qb >= 8) ? qb - 8 : 0; k.j_hi = qb + 1; k.b = b; k.hb = g * 4;
    } else {
        const int bh = bg * 4 + (qb & 3), qf = 15 - (qb >> 2);
        k.Q = uptr((const bf16_t*)(ws + WS_FQ) + ((size_t)bh * T + qf * 256) * 128); k.K = uptr((const bf16_t*)(ws + WS_FK) + (size_t)bh * T * 128); k.V = uptr((const bf16_t*)(ws + WS_FV) + (size_t)bh * T * 128);
        k.KB = uptr((const float*)(ws + WS_KBIAS) + (size_t)bh * T); k.mode = M_FOX; k.P0 = qf * 256; k.j_lo = 0; k.j_hi = 4 * qf + 4; k.b = bh >> 3; k.hb = bh & 7;
    }
    k.mode = __builtin_amdgcn_readfirstlane(k.mode); k.P0 = __builtin_amdgcn_readfirstlane(k.P0); k.j_lo = __builtin_amdgcn_readfirstlane(k.j_lo); k.j_hi = __builtin_amdgcn_readfirstlane(k.j_hi);
    k.b = __builtin_amdgcn_readfirstlane(k.b); k.hb = __builtin_amdgcn_readfirstlane(k.hb);
    return k;
}
__device__ __forceinline__ void attn_phase(const Args& a, LAS char* lds, int vcu, int G) {
    unsigned char* ws = a.ws;
    EpiCtx ec{(bf16_t*)(ws + WS_AO), (float*)(ws + WS_NSAO), (const float*)(ws + WS_GATES)};
    Seam S;
    constexpr int ST0 = (DEV_ATT == 1) ? 2 : 0, ST1 = (DEV_ATT == 2) ? 2 : 3;
    for (int i = vcu; i < 256; i += G) {
#ifndef NO_CMP
        if (DEV_ATT & 2) { const int bg = i >> 6, qb = i & 63; nsa_cmp_item(bg >> 1, bg & 1, qb, (const bf16_t*)(ws + WS_NQ), (const bf16_t*)(ws + WS_KCMP), (const bf16_t*)(ws + WS_VCMP), ec.GATES, ec.NSAO, lds); }
#endif
#ifndef NO_BLK
        Blk cur = make_blk(ws, i, ST0);
        attn_prime(cur, lds, S);
        for (int st = ST0; st < ST1; ++st) { const Blk nxt = make_blk(ws, i, st + 1 < ST1 ? st + 1 : st);
            attn_block(cur, nxt, lds, S, ec); cur = nxt; }
#endif
    }
}
#undef KSWZ
#undef SBAR
}


__device__ __forceinline__ int win_src_col(int pg) {
    const int pn = pg >> 8, p = pg & 255;
    if (pn == 22) { if (p < 8) return C_FZ + p; if (p < 32) return C_GZ + p - 8; return -1; }
    const int bj = p >> 7, q = p & 127;
    const int d = 16 * (q >> 5) + 4 * ((q >> 3) & 3) + (q & 3) + 64 * ((q >> 2) & 1);
    int base;
    if (pn < 4) base = C_FQ + pn * 256; else if (pn < 8) base = C_FK + (pn - 4) * 256; else if (pn < 12) base = C_FV + (pn - 8) * 256;
    else if (pn < 16) base = C_NQ + (pn - 12) * 256; else base = C_KC + (pn - 16) * 256;
    return base + bj * 128 + d;
}
template <int SRC>
__device__ __forceinline__ void transpose_item(const float* W, int K, int N, bf16_t* WT, LAS float* scr, int item, int nblk, int lane) {
    const int kb = item / nblk, nb = item % nblk, k0 = 64 * kb, n0 = 32 * nb;
    int sc = n0 + (lane & 31); if (SRC == 1) sc = win_src_col(sc);
#pragma unroll 8
    for (int i = 0; i < 32; ++i) { const int kk = 2 * i + (lane >> 5); scr[kk * 33 + (lane & 31)] = sc >= 0 ? W[(size_t)(k0 + kk) * N + sc] : 0.f; }
    asm volatile("s_waitcnt lgkmcnt(0)" ::: "memory");
    const int cch = lane & 7;
#pragma unroll
    for (int j = 0; j < 4; ++j) { const int n = (lane >> 3) + 8 * j; const LAS float* s = scr + (8 * cch) * 33 + n;
        u32x4 o; o.x = cvt_pk_bf16(s[0 * 33], s[1 * 33]); o.y = cvt_pk_bf16(s[2 * 33], s[3 * 33]); o.z = cvt_pk_bf16(s[4 * 33], s[5 * 33]); o.w = cvt_pk_bf16(s[6 * 33], s[7 * 33]);
        *(u32x4*)(WT + (size_t)(n0 + n) * K + k0 + 8 * cch) = o; }
    asm volatile("s_waitcnt lgkmcnt(0)" ::: "memory");
}

__device__ __forceinline__ void p0_prologue(const Args& a, LAS unsigned char* lds, int vcu, int G) {
    int tid = threadIdx.x; asm volatile("" : "+v"(tid)); const int lane = tid & 63, wave = __builtin_amdgcn_readfirstlane(tid >> 6);
    LAS float* ca = (LAS float*)lds;
    for (int i = tid; i < 2 * DM; i += NTHR) { const float v = a.c[i]; ca[i] = v / (1.f + __expf(-v)); }
    __syncthreads();
    const int gw = vcu * NWAVES + wave, NGW = G * NWAVES;
    float* modp = (float*)(a.ws + WS_MODP);
    if (wave < 3) { const int it = vcu * 3 + wave;
        if (it < 16 * 48) { const int kc = it / 48, cq = (it % 48) * 64 + lane;
            f32x4 a0 = (f32x4){0.f, 0.f, 0.f, 0.f}, a1 = a0;
            const float* wp = a.w_ada + (size_t)(kc * 128) * (6 * DM) + 4 * cq;
#pragma unroll 16
            for (int k = 0; k < 128; ++k) { const f32x4 w = *(const f32x4*)(wp + (size_t)k * (6 * DM)); a0 += w * ca[kc * 128 + k]; a1 += w * ca[DM + kc * 128 + k]; }
            *(f32x4*)(modp + ((size_t)kc * 2 + 0) * (6 * DM) + 4 * cq) = a0; *(f32x4*)(modp + ((size_t)kc * 2 + 1) * (6 * DM) + 4 * cq) = a1; } }
    LAS float* scr = (LAS float*)(lds + 16384 + wave * 16384);
    constexpr int I_IN = 32 * (NPAD / 32), I_OUT = 32 * 64, I_UP = 32 * 256, I_DN = 128 * 64, I_W1 = 64 * 8, I_W2 = 4 * 4;
    constexpr int NIT = I_IN + I_OUT + I_UP + I_DN + 2 * I_W1 + 2 * I_W2;
    unsigned* qctr = (unsigned*)(a.ws + WS_CTL);
    for (;;) { int it; { unsigned v = 0; if (lane == 0) v = atomicAdd(qctr, 1u); it = __builtin_amdgcn_readfirstlane((int)v); }
        if (it >= NIT) break; int r = it;
        if (r < I_IN) { transpose_item<1>(a.w_in, DM, DIN, (bf16_t*)(a.ws + WS_WIN), scr, r, NPAD / 32, lane); continue; } r -= I_IN;
        if (r < I_OUT) { transpose_item<0>(a.w_out, DM, DM, (bf16_t*)(a.ws + WS_WOUT), scr, r, 64, lane); continue; } r -= I_OUT;
        if (r < I_UP) { transpose_item<0>(a.w_up, DM, DFF, (bf16_t*)(a.ws + WS_WUP), scr, r, 256, lane); continue; } r -= I_UP;
        if (r < I_DN) { transpose_item<0>(a.w_down, DFF, DM, (bf16_t*)(a.ws + WS_WDN), scr, r, 64, lane); continue; } r -= I_DN;
        if (r < I_W1) { transpose_item<0>(a.cmp_w1_k, 4096, 256, (bf16_t*)(a.ws + WS_W1T), scr, r, 8, lane); continue; } r -= I_W1;
        if (r < I_W1) { transpose_item<0>(a.cmp_w1_v, 4096, 256, (bf16_t*)(a.ws + WS_W1T) + 256 * 4096, scr, r, 8, lane); continue; } r -= I_W1;
        if (r < I_W2) { transpose_item<0>(a.cmp_w2_k, 256, 128, (bf16_t*)(a.ws + WS_W2T), scr, r, 4, lane); continue; } r -= I_W2;
        transpose_item<0>(a.cmp_w2_v, 256, 128, (bf16_t*)(a.ws + WS_W2T) + 128 * 256, scr, r, 4, lane);
    }
    float* rope = (float*)(a.ws + WS_ROPE);
    for (int e = (vcu * NTHR + tid); e < T * 64; e += G * NTHR) { const int t = e >> 6, i = e & 63;
        const float inv_freq = (float)pow(10000.0, -(double)i / 64.0); const float ang = (float)t * inv_freq;
        rope[2 * e] = (float)cos((double)ang); rope[2 * e + 1] = (float)sin((double)ang); }
    float* pebp = (float*)(a.ws + WS_PEBP);
    for (int it = gw; it < 2 * 4 * 64; it += NGW) { const int kv = it >> 8, cg_ = (it >> 6) & 3, ch = it & 63, col = cg_ * 64 + lane;
        const float* pe = kv ? a.cmp_pe_v : a.cmp_pe_k; const float* w1 = kv ? a.cmp_w1_v : a.cmp_w1_k; float s = 0.f;
#pragma unroll 8
        for (int i = 0; i < 64; ++i) s += pe[ch * 64 + i] * w1[(size_t)(ch * 64 + i) * 256 + col];
        pebp[((size_t)kv * 64 + ch) * 256 + col] = s; }
}

template <bool FIRST>
__device__ __forceinline__ void norm_phase(const Args& a, LAS unsigned char* lds, const float* xsrc, const float* gain, int shift_off, int scale_off, int bid, int G) {
    int tid = threadIdx.x; asm volatile("" : "+v"(tid)); const int lane = tid & 63, wave = __builtin_amdgcn_readfirstlane(tid >> 6);
    LAS float* AS = (LAS float*)lds; LAS float* SH = AS + DM;
    const float* modp = (const float*)(a.ws + WS_MODP); float* mod = (float*)(a.ws + WS_MOD);
    const int rows_per = M / G, b = (bid * rows_per) / T;
    for (int d = tid; d < DM; d += NTHR) { float sc, sh;
        if (FIRST) { sc = a.b_ada[scale_off + d]; sh = a.b_ada[shift_off + d];
#pragma unroll
            for (int kc = 0; kc < 16; ++kc) { sc += modp[((size_t)kc * 2 + b) * (6 * DM) + scale_off + d]; sh += modp[((size_t)kc * 2 + b) * (6 * DM) + shift_off + d]; } }
        else { sc = mod[b * 6 * DM + scale_off + d]; sh = mod[b * 6 * DM + shift_off + d]; }
        AS[d] = gain[d] * (1.f + sc); SH[d] = sh; }
    if (FIRST) {
        for (int e = bid * NTHR + tid; e < 2 * 6 * DM; e += G * NTHR) { const int bb = e / (6 * DM), j = e % (6 * DM); float s = a.b_ada[j];
#pragma unroll
            for (int kc = 0; kc < 16; ++kc) s += modp[((size_t)kc * 2 + bb) * (6 * DM) + j];
            mod[e] = s; }
        if (bid == 0) { const float* pebp = (const float*)(a.ws + WS_PEBP); float* peb = (float*)(a.ws + WS_PEB); const int kv = tid >> 8, j = tid & 255; float s = 0.f;
            for (int ch = 0; ch < 64; ++ch) s += pebp[((size_t)kv * 64 + ch) * 256 + j];
            peb[kv * 256 + j] = s; }
    }
    __syncthreads();
    bf16_t* XN = (bf16_t*)(a.ws + WS_XN);
    for (int r = wave; r < rows_per; r += NWAVES) { const int row = bid * rows_per + r;
        const f32x4* xr = (const f32x4*)(xsrc + (size_t)row * DM) + lane;
        f32x4 v[8]; float ss = 0.f;
#pragma unroll
        for (int j = 0; j < 8; ++j) { v[j] = xr[64 * j]; ss += (v[j][0] * v[j][0] + v[j][1] * v[j][1]) + (v[j][2] * v[j][2] + v[j][3] * v[j][3]); }
        const float rstd = 1.0f / sqrtf(wave_sum(ss) * (1.f / DM) + EPS);
        u32x2* o8 = (u32x2*)(XN + (size_t)row * DM) + lane;
#pragma unroll
        for (int j = 0; j < 8; ++j) { const f32x4 as = *(const LAS f32x4*)(AS + 4 * lane + 256 * j), sh = *(const LAS f32x4*)(SH + 4 * lane + 256 * j);
            const f32x4 h = v[j] * rstd * as + sh; u32x2 w; w.x = cvt_pk_bf16(h[0], h[1]); w.y = cvt_pk_bf16(h[2], h[3]); o8[64 * j] = w; }
    }
    __syncthreads();
}


__device__ __forceinline__ void cmp2_phase(const Args& a, LAS unsigned char* lds, int vcu, int G) {
    int tid = threadIdx.x; asm volatile("" : "+v"(tid)); const int lane = tid & 63, wave = __builtin_amdgcn_readfirstlane(tid >> 6);
    unsigned char* ws = a.ws;
    for (int L = vcu; L < 64 + 16; L += G) {
        if (L < 64) {
            const int kv = L >> 5, bg = (L >> 3) & 3, rt = L & 7;
            LAS bf16_t* hidL = (LAS bf16_t*)lds;
            LAS float* red = (LAS float*)(lds + 32768);
            { const int row = tid >> 4, c0 = (tid & 15) * 16;
              const float* pp = (const float*)(ws + WS_PART) + ((size_t)(kv * 4 + bg) * 16) * 65536 + (size_t)(rt * 32 + row) * 256 + c0;
              const float* peb = (const float*)(ws + WS_PEB) + kv * 256 + c0;
              f32x4 s0 = *(const f32x4*)peb, s1 = *(const f32x4*)(peb + 4), s2 = *(const f32x4*)(peb + 8), s3 = *(const f32x4*)(peb + 12);
#pragma unroll 4
              for (int ks = 0; ks < 16; ++ks) { const float* q = pp + (size_t)ks * 65536; s0 += *(const f32x4*)q; s1 += *(const f32x4*)(q + 4); s2 += *(const f32x4*)(q + 8); s3 += *(const f32x4*)(q + 12); }
              f32x4 sv[4] = {s0, s1, s2, s3}; unsigned w[8];
#pragma unroll
              for (int i = 0; i < 4; ++i) { f32x4 v = sv[i];
#pragma unroll
                  for (int e = 0; e < 4; ++e) v[e] = v[e] / (1.f + __expf(-v[e]));
                  w[2 * i] = cvt_pk_bf16(v[0], v[1]); w[2 * i + 1] = cvt_pk_bf16(v[2], v[3]); }
              *(LAS u32x4*)(hidL + row * 264 + c0) = (u32x4){w[0], w[1], w[2], w[3]}; *(LAS u32x4*)(hidL + row * 264 + c0 + 8) = (u32x4){w[4], w[5], w[6], w[7]}; }
            __syncthreads();
            const int fr = lane & 15, fq = lane >> 4;
            f32x4 acc[2] = {(f32x4){0.f, 0.f, 0.f, 0.f}, (f32x4){0.f, 0.f, 0.f, 0.f}};
            const bf16_t* w2 = (const bf16_t*)(ws + WS_W2T) + (size_t)kv * 128 * 256 + (size_t)(16 * wave + fr) * 256 + 8 * fq;
#pragma unroll
            for (int ks = 0; ks < 8; ++ks) { const bf16x8 bf = *(const bf16x8*)(w2 + ks * 32);
#pragma unroll
                for (int rg = 0; rg < 2; ++rg) { const bf16x8 af = *(const LAS bf16x8*)(hidL + (rg * 16 + fr) * 264 + ks * 32 + 8 * fq);
                    acc[rg] = __builtin_amdgcn_mfma_f32_16x16x32_bf16(af, bf, acc[rg], 0, 0, 0); } }
            float rstd[2][4];
            if (kv == 0) {
#pragma unroll
                for (int rg = 0; rg < 2; ++rg)
#pragma unroll
                    for (int e = 0; e < 4; ++e) { float q = acc[rg][e] * acc[rg][e]; q += __shfl_xor(q, 1); q += __shfl_xor(q, 2); q += __shfl_xor(q, 4); q += __shfl_xor(q, 8);
                        if (fr == 0) red[(rg * 16 + 4 * fq + e) * 8 + wave] = q; }
                __syncthreads();
#pragma unroll
                for (int rg = 0; rg < 2; ++rg)
#pragma unroll
                    for (int e = 0; e < 4; ++e) { const LAS float* rp = red + (rg * 16 + 4 * fq + e) * 8; const float tot = ((rp[0] + rp[1]) + (rp[2] + rp[3])) + ((rp[4] + rp[5]) + (rp[6] + rp[7]));
                        rstd[rg][e] = 1.0f / sqrtf(tot * (1.f / 128.f) + EPS) * a.cmp_k_norm[16 * wave + fr]; }
            } else {
#pragma unroll
                for (int rg = 0; rg < 2; ++rg)
#pragma unroll
                    for (int e = 0; e < 4; ++e) rstd[rg][e] = 1.f;
            }
            bf16_t* dst = (bf16_t*)(ws + (kv ? WS_VCMP : WS_KCMP)) + (size_t)bg * 256 * 128;
#pragma unroll
            for (int rg = 0; rg < 2; ++rg)
#pragma unroll
                for (int e = 0; e < 4; ++e) { const int n = rt * 32 + rg * 16 + 4 * fq + e; const float v = (n == 255) ? 0.f : acc[rg][e] * rstd[rg][e];
                    dst[(size_t)n * 128 + 16 * wave + fr] = (bf16_t)(cvt_pk_bf16(v, 0.f) & 0xffffu); }
            __syncthreads();
        } else {
            const int bh = L - 64; LAS double* part = (LAS double*)lds;
            const float* lf = (const float*)(ws + WS_LOGF) + (size_t)bh * T + tid * 8; float* kb = (float*)(ws + WS_KBIAS) + (size_t)bh * T + tid * 8;
            const f32x4 v0 = *(const f32x4*)lf, v1 = *(const f32x4*)(lf + 4);
            double loc[8]; double run = 0.0;
            { const float vv[8] = {v0[0], v0[1], v0[2], v0[3], v1[0], v1[1], v1[2], v1[3]};
#pragma unroll
              for (int i = 0; i < 8; ++i) { run += (double)vv[i]; loc[i] = run; } }
            part[tid] = run; __syncthreads();
            double off = 0.0; for (int i = 0; i < tid; ++i) off += part[i];
            f32x4 o0, o1;
#pragma unroll
            for (int i = 0; i < 4; ++i) { o0[i] = (float)(-(off + loc[i]) * (double)(1.0f / SCALE)); o1[i] = (float)(-(off + loc[4 + i]) * (double)(1.0f / SCALE)); }
            *(f32x4*)kb = o0; *(f32x4*)(kb + 4) = o1;
            __syncthreads();
        }
    }
}

enum { PH_PRO = 0, PH_NORM1 = 1, PH_INPROJ = 2, PH_CMP1 = 3, PH_CMP2 = 4, PH_ATTN = 5, PH_OUTPROJ = 6, PH_NORM2 = 7, PH_UP = 8, PH_DOWN = 9, PH_END = 10 };

__global__ void __launch_bounds__(NTHR, 2) mega_kernel(Args a) {
    extern __shared__ __attribute__((aligned(16))) unsigned char lds_raw[];
    LAS unsigned char* lds = (LAS unsigned char*)lds_raw;
    const int G = gridDim.x, bid = blockIdx.x;
    const int vcu = (G % 8 == 0) ? (bid % 8) * (G / 8) + bid / 8 : bid;
    cg::grid_group grid = cg::this_grid();
    unsigned char* ws = a.ws;
#ifndef PHMASK
#define PHMASK 0xffff
#endif
#define IN(k) (((PHMASK >> (k)) & 1) && a.ph_lo <= (k) && (k) < a.ph_hi)
#define SEAM(k) do { if (IN(k) && IN((k) + 1)) grid.sync(); } while (0)
    if (IN(PH_PRO)) { p0_prologue(a, lds, vcu, G); } SEAM(PH_PRO);
    if (IN(PH_NORM1)) { norm_phase<true>(a, lds, a.x, a.norm1_g, 0, DM, bid, G); } SEAM(PH_NORM1);
    if (IN(PH_INPROJ)) {
        pg8::StaticOrder S; S.init(M, NPAD, G, bid, ws + WS_XN, ws + WS_WIN, DM, DM);
        pg8::EpiIn E{(bf16_t*)(ws + WS_FQ), (bf16_t*)(ws + WS_FK), (bf16_t*)(ws + WS_FV), (bf16_t*)(ws + WS_NQ), (bf16_t*)(ws + WS_NQR), (bf16_t*)(ws + WS_KC), (bf16_t*)(ws + WS_VC),
                     (bf16_t*)(ws + WS_KSL), (bf16_t*)(ws + WS_VSL), (bf16_t*)(ws + WS_KW), (bf16_t*)(ws + WS_VW), (float*)(ws + WS_LOGF), (float*)(ws + WS_GATES),
                     a.fox_q_norm, a.fox_k_norm, a.nsa_q_norm, a.slc_k_norm, a.win_k_norm, a.b_forget, (const float*)(ws + WS_ROPE), (LAS float*)(lds + LDS_STATS)};
        pg8::gemm_phase(lds, DM, DM, DM, S, E);
    } SEAM(PH_INPROJ);
    if (IN(PH_CMP1)) {
        pg8::CmpOrder S{G, bid, (const char*)(ws + WS_KC), (const char*)(ws + WS_VC), (const char*)(ws + WS_W1T)};
        pg8::EpiPart E{(float*)(ws + WS_PART)};
        pg8::gemm_phase(lds, 2048, 4096, 256, S, E);
    } SEAM(PH_CMP1);
    if (IN(PH_CMP2)) { cmp2_phase(a, lds, vcu, G); } SEAM(PH_CMP2);
    if (IN(PH_ATTN)) { att::attn_phase(a, (LAS char*)lds, vcu, G); } SEAM(PH_ATTN);
    if (IN(PH_OUTPROJ)) {
        pg8::StaticOrder S; S.init(M, DM, G, bid, ws + WS_AO, ws + WS_WOUT, DM, DM);
        pg8::EpiRes E{a.x, a.out, (const float*)(ws + WS_MOD) + 2 * DM};
        pg8::gemm_phase(lds, DM, DM, DM, S, E);
    } SEAM(PH_OUTPROJ);
    if (IN(PH_NORM2)) { norm_phase<false>(a, lds, a.out, a.norm2_g, 3 * DM, 4 * DM, bid, G); } SEAM(PH_NORM2);
    if (IN(PH_UP)) {
        pg8::StaticOrder S; S.init(M, DFF, G, bid, ws + WS_XN, ws + WS_WUP, DM, DM);
        pg8::EpiUp E{(bf16_t*)(ws + WS_U), DFF};
        pg8::gemm_phase(lds, DM, DM, DM, S, E);
    } SEAM(PH_UP);
    if (IN(PH_DOWN)) {
        pg8::StaticOrder S; S.init(M, DM, G, bid, ws + WS_U, ws + WS_WDN, DFF, DFF);
        pg8::EpiRes E{a.out, a.out, (const float*)(ws + WS_MOD) + 5 * DM};
        pg8::gemm_phase(lds, DFF, DFF, DFF, S, E);
    }
#undef IN
#undef SEAM
}

__global__ void dev_cum_from_kb_kernel(const float* __restrict__ kb, float* __restrict__ cum) { const int i = blockIdx.x * 256 + threadIdx.x; cum[i] = -kb[i] * SCALE; }
__global__ void dev_cumsum_kernel(const float* __restrict__ logf, float* __restrict__ cum) {
    const int i = threadIdx.x; if (i >= 16) return; float s = 0.f;
    for (int t = 0; t < T; ++t) { s += logf[(size_t)i * T + t]; cum[(size_t)i * T + t] = s; }
}
template <class F>
__device__ __forceinline__ void attend_wave(const float* qs, float* sc, int nk, F keyfn, int lane, float& o0, float& o1, float* inv_sum_out) {
    float mx = -INFINITY;
    for (int i = lane; i < nk; i += 64) {
        const bf16_t* kp; const bf16_t* vp; float bias; float s = -INFINITY;
        if (keyfn(i, kp, vp, bias)) { float acc = 0.f;
#pragma unroll 4
            for (int d = 0; d < 128; d += 8) { const u32x4 kv = *(const u32x4*)(kp + d);
                acc += __uint_as_float(kv.x << 16) * qs[d] + __uint_as_float(kv.x & 0xffff0000u) * qs[d + 1] + __uint_as_float(kv.y << 16) * qs[d + 2] + __uint_as_float(kv.y & 0xffff0000u) * qs[d + 3]
                     + __uint_as_float(kv.z << 16) * qs[d + 4] + __uint_as_float(kv.z & 0xffff0000u) * qs[d + 5] + __uint_as_float(kv.w << 16) * qs[d + 6] + __uint_as_float(kv.w & 0xffff0000u) * qs[d + 7]; }
            s = acc * SCALE + bias; }
        sc[i] = s; mx = fmaxf(mx, s);
    }
    mx = wave_max(mx); if (mx == -INFINITY) mx = 0.f;
    float sum = 0.f;
    for (int i = lane; i < nk; i += 64) { const float s = sc[i]; const float e = (s == -INFINITY) ? 0.f : expf(s - mx); sc[i] = e; sum += e; }
    sum = wave_sum(sum);
    const float inv = 1.0f / fmaxf(sum, 1e-30f);
    __builtin_amdgcn_s_waitcnt(0);
    float a0 = 0.f, a1 = 0.f;
    for (int i = 0; i < nk; ++i) { const float p = sc[i];
        if (p != 0.f) { const bf16_t* kp; const bf16_t* vp; float bias; keyfn(i, kp, vp, bias); a0 += p * bf2f(vp[lane]); a1 += p * bf2f(vp[64 + lane]); } }
    o0 = a0 * inv; o1 = a1 * inv; *inv_sum_out = inv;
}
__global__ __launch_bounds__(128) void dev_fox_kernel(const bf16_t* __restrict__ FQ, const bf16_t* __restrict__ FK, const bf16_t* __restrict__ FV, const float* __restrict__ cum, bf16_t* __restrict__ AO) {
    __shared__ __attribute__((aligned(16))) float qs[2][128];
    __shared__ float sc[2][T];
    const int wave = threadIdx.x >> 6, lane = threadIdx.x & 63;
    const int gw = blockIdx.x * 2 + wave; const int t = gw % T, bh = gw / T, b = bh / 8, h = bh % 8;
    const bf16_t* qrow = FQ + ((size_t)bh * T + t) * 128;
    qs[wave][lane] = bf2f(qrow[lane]); qs[wave][64 + lane] = bf2f(qrow[64 + lane]);
    const float* cu = cum + (size_t)bh * T; const float ct = cu[t];
    const bf16_t* Kb = FK + (size_t)bh * T * 128; const bf16_t* Vb = FV + (size_t)bh * T * 128;
    float o0, o1, inv;
    attend_wave(qs[wave], sc[wave], t + 1, [&](int i, const bf16_t*& kp, const bf16_t*& vp, float& bias) { kp = Kb + (size_t)i * 128; vp = Vb + (size_t)i * 128; bias = ct - cu[i]; return true; }, lane, o0, o1, &inv);
    bf16_t* orow = AO + (size_t)(b * T + t) * DM + h * 128;
    orow[lane] = (bf16_t)(cvt_pk_bf16(o0, 0.f) & 0xffff); orow[64 + lane] = (bf16_t)(cvt_pk_bf16(o1, 0.f) & 0xffff);
}
__global__ __launch_bounds__(128) void dev_nsa_kernel(const bf16_t* __restrict__ NQ, const bf16_t* __restrict__ NQR, const bf16_t* __restrict__ KCMP, const bf16_t* __restrict__ VCMP,
                                                      const bf16_t* __restrict__ KSL, const bf16_t* __restrict__ VSL, const bf16_t* __restrict__ KW, const bf16_t* __restrict__ VW,
                                                      const float* __restrict__ GATES, bf16_t* __restrict__ AO) {
    __shared__ __attribute__((aligned(16))) float qs[2][128];
    __shared__ float sc[2][1024];
    __shared__ float psum[2][256];
    __shared__ float impv[2][64];
    const int wave = threadIdx.x >> 6, lane = threadIdx.x & 63;
    const int gw = blockIdx.x * 2 + wave; const int g = gw & 1, row = gw >> 1, t = row % T, b = row / T;
    float* ps = psum[wave];
    for (int i = lane; i < 256; i += 64) ps[i] = 0.f;
    float oc[4][2], osl[4][2], ow[4][2];
    const bf16_t* KC = KCMP + (size_t)(b * 2 + g) * 256 * 128; const bf16_t* VC = VCMP + (size_t)(b * 2 + g) * 256 * 128;
#pragma unroll
    for (int hh = 0; hh < 4; ++hh) {
        const bf16_t* qrow = NQ + (((size_t)b * 8 + g * 4 + hh) * T + t) * 128;
        qs[wave][lane] = bf2f(qrow[lane]); qs[wave][64 + lane] = bf2f(qrow[64 + lane]);
        float inv;
        attend_wave(qs[wave], sc[wave], NCMP, [&](int i, const bf16_t*& kp, const bf16_t*& vp, float& bias) { kp = KC + (size_t)i * 128; vp = VC + (size_t)i * 128; bias = 0.f; return (16 * i + 31) <= t; }, lane, oc[hh][0], oc[hh][1], &inv);
        for (int i = lane; i < NCMP; i += 64) ps[i] += sc[wave][i] * inv;
    }
    const int qblk = t / 64;
    { const int j = lane; float im = 0.f;
      for (int n = 4 * j - 1; n <= 4 * j + 3; ++n) { if (n < 0 || n >= NCMP) continue; const int lo = max(16 * n, 64 * j), hi = min(16 * n + 32, 64 * j + 64); const int ov = hi - lo; if (ov > 0) im += ps[n] * ((float)ov / 32.f); }
      const bool forced = (j == 0) || (j == qblk) || (j == qblk - 1); const bool causal = j <= qblk;
      impv[wave][j] = forced ? INFINITY : (causal ? im : -INFINITY); }
    unsigned long long selmask;
    { const int j = lane; const float v = impv[wave][j]; int rank = 0;
      for (int jj = 0; jj < 64; ++jj) { const float u = impv[wave][jj]; rank += (u > v || (u == v && jj < j)) ? 1 : 0; }
      selmask = __ballot(rank < 16 && j <= qblk); }
    const int nsel = __popcll(selmask);
    const bf16_t* KS = KSL + (size_t)(b * 2 + g) * T * 128; const bf16_t* VS = VSL + (size_t)(b * 2 + g) * T * 128;
    const bf16_t* KWp = KW + (size_t)(b * 2 + g) * T * 128; const bf16_t* VWp = VW + (size_t)(b * 2 + g) * T * 128;
#pragma unroll
    for (int hh = 0; hh < 4; ++hh) {
        const bf16_t* qrow = NQR + (((size_t)b * 8 + g * 4 + hh) * T + t) * 128;
        qs[wave][lane] = bf2f(qrow[lane]); qs[wave][64 + lane] = bf2f(qrow[64 + lane]);
        float inv;
        attend_wave(qs[wave], sc[wave], nsel * 64, [&](int i, const bf16_t*& kp, const bf16_t*& vp, float& bias) {
            int bi = i >> 6; unsigned long long mm = selmask; for (int z = 0; z < bi; ++z) mm &= mm - 1; const int blk = __ffsll((long long)mm) - 1;
            const int kpos = blk * 64 + (i & 63); kp = KS + (size_t)kpos * 128; vp = VS + (size_t)kpos * 128; bias = 0.f; return kpos <= t; }, lane, osl[hh][0], osl[hh][1], &inv);
        const int w0 = max(0, t - 511);
        attend_wave(qs[wave], sc[wave], t - w0 + 1, [&](int i, const bf16_t*& kp, const bf16_t*& vp, float& bias) { const int kpos = w0 + i; kp = KWp + (size_t)kpos * 128; vp = VWp + (size_t)kpos * 128; bias = 0.f; return true; }, lane, ow[hh][0], ow[hh][1], &inv);
    }
#pragma unroll
    for (int hh = 0; hh < 4; ++hh) { const int head = g * 4 + hh; const float* gp = GATES + (size_t)row * 24 + head * 3; const float g0 = gp[0], g1 = gp[1], g2 = gp[2];
        bf16_t* orow = AO + (size_t)row * DM + 1024 + head * 128;
        orow[lane] = (bf16_t)(cvt_pk_bf16(g0 * oc[hh][0] + g1 * osl[hh][0] + g2 * ow[hh][0], 0.f) & 0xffff);
        orow[64 + lane] = (bf16_t)(cvt_pk_bf16(g0 * oc[hh][1] + g1 * osl[hh][1] + g2 * ow[hh][1], 0.f) & 0xffff); }
}
__global__ __launch_bounds__(256) void dev_build_xb_kernel(const bf16_t* __restrict__ src, const float* __restrict__ pe, float* __restrict__ xb) {
    const int r = blockIdx.x, n = r % NCMP, bg = r / NCMP;
    for (int i = threadIdx.x; i < 4096; i += 256) xb[(size_t)r * 4096 + i] = bf2f(src[((size_t)bg * T + 16 * n) * 128 + i]) + pe[i];
}
template <int EPI>
__global__ __launch_bounds__(256) void dev_gemm_f32(const float* __restrict__ A, int lda, const float* __restrict__ B, int ldb, float* __restrict__ C, int ldc, int Mr, int N, int K) {
    __shared__ float As[16][68]; __shared__ float Bs[16][68];
    const int tid = threadIdx.x, tx = tid & 15, ty = tid >> 4; const int m0 = blockIdx.y * 64, n0 = blockIdx.x * 64;
    float acc[4][4] = {}; const int ar = tid >> 2, ak = (tid & 3) * 4; const int bk = tid >> 4, bn = (tid & 15) * 4;
    for (int k0 = 0; k0 < K; k0 += 16) {
        float4 av = make_float4(0.f, 0.f, 0.f, 0.f), bv = make_float4(0.f, 0.f, 0.f, 0.f);
        if (m0 + ar < Mr) av = *(const float4*)(A + (size_t)(m0 + ar) * lda + k0 + ak);
        if (n0 + bn < N) bv = *(const float4*)(B + (size_t)(k0 + bk) * ldb + n0 + bn);
        __syncthreads();
        As[ak + 0][ar] = av.x; As[ak + 1][ar] = av.y; As[ak + 2][ar] = av.z; As[ak + 3][ar] = av.w; *(float4*)&Bs[bk][bn] = bv;
        __syncthreads();
#pragma unroll
        for (int k = 0; k < 16; ++k) { const float4 a4 = *(const float4*)&As[k][ty * 4]; const float4 b4 = *(const float4*)&Bs[k][tx * 4];
            const float aa[4] = {a4.x, a4.y, a4.z, a4.w}, bb[4] = {b4.x, b4.y, b4.z, b4.w};
#pragma unroll
            for (int i = 0; i < 4; ++i)
#pragma unroll
                for (int j = 0; j < 4; ++j) acc[i][j] += aa[i] * bb[j]; }
    }
#pragma unroll
    for (int i = 0; i < 4; ++i) { const int m = m0 + ty * 4 + i; if (m >= Mr) continue;
#pragma unroll
        for (int j = 0; j < 4; ++j) { const int n = n0 + tx * 4 + j; if (n >= N) continue; float v = acc[i][j]; if (EPI == 2) v = v / (1.f + expf(-v)); C[(size_t)m * ldc + n] = v; } }
}
__global__ __launch_bounds__(64) void dev_cmp_out_kernel(const float* __restrict__ kc, const float* __restrict__ g, bf16_t* __restrict__ dst) {
    const int r = blockIdx.x, n = r & 255, bg = r >> 8, lane = threadIdx.x; bf16_t* o = dst + (size_t)r * 128;
    if (n == 255) { o[lane] = 0; o[64 + lane] = 0; return; }
    const float* p = kc + ((size_t)bg * NCMP + n) * 128; float v0 = p[lane], v1 = p[64 + lane];
    if (g) { const float ss = wave_sum(v0 * v0 + v1 * v1); const float rstd = 1.0f / sqrtf(ss / 128.f + EPS); v0 = v0 * rstd * g[lane]; v1 = v1 * rstd * g[64 + lane]; }
    o[lane] = (bf16_t)(cvt_pk_bf16(v0, 0.f) & 0xffff); o[64 + lane] = (bf16_t)(cvt_pk_bf16(v1, 0.f) & 0xffff);
}

static void launch_phases(const Args& a0, int lo, int hi, int grid, hipStream_t stream) {
    Args a = a0; a.ph_lo = lo; a.ph_hi = hi; void* args[] = {&a};
    hipError_t e = hipLaunchCooperativeKernel((void*)mega_kernel, dim3(grid), dim3(NTHR), args, LDS_BYTES, stream);
    if (e != hipSuccess) fprintf(stderr, "cooperative launch failed: %s (grid %d)\n", hipGetErrorString(e), grid);
}

extern "C" void kernel_launch(void* const* d_in, const int* in_sizes, int n_in, void* d_out, int out_size, void* d_ws, size_t ws_size, hipStream_t stream) {
    static int grid = 0;
    if (grid == 0) {
        int dev = 0, cus = 0, per_cu = 0; hipGetDevice(&dev); hipDeviceGetAttribute(&cus, hipDeviceAttributeMultiprocessorCount, dev);
        hipFuncSetAttribute((const void*)mega_kernel, hipFuncAttributeMaxDynamicSharedMemorySize, LDS_BYTES);
        hipOccupancyMaxActiveBlocksPerMultiprocessor(&per_cu, (const void*)mega_kernel, NTHR, LDS_BYTES);
        if (per_cu < 1) { fprintf(stderr, "occupancy query says %d blocks/CU\n", per_cu); per_cu = 1; }
        grid = cus;
        if (ws_size < WS_END + 24 * MiB) fprintf(stderr, "workspace too small: %zu\n", ws_size);
    }
    hipMemsetAsync((char*)d_ws + WS_CTL, 0, 4096, stream);
    Args a{};
    const float** ap = (const float**)&a;
    for (int i = 0; i < 23; ++i) ap[i] = (const float*)d_in[i];
    a.out = (float*)d_out; a.ws = (unsigned char*)d_ws;
    unsigned char* ws = a.ws;
    launch_phases(a, PH_PRO, PH_END, grid, stream);
}
```

```cpp
#include <hip/hip_runtime.h>
#include <hip/hip_cooperative_groups.h>
#include <stdint.h>
#include <math.h>
#include <cstdio>
namespace cg = cooperative_groups;
#define NF_IN 3

constexpr int DM = 2048, NB = 2, T = 4096, M = NB * T, HD = 128;
constexpr int DIN = 5664, DFF = 8192, NPAD = 5888;
constexpr int C_FQ = 0, C_FK = 1024, C_FV = 2048, C_FZ = 3072, C_NQ = 3080, C_KC = 4104, C_VC = 4360, C_KSL = 4616, C_VSL = 4872,
              C_KW = 5128, C_VW = 5384, C_GZ = 5640;
constexpr int NCMP = 255;
constexpr float SCALE = 0.08838834764831845f;
constexpr float EPS = 1e-6f;
constexpr int NWAVES = 8, NTHR = 512;

constexpr size_t MiB = 1u << 20;
constexpr size_t WS_CTL = 0;
constexpr size_t CTL_CNT_GATE = 21504;
constexpr size_t CTL_CNT_KCVC = 20480, CTL_CNT_PART = 20736, CTL_CNT_ADALN = 20992, CTL_CNT_PANEL = 32768, CTL_CNT_ATTN = 40960;
constexpr size_t WS_SLOTS = 64 * 1024;
constexpr size_t WS_MODP = 384 * 1024;
constexpr size_t WS_MOD = 2 * MiB;
constexpr size_t WS_ROPE = 3 * MiB;
constexpr size_t WS_PEBP = 5 * MiB;
constexpr size_t WS_PEB = 5 * MiB + 256 * 1024;
constexpr size_t WS_MBOUND = 5 * MiB + 300 * 1024;
constexpr size_t WS_LOGF = 5 * MiB + 320 * 1024;
constexpr size_t WS_KBIAS = 5 * MiB + 640 * 1024;
constexpr size_t WS_GATES = 6 * MiB;
constexpr size_t WS_W2T = 7 * MiB;
constexpr size_t WS_W1T = 8 * MiB;
constexpr size_t WS_WIN = 12 * MiB;
constexpr size_t WS_WOUT = 36 * MiB;
constexpr size_t WS_WUP = 44 * MiB;
constexpr size_t WS_WDN = 76 * MiB;
constexpr size_t WS_XN = 108 * MiB;
constexpr size_t WS_FQ = 140 * MiB, WS_FK = 156 * MiB, WS_FV = 172 * MiB, WS_NQ = 188 * MiB, WS_NQR = 204 * MiB;
constexpr size_t WS_KC = 220 * MiB, WS_VC = 224 * MiB, WS_KSL = 228 * MiB, WS_VSL = 232 * MiB, WS_KW = 236 * MiB, WS_VW = 240 * MiB;
constexpr size_t WS_KCMP = 244 * MiB, WS_VCMP = 244 * MiB + 512 * 1024;
constexpr size_t WS_PART = 245 * MiB;
constexpr size_t WS_NSAO = 277 * MiB;
constexpr size_t WS_AO = 309 * MiB;
constexpr size_t WS_U = 140 * MiB;
constexpr size_t WS_END = 341 * MiB;
constexpr size_t WS_DEV_CUM = 341 * MiB;
constexpr size_t WS_DEV_XB = 342 * MiB;
constexpr size_t WS_DEV_HID = 358 * MiB;
constexpr size_t WS_DEV_KC = 360 * MiB;

constexpr int LDS_STATS = 131072;
constexpr int LDS_BYTES = 155648;

#define LAS __attribute__((address_space(3)))
#define GAS __attribute__((address_space(1)))
typedef unsigned short bf16_t;
typedef short bf16x8 __attribute__((ext_vector_type(8)));
typedef float f32x4 __attribute__((ext_vector_type(4)));
typedef float f32x2 __attribute__((ext_vector_type(2)));
typedef unsigned u32x4 __attribute__((ext_vector_type(4)));
typedef unsigned u32x2 __attribute__((ext_vector_type(2)));

typedef __bf16 bf16x2_t __attribute__((ext_vector_type(2)));
__device__ __forceinline__ unsigned cvt_pk_bf16(float lo, float hi) { f32x2 v = {lo, hi}; bf16x2_t b = __builtin_convertvector(v, bf16x2_t); return __builtin_bit_cast(unsigned, b); }
__device__ __forceinline__ float bf2f(bf16_t v) { return __uint_as_float(((unsigned)v) << 16); }
__device__ __forceinline__ float wave_sum(float v) {
#pragma unroll
    for (int o = 1; o < 64; o <<= 1) v += __shfl_xor(v, o);
    return v;
}
__device__ __forceinline__ float wave_max(float v) {
#pragma unroll
    for (int o = 1; o < 64; o <<= 1) v = fmaxf(v, __shfl_xor(v, o));
    return v;
}


__device__ __forceinline__ void handoff_signal(unsigned* cnt, int lane) {
    asm volatile("s_waitcnt vmcnt(0)" ::: "memory");
    if (lane == 0) __hip_atomic_fetch_add(cnt, 1u, __ATOMIC_RELAXED, __HIP_MEMORY_SCOPE_AGENT);
}
__device__ __forceinline__ void handoff_wait(unsigned* cnt, unsigned target) {
    if (threadIdx.x < 64) { unsigned sp = 0;
        while ((unsigned)__builtin_amdgcn_readfirstlane(__hip_atomic_load(cnt, __ATOMIC_RELAXED, __HIP_MEMORY_SCOPE_AGENT)) < target) { __builtin_amdgcn_s_sleep(4); if (++sp > (1u << 24)) break; }
        __builtin_amdgcn_fence(__ATOMIC_ACQUIRE, "agent"); asm volatile("s_waitcnt vmcnt(0)" ::: "memory"); }
    __syncthreads();
}

namespace pg8 {
constexpr int BM = 256, BK = 64, HALF = 128, HTB = HALF * BK * 2, STAGE_BYTES = 8 * HTB, NXCD = 8, WGM = 8;
__host__ __device__ __forceinline__ int lds_byte(int r, int c) { const int st = (r >> 4) * 2 + (c >> 5), rr = r & 15, cc = c & 31, ob = rr * 64 + cc * 2; return st * 1024 + (ob ^ (((ob >> 9) & 1) << 5)); }
__host__ __device__ __forceinline__ void stage_rc(int b, int& R, int& C) { const int st = b / 1024, sb = b % 1024, swz = sb ^ (((sb >> 9) & 1) << 5); R = (st >> 1) * 16 + swz / 64; C = (st & 1) * 32 + (swz % 64) / 2; }
__host__ __device__ __forceinline__ int perm32(int rho) { const int n = rho >> 4, i = rho & 15; return 8 * (i >> 2) + 4 * n + (i & 3); }

struct Unit { int pm, pn, aux; };
#define NF_ERN 3
#define NF_RES 4
#ifndef NF_IN
#define NF_IN 2
#endif

struct StaticOrder {
    int nM, nN, nwg, G, c; const char* A; const char* Bt; size_t tsA, tsB; int rm = 0;
    __device__ __forceinline__ void init(int M_, int N_, int G_, int c_, const void* A_, const void* Bt_, int lda, int ldb) { nM = M_ / BM; nN = N_ / BM; nwg = nM * nN; G = G_; c = c_; A = (const char*)A_; Bt = (const char*)Bt_; tsA = (size_t)BM * lda * 2; tsB = (size_t)BM * ldb * 2; }
    __device__ __forceinline__ bool next(int i, Unit& u) const {
        const long L = (long)i * G + c; if (L >= nwg) return false;
        int wgid = (int)L; { const int q = nwg / NXCD, r = nwg % NXCD, xcd = wgid % NXCD, off = wgid / NXCD; wgid = (xcd < r ? xcd * (q + 1) : r * (q + 1) + (xcd - r) * q) + off; }
        const int nig = WGM * nN, gid = wgid / nig, fm = gid * WGM, gsz = (nM - fm) < WGM ? (nM - fm) : WGM;
        u.pm = fm + ((wgid % nig) % gsz); u.pn = (wgid % nig) / gsz; u.aux = 0;
        if (rm) { const int p = u.pn; u.pn = (int)(((p < 12 ? 0x4a0e6734a418820ull : 0x5ab49ad507b251ull) >> (5 * (p < 12 ? p : p - 12))) & 31ull); }
        return true;
    }
    __device__ __forceinline__ void ptrs(const Unit& u, const char*& a, const char*& b) const { a = A + (size_t)u.pm * tsA; b = Bt + (size_t)u.pn * tsB; }
};

template <class Epi, class Sched>
__device__ __forceinline__ void gemm_phase(LAS unsigned char* lds, const int lda, const int ldb, const int K, const Sched& S, const Epi& E) {
    int tid = threadIdx.x; asm volatile("" : "+v"(tid));
    const int wid = __builtin_amdgcn_readfirstlane(tid >> 6), lane = tid & 63, wr = wid >> 2, wc = wid & 3, fr = lane & 15, fq = lane >> 4;
    const int nt = K / BK;
    unsigned voffA[2], voffB[2];
#pragma unroll
    for (int i = 0; i < 2; ++i) { int R, C; stage_rc(tid * 16 + i * 8192, R, C); const int Rb = Epi::PERM ? ((R & ~31) + perm32(R & 31)) : R;
        voffA[i] = (unsigned)(R * lda + C) * 2u; voffB[i] = (unsigned)(Rb * ldb + C) * 2u; }
    const size_t kstep = (size_t)(BK * 2);
    const size_t hsA = (size_t)HALF * lda * 2, hsB = (size_t)HALF * ldb * 2;
    const unsigned ldsw = (unsigned)wid * 1024u;
    const int aoff = lds_byte(wr * 64 + fr, fq * 8), boff = lds_byte(wc * 32 + fr, fq * 8);
#define PG8_SA(b, h) (((b) * 2 + (h)) * HTB)
#define PG8_SB(b, h) ((4 + (b) * 2 + (h)) * HTB)
#define PG8_STAGE(bufoff, gbase, voff) do { _Pragma("unroll") for (int _i = 0; _i < 2; ++_i) \
        __builtin_amdgcn_global_load_lds((const unsigned*)((const char*)(gbase) + (voff)[_i]), (LAS unsigned*)(lds + (bufoff) + ldsw + _i * 8192), 16, 0, 0); } while (0)
#define PG8_LDA(dst, b, h) do { _Pragma("unroll") for (int m = 0; m < 4; ++m) _Pragma("unroll") for (int k = 0; k < 2; ++k) dst[m][k] = *(const LAS bf16x8*)(lds + PG8_SA(b, h) + aoff + m * 2048 + k * 1024); } while (0)
#define PG8_LDB(dst, b, h) do { _Pragma("unroll") for (int n = 0; n < 2; ++n) _Pragma("unroll") for (int k = 0; k < 2; ++k) dst[n][k] = *(const LAS bf16x8*)(lds + PG8_SB(b, h) + boff + n * 2048 + k * 1024); } while (0)
#define PG8_MMA(ai, bj, At, Bt) do { __builtin_amdgcn_s_setprio(1); _Pragma("unroll") for (int m = 0; m < 4; ++m) _Pragma("unroll") for (int n = 0; n < 2; ++n) _Pragma("unroll") for (int k = 0; k < 2; ++k) \
        acc[ai][bj][m][n] = __builtin_amdgcn_mfma_f32_16x16x32_bf16(Bt[n][k], At[m][k], acc[ai][bj][m][n], 0, 0, 0); __builtin_amdgcn_s_setprio(0); } while (0)
#define PG8_WAIT_V(n) asm volatile("s_waitcnt vmcnt(" #n ")" ::: "memory")
#define PG8_WAIT_VX do { static_assert(Epi::NS == 0 || Epi::NS == 16, "unit-boundary wait count"); asm volatile("s_waitcnt vmcnt(24)" ::: "memory"); } while (0)
#define PG8_WAIT_L(n) asm volatile("s_waitcnt lgkmcnt(" #n ")" ::: "memory")
#define PG8_BAR __builtin_amdgcn_s_barrier()
#define PG8_SCHED __builtin_amdgcn_sched_barrier(0)
    Unit cur, nxt; int ui = 0; bool fresh = false;
    if (!S.next(0, cur)) return;
    f32x4 acc[2][2][4][2];
#pragma unroll
    for (int a = 0; a < 2; ++a)
#pragma unroll
        for (int b = 0; b < 2; ++b)
#pragma unroll
            for (int m = 0; m < 4; ++m)
#pragma unroll
                for (int n = 0; n < 2; ++n) acc[a][b][m][n] = (f32x4){0.f, 0.f, 0.f, 0.f};
    bf16x8 At[4][2], B0[2][2], B1[2][2];
    const char* cA; const char* cB; S.ptrs(cur, cA, cB);
    PG8_STAGE(PG8_SB(0, 0), cB, voffB); PG8_STAGE(PG8_SB(0, 1), cB + hsB, voffB); PG8_STAGE(PG8_SA(0, 0), cA, voffA); PG8_STAGE(PG8_SA(0, 1), cA + hsA, voffA);
    if (wr == 1) PG8_BAR;
    PG8_WAIT_V(2); PG8_BAR;
    PG8_STAGE(PG8_SB(1, 0), cB + kstep, voffB); PG8_STAGE(PG8_SA(1, 0), cA + kstep, voffA); PG8_STAGE(PG8_SB(1, 1), cB + hsB + kstep, voffB);
    PG8_WAIT_V(6); PG8_BAR;
    if constexpr (Epi::PREFETCH) E.prefetch(cur, lds + STAGE_BYTES, wid, lane);
    for (;;) {
        const bool has_next = S.next(ui + 1, nxt);
        const char* nA = cA; const char* nB = cB; if (has_next) S.ptrs(nxt, nA, nB);
#pragma nounroll
        for (int t = 0; t < nt; t += 2) {
            const bool last = (t == nt - 2);
            const char* a1 = cA + (size_t)(t + 1) * kstep;
            const char* a2 = last ? nA : cA + (size_t)(t + 2) * kstep; const char* b2 = last ? nB : cB + (size_t)(t + 2) * kstep;
            const char* a3 = a2 + kstep; const char* b3 = b2 + kstep;
            const bool fz = (Epi::NS > 0) && fresh && t == 0;
            PG8_LDB(B0, 0, 0); PG8_LDB(B1, 0, 1); PG8_SCHED; PG8_LDA(At, 0, 0); PG8_STAGE(PG8_SA(1, 1), a1 + hsA, voffA);
            if (fz) PG8_WAIT_VX; else PG8_WAIT_V(8);
            PG8_WAIT_L(0); PG8_BAR; PG8_MMA(0, 0, At, B0); PG8_MMA(0, 1, At, B1); PG8_BAR; PG8_SCHED;
            PG8_LDA(At, 0, 1); PG8_STAGE(PG8_SB(0, 0), b2, voffB); PG8_STAGE(PG8_SB(0, 1), b2 + hsB, voffB); PG8_STAGE(PG8_SA(0, 0), a2, voffA);
            if (fz) PG8_WAIT_VX; else PG8_WAIT_V(8);
            PG8_WAIT_L(0); PG8_BAR; PG8_MMA(1, 0, At, B0); PG8_MMA(1, 1, At, B1); PG8_BAR; PG8_SCHED;
            PG8_LDB(B0, 1, 0); PG8_LDB(B1, 1, 1); PG8_SCHED; PG8_LDA(At, 1, 0); PG8_STAGE(PG8_SA(0, 1), a2 + hsA, voffA);
            PG8_WAIT_V(8); PG8_WAIT_L(0); PG8_BAR; PG8_MMA(0, 0, At, B0); PG8_MMA(0, 1, At, B1); PG8_BAR; PG8_SCHED;
            PG8_LDA(At, 1, 1); PG8_STAGE(PG8_SB(1, 0), b3, voffB); PG8_STAGE(PG8_SB(1, 1), b3 + hsB, voffB); PG8_STAGE(PG8_SA(1, 0), a3, voffA);
            PG8_WAIT_V(8); PG8_WAIT_L(0); PG8_BAR; PG8_MMA(1, 0, At, B0); PG8_MMA(1, 1, At, B1); PG8_BAR; PG8_SCHED;
        }
        if (wr == 0) PG8_BAR;
        E(acc, cur, wr, wc, fr, fq);
        if (!has_next) break;
#pragma unroll
        for (int a = 0; a < 2; ++a)
#pragma unroll
            for (int b = 0; b < 2; ++b)
#pragma unroll
                for (int m = 0; m < 4; ++m)
#pragma unroll
                    for (int n = 0; n < 2; ++n) acc[a][b][m][n] = (f32x4){0.f, 0.f, 0.f, 0.f};
        cur = nxt; cA = nA; cB = nB; ++ui; fresh = true;
        if (wr == 1) PG8_BAR;
    }
    PG8_WAIT_V(0);
    PG8_BAR;
#undef PG8_SA
#undef PG8_SB
#undef PG8_STAGE
#undef PG8_LDA
#undef PG8_LDB
#undef PG8_MMA
#undef PG8_WAIT_V
#undef PG8_WAIT_VX
#undef PG8_WAIT_L
#undef PG8_BAR
#undef PG8_SCHED
}


struct EpiRes {
    static constexpr int NS = 0; static constexpr bool PERM = true, PREFETCH = false;
    const float* base; float* out; const float* gate;
    __device__ __forceinline__ void prefetch(const Unit& u, LAS unsigned char* dummy, int wid, int lane) const {
        const float* p = base + (size_t)(u.pm * BM + wid * 32) * DM + u.pn * BM + lane * 4;
#pragma unroll 8
        for (int r = 0; r < 32; ++r) __builtin_amdgcn_global_load_lds((const unsigned*)(p + (size_t)r * DM), (LAS unsigned*)(dummy + wid * 1024), 16, 0, 0);
    }
    __device__ __forceinline__ void operator()(const f32x4 (&acc)[2][2][4][2], const Unit& u, int wr, int wc, int fr, int fq) const {
        const int row0 = u.pm * BM + wr * 64 + fr, col0 = u.pn * BM + wc * 32 + 8 * fq;
        const int b = (u.pm * BM) / T;
        f32x4 gv[2][2];
#pragma unroll
        for (int bj = 0; bj < 2; ++bj)
#pragma unroll
            for (int n = 0; n < 2; ++n) gv[bj][n] = *(const f32x4*)(gate + (size_t)b * 6 * DM + col0 + bj * HALF + 4 * n);
        f32x4 bs[NF_RES][2][2];
#define ER_LD(g) do { const size_t off_ = (size_t)(row0 + ((g) >> 2) * HALF + ((g) & 3) * 16) * DM + col0; _Pragma("unroll") for (int bj = 0; bj < 2; ++bj) _Pragma("unroll") for (int n = 0; n < 2; ++n) \
            bs[(g) % NF_RES][bj][n] = *(const f32x4*)(base + off_ + bj * HALF + 4 * n); } while (0)
        _Pragma("unroll") for (int g = 0; g < NF_RES; ++g) ER_LD(g);
        asm volatile("" ::: "memory");
#pragma unroll
        for (int g = 0; g < 8; ++g) { const int ai = g >> 2, m = g & 3; const size_t off = (size_t)(row0 + ai * HALF + m * 16) * DM + col0;
            f32x4 r[2][2];
#pragma unroll
            for (int bj = 0; bj < 2; ++bj)
#pragma unroll
                for (int n = 0; n < 2; ++n) r[bj][n] = bs[g % NF_RES][bj][n] + gv[bj][n] * acc[ai][bj][m][n];
            if (g + NF_RES < 8) ER_LD(g + NF_RES);
#pragma unroll
            for (int bj = 0; bj < 2; ++bj)
#pragma unroll
                for (int n = 0; n < 2; ++n) *(f32x4*)(out + off + bj * HALF + 4 * n) = r[bj][n];
            asm volatile("" ::: "memory"); }
#undef ER_LD
    }
};

struct EpiResNorm {
    static constexpr int NS = 0; static constexpr bool PERM = true, PREFETCH = false;
    const float* base; float* out; const float* mod; const float* g2; bf16_t* XN; float* slots; unsigned* cnt; LAS float* tab;
    __device__ __forceinline__ void prefetch(const Unit& u, LAS unsigned char* dummy, int wid, int lane) const {
        const float* p = base + (size_t)(u.pm * BM + wid * 32) * DM + u.pn * BM + lane * 4;
#pragma unroll 8
        for (int r = 0; r < 32; ++r) __builtin_amdgcn_global_load_lds((const unsigned*)(p + (size_t)r * DM), (LAS unsigned*)(dummy + wid * 1024), 16, 0, 0);
    }
    __device__ __forceinline__ void operator()(f32x4 (&acc)[2][2][4][2], const Unit& u, int wr, int wc, int fr, int fq) const {
        const int row0 = u.pm * BM + wr * 64 + fr, col0 = u.pn * BM + wc * 32 + 8 * fq;
        const int b = (u.pm * BM) / T; const int wid = wr * 4 + wc, lane = fr + 16 * fq;
        const float* mb = mod + (size_t)b * 6 * DM;
        {   f32x4 gv[2][2];
#pragma unroll
            for (int bj = 0; bj < 2; ++bj)
#pragma unroll
                for (int n = 0; n < 2; ++n) gv[bj][n] = *(const f32x4*)(mb + 2 * DM + col0 + bj * HALF + 4 * n);
            f32x4 bs[NF_ERN][2][2];
#define ER_LD(g) do { const size_t off_ = (size_t)(row0 + ((g) >> 2) * HALF + ((g) & 3) * 16) * DM + col0; _Pragma("unroll") for (int bj = 0; bj < 2; ++bj) _Pragma("unroll") for (int n = 0; n < 2; ++n) \
            bs[(g) % NF_ERN][bj][n] = *(const f32x4*)(base + off_ + bj * HALF + 4 * n); } while (0)
            _Pragma("unroll") for (int g = 0; g < NF_ERN; ++g) ER_LD(g);
            asm volatile("" ::: "memory");
#pragma unroll
            for (int g = 0; g < 8; ++g) { const int ai = g >> 2, m = g & 3; float ss = 0.f;
#pragma unroll
                for (int bj = 0; bj < 2; ++bj)
#pragma unroll
                    for (int n = 0; n < 2; ++n) { const f32x4 v = bs[g % NF_ERN][bj][n] + gv[bj][n] * acc[ai][bj][m][n];
                        acc[ai][bj][m][n] = v; ss += (v[0] * v[0] + v[1] * v[1]) + (v[2] * v[2] + v[3] * v[3]); }
                if (g + NF_ERN < 8) ER_LD(g + NF_ERN);
                ss += __shfl_xor(ss, 16); ss += __shfl_xor(ss, 32);
                if (fq == 0) tab[(ai * HALF + wr * 64 + m * 16 + fr) * 4 + wc] = ss;
                asm volatile("" ::: "memory"); }
#undef ER_LD
        }
        asm volatile("s_waitcnt lgkmcnt(0)" ::: "memory"); __builtin_amdgcn_s_barrier(); asm volatile("" ::: "memory");
        const int prow = wid * 32 + (lane & 31);
        if (lane < 32) { const f32x4 q = *(const LAS f32x4*)(tab + prow * 4);
            __hip_atomic_store((unsigned*)slots + ((size_t)(u.pm * BM + prow) * 8 + u.pn), __float_as_uint((q[0] + q[1]) + (q[2] + q[3])), __ATOMIC_RELAXED, __HIP_MEMORY_SCOPE_AGENT); }
        asm volatile("s_waitcnt vmcnt(0)" ::: "memory");
        if (lane == 0) __hip_atomic_fetch_add(cnt + 64 * u.pm, 1u, __ATOMIC_RELAXED, __HIP_MEMORY_SCOPE_AGENT);
        f32x4 av[2][2], sv[2][2];
#pragma unroll
        for (int bj = 0; bj < 2; ++bj)
#pragma unroll
            for (int n = 0; n < 2; ++n) { const int c = col0 + bj * HALF + 4 * n; const f32x4 gg = *(const f32x4*)(g2 + c), sc = *(const f32x4*)(mb + 4 * DM + c);
                av[bj][n] = gg * (sc + 1.f); sv[bj][n] = *(const f32x4*)(mb + 3 * DM + c); }
        if (wid == 0) { unsigned sp = 0;
            while ((unsigned)__builtin_amdgcn_readfirstlane(__hip_atomic_load(cnt + 64 * u.pm, __ATOMIC_RELAXED, __HIP_MEMORY_SCOPE_AGENT)) < 64u) { __builtin_amdgcn_s_sleep(2); if (++sp > (1u << 22)) break; }
            __builtin_amdgcn_fence(__ATOMIC_ACQUIRE, "agent"); }
        asm volatile("s_waitcnt vmcnt(0) lgkmcnt(0)" ::: "memory"); __builtin_amdgcn_s_barrier(); asm volatile("" ::: "memory");
        if (lane < 32) { const unsigned* sl = (const unsigned*)slots + (size_t)(u.pm * BM + prow) * 8; float tot = 0.f;
#pragma unroll
            for (int t = 0; t < 8; ++t) tot += __uint_as_float(__hip_atomic_load(sl + t, __ATOMIC_RELAXED, __HIP_MEMORY_SCOPE_AGENT));
            tab[1024 + prow] = __builtin_amdgcn_rsqf(tot * (1.f / DM) + EPS); }
        asm volatile("s_waitcnt vmcnt(0) lgkmcnt(0)" ::: "memory"); __builtin_amdgcn_s_barrier(); asm volatile("" ::: "memory");
#pragma unroll
        for (int ai = 0; ai < 2; ++ai)
#pragma unroll
            for (int m = 0; m < 4; ++m) { const int rl = ai * HALF + wr * 64 + m * 16 + fr; const float rstd = tab[1024 + rl]; const size_t off = (size_t)(u.pm * BM + rl) * DM + col0;
#pragma unroll
                for (int bj = 0; bj < 2; ++bj) {
                    *(f32x4*)(out + off + bj * HALF) = acc[ai][bj][m][0]; *(f32x4*)(out + off + bj * HALF + 4) = acc[ai][bj][m][1];
                    const f32x4 h0 = acc[ai][bj][m][0] * rstd * av[bj][0] + sv[bj][0], h1 = acc[ai][bj][m][1] * rstd * av[bj][1] + sv[bj][1];
                    u32x4 w; w.x = cvt_pk_bf16(h0[0], h0[1]); w.y = cvt_pk_bf16(h0[2], h0[3]); w.z = cvt_pk_bf16(h1[0], h1[1]); w.w = cvt_pk_bf16(h1[2], h1[3]);
                    *(u32x4*)(XN + off + bj * HALF) = w; }
                asm volatile("" ::: "memory"); }
    }
};
struct EpiUp {
    static constexpr int NS = 16;   static constexpr bool PERM = true, PREFETCH = false;
    bf16_t* O; int ldc;
    __device__ __forceinline__ void operator()(const f32x4 (&acc)[2][2][4][2], const Unit& u, int wr, int wc, int fr, int fq) const {
        const int row0 = u.pm * BM + wr * 64 + fr, col0 = u.pn * BM + wc * 32 + 8 * fq;
#pragma unroll
        for (int ai = 0; ai < 2; ++ai)
#pragma unroll
            for (int m = 0; m < 4; ++m) { bf16_t* rowp = O + (size_t)(row0 + ai * HALF + m * 16) * ldc + col0;
#pragma unroll
                for (int bj = 0; bj < 2; ++bj) { f32x4 v0 = acc[ai][bj][m][0], v1 = acc[ai][bj][m][1];
                    v0 = __builtin_elementwise_max(v0, (f32x4){0.f, 0.f, 0.f, 0.f}); v1 = __builtin_elementwise_max(v1, (f32x4){0.f, 0.f, 0.f, 0.f}); v0 = v0 * v0; v1 = v1 * v1;
                    u32x4 w; w.x = cvt_pk_bf16(v0[0], v0[1]); w.y = cvt_pk_bf16(v0[2], v0[3]); w.z = cvt_pk_bf16(v1[0], v1[1]); w.w = cvt_pk_bf16(v1[2], v1[3]);
                    *(u32x4*)(rowp + bj * HALF) = w; } }
    }
};
struct EpiIn {
    static constexpr int NS = 0; static constexpr bool PERM = true, PREFETCH = false;
    unsigned char* wsb;
    const float *g_fq, *g_fk, *g_nq, *g_slc, *g_win, *b_forget; LAS float* stats; unsigned* kcvc_cnt; unsigned* gate_cnt;
    __device__ __forceinline__ void operator()(const f32x4 (&acc)[2][2][4][2], const Unit& u, int wr, int wc, int fr, int fq) const {
        const int pn = u.pn;
        unsigned char* w_ = wsb; asm volatile("" : "+s"(w_));
        GAS bf16_t* const FQ = (GAS bf16_t*)(w_ + WS_FQ); GAS bf16_t* const FK = (GAS bf16_t*)(w_ + WS_FK); GAS bf16_t* const FV = (GAS bf16_t*)(w_ + WS_FV); GAS bf16_t* const NQ = (GAS bf16_t*)(w_ + WS_NQ); GAS bf16_t* const NQR = (GAS bf16_t*)(w_ + WS_NQR);
        GAS bf16_t* const KC = (GAS bf16_t*)(w_ + WS_KC); GAS bf16_t* const VC = (GAS bf16_t*)(w_ + WS_VC); GAS bf16_t* const KSL = (GAS bf16_t*)(w_ + WS_KSL); GAS bf16_t* const VSL = (GAS bf16_t*)(w_ + WS_VSL); GAS bf16_t* const KW = (GAS bf16_t*)(w_ + WS_KW); GAS bf16_t* const VW = (GAS bf16_t*)(w_ + WS_VW);
        GAS float* const LOGF = (GAS float*)(w_ + WS_LOGF); GAS float* const GATES = (GAS float*)(w_ + WS_GATES); const GAS float* const rope = (const GAS float*)(w_ + WS_ROPE);
        const int b = u.pm >> 4, t0 = (u.pm & 15) * BM + wr * 64 + fr;
        if (pn == 12) {
            if (wc == 0) {
#pragma unroll
                for (int ai = 0; ai < 2; ++ai)
#pragma unroll
                    for (int m = 0; m < 4; ++m) { const int t = t0 + ai * HALF + m * 16;
#pragma unroll
                        for (int n = 0; n < 2; ++n)
#pragma unroll
                            for (int e = 0; e < 4; ++e) { const int p = 8 * fq + 4 * n + e; const float v = acc[ai][0][m][n][e];
                                if (p < 8) { const float z = v + b_forget[p]; __hip_atomic_store((GAS unsigned*)(LOGF + ((size_t)b * 8 + p) * T + t), __float_as_uint(fminf(z, 0.f) - __logf(1.f + __expf(-fabsf(z)))), __ATOMIC_RELAXED, __HIP_MEMORY_SCOPE_AGENT); }
                                else { GATES[((size_t)b * T + t) * 24 + (p - 8)] = 1.f / (1.f + __expf(-v)); } } }
            }
            handoff_signal(gate_cnt, fr + 16 * fq);
            return;
        }
        if (pn < 4) body<true, true, false, false>(acc, u, wr, wc, fr, fq, FQ, nullptr, g_fq, rope, 8, 2 * pn);
        else if (pn < 8) body<true, true, false, false>(acc, u, wr, wc, fr, fq, FK, nullptr, g_fk, rope, 8, 2 * (pn - 4));
        else if (pn < 12) body<false, true, false, false>(acc, u, wr, wc, fr, fq, FV, nullptr, nullptr, rope, 8, 2 * (pn - 8));
        else if (pn < 17) body<true, true, true, false>(acc, u, wr, wc, fr, fq, NQ, NQR, g_nq, rope, 8, 2 * (pn - 13));
        else if (pn < 19) body<false, true, false, true>(acc, u, wr, wc, fr, fq, pn == 17 ? KC : VC, nullptr, nullptr, rope, 2, 0);
        else if (pn < 21) body<true, false, true, false>(acc, u, wr, wc, fr, fq, nullptr, pn == 19 ? KSL : KW, pn == 19 ? g_slc : g_win, rope, 2, 0);
        else body<false, true, false, false>(acc, u, wr, wc, fr, fq, pn == 21 ? VSL : VW, nullptr, nullptr, rope, 2, 0);
    }
    template <bool NORM, bool D1, bool D2, bool WT>
    __device__ __forceinline__ void body(const f32x4 (&acc)[2][2][4][2], const Unit& u, int wr, int wc, int fr, int fq, GAS bf16_t* d1, GAS bf16_t* d2, const float* gain, const GAS float* rope, int nh, int h0) const {
        const int b = u.pm >> 4, t0 = (u.pm & 15) * BM + wr * 64 + fr;
        const int dlo = 16 * wc + 4 * fq;
        f32x4 g0 = (f32x4){1.f, 1.f, 1.f, 1.f}, g1 = g0;
        if (NORM) { g0 = *(const f32x4*)(gain + dlo); g1 = *(const f32x4*)(gain + 64 + dlo); }
        f32x4 cs[NF_IN][2];
#define EI_LD(g) do { const int tn_ = t0 + ((g) >> 2) * HALF + ((g) & 3) * 16; const GAS float* rp_ = rope + ((size_t)tn_ * 64 + dlo) * 2; cs[(g) % NF_IN][0] = *(const GAS f32x4*)rp_; cs[(g) % NF_IN][1] = *(const GAS f32x4*)(rp_ + 4); } while (0)
        if (D2) { _Pragma("unroll") for (int g = 0; g < NF_IN; ++g) EI_LD(g); }
        if (NORM) {
#pragma unroll
            for (int ai = 0; ai < 2; ++ai)
#pragma unroll
                for (int m = 0; m < 4; ++m)
#pragma unroll
                    for (int bj = 0; bj < 2; ++bj) { const f32x4 a = acc[ai][bj][m][0], c = acc[ai][bj][m][1];
                        float s = (a[0] * a[0] + a[1] * a[1]) + (a[2] * a[2] + a[3] * a[3]) + (c[0] * c[0] + c[1] * c[1]) + (c[2] * c[2] + c[3] * c[3]);
                        { const unsigned x = __float_as_uint(s); const auto r = __builtin_amdgcn_permlane32_swap(x, x, false, false); s = __uint_as_float(r[0]) + __uint_as_float(r[1]); }
                        { const unsigned x = __float_as_uint(s); const auto r = __builtin_amdgcn_permlane16_swap(x, x, false, false); s = __uint_as_float(r[0]) + __uint_as_float(r[1]); }
                        if (fq == 0) stats[(ai * HALF + wr * 64 + m * 16 + fr) * 8 + bj * 4 + wc] = s; }
            asm volatile("s_waitcnt lgkmcnt(0)" ::: "memory"); __builtin_amdgcn_s_barrier(); asm volatile("" ::: "memory");
        }
#pragma unroll
        for (int g = 0; g < 8; ++g) { const int ai = g >> 2, m = g & 3; const int t = t0 + ai * HALF + m * 16;
            float rsv[2] = {1.f, 1.f};
            if (NORM) {
#pragma unroll
                for (int bj = 0; bj < 2; ++bj) { const f32x4 q = *(const LAS f32x4*)(stats + (ai * HALF + wr * 64 + m * 16 + fr) * 8 + bj * 4);
                    rsv[bj] = __builtin_amdgcn_rsqf(((q[0] + q[1]) + (q[2] + q[3])) * (1.f / 128.f) + EPS); } }
            f32x4 c = g0, sn = g0;
            if (D2) { c = (f32x4){cs[g % NF_IN][0][0], cs[g % NF_IN][0][2], cs[g % NF_IN][1][0], cs[g % NF_IN][1][2]}; sn = (f32x4){cs[g % NF_IN][0][1], cs[g % NF_IN][0][3], cs[g % NF_IN][1][1], cs[g % NF_IN][1][3]}; }
            if (D2 && g + NF_IN < 8) EI_LD(g + NF_IN);
#pragma unroll
            for (int bj = 0; bj < 2; ++bj) { f32x4 v0 = acc[ai][bj][m][0], v1 = acc[ai][bj][m][1];
                if (NORM) { const float r = rsv[bj]; v0 = v0 * r * g0; v1 = v1 * r * g1; }
                const size_t off = (((size_t)b * nh + h0 + bj) * T + t) * 128 + dlo;
                if (D1) { u32x2 w0, w1; w0.x = cvt_pk_bf16(v0[0], v0[1]); w0.y = cvt_pk_bf16(v0[2], v0[3]); w1.x = cvt_pk_bf16(v1[0], v1[1]); w1.y = cvt_pk_bf16(v1[2], v1[3]);
                    if (WT) { __hip_atomic_store((GAS unsigned long long*)(d1 + off), ((unsigned long long)w0.y << 32) | w0.x, __ATOMIC_RELAXED, __HIP_MEMORY_SCOPE_AGENT);
                        __hip_atomic_store((GAS unsigned long long*)(d1 + off + 64), ((unsigned long long)w1.y << 32) | w1.x, __ATOMIC_RELAXED, __HIP_MEMORY_SCOPE_AGENT); }
                    else { *(GAS u32x2*)(d1 + off) = w0; *(GAS u32x2*)(d1 + off + 64) = w1; } }
                if (D2) { const f32x4 r0 = v0 * c - v1 * sn, r1 = v1 * c + v0 * sn;
                    u32x2 w0, w1; w0.x = cvt_pk_bf16(r0[0], r0[1]); w0.y = cvt_pk_bf16(r0[2], r0[3]); w1.x = cvt_pk_bf16(r1[0], r1[1]); w1.y = cvt_pk_bf16(r1[2], r1[3]);
                    *(GAS u32x2*)(d2 + off) = w0; *(GAS u32x2*)(d2 + off + 64) = w1; } }
            asm volatile("" ::: "memory"); }
#undef EI_LD
        if (WT) handoff_signal(kcvc_cnt, fr + 16 * fq);
    }
};

struct EpiPart {
    static constexpr int NS = 0; static constexpr bool PERM = true, PREFETCH = false;
    float* P; unsigned* done_cnt;
    __device__ __forceinline__ void operator()(const f32x4 (&acc)[2][2][4][2], const Unit& u, int wr, int wc, int fr, int fq) const {
        const __amdgpu_buffer_rsrc_t rsrc = __builtin_amdgcn_make_buffer_rsrc(P, 0, 128 * 65536 * 4, 0x00020000);
        const unsigned base = ((unsigned)u.aux * 65536u + (unsigned)(wr * 64 + fr) * 256u + (unsigned)(wc * 32 + 8 * fq)) * 4u;
#pragma unroll
        for (int ai = 0; ai < 2; ++ai)
#pragma unroll
            for (int m = 0; m < 4; ++m) { const unsigned rp = base + (unsigned)(ai * HALF + m * 16) * 1024u;
#pragma unroll
                for (int bj = 0; bj < 2; ++bj)
#pragma unroll
                    for (int n = 0; n < 2; ++n) __builtin_amdgcn_raw_buffer_store_b128(__builtin_bit_cast(u32x4, acc[ai][bj][m][n]), rsrc, rp + (unsigned)(bj * HALF + 4 * n) * 4u, 0, 16);
                asm volatile("" ::: "memory"); }
        handoff_signal(done_cnt, fr + 16 * fq);
    }
};
struct CmpOrder {
    int G, c; const char* KC; const char* VC; const char* W1T;
    __device__ __forceinline__ bool next(int i, Unit& u) const { const int L = i * G + c; if (L >= 32) return false; u.pm = 0; u.pn = 0; u.aux = L; return true; }
    __device__ __forceinline__ void ptrs(const Unit& u, const char*& a, const char*& b) const { const int L = u.aux, kv = L >> 4, bg = (L >> 2) & 3, ks = L & 3;
        a = (kv ? VC : KC) + ((size_t)bg * T * 128 + ks * 1024) * 2; b = W1T + ((size_t)kv * 256 * 4096 + ks * 1024) * 2; }
};
}


struct Args {
    const float *x, *c, *w_ada, *b_ada, *norm1_g, *w_in, *b_forget, *fox_q_norm, *fox_k_norm, *nsa_q_norm, *cmp_k_norm, *slc_k_norm, *win_k_norm,
        *cmp_pe_k, *cmp_w1_k, *cmp_w2_k, *cmp_pe_v, *cmp_w1_v, *cmp_w2_v, *w_out, *norm2_g, *w_up, *w_down;
    float* out; unsigned char* ws; int ph_lo, ph_hi;
};

#ifndef DEV_ATT
#define DEV_ATT 3
#endif
namespace att {
typedef float f32x16 __attribute__((ext_vector_type(16)));
typedef short s16x4 __attribute__((ext_vector_type(4)));
constexpr int NW = 8, QBLK = 32, KVBLK = 64, D = 128;
constexpr int SHM_V = KVBLK * D * 2, SHM_K = KVBLK * D * 2;
constexpr int L_V = 0, L_K = 2 * SHM_V, L_WS = 2 * SHM_V + 2 * SHM_K, L_Q = L_WS + 2048;
constexpr int LC_V = 0, LC_K = 65536, LC_WS = 131072, LC_IMP = 133120;
constexpr int L_KB = 133120;
constexpr int L_SEL = 149504;
constexpr float THR = 8.f;
constexpr float C2 = 1.4426950408889634f * SCALE;
enum { M_FOX = 0, M_WIN = 1, M_SLC = 2 };
#define KSWZ(row, colB) ((row) * 256 + ((colB) ^ (((row) & 7) << 4)))
#define SBAR() __builtin_amdgcn_sched_barrier(0)
__device__ __forceinline__ int v_st(int k, int c) { const int kk = (k & ~0xC) | ((k & 4) << 1) | ((k & 8) >> 1); return ((kk >> 3) * 4 + (c >> 5)) * 512 + ((kk & 7) * 32 + (c & 31)) * 2; }
__device__ __forceinline__ int v_rd_base(int lane) { return ((lane & 3) << 3) | (((lane >> 2) & 3) << 6) | (((lane >> 4) & 1) << 5) | (((lane >> 5) & 1) << 8); }
constexpr int v_rd_off(int d0, int ks, int half) { return d0 * 512 + ks * 4096 + half * 2048; }
__device__ __forceinline__ int crow(int r, int hi) { return (r & 3) + 8 * (r >> 2) + 4 * hi; }
__device__ __forceinline__ bf16x8 load8(const bf16_t* p) { return *(const GAS bf16x8*)p; }
__device__ __forceinline__ void mask_tile(f32x16& p0, f32x16& p1, int dq, unsigned W) {
    const float NEG = -__builtin_inff();
#pragma unroll
    for (int r = 0; r < 16; ++r) { const int c = (r & 3) + 8 * (r >> 2);
        if ((unsigned)(dq - c) >= W) p0[r] = NEG;
        if ((unsigned)(dq - c - 32) >= W) p1[r] = NEG; }
}
__device__ __forceinline__ void partialSM(f32x16& p0, f32x16& p1, float& m_reg, float& mn, float& alpha) {
    float pmax = p0[0];
#pragma unroll
    for (int r = 1; r < 16; ++r) pmax = fmaxf(pmax, p0[r]);
#pragma unroll
    for (int r = 0; r < 16; ++r) pmax = fmaxf(pmax, p1[r]);
    { auto rr = __builtin_amdgcn_permlane32_swap(__float_as_uint(pmax), __float_as_uint(pmax), false, false);
      pmax = fmaxf(__uint_as_float(rr[0]), __uint_as_float(rr[1])); }
    if (__builtin_expect(__all((pmax - m_reg) * SCALE <= THR), 1)) { mn = m_reg; alpha = 1.f; }
    else { mn = fmaxf(m_reg, pmax); alpha = __builtin_amdgcn_exp2f((m_reg - mn) * C2); m_reg = mn; }
    const float mnL = -mn * C2;
#pragma unroll
    for (int r = 0; r < 16; ++r) p0[r] = fmaf(p0[r], C2, mnL);
#pragma unroll
    for (int r = 0; r < 16; ++r) p1[r] = fmaf(p1[r], C2, mnL);
#pragma unroll
    for (int r = 0; r < 16; ++r) p0[r] = __builtin_amdgcn_exp2f(p0[r]);
}
#define PK4(P, B_, OUT) do { unsigned a0 = cvt_pk_bf16(P[B_+0], P[B_+1]), a1 = cvt_pk_bf16(P[B_+2], P[B_+3]);                          \
        unsigned b0 = cvt_pk_bf16(P[B_+4], P[B_+5]), b1 = cvt_pk_bf16(P[B_+6], P[B_+7]);                                             \
        auto r0 = __builtin_amdgcn_permlane32_swap(a0, b0, false, false); auto r1 = __builtin_amdgcn_permlane32_swap(a1, b1, false, false); \
        u32x4 w = {r0[0], r1[0], r0[1], r1[1]}; OUT = *reinterpret_cast<bf16x8*>(&w); } while (0)
__device__ __forceinline__ void finishSM(f32x16& p0, f32x16& p1, float alpha, float& l_reg, bf16x8& pa0, bf16x8& pa1, bf16x8& pa2, bf16x8& pa3, bool on = true) {
#pragma unroll
    for (int r = 0; r < 16; ++r) p1[r] = __builtin_amdgcn_exp2f(p1[r]);
    float ps = 0;
#pragma unroll
    for (int r = 0; r < 16; ++r) ps += p0[r];
#pragma unroll
    for (int r = 0; r < 16; ++r) ps += p1[r];
    { auto rr = __builtin_amdgcn_permlane32_swap(__float_as_uint(ps), __float_as_uint(ps), false, false);
      ps = __uint_as_float(rr[0]) + __uint_as_float(rr[1]); }
    l_reg = l_reg * alpha + (on ? ps : 0.f);
    PK4(p0, 0, pa0); PK4(p0, 8, pa1); PK4(p1, 0, pa2); PK4(p1, 8, pa3);
    if (!on) { const bf16x8 z = {0, 0, 0, 0, 0, 0, 0, 0}; pa0 = z; pa1 = z; pa2 = z; pa3 = z; }
}
template <int KB>
__device__ __forceinline__ void qkt(f32x16& p0, f32x16& p1, const LAS char* K_lds, int r32, int hi, const LAS char* qs) {
    const LAS char* kb[4];
#pragma unroll
    for (int dd = 0; dd < 4; ++dd) kb[dd] = K_lds + KB * SHM_K + KSWZ(r32, (dd * 16 + hi * 8) * 2);
#pragma unroll
    for (int d0 = 0; d0 < 8; ++d0) { const LAS char* a = kb[d0 & 3] + (d0 >> 2) * 128;
        const bf16x8 q = *reinterpret_cast<const LAS bf16x8*>(qs + d0 * 1024);
        bf16x8 b0 = *reinterpret_cast<const LAS bf16x8*>(a);
        bf16x8 b1 = *reinterpret_cast<const LAS bf16x8*>(a + 32 * 256);
        p0 = __builtin_amdgcn_mfma_f32_32x32x16_bf16(b0, q, p0, 0, 0, 0);
        p1 = __builtin_amdgcn_mfma_f32_32x32x16_bf16(b1, q, p1, 0, 0, 0); }
}
template <int KB>
__device__ __forceinline__ void qkt_r(f32x16& p0, f32x16& p1, const LAS char* K_lds, int r32, int hi, const bf16x8* qr) {
    const LAS char* kb[4];
#pragma unroll
    for (int dd = 0; dd < 4; ++dd) kb[dd] = K_lds + KB * SHM_K + KSWZ(r32, (dd * 16 + hi * 8) * 2);
#pragma unroll
    for (int d0 = 0; d0 < 8; ++d0) { const LAS char* a = kb[d0 & 3] + (d0 >> 2) * 128;
        bf16x8 b0 = *reinterpret_cast<const LAS bf16x8*>(a);
        bf16x8 b1 = *reinterpret_cast<const LAS bf16x8*>(a + 32 * 256);
        p0 = __builtin_amdgcn_mfma_f32_32x32x16_bf16(b0, qr[d0], p0, 0, 0, 0);
        p1 = __builtin_amdgcn_mfma_f32_32x32x16_bf16(b1, qr[d0], p1, 0, 0, 0); }
}
template <int VB>
__device__ __forceinline__ void pv_tile(f32x16* o, int vb0, bf16x8 pa0, bf16x8 pa1, bf16x8 pa2, bf16x8 pa3) {
#define TRRD(dst, off) asm volatile("ds_read_b64_tr_b16 %0, %1 offset:%2" : "=&v"(dst) : "v"(vb0), "i"(off) : "memory")
#define PV_D0(d0) do { s16x4 l0, l1, l2, l3, h0, h1, h2, h3; constexpr int b_ = VB * SHM_V + v_rd_off(d0, 0, 0); \
        TRRD(l0, b_); TRRD(h0, b_ + 2048); TRRD(l1, b_ + 4096); TRRD(h1, b_ + 6144); TRRD(l2, b_ + 8192); TRRD(h2, b_ + 10240); TRRD(l3, b_ + 12288); TRRD(h3, b_ + 14336); \
        asm volatile("s_waitcnt lgkmcnt(0)" ::: "memory"); SBAR(); \
        o[d0] = __builtin_amdgcn_mfma_f32_32x32x16_bf16(pa0, (bf16x8){l0[0], l0[1], l0[2], l0[3], h0[0], h0[1], h0[2], h0[3]}, o[d0], 0, 0, 0);   \
        o[d0] = __builtin_amdgcn_mfma_f32_32x32x16_bf16(pa1, (bf16x8){l1[0], l1[1], l1[2], l1[3], h1[0], h1[1], h1[2], h1[3]}, o[d0], 0, 0, 0);   \
        o[d0] = __builtin_amdgcn_mfma_f32_32x32x16_bf16(pa2, (bf16x8){l2[0], l2[1], l2[2], l2[3], h2[0], h2[1], h2[2], h2[3]}, o[d0], 0, 0, 0);   \
        o[d0] = __builtin_amdgcn_mfma_f32_32x32x16_bf16(pa3, (bf16x8){l3[0], l3[1], l3[2], l3[3], h3[0], h3[1], h3[2], h3[3]}, o[d0], 0, 0, 0); } while (0)
    PV_D0(0); PV_D0(1); PV_D0(2); PV_D0(3);
#undef PV_D0
#undef TRRD
}

struct Blk {
    const bf16_t* Q;
    const bf16_t* K; const bf16_t* V;
    const float* KB;
    int mode, P0, j_lo, j_hi, b, hb;
};
struct Seam { bf16x8 st_v0, st_v1, st_k0, st_k1; };
__device__ __forceinline__ int q_lane_off(int mode, int wid, int r32) { return mode == M_FOX ? (wid * 32 + r32) * 128 : ((r32 >> 3) * T + wid * 8 + (r32 & 7)) * 128; }
#define ROW(p, k0, rr) ((p) + (size_t)((k0) + (rr)) * D + sc)
#define VMW() asm volatile("s_waitcnt vmcnt(0)" ::: "memory")
#define VMWN(n) asm volatile("s_waitcnt vmcnt(%0)" :: "i"(n) : "memory")
#define SLOAD_H(Kp, Vp, k0) do { S.st_v0 = load8(ROW(Vp, k0, sr)); S.st_v1 = load8(ROW(Vp, k0, 32 + sr)); S.st_k0 = load8(ROW(Kp, k0, sr)); S.st_k1 = load8(ROW(Kp, k0, 32 + sr)); } while (0)
#define SWRITE_HK(bf) do { *(LAS bf16x8*)(K_lds + (bf) * SHM_K + kws) = S.st_k0; *(LAS bf16x8*)(K_lds + (bf) * SHM_K + kws + 32 * 256) = S.st_k1; } while (0)
#define SWRITE_HV(bf) do { *(LAS bf16x8*)(V_lds + (bf) * SHM_V + vst0) = S.st_v0; *(LAS bf16x8*)(V_lds + (bf) * SHM_V + vst1) = S.st_v1; } while (0)
#define SWRITE_H(bf) do { SWRITE_HV(bf); SWRITE_HK(bf); } while (0)
__device__ __forceinline__ void attn_prime(const Blk& cur, LAS char* lds, Seam& S) {
    const int tid = threadIdx.x;
    const int sr = tid >> 4, sc = (tid & 15) * 8, kws = KSWZ(sr, sc * 2); LAS char* K_lds = lds + L_K;
    const int kb0 = cur.j_lo * KVBLK;
    SLOAD_H(cur.K, cur.V, kb0); VMW(); SWRITE_HK(0);
    __syncthreads();
}
struct EpiCtx { bf16_t* AO; float* NSAO; const float* GATES; unsigned* panel_cnt; };
__device__ __forceinline__ void attn_block(const Blk& cur, const Blk& nxt, LAS char* lds, Seam& S, const EpiCtx& ec) {
    int tid = threadIdx.x; asm volatile("" : "+v"(tid));
    const int wid = __builtin_amdgcn_readfirstlane(tid >> 6), lane = tid & 63, r32 = lane & 31, hi = lane >> 5;
    const int mode = cur.mode;
    const int j_lo = cur.j_lo, NT = cur.j_hi - cur.j_lo;
    const int kbn = nxt.j_lo * KVBLK;
    const bool fox = mode == M_FOX;
    const int wlo = cur.P0 + (fox ? wid * 32 : wid * 8), whi = wlo + (fox ? 31 : 7);
    const int pos = cur.P0 + (fox ? wid * 32 + r32 : wid * 8 + (r32 & 7)), qm = pos - 4 * hi;
    const unsigned Wu = (mode == M_WIN) ? 512u : (1u << 30);
    LAS char* V_lds = lds + L_V; LAS char* K_lds = lds + L_K;
    LAS float* ws = (LAS float*)(lds + L_WS) + wid * 64; LAS float* li_l = ws; LAS float* al_l = ws + 32;
    float m_reg = -1e30f, l_reg = 0; f32x16 o[4] = {};
    const int sr = tid >> 4, sc = (tid & 15) * 8, vst0 = v_st(sr, sc), vst1 = v_st(32 + sr, sc), kws = KSWZ(sr, sc * 2);
    const int vb0 = (int)(unsigned)(uintptr_t)V_lds + v_rd_base(lane);
    const bf16_t* Kh = cur.K; const bf16_t* Vh = cur.V;
    unsigned long long sel = ~0ull;
    if (mode == M_SLC) sel = *(const LAS unsigned long long*)(lds + L_SEL + (wid * 8 + (r32 & 7)) * 8);
#define RESC(a_) do { if (__any((a_) < 1.f)) { if (hi == 0) al_l[r32] = (a_); asm volatile("s_waitcnt lgkmcnt(0)" ::: "memory");              \
                     _Pragma("unroll") for (int d_ = 0; d_ < 4; ++d_) _Pragma("unroll") for (int r = 0; r < 16; ++r) o[d_][r] *= al_l[crow(r, hi)]; } } while (0)
#define KBASE(t) ((j_lo + (t)) * KVBLK)
#define PRELOAD(P0_, P1_, t) do { if (fox) { const LAS float* kbp_ = (const LAS float*)(lds + L_KB) + KBASE(t) + 4 * hi; \
            _Pragma("unroll") for (int q_ = 0; q_ < 4; ++q_) { const f32x4 a_ = *(const LAS f32x4*)(kbp_ + 8 * q_), b_ = *(const LAS f32x4*)(kbp_ + 32 + 8 * q_); \
                P0_[4*q_] = a_[0]; P0_[4*q_+1] = a_[1]; P0_[4*q_+2] = a_[2]; P0_[4*q_+3] = a_[3]; P1_[4*q_] = b_[0]; P1_[4*q_+1] = b_[1]; P1_[4*q_+2] = b_[2]; P1_[4*q_+3] = b_[3]; } } \
        else { P0_ = f32x16{}; P1_ = f32x16{}; } } while (0)
#define MASKT(P0_, P1_, t) do { const int kb_ = KBASE(t); \
        if (kb_ + KVBLK - 1 > wlo || kb_ + (int)Wu <= whi) mask_tile(P0_, P1_, qm - kb_, Wu); } while (0)
#define ONT(t) (mode != M_SLC || ((sel >> (j_lo + (t))) & 1ull) != 0ull)
    if (wid >= 4) __builtin_amdgcn_s_setprio(1);
    f32x16 pA0, pA1, pB0, pB1; float mnA, mnB, alA, alB; bf16x8 pa0, pa1, pa2, pa3;
    LAS char* qs = lds + L_Q + wid * 8192 + lane * 16;
    { const bf16_t* qp = cur.Q + q_lane_off(mode, wid, r32) + hi * 8; bf16x8 tq[8];
#pragma unroll
      for (int d0 = 0; d0 < 8; ++d0) tq[d0] = load8(qp + d0 * 16);
#pragma unroll
      for (int d0 = 0; d0 < 8; ++d0) *(LAS bf16x8*)(qs + d0 * 1024) = tq[d0]; }
    PRELOAD(pA0, pA1, 0);
    SWRITE_HV(0); SBAR();
    if (NT > 1) SLOAD_H(Kh, Vh, KBASE(1));
    SBAR(); qkt<0>(pA0, pA1, K_lds, r32, hi, qs);
    if (NT > 1) PRELOAD(pB0, pB1, 1); else { pB0 = f32x16{}; pB1 = f32x16{}; }
    MASKT(pA0, pA1, 0); partialSM(pA0, pA1, m_reg, mnA, alA);
    if (NT > 1) { VMW(); SWRITE_H(1); }
    __syncthreads();
#define HALF_STEP(PX0, PX1, mnX, alX, PY0, PY1, alY, t, KB_, VB_, SB_) do {                                                      \
        SBAR(); if ((t) + 1 < NT) { SLOAD_H(Kh, Vh, KBASE((t) + 1)); SBAR(); }         \
        qkt<KB_>(PX0, PX1, K_lds, r32, hi, qs);                                             \
        finishSM(PY0, PY1, alY, l_reg, pa0, pa1, pa2, pa3, ONT((t) - 1)); SBAR();                                                           \
        if ((t) + 1 < NT) { PRELOAD(PY0, PY1, (t) + 1); SBAR(); }                                               \
        pv_tile<VB_>(o, vb0, pa0, pa1, pa2, pa3); MASKT(PX0, PX1, (t)); partialSM(PX0, PX1, m_reg, mnX, alX);                                        \
        __syncthreads();                                                                                                      \
        if ((t) + 1 < NT) { VMW(); SWRITE_H(SB_); }                                                                          \
        RESC(alX); __syncthreads(); } while (0)
    for (int t = 1; t + 1 < NT; t += 2) {
        HALF_STEP(pB0, pB1, mnB, alB, pA0, pA1, alA, t, 1, 0, 0);
        HALF_STEP(pA0, pA1, mnA, alA, pB0, pB1, alB, t + 1, 0, 1, 1);
    }
    const bool even = (NT & 1) == 0;
    if (even) { SBAR(); qkt<1>(pB0, pB1, K_lds, r32, hi, qs); SBAR(); }
    SLOAD_H(nxt.K, nxt.V, kbn); SBAR();
    SBAR();
    finishSM(pA0, pA1, alA, l_reg, pa0, pa1, pa2, pa3, ONT(even ? NT - 2 : NT - 1)); SBAR();
    pv_tile<0>(o, vb0, pa0, pa1, pa2, pa3);
    if (even) { MASKT(pB0, pB1, NT - 1); partialSM(pB0, pB1, m_reg, mnB, alB); __syncthreads(); RESC(alB);
        finishSM(pB0, pB1, alB, l_reg, pa0, pa1, pa2, pa3, ONT(NT - 1)); SBAR(); pv_tile<1>(o, vb0, pa0, pa1, pa2, pa3); }
    SBAR(); VMW(); SWRITE_HK(0); SBAR();
    if (hi == 0) li_l[r32] = l_reg; asm volatile("s_waitcnt lgkmcnt(0)" ::: "memory");
    if (fox) {
        bf16_t* Ow = ec.AO + ((size_t)cur.b * T + cur.P0 + wid * QBLK) * DM + cur.hb * 128;
#pragma unroll
        for (int r = 0; r < 16; ++r) { const int orow = crow(r, hi); const float li = li_l[orow]; const float rl = li > 0.f ? __builtin_amdgcn_rcpf(li) : 0.f;
#pragma unroll
            for (int d0 = 0; d0 < 4; ++d0) { const float v = o[d0][r] * rl; const float vn = __shfl_xor(v, 1);
                if ((r32 & 1) == 0) *(GAS unsigned*)(Ow + (size_t)orow * DM + d0 * 32 + r32) = cvt_pk_bf16(v, vn); } }
    } else {
        const int br = (mode == M_WIN) ? 2 : 1;
#pragma unroll
        for (int h8 = 0; h8 < 2; ++h8) {
            float gv[8]; float av[8][4], bv[8][4];
#pragma unroll
            for (int q = 0; q < 8; ++q) { const int rho = crow(h8 * 8 + q, hi);
                const int tok = cur.P0 + wid * 8 + (rho & 7), head = cur.hb + (rho >> 3); const size_t trow = (size_t)cur.b * T + tok;
                gv[q] = ((const GAS float*)ec.GATES)[trow * 24 + head * 3 + br];
                if (mode == M_SLC) { const GAS float* np = (const GAS float*)(ec.NSAO + trow * 1024 + head * 128 + r32); const GAS float* np2 = np + (ptrdiff_t)((WS_PART - WS_NSAO) / 4);
#pragma unroll
                    for (int d0 = 0; d0 < 4; ++d0) { av[q][d0] = np[d0 * 32]; bv[q][d0] = np2[d0 * 32]; } }
                else {
#pragma unroll
                    for (int d0 = 0; d0 < 4; ++d0) { av[q][d0] = 0.f; bv[q][d0] = 0.f; } } }
#pragma unroll
            for (int q = 0; q < 8; ++q) { const int r = h8 * 8 + q; const int rho = crow(r, hi); const float li = li_l[rho]; const float rl = li > 0.f ? __builtin_amdgcn_rcpf(li) : 0.f;
                const int tok = cur.P0 + wid * 8 + (rho & 7), head = cur.hb + (rho >> 3); const size_t trow = (size_t)cur.b * T + tok;
                const float gt = gv[q] * rl;
                GAS float* np2 = (GAS float*)(ec.NSAO + trow * 1024 + head * 128 + r32 + (ptrdiff_t)((WS_PART - WS_NSAO) / 4));
#pragma unroll
                for (int d0 = 0; d0 < 4; ++d0) {
                    if (mode == M_WIN) np2[d0 * 32] = gt * o[d0][r];
                    else { const float v = av[q][d0] + bv[q][d0] + gt * o[d0][r]; const float vn = __shfl_xor(v, 1); if ((r32 & 1) == 0) *(GAS unsigned*)(ec.AO + trow * DM + 1024 + head * 128 + d0 * 32 + r32) = cvt_pk_bf16(v, vn); } } }
            asm volatile("" ::: "memory"); }
    }
    __builtin_amdgcn_s_setprio(0);
    __syncthreads();
#undef RESC
#undef KBASE
#undef PRELOAD
#undef MASKT
#undef ONT
#undef HALF_STEP
}
#undef ROW
#undef SLOAD_H
#undef SWRITE_HK
#undef SWRITE_HV
#undef SWRITE_H

__device__ __forceinline__ bf16x8 ovfrag(int n0, int J) {
    asm volatile("" : "+v"(n0));
    unsigned w[4];
#pragma unroll
    for (int q = 0; q < 4; ++q) { unsigned lohi[2];
#pragma unroll
        for (int e = 0; e < 2; ++e) { const int dl = n0 + 2 * q + e - 4 * J; lohi[e] = (dl >= 0 && dl <= 2) ? 0x3F80u : ((dl == 3 || dl == -1) ? 0x3F00u : 0u); }
        w[q] = lohi[0] | (lohi[1] << 16); }
    u32x4 v = {w[0], w[1], w[2], w[3]}; return *reinterpret_cast<bf16x8*>(&v);
}
__device__ __forceinline__ void nsa_cmp_item(int b, int g, int qb, const bf16_t* NQ, const bf16_t* KCMP, const bf16_t* VCMP, const float* GATES, const float* mbound, float* NSAO, LAS char* lds) {
    int tid = threadIdx.x; asm volatile("" : "+v"(tid));
    const int wid = __builtin_amdgcn_readfirstlane(tid >> 6), lane = tid & 63, r32 = lane & 31, hi = lane >> 5;
    LAS char* V_lds = lds + LC_V; LAS char* K_lds = lds + LC_K;
    LAS float* ws = (LAS float*)(lds + LC_WS) + wid * 64; LAS float* li_l = ws;
    LAS float* impL = (LAS float*)(lds + LC_IMP);
    const int sr = tid >> 4, sc = (tid & 15) * 8, vst0 = v_st(sr, sc), vst1 = v_st(32 + sr, sc), kws = KSWZ(sr, sc * 2);
    const bf16_t* Kc = KCMP + (size_t)(b * 2 + g) * 256 * 128; const bf16_t* Vc = VCMP + (size_t)(b * 2 + g) * 256 * 128;
    const int ntile = ((4 * qb + 2) >> 6) + 1;
    bf16x8 qr[8];
    { const bf16_t* qp = NQ + (((size_t)b * 8 + g * 4) * T + qb * 64) * 128 + q_lane_off(M_WIN, wid, r32) + hi * 8;
#pragma unroll
      for (int d0 = 0; d0 < 8; ++d0) qr[d0] = load8(qp + d0 * 16); }
    {
        bf16x8 kk[4][2], vv[4][2];
#pragma unroll
        for (int tl = 0; tl < 4; ++tl) { kk[tl][0] = load8(Kc + (size_t)(tl * 64 + sr) * 128 + sc); kk[tl][1] = load8(Kc + (size_t)(tl * 64 + 32 + sr) * 128 + sc); }
#pragma unroll
        for (int tl = 0; tl < 4; ++tl) { vv[tl][0] = load8(Vc + (size_t)(tl * 64 + sr) * 128 + sc); vv[tl][1] = load8(Vc + (size_t)(tl * 64 + 32 + sr) * 128 + sc); }
#pragma unroll
        for (int tl = 0; tl < 4; ++tl) { *(LAS bf16x8*)(K_lds + tl * SHM_K + kws) = kk[tl][0]; *(LAS bf16x8*)(K_lds + tl * SHM_K + kws + 32 * 256) = kk[tl][1]; }
#pragma unroll
        for (int tl = 0; tl < 4; ++tl) { *(LAS bf16x8*)(V_lds + tl * SHM_V + vst0) = vv[tl][0]; *(LAS bf16x8*)(V_lds + tl * SHM_V + vst1) = vv[tl][1]; }
        asm volatile("" ::: "memory");
    }
    __syncthreads();
    const int pos = qb * 64 + wid * 8 + (r32 & 7);
    const int nmax = (pos - 31) >> 4;
    const float NEG = -__builtin_inff();
#define CMASK(P0_, P1_, tl) do { _Pragma("unroll") for (int r = 0; r < 16; ++r) { const int n_ = (tl) * 64 + crow(r, hi); if (n_ > nmax) P0_[r] = NEG; if (n_ + 32 > nmax) P1_[r] = NEG; } } while (0)
    const float mL = -(*(const GAS float*)mbound) * C2;
    float l_reg = 0.f;
    const int vb0 = (int)(unsigned)(uintptr_t)V_lds + v_rd_base(lane);
    f32x16 o[4] = {}; f32x16 io[2] = {};
#pragma nounroll
    for (int tl = 0; tl < ntile; ++tl) { f32x16 p0 = f32x16{}, p1 = f32x16{}; qkt_r<0>(p0, p1, K_lds + tl * SHM_K, r32, hi, qr); CMASK(p0, p1, tl);
        float ps = 0.f;
#pragma unroll
        for (int r = 0; r < 16; ++r) { p0[r] = __builtin_amdgcn_exp2f(fmaf(p0[r], C2, mL)); p1[r] = __builtin_amdgcn_exp2f(fmaf(p1[r], C2, mL)); ps += p0[r] + p1[r]; }
        l_reg += ps; bf16x8 pa0, pa1, pa2, pa3; PK4(p0, 0, pa0); PK4(p0, 8, pa1); PK4(p1, 0, pa2); PK4(p1, 8, pa3);
        pv_tile<0>(o, vb0 + tl * SHM_V, pa0, pa1, pa2, pa3); SBAR();
#pragma unroll
        for (int d0 = 0; d0 < 2; ++d0) { const int J = d0 * 32 + r32;
            io[d0] = __builtin_amdgcn_mfma_f32_32x32x16_bf16(pa0, ovfrag(tl * 64 + 0 + 8 * hi, J), io[d0], 0, 0, 0);
            io[d0] = __builtin_amdgcn_mfma_f32_32x32x16_bf16(pa1, ovfrag(tl * 64 + 16 + 8 * hi, J), io[d0], 0, 0, 0);
            io[d0] = __builtin_amdgcn_mfma_f32_32x32x16_bf16(pa2, ovfrag(tl * 64 + 32 + 8 * hi, J), io[d0], 0, 0, 0);
            io[d0] = __builtin_amdgcn_mfma_f32_32x32x16_bf16(pa3, ovfrag(tl * 64 + 48 + 8 * hi, J), io[d0], 0, 0, 0); } SBAR(); }
    { auto rr = __builtin_amdgcn_permlane32_swap(__float_as_uint(l_reg), __float_as_uint(l_reg), false, false); l_reg = __uint_as_float(rr[0]) + __uint_as_float(rr[1]); }
    if (hi == 0) li_l[r32] = l_reg; asm volatile("s_waitcnt lgkmcnt(0)" ::: "memory");
    {
        float gv[16];
#pragma unroll
        for (int r = 0; r < 16; ++r) { const int rho = crow(r, hi); gv[r] = ((const GAS float*)GATES)[((size_t)b * T + qb * 64 + wid * 8 + (rho & 7)) * 24 + (g * 4 + (rho >> 3)) * 3 + 0]; }
        float imps[2][4] = {};
#pragma unroll
        for (int r = 0; r < 16; ++r) { const int rho = crow(r, hi); const float li = li_l[rho]; const float rl = li > 0.f ? __builtin_amdgcn_rcpf(li) : 0.f;
            const int tok = qb * 64 + wid * 8 + (rho & 7), head = g * 4 + (rho >> 3);
            const size_t trow = (size_t)b * T + tok;
            const float gt = gv[r] * rl;
            GAS float* np = (GAS float*)(NSAO + trow * 1024 + head * 128 + r32);
#pragma unroll
            for (int d0 = 0; d0 < 4; ++d0) np[d0 * 32] = gt * o[d0][r];
            imps[0][r & 3] += io[0][r] * rl; imps[1][r & 3] += io[1][r] * rl; }
#pragma unroll
        for (int d0 = 0; d0 < 2; ++d0)
#pragma unroll
            for (int e = 0; e < 4; ++e) impL[(wid * 8 + e + 4 * hi) * 64 + d0 * 32 + r32] = imps[d0][e];
    }
#undef CMASK
    __syncthreads();
#pragma nounroll
    for (int tk = 0; tk < 8; ++tk) { const int tl = wid * 8 + tk; const int J = lane;
        const float im = impL[tl * 64 + J];
        const bool forced = (J == 0) || (J == qb) || (J == qb - 1);
        const float v = forced ? __builtin_inff() : (J <= qb ? im : NEG);
        impL[tl * 64 + J] = v; asm volatile("s_waitcnt lgkmcnt(0)" ::: "memory");
        f32x4 uv[16];
#pragma unroll
        for (int q = 0; q < 16; ++q) uv[q] = *(const LAS f32x4*)(impL + tl * 64 + 4 * q);
        int rank = 0;
#pragma unroll
        for (int q = 0; q < 16; ++q)
#pragma unroll
            for (int e = 0; e < 4; ++e) { const float u = uv[q][e]; const int jj = 4 * q + e; rank += (u > v || (u == v && jj < J)) ? 1 : 0; }
        const unsigned long long mk = __ballot(rank < 16 && J <= qb);
        if (lane == 0) *(LAS unsigned long long*)(lds + L_SEL + tl * 8) = mk; }
    __syncthreads();
}
#undef PK4
#undef VMW
#undef VMWN

template <class P> __device__ __forceinline__ P* uptr(P* p) { const unsigned long long v = (unsigned long long)p;
    const unsigned lo = __builtin_amdgcn_readfirstlane((unsigned)v), hi = __builtin_amdgcn_readfirstlane((unsigned)(v >> 32)); return (P*)(((unsigned long long)hi << 32) | lo); }
__device__ __forceinline__ Blk make_blk(unsigned char* ws, int i, int st) {
    const int bg = i >> 6, qb = i & 63, b = bg >> 1, g = bg & 1; Blk k;
    if (st < 2) {
        k.Q = uptr((const bf16_t*)(ws + WS_NQR) + (((size_t)b * 8 + g * 4) * T + qb * 64) * 128);
        k.K = uptr((const bf16_t*)(ws + (st == 0 ? WS_KW : WS_KSL)) + (size_t)bg * T * 128); k.V = uptr((const bf16_t*)(ws + (st == 0 ? WS_VW : WS_VSL)) + (size_t)bg * T * 128);
        k.KB = nullptr; k.mode = st == 0 ? M_WIN : M_SLC; k.P0 = qb * 64; k.j_lo = (st == 0 && qb >= 8) ? qb - 8 : 0; k.j_hi = qb + 1; k.b = b; k.hb = g * 4;
    } else {
        const int bh = bg * 4 + (qb & 3), qf = 15 - (qb >> 2);
        k.Q = uptr((const bf16_t*)(ws + WS_FQ) + ((size_t)bh * T + qf * 256) * 128); k.K = uptr((const bf16_t*)(ws + WS_FK) + (size_t)bh * T * 128); k.V = uptr((const bf16_t*)(ws + WS_FV) + (size_t)bh * T * 128);
        k.KB = uptr((const float*)(ws + WS_KBIAS) + (size_t)bh * T); k.mode = M_FOX; k.P0 = qf * 256; k.j_lo = 0; k.j_hi = 4 * qf + 4; k.b = bh >> 3; k.hb = bh & 7;
    }
    k.mode = __builtin_amdgcn_readfirstlane(k.mode); k.P0 = __builtin_amdgcn_readfirstlane(k.P0); k.j_lo = __builtin_amdgcn_readfirstlane(k.j_lo); k.j_hi = __builtin_amdgcn_readfirstlane(k.j_hi);
    k.b = __builtin_amdgcn_readfirstlane(k.b); k.hb = __builtin_amdgcn_readfirstlane(k.hb);
    return k;
}
__device__ __forceinline__ void compute_kb(unsigned char* ws, int bh, LAS char* lds) {
    int tid = threadIdx.x; asm volatile("" : "+v"(tid));
    LAS double* part = (LAS double*)(lds + LC_IMP);
    const float* lf = (const float*)(ws + WS_LOGF) + (size_t)bh * T + tid * 8; float* kb = (float*)(ws + WS_KBIAS) + (size_t)bh * T + tid * 8;
    const f32x4 v0 = *(const f32x4*)lf, v1 = *(const f32x4*)(lf + 4);
    double loc[8]; double run = 0.0;
    { const float vv[8] = {v0[0], v0[1], v0[2], v0[3], v1[0], v1[1], v1[2], v1[3]};
#pragma unroll
      for (int i = 0; i < 8; ++i) { run += (double)vv[i]; loc[i] = run; } }
    const int lane = tid & 63, wv = tid >> 6; double inc = run;
#pragma unroll
    for (int o = 1; o < 64; o <<= 1) { const double up = __shfl_up(inc, o); if (lane >= o) inc += up; }
    if (lane == 63) part[wv] = inc;
    __syncthreads();
    double off = inc - run;
    for (int w = 0; w < wv; ++w) off += part[w];
    f32x4 o0, o1;
#pragma unroll
    for (int i = 0; i < 4; ++i) { o0[i] = (float)(-(off + loc[i]) * (double)(1.0f / SCALE)); o1[i] = (float)(-(off + loc[4 + i]) * (double)(1.0f / SCALE)); }
    *(f32x4*)kb = o0; *(f32x4*)(kb + 4) = o1;
    asm volatile("s_waitcnt vmcnt(0)" ::: "memory");
    __syncthreads();
}
__device__ __forceinline__ void stage_kb(const float* kbg, LAS char* lds) {
    int tid = threadIdx.x; asm volatile("" : "+v"(tid));
    const f32x4 v0 = *(const GAS f32x4*)(kbg + tid * 8), v1 = *(const GAS f32x4*)(kbg + tid * 8 + 4);
    LAS float* kl = (LAS float*)(lds + L_KB) + tid * 8;
    *(LAS f32x4*)kl = v0; *(LAS f32x4*)(kl + 4) = v1;
    __syncthreads();
}
__device__ __forceinline__ void attn_phase(const Args& a, LAS char* lds, int vcu, int G) {
    unsigned char* ws = a.ws;
    EpiCtx ec{(bf16_t*)(ws + WS_AO), (float*)(ws + WS_NSAO), (const float*)(ws + WS_GATES), (unsigned*)(ws + CTL_CNT_ATTN)};
    Seam S;
    constexpr int ST0 = (DEV_ATT == 1) ? 2 : 0, ST1 = (DEV_ATT == 2) ? 2 : 3;
    for (int i = vcu; i < 256; i += G) {
#ifndef NO_CMP
        if (DEV_ATT & 2) { const int bg = i >> 6, qb = i & 63; nsa_cmp_item(bg >> 1, bg & 1, qb, (const bf16_t*)(ws + WS_NQ), (const bf16_t*)(ws + WS_KCMP), (const bf16_t*)(ws + WS_VCMP), ec.GATES, (const float*)(ws + WS_MBOUND), ec.NSAO, lds); }
#endif
#ifndef NO_BLK
        Blk cur = make_blk(ws, i, ST0);
        attn_prime(cur, lds, S);
        for (int st = ST0; st < ST1; ++st) { const Blk nxt = make_blk(ws, i, st + 1 < ST1 ? st + 1 : st);
            if (st == 2) stage_kb(cur.KB, lds);
            attn_block(cur, nxt, lds, S, ec); cur = nxt; }
#endif
    }
}
#undef KSWZ
#undef SBAR
}


__device__ __forceinline__ int win_src_col(int pg) {
    const int pn = pg >> 8, p = pg & 255;
    if (pn == 12) { if (p < 8) return C_FZ + p; if (p < 32) return C_GZ + p - 8; return -1; }
    const int bj = p >> 7, q = p & 127;
    const int d = 16 * (q >> 5) + 4 * ((q >> 3) & 3) + (q & 3) + 64 * ((q >> 2) & 1);
    int base;
    if (pn < 4) base = C_FQ + pn * 256; else if (pn < 8) base = C_FK + (pn - 4) * 256; else if (pn < 12) base = C_FV + (pn - 8) * 256;
    else if (pn < 17) base = C_NQ + (pn - 13) * 256; else if (pn == 17) base = C_KC; else if (pn == 18) base = C_VC; else if (pn == 19) base = C_KSL;
    else if (pn == 20) base = C_KW; else if (pn == 21) base = C_VSL; else base = C_VW;
    return base + bj * 128 + d;
}
template <int SRC>
__device__ __forceinline__ void transpose_item(const float* W, int K, int N, bf16_t* WT, LAS float* scr, int item, int nblk, int lane) {
    const int kb = item / nblk, nb = item % nblk, k0 = 64 * kb, n0 = 32 * nb;
    int sc = n0 + (lane & 31); if (SRC == 1) sc = win_src_col(sc);
    float tv[32];
    const float* wp = W + (size_t)(k0 + (lane >> 5)) * N + (sc >= 0 ? sc : 0);
#pragma unroll
    for (int i = 0; i < 32; ++i) tv[i] = wp[(size_t)(2 * i) * N];
#pragma unroll
    for (int i = 0; i < 32; ++i) { const int kk = 2 * i + (lane >> 5); scr[kk * 33 + (lane & 31)] = sc >= 0 ? tv[i] : 0.f; }
    asm volatile("s_waitcnt lgkmcnt(0)" ::: "memory");
    const int cch = lane & 7;
#pragma unroll
    for (int j = 0; j < 4; ++j) { const int n = (lane >> 3) + 8 * j; const LAS float* s = scr + (8 * cch) * 33 + n;
        u32x4 o; o.x = cvt_pk_bf16(s[0 * 33], s[1 * 33]); o.y = cvt_pk_bf16(s[2 * 33], s[3 * 33]); o.z = cvt_pk_bf16(s[4 * 33], s[5 * 33]); o.w = cvt_pk_bf16(s[6 * 33], s[7 * 33]);
        *(u32x4*)(WT + (size_t)(n0 + n) * K + k0 + 8 * cch) = o; }
    asm volatile("s_waitcnt lgkmcnt(0)" ::: "memory");
}

__device__ __forceinline__ void p0_prologue(const Args& a, LAS unsigned char* lds, int vcu, int G) {
    int tid = threadIdx.x; asm volatile("" : "+v"(tid)); const int lane = tid & 63, wave = __builtin_amdgcn_readfirstlane(tid >> 6);
    LAS float* ca = (LAS float*)lds;
    for (int i = tid; i < 2 * DM; i += NTHR) { const float v = a.c[i]; ca[i] = v / (1.f + __expf(-v)); }
    __syncthreads();
    const int gw = vcu * NWAVES + wave, NGW = G * NWAVES;
    float* modp = (float*)(a.ws + WS_MODP);
    if (wave < 3) { const int it = vcu * 3 + wave;
        if (it < 16 * 48) { const int kc = it / 48, cq = (it % 48) * 64 + lane;
            f32x4 a0 = (f32x4){0.f, 0.f, 0.f, 0.f}, a1 = a0;
            const float* wp = a.w_ada + (size_t)(kc * 128) * (6 * DM) + 4 * cq;
#pragma unroll 16
            for (int k = 0; k < 128; ++k) { const f32x4 w = *(const f32x4*)(wp + (size_t)k * (6 * DM)); a0 += w * ca[kc * 128 + k]; a1 += w * ca[DM + kc * 128 + k]; }
            const __amdgpu_buffer_rsrc_t rsrc = __builtin_amdgcn_make_buffer_rsrc(modp, 0, 16 * 2 * 6 * DM * 4, 0x00020000);
            __builtin_amdgcn_raw_buffer_store_b128(__builtin_bit_cast(u32x4, a0), rsrc, (unsigned)((((size_t)kc * 2 + 0) * (6 * DM) + 4 * cq) * 4), 0, 16);
            __builtin_amdgcn_raw_buffer_store_b128(__builtin_bit_cast(u32x4, a1), rsrc, (unsigned)((((size_t)kc * 2 + 1) * (6 * DM) + 4 * cq) * 4), 0, 16);
            handoff_signal((unsigned*)(a.ws + CTL_CNT_ADALN), lane); } }
    LAS float* scr = (LAS float*)(lds + 16384 + wave * 16384);
    constexpr int I_IN = 32 * (NPAD / 32), I_OUT = 32 * 64, I_UP = 32 * 256, I_DN = 128 * 64, I_W1 = 64 * 8, I_W2 = 4 * 4;
    constexpr int NIT = I_IN + I_OUT + I_UP + I_DN + 2 * I_W1 + 2 * I_W2;
    const int nslot = (NIT + G - 1) / G;
    for (int m = 0;; ++m) { int j; if (wave < 3) { if (m >= 6) break; j = wave * 6 + m; } else { j = 18 + (wave - 3) + 5 * m; }
        if (j >= nslot) break; const int it = vcu + G * j; if (it >= NIT) break; int r = it;
        if (r < I_IN) { transpose_item<1>(a.w_in, DM, DIN, (bf16_t*)(a.ws + WS_WIN), scr, r, NPAD / 32, lane); continue; } r -= I_IN;
        if (r < I_OUT) { transpose_item<0>(a.w_out, DM, DM, (bf16_t*)(a.ws + WS_WOUT), scr, r, 64, lane); continue; } r -= I_OUT;
        if (r < I_UP) { transpose_item<0>(a.w_up, DM, DFF, (bf16_t*)(a.ws + WS_WUP), scr, r, 256, lane); continue; } r -= I_UP;
        if (r < I_DN) { transpose_item<0>(a.w_down, DFF, DM, (bf16_t*)(a.ws + WS_WDN), scr, r, 64, lane); continue; } r -= I_DN;
        if (r < I_W1) { transpose_item<0>(a.cmp_w1_k, 4096, 256, (bf16_t*)(a.ws + WS_W1T), scr, r, 8, lane); continue; } r -= I_W1;
        if (r < I_W1) { transpose_item<0>(a.cmp_w1_v, 4096, 256, (bf16_t*)(a.ws + WS_W1T) + 256 * 4096, scr, r, 8, lane); continue; } r -= I_W1;
        if (r < I_W2) { transpose_item<0>(a.cmp_w2_k, 256, 128, (bf16_t*)(a.ws + WS_W2T), scr, r, 4, lane); continue; } r -= I_W2;
        transpose_item<0>(a.cmp_w2_v, 256, 128, (bf16_t*)(a.ws + WS_W2T) + 128 * 256, scr, r, 4, lane);
    }
    if (vcu == 255 && wave == 7) { const float gk = fmaxf(fabsf(a.cmp_k_norm[lane]), fabsf(a.cmp_k_norm[64 + lane])), gq = fmaxf(fabsf(a.nsa_q_norm[lane]), fabsf(a.nsa_q_norm[64 + lane]));
        const float mb = wave_max(gk) * wave_max(gq) * (128.f * 1.02f); if (lane == 0) *(float*)(a.ws + WS_MBOUND) = mb; }
    float* rope = (float*)(a.ws + WS_ROPE);
    for (int e = (vcu * NTHR + tid); e < T * 64; e += G * NTHR) { const int t = e >> 6, i = e & 63;
        const float inv_freq = (float)pow(10000.0, -(double)i / 64.0); const float ang = (float)t * inv_freq;
        rope[2 * e] = (float)cos((double)ang); rope[2 * e + 1] = (float)sin((double)ang); }
    float* pebp = (float*)(a.ws + WS_PEBP);
    for (int it = gw; it < 2 * 4 * 64; it += NGW) { const int kv = it >> 8, cg_ = (it >> 6) & 3, ch = it & 63, col = cg_ * 64 + lane;
        const float* pe = kv ? a.cmp_pe_v : a.cmp_pe_k; const float* w1 = kv ? a.cmp_w1_v : a.cmp_w1_k; float s = 0.f;
#pragma unroll
        for (int i = 0; i < 64; ++i) s += pe[ch * 64 + i] * w1[(size_t)(ch * 64 + i) * 256 + col];
        pebp[((size_t)kv * 64 + ch) * 256 + col] = s; }
}

template <bool FIRST>
__device__ __forceinline__ void norm_phase(const Args& a, LAS unsigned char* lds, const float* xsrc, const float* gain, int shift_off, int scale_off, int bid, int G) {
    int tid = threadIdx.x; asm volatile("" : "+v"(tid)); const int lane = tid & 63, wave = __builtin_amdgcn_readfirstlane(tid >> 6);
    LAS float* AS = (LAS float*)lds; LAS float* SH = AS + DM;
    const float* modp = (const float*)(a.ws + WS_MODP); float* mod = (float*)(a.ws + WS_MOD);
    const int rows_per = M / G, b = (bid * rows_per) / T;
    f32x4 v[4][8];
#pragma unroll
    for (int rr = 0; rr < 4; ++rr) { const f32x4* xr = (const f32x4*)(xsrc + (size_t)(bid * rows_per + wave + 8 * rr) * DM) + lane;
#pragma unroll
        for (int j = 0; j < 8; ++j) v[rr][j] = xr[64 * j]; }
    if (FIRST) handoff_wait((unsigned*)(a.ws + CTL_CNT_ADALN), 16u * 48u);
    for (int d = tid; d < DM; d += NTHR) { float sc, sh;
        if (FIRST) { sc = a.b_ada[scale_off + d]; sh = a.b_ada[shift_off + d];
#pragma unroll
            for (int kc = 0; kc < 16; ++kc) { sc += modp[((size_t)kc * 2 + b) * (6 * DM) + scale_off + d]; sh += modp[((size_t)kc * 2 + b) * (6 * DM) + shift_off + d]; } }
        else { sc = mod[b * 6 * DM + scale_off + d]; sh = mod[b * 6 * DM + shift_off + d]; }
        AS[d] = gain[d] * (1.f + sc); SH[d] = sh; }
    if (FIRST) {
        for (int e = bid * NTHR + tid; e < 2 * 6 * DM; e += G * NTHR) { const int bb = e / (6 * DM), j = e % (6 * DM); float s = a.b_ada[j];
#pragma unroll
            for (int kc = 0; kc < 16; ++kc) s += modp[((size_t)kc * 2 + bb) * (6 * DM) + j];
            mod[e] = s; }
    }
    __syncthreads();
    bf16_t* XN = (bf16_t*)(a.ws + WS_XN);
    for (int r0 = 0; r0 < rows_per; r0 += 32) {
        if (r0 > 0) {
#pragma unroll
            for (int rr = 0; rr < 4; ++rr) { const f32x4* xr = (const f32x4*)(xsrc + (size_t)(bid * rows_per + r0 + wave + 8 * rr) * DM) + lane;
#pragma unroll
                for (int j = 0; j < 8; ++j) v[rr][j] = xr[64 * j]; } }
#pragma unroll
        for (int rr = 0; rr < 4; ++rr) { const int row = bid * rows_per + r0 + wave + 8 * rr; float ss = 0.f;
#pragma unroll
            for (int j = 0; j < 8; ++j) ss += (v[rr][j][0] * v[rr][j][0] + v[rr][j][1] * v[rr][j][1]) + (v[rr][j][2] * v[rr][j][2] + v[rr][j][3] * v[rr][j][3]);
            const float rstd = 1.0f / sqrtf(wave_sum(ss) * (1.f / DM) + EPS);
            u32x2* o8 = (u32x2*)(XN + (size_t)row * DM) + lane;
#pragma unroll
            for (int j = 0; j < 8; ++j) { const f32x4 as = *(const LAS f32x4*)(AS + 4 * lane + 256 * j), sh = *(const LAS f32x4*)(SH + 4 * lane + 256 * j);
                const f32x4 h = v[rr][j] * rstd * as + sh; u32x2 w; w.x = cvt_pk_bf16(h[0], h[1]); w.y = cvt_pk_bf16(h[2], h[3]); o8[64 * j] = w; } }
    }
    __syncthreads();
}


__device__ __forceinline__ void cmp2_phase(const Args& a, LAS unsigned char* lds, int L0, int Lstride) {
    int tid = threadIdx.x; asm volatile("" : "+v"(tid)); const int lane = tid & 63, wave = __builtin_amdgcn_readfirstlane(tid >> 6);
    unsigned char* ws = a.ws;
    for (int L = L0; L < 64; L += Lstride) {
        {
            const int kv = L >> 5, bg = (L >> 3) & 3, rt = L & 7;
            LAS bf16_t* hidL = (LAS bf16_t*)lds;
            LAS float* red = (LAS float*)(lds + 32768);
            LAS float* pebL = (LAS float*)(lds + 36864);
            if (tid < 256) { const float* pebp = (const float*)(ws + WS_PEBP) + (size_t)kv * 64 * 256 + tid; float sp = 0.f;
#pragma unroll
                for (int ch = 0; ch < 64; ++ch) sp += pebp[ch * 256];
                pebL[tid] = sp; }
            __syncthreads();
            { const int row = tid >> 4, c0 = (tid & 15) * 16;
              const float* pp = (const float*)(ws + WS_PART) + ((size_t)(kv * 4 + bg) * 4) * 65536 + (size_t)(rt * 32 + row) * 256 + c0;
              const LAS float* peb = pebL + c0;
              f32x4 s0 = *(const LAS f32x4*)peb, s1 = *(const LAS f32x4*)(peb + 4), s2 = *(const LAS f32x4*)(peb + 8), s3 = *(const LAS f32x4*)(peb + 12);
#pragma unroll 4
              for (int ks = 0; ks < 4; ++ks) { const float* q = pp + (size_t)ks * 65536; s0 += *(const f32x4*)q; s1 += *(const f32x4*)(q + 4); s2 += *(const f32x4*)(q + 8); s3 += *(const f32x4*)(q + 12); }
              f32x4 sv[4] = {s0, s1, s2, s3}; unsigned w[8];
#pragma unroll
              for (int i = 0; i < 4; ++i) { f32x4 v = sv[i];
#pragma unroll
                  for (int e = 0; e < 4; ++e) v[e] = v[e] / (1.f + __expf(-v[e]));
                  w[2 * i] = cvt_pk_bf16(v[0], v[1]); w[2 * i + 1] = cvt_pk_bf16(v[2], v[3]); }
              *(LAS u32x4*)(hidL + row * 264 + c0) = (u32x4){w[0], w[1], w[2], w[3]}; *(LAS u32x4*)(hidL + row * 264 + c0 + 8) = (u32x4){w[4], w[5], w[6], w[7]}; }
            __syncthreads();
            const int fr = lane & 15, fq = lane >> 4;
            f32x4 acc[2] = {(f32x4){0.f, 0.f, 0.f, 0.f}, (f32x4){0.f, 0.f, 0.f, 0.f}};
            const bf16_t* w2 = (const bf16_t*)(ws + WS_W2T) + (size_t)kv * 128 * 256 + (size_t)(16 * wave + fr) * 256 + 8 * fq;
#pragma unroll
            for (int ks = 0; ks < 8; ++ks) { const bf16x8 bf = *(const bf16x8*)(w2 + ks * 32);
#pragma unroll
                for (int rg = 0; rg < 2; ++rg) { const bf16x8 af = *(const LAS bf16x8*)(hidL + (rg * 16 + fr) * 264 + ks * 32 + 8 * fq);
                    acc[rg] = __builtin_amdgcn_mfma_f32_16x16x32_bf16(af, bf, acc[rg], 0, 0, 0); } }
            float rstd[2][4];
            if (kv == 0) {
#pragma unroll
                for (int rg = 0; rg < 2; ++rg)
#pragma unroll
                    for (int e = 0; e < 4; ++e) { float q = acc[rg][e] * acc[rg][e]; q += __shfl_xor(q, 1); q += __shfl_xor(q, 2); q += __shfl_xor(q, 4); q += __shfl_xor(q, 8);
                        if (fr == 0) red[(rg * 16 + 4 * fq + e) * 8 + wave] = q; }
                __syncthreads();
#pragma unroll
                for (int rg = 0; rg < 2; ++rg)
#pragma unroll
                    for (int e = 0; e < 4; ++e) { const LAS float* rp = red + (rg * 16 + 4 * fq + e) * 8; const float tot = ((rp[0] + rp[1]) + (rp[2] + rp[3])) + ((rp[4] + rp[5]) + (rp[6] + rp[7]));
                        rstd[rg][e] = 1.0f / sqrtf(tot * (1.f / 128.f) + EPS) * a.cmp_k_norm[16 * wave + fr]; }
            } else {
#pragma unroll
                for (int rg = 0; rg < 2; ++rg)
#pragma unroll
                    for (int e = 0; e < 4; ++e) rstd[rg][e] = 1.f;
            }
            bf16_t* dst = (bf16_t*)(ws + (kv ? WS_VCMP : WS_KCMP)) + (size_t)bg * 256 * 128;
#pragma unroll
            for (int rg = 0; rg < 2; ++rg)
#pragma unroll
                for (int e = 0; e < 4; ++e) { const int n = rt * 32 + rg * 16 + 4 * fq + e; const float v = (n == 255) ? 0.f : acc[rg][e] * rstd[rg][e];
                    dst[(size_t)n * 128 + 16 * wave + fr] = (bf16_t)(cvt_pk_bf16(v, 0.f) & 0xffffu); }
            __syncthreads();
        }
    }
}


#define XB_TMO      128
#define XB_XCNT(j)  (256  + 64 * (j))
#define XB_XSUB(j)  (1280 + 64 * (j))
#define XB_XGEN(j)  (2304 + 64 * (j))
#define XB_TOP      3328
#define XB_TOPGEN   3392
#define XCD_BAR_WORDS 3456
#define XB_SPIN_CAP (1u << 22)
__device__ __forceinline__ unsigned xb_ld(unsigned* p)              { return __hip_atomic_load(p, __ATOMIC_RELAXED, __HIP_MEMORY_SCOPE_AGENT); }
__device__ __forceinline__ unsigned xb_add(unsigned* p, unsigned v) { return __hip_atomic_fetch_add(p, v, __ATOMIC_RELAXED, __HIP_MEMORY_SCOPE_AGENT); }
__device__ __forceinline__ unsigned xb_xcc_id() { return (unsigned)__builtin_amdgcn_s_getreg((3 << 11) | 20) & 0xFu; }
#define XB_SPIN(cond, bar) do { unsigned _sp = 0; while (cond) { __builtin_amdgcn_s_sleep(1); \
    if ((++_sp & 255u) == 0u) { if (xb_ld(&(bar)[XB_TMO])) break; if (_sp > XB_SPIN_CAP) { atomicAdd(&(bar)[XB_TMO], 1u); break; } } } } while (0)
struct XcdBarrier { unsigned* bar; unsigned x; volatile LAS unsigned* st; };
__device__ __forceinline__ XcdBarrier xcd_barrier_post(unsigned* bar, volatile LAS unsigned* st) {
    XcdBarrier b; b.bar = bar; b.x = xb_xcc_id(); b.st = st;
    if (threadIdx.x == 0) (void)xb_add(&bar[XB_XCNT(b.x)], 1u);
    return b;
}
__device__ __forceinline__ void xcd_barrier_complete(unsigned* bar, unsigned x, unsigned& nloc, unsigned& nx) {
    const unsigned G = gridDim.x * gridDim.y * gridDim.z;
    unsigned sum, cnt, mine, sp = 0u;
    for (;;) {
        sum = 0u; cnt = 0u; mine = 0u;
#pragma unroll
        for (unsigned j = 0; j < 16; ++j) { const unsigned c = xb_ld(&bar[XB_XCNT(j)]); sum += c; cnt += (c > 0u) ? 1u : 0u; mine = (j == x) ? c : mine; }
        if (sum == G) break;
        __builtin_amdgcn_s_sleep(1);
        if ((++sp & 255u) == 0u) { if (xb_ld(&bar[XB_TMO])) break; if (sp > XB_SPIN_CAP) { atomicAdd(&bar[XB_TMO], 1u); break; } }
    }
    nloc = mine > 0u ? mine : 1u; nx = cnt > 0u ? cnt : 1u;
}
__device__ __forceinline__ void xcd_barrier(const XcdBarrier& b) {
    asm volatile("s_waitcnt vmcnt(0)" ::: "memory");
    __syncthreads();
    if (threadIdx.x == 0) {
        unsigned* bar = b.bar;
        __builtin_amdgcn_s_waitcnt(0);
        unsigned nloc = b.st[0], nx = b.st[1];
        if (nloc == 0u) { xcd_barrier_complete(bar, b.x, nloc, nx); b.st[0] = nloc; b.st[1] = nx; }
        const unsigned old = xb_add(&bar[XB_XSUB(b.x)], 1u);
        const unsigned gen = old / nloc;
        if (old + 1u == (gen + 1u) * nloc) {
            __builtin_amdgcn_fence(__ATOMIC_RELEASE, "agent");
            asm volatile("s_waitcnt vmcnt(0)" ::: "memory");
            const unsigned og = xb_add(&bar[XB_TOP], 1u);
            const unsigned tg = og / nx;
            if (og + 1u == (tg + 1u) * nx) xb_add(&bar[XB_TOPGEN], 1u);
            else XB_SPIN(xb_ld(&bar[XB_TOPGEN]) == tg, bar);
            __builtin_amdgcn_fence(__ATOMIC_ACQUIRE, "agent");
            xb_add(&bar[XB_XGEN(b.x)], 1u);
            asm volatile("s_waitcnt vmcnt(0)" ::: "memory");
        } else {
            XB_SPIN(xb_ld(&bar[XB_XGEN(b.x)]) == gen, bar);
            __builtin_amdgcn_fence(__ATOMIC_ACQUIRE, "agent");
            asm volatile("s_waitcnt vmcnt(0)" ::: "memory");
        }
    }
    __syncthreads();
}

enum { PH_PRO = 0, PH_INPROJ = 1, PH_ATTN = 2, PH_OUTPROJ = 3, PH_UP = 4, PH_DOWN = 5, PH_END = 6 };

__global__ void __launch_bounds__(NTHR, 2) mega_kernel(Args a) {
    extern __shared__ __attribute__((aligned(16))) unsigned char lds_raw[];
    LAS unsigned char* lds = (LAS unsigned char*)lds_raw;
    const int G = gridDim.x, bid = blockIdx.x;
    const int vcu = (G % 8 == 0) ? (bid % 8) * (G / 8) + bid / 8 : bid;
    unsigned char* ws = a.ws;
    volatile LAS unsigned* bst = (volatile LAS unsigned*)(lds + LDS_BYTES - 64);
    if (threadIdx.x < 2) bst[threadIdx.x] = 0u;
    __syncthreads();
    const XcdBarrier gbar = xcd_barrier_post((unsigned*)(ws + WS_CTL) + 1024, bst);
#ifndef PHMASK
#define PHMASK 0xffff
#endif
#define IN(k) (((PHMASK >> (k)) & 1) && a.ph_lo <= (k) && (k) < a.ph_hi)
#ifdef PROBE_PHASE
#define STAMP(k) do { if (bid == 0 && threadIdx.x == 0) ((unsigned long long*)(ws + WS_CTL + 24576))[(k)] = __builtin_amdgcn_s_memrealtime(); } while (0)
#else
#define STAMP(k) do { } while (0)
#endif
#define SEAM(k) do { if (IN(k) && IN((k) + 1)) xcd_barrier(gbar); STAMP((k) + 1); } while (0)
    STAMP(0);
    if (IN(PH_PRO)) { p0_prologue(a, lds, vcu, G); __syncthreads(); norm_phase<true>(a, lds, a.x, a.norm1_g, 0, DM, bid, G); } SEAM(PH_PRO);
    if (IN(PH_INPROJ)) {
        pg8::StaticOrder S; S.init(M, NPAD, G, bid, ws + WS_XN, ws + WS_WIN, DM, DM); S.rm = 1;
        pg8::EpiIn E{ws, a.fox_q_norm, a.fox_k_norm, a.nsa_q_norm, a.slc_k_norm, a.win_k_norm, a.b_forget, (LAS float*)(lds + LDS_STATS), (unsigned*)(ws + CTL_CNT_KCVC), (unsigned*)(ws + CTL_CNT_GATE)};
        pg8::gemm_phase(lds, DM, DM, DM, S, E);
        if (bid >= 224) {
            handoff_wait((unsigned*)(ws + CTL_CNT_KCVC), 64u * 8u);
            pg8::CmpOrder S2{32, bid - 224, (const char*)(ws + WS_KC), (const char*)(ws + WS_VC), (const char*)(ws + WS_W1T)};
            pg8::EpiPart E2{(float*)(ws + WS_PART), (unsigned*)(ws + CTL_CNT_PART)};
            pg8::gemm_phase(lds, 2048, 4096, 1024, S2, E2);
        }
        else if ((bid & 1) == 0 && (bid >> 3) < 16) {
            handoff_wait((unsigned*)(ws + CTL_CNT_PART), 32u * 8u);
            cmp2_phase(a, lds, (bid >> 3) * 4 + ((bid & 7) >> 1), 64);
        }
        else if ((bid & 1) == 0 && (bid >> 3) < 20) {
            handoff_wait((unsigned*)(ws + CTL_CNT_GATE), 32u * 8u);
            att::compute_kb(ws, ((bid >> 3) - 16) * 4 + ((bid & 7) >> 1), (LAS char*)lds);
        }
    } SEAM(PH_INPROJ);
#ifdef PROBE_PHASE
    unsigned long long tA0 = __builtin_amdgcn_s_memrealtime();
#endif
    if (IN(PH_ATTN)) { att::attn_phase(a, (LAS char*)lds, vcu, G); }
#ifdef PROBE_PHASE
    if (threadIdx.x == 0) { const unsigned d = (unsigned)(__builtin_amdgcn_s_memrealtime() - tA0); atomicMax((unsigned*)(ws + WS_CTL + 24576 + 256), d); atomicMax((unsigned*)(ws + WS_CTL + 24576 + 260), 0xffffffffu - d); }
#endif
    SEAM(PH_ATTN);
    if (IN(PH_OUTPROJ)) {
        pg8::StaticOrder S; S.init(M, DM, G, bid, ws + WS_AO, ws + WS_WOUT, DM, DM);
        pg8::EpiResNorm E{a.x, a.out, (const float*)(ws + WS_MOD), a.norm2_g, (bf16_t*)(ws + WS_XN), (float*)(ws + WS_SLOTS), (unsigned*)(ws + CTL_CNT_PANEL), (LAS float*)(lds + LDS_STATS)};
        pg8::gemm_phase(lds, DM, DM, DM, S, E);
    } SEAM(PH_OUTPROJ);
    if (IN(PH_UP)) {
        pg8::StaticOrder S; S.init(M, DFF, G, bid, ws + WS_XN, ws + WS_WUP, DM, DM);
        pg8::EpiUp E{(bf16_t*)(ws + WS_U), DFF};
        pg8::gemm_phase(lds, DM, DM, DM, S, E);
    } SEAM(PH_UP);
    if (IN(PH_DOWN)) {
        pg8::StaticOrder S; S.init(M, DM, G, bid, ws + WS_U, ws + WS_WDN, DFF, DFF);
        pg8::EpiRes E{a.out, a.out, (const float*)(ws + WS_MOD) + 5 * DM};
        pg8::gemm_phase(lds, DFF, DFF, DFF, S, E);
    }
    STAMP(PH_END);
#undef IN
#undef SEAM
}

#ifdef PROBE_PHASE
__global__ void probe_kernel(const unsigned long long* tsp, float* out) {
#if PROBE_PHASE == 98
    out[0] = (float)(((const unsigned*)tsp)[64]) * 1e-3f;
#elif PROBE_PHASE == 97
    out[0] = (float)(0xffffffffu - ((const unsigned*)tsp)[65]) * 1e-3f;
#elif PROBE_PHASE == 99
    out[0] = (float)(tsp[PH_END] - tsp[0]) * 5e-4f;
#else
    const unsigned long long t1 = tsp[PROBE_PHASE + 1], t0 = tsp[PROBE_PHASE]; out[0] = (float)(t1 - t0) * 1e-2f;
#endif
}
#endif
static void launch_phases(const Args& a0, int lo, int hi, int grid, hipStream_t stream) {
    Args a = a0; a.ph_lo = lo; a.ph_hi = hi; void* args[] = {&a};
    (void)args; hipLaunchKernelGGL(mega_kernel, dim3(grid), dim3(NTHR), LDS_BYTES, stream, a);
    hipError_t e = hipPeekAtLastError();
    if (e != hipSuccess) fprintf(stderr, "launch failed: %s (grid %d)\n", hipGetErrorString(e), grid);
}

extern "C" void kernel_launch(void* const* d_in, const int* in_sizes, int n_in, void* d_out, int out_size, void* d_ws, size_t ws_size, hipStream_t stream) {
    static int grid = 0;
    if (grid == 0) {
        int dev = 0, cus = 0, per_cu = 0; hipGetDevice(&dev); hipDeviceGetAttribute(&cus, hipDeviceAttributeMultiprocessorCount, dev);
        hipFuncSetAttribute((const void*)mega_kernel, hipFuncAttributeMaxDynamicSharedMemorySize, LDS_BYTES);
        hipOccupancyMaxActiveBlocksPerMultiprocessor(&per_cu, (const void*)mega_kernel, NTHR, LDS_BYTES);
        if (per_cu < 1) { fprintf(stderr, "occupancy query says %d blocks/CU\n", per_cu); per_cu = 1; }
        grid = 256;
        if (cus < 256) fprintf(stderr, "this kernel needs >= 256 CUs for a resident grid (device has %d)\n", cus);
        if (ws_size < WS_END + 24 * MiB) fprintf(stderr, "workspace too small: %zu\n", ws_size);
    }
    hipMemsetAsync((char*)d_ws + WS_CTL, 0, 49152, stream);
    Args a{};
    const float** ap = (const float**)&a;
    for (int i = 0; i < 23; ++i) ap[i] = (const float*)d_in[i];
    a.out = (float*)d_out; a.ws = (unsigned char*)d_ws;
    unsigned char* ws = a.ws;
    launch_phases(a, PH_PRO, PH_END, grid, stream);
#ifdef PROBE_PHASE
    probe_kernel<<<1, 1, 0, stream>>>((const unsigned long long*)(ws + WS_CTL + 24576), a.out);
#endif
}
```

```cpp
#include <hip/hip_runtime.h>
#include <hip/hip_cooperative_groups.h>
#include <stdint.h>
#include <math.h>
#include <cstdio>
namespace cg = cooperative_groups;
#define NF_IN 3

constexpr int DM = 2048, NB = 2, T = 4096, M = NB * T, HD = 128;
constexpr int DIN = 5664, DFF = 8192, NPAD = 5888;
constexpr int C_FQ = 0, C_FK = 1024, C_FV = 2048, C_FZ = 3072, C_NQ = 3080, C_KC = 4104, C_VC = 4360, C_KSL = 4616, C_VSL = 4872,
              C_KW = 5128, C_VW = 5384, C_GZ = 5640;
constexpr int NCMP = 255;
constexpr float SCALE = 0.08838834764831845f;
constexpr float EPS = 1e-6f;
constexpr int NWAVES = 8, NTHR = 512;

constexpr size_t MiB = 1u << 20;
constexpr size_t WS_CTL = 0;
constexpr size_t CTL_CNT_GATE = 21504;
constexpr size_t CTL_CNT_KCVC = 20480, CTL_CNT_PART = 20736, CTL_CNT_ADALN = 20992, CTL_CNT_PANEL = 32768, CTL_CNT_ATTN = 40960;
constexpr size_t WS_SLOTS = 64 * 1024;
constexpr size_t WS_MODP = 384 * 1024;
constexpr size_t WS_MOD = 2 * MiB;
constexpr size_t WS_ROPE = 3 * MiB;
constexpr size_t WS_PEBP = 5 * MiB;
constexpr size_t WS_PEB = 5 * MiB + 256 * 1024;
constexpr size_t WS_MBOUND = 5 * MiB + 300 * 1024;
constexpr size_t WS_LOGF = 5 * MiB + 320 * 1024;
constexpr size_t WS_KBIAS = 5 * MiB + 640 * 1024;
constexpr size_t WS_GATES = 6 * MiB;
constexpr size_t WS_W2T = 7 * MiB;
constexpr size_t WS_W1T = 8 * MiB;
constexpr size_t WS_WIN = 12 * MiB;
constexpr size_t WS_WOUT = 36 * MiB;
constexpr size_t WS_WUP = 44 * MiB;
constexpr size_t WS_WDN = 76 * MiB;
constexpr size_t WS_XN = 108 * MiB;
constexpr size_t WS_FQ = 140 * MiB, WS_FK = 156 * MiB, WS_FV = 172 * MiB, WS_NQ = 188 * MiB, WS_NQR = 204 * MiB;
constexpr size_t WS_KC = 220 * MiB, WS_VC = 224 * MiB, WS_KSL = 228 * MiB, WS_VSL = 232 * MiB, WS_KW = 236 * MiB, WS_VW = 240 * MiB;
constexpr size_t WS_KCMP = 244 * MiB, WS_VCMP = 244 * MiB + 512 * 1024;
constexpr size_t WS_PART = 245 * MiB;
constexpr size_t WS_NSAO = 277 * MiB;
constexpr size_t WS_AO = 309 * MiB;
constexpr size_t WS_U = 140 * MiB;
constexpr size_t WS_END = 341 * MiB;
constexpr size_t WS_DEV_CUM = 341 * MiB;
constexpr size_t WS_DEV_XB = 342 * MiB;
constexpr size_t WS_DEV_HID = 358 * MiB;
constexpr size_t WS_DEV_KC = 360 * MiB;

constexpr int LDS_STATS = 131072;
constexpr int LDS_BYTES = 155648;

#define LAS __attribute__((address_space(3)))
#define GAS __attribute__((address_space(1)))
typedef unsigned short bf16_t;
typedef short bf16x8 __attribute__((ext_vector_type(8)));
typedef float f32x4 __attribute__((ext_vector_type(4)));
typedef float f32x2 __attribute__((ext_vector_type(2)));
typedef unsigned u32x4 __attribute__((ext_vector_type(4)));
typedef unsigned u32x2 __attribute__((ext_vector_type(2)));

typedef __bf16 bf16x2_t __attribute__((ext_vector_type(2)));
__device__ __forceinline__ unsigned cvt_pk_bf16(float lo, float hi) { f32x2 v = {lo, hi}; bf16x2_t b = __builtin_convertvector(v, bf16x2_t); return __builtin_bit_cast(unsigned, b); }
__device__ __forceinline__ float bf2f(bf16_t v) { return __uint_as_float(((unsigned)v) << 16); }
__device__ __forceinline__ float wave_sum(float v) {
#pragma unroll
    for (int o = 1; o < 64; o <<= 1) v += __shfl_xor(v, o);
    return v;
}
__device__ __forceinline__ float wave_max(float v) {
#pragma unroll
    for (int o = 1; o < 64; o <<= 1) v = fmaxf(v, __shfl_xor(v, o));
    return v;
}


__device__ __forceinline__ void handoff_signal(unsigned* cnt, int lane) {
    asm volatile("s_waitcnt vmcnt(0)" ::: "memory");
    if (lane == 0) __hip_atomic_fetch_add(cnt, 1u, __ATOMIC_RELAXED, __HIP_MEMORY_SCOPE_AGENT);
}
__device__ __forceinline__ void handoff_wait(unsigned* cnt, unsigned target) {
    if (threadIdx.x < 64) { unsigned sp = 0;
        while ((unsigned)__builtin_amdgcn_readfirstlane(__hip_atomic_load(cnt, __ATOMIC_RELAXED, __HIP_MEMORY_SCOPE_AGENT)) < target) { __builtin_amdgcn_s_sleep(4); if (++sp > (1u << 24)) break; }
        __builtin_amdgcn_fence(__ATOMIC_ACQUIRE, "agent"); asm volatile("s_waitcnt vmcnt(0)" ::: "memory"); }
    __syncthreads();
}

namespace pg8 {
constexpr int BM = 256, BK = 64, HALF = 128, HTB = HALF * BK * 2, STAGE_BYTES = 8 * HTB, NXCD = 8, WGM = 8;
__host__ __device__ __forceinline__ int lds_byte(int r, int c) { const int st = (r >> 4) * 2 + (c >> 5), rr = r & 15, cc = c & 31, ob = rr * 64 + cc * 2; return st * 1024 + (ob ^ (((ob >> 9) & 1) << 5)); }
__host__ __device__ __forceinline__ void stage_rc(int b, int& R, int& C) { const int st = b / 1024, sb = b % 1024, swz = sb ^ (((sb >> 9) & 1) << 5); R = (st >> 1) * 16 + swz / 64; C = (st & 1) * 32 + (swz % 64) / 2; }
__host__ __device__ __forceinline__ int perm32(int rho) { const int n = rho >> 4, i = rho & 15; return 8 * (i >> 2) + 4 * n + (i & 3); }

struct Unit { int pm, pn, aux; };
#define NF_ERN 3
#ifndef NF_IN
#define NF_IN 2
#endif

struct StaticOrder {
    int nM, nN, nwg, G, c; const char* A; const char* Bt; size_t tsA, tsB; int rm = 0;
    __device__ __forceinline__ void init(int M_, int N_, int G_, int c_, const void* A_, const void* Bt_, int lda, int ldb) { nM = M_ / BM; nN = N_ / BM; nwg = nM * nN; G = G_; c = c_; A = (const char*)A_; Bt = (const char*)Bt_; tsA = (size_t)BM * lda * 2; tsB = (size_t)BM * ldb * 2; }
    __device__ __forceinline__ bool next(int i, Unit& u) const {
        const long L = (long)i * G + c; if (L >= nwg) return false;
        int wgid = (int)L; { const int q = nwg / NXCD, r = nwg % NXCD, xcd = wgid % NXCD, off = wgid / NXCD; wgid = (xcd < r ? xcd * (q + 1) : r * (q + 1) + (xcd - r) * q) + off; }
        const int nig = WGM * nN, gid = wgid / nig, fm = gid * WGM, gsz = (nM - fm) < WGM ? (nM - fm) : WGM;
        u.pm = fm + ((wgid % nig) % gsz); u.pn = (wgid % nig) / gsz; u.aux = 0;
        if (rm) { const int p = u.pn; u.pn = (int)(((p < 12 ? 0x4a0e6734a418820ull : 0x5ab49ad507b251ull) >> (5 * (p < 12 ? p : p - 12))) & 31ull); }
        return true;
    }
    __device__ __forceinline__ void ptrs(const Unit& u, const char*& a, const char*& b) const { a = A + (size_t)u.pm * tsA; b = Bt + (size_t)u.pn * tsB; }
};

template <class Epi, class Sched>
__device__ __forceinline__ void gemm_phase(LAS unsigned char* lds, const int lda, const int ldb, const int K, const Sched& S, const Epi& E) {
    int tid = threadIdx.x; asm volatile("" : "+v"(tid));
    const int wid = __builtin_amdgcn_readfirstlane(tid >> 6), lane = tid & 63, wr = wid >> 2, wc = wid & 3, fr = lane & 15, fq = lane >> 4;
    const int nt = K / BK;
    unsigned voffA[2], voffB[2];
#pragma unroll
    for (int i = 0; i < 2; ++i) { int R, C; stage_rc(tid * 16 + i * 8192, R, C); const int Rb = Epi::PERM ? ((R & ~31) + perm32(R & 31)) : R;
        voffA[i] = (unsigned)(R * lda + C) * 2u; voffB[i] = (unsigned)(Rb * ldb + C) * 2u; }
    const size_t kstep = (size_t)(BK * 2);
    const size_t hsA = (size_t)HALF * lda * 2, hsB = (size_t)HALF * ldb * 2;
    const unsigned ldsw = (unsigned)wid * 1024u;
    const int aoff = lds_byte(wr * 64 + fr, fq * 8), boff = lds_byte(wc * 32 + fr, fq * 8);
#define PG8_SA(b, h) (((b) * 2 + (h)) * HTB)
#define PG8_SB(b, h) ((4 + (b) * 2 + (h)) * HTB)
#define PG8_STAGE(bufoff, gbase, voff) do { _Pragma("unroll") for (int _i = 0; _i < 2; ++_i) \
        __builtin_amdgcn_global_load_lds((const unsigned*)((const char*)(gbase) + (voff)[_i]), (LAS unsigned*)(lds + (bufoff) + ldsw + _i * 8192), 16, 0, 0); } while (0)
#define PG8_LDA(dst, b, h) do { _Pragma("unroll") for (int m = 0; m < 4; ++m) _Pragma("unroll") for (int k = 0; k < 2; ++k) dst[m][k] = *(const LAS bf16x8*)(lds + PG8_SA(b, h) + aoff + m * 2048 + k * 1024); } while (0)
#define PG8_LDB(dst, b, h) do { _Pragma("unroll") for (int n = 0; n < 2; ++n) _Pragma("unroll") for (int k = 0; k < 2; ++k) dst[n][k] = *(const LAS bf16x8*)(lds + PG8_SB(b, h) + boff + n * 2048 + k * 1024); } while (0)
#define PG8_MMA(ai, bj, At, Bt) do { __builtin_amdgcn_s_setprio(1); _Pragma("unroll") for (int m = 0; m < 4; ++m) _Pragma("unroll") for (int n = 0; n < 2; ++n) _Pragma("unroll") for (int k = 0; k < 2; ++k) \
        acc[ai][bj][m][n] = __builtin_amdgcn_mfma_f32_16x16x32_bf16(Bt[n][k], At[m][k], acc[ai][bj][m][n], 0, 0, 0); __builtin_amdgcn_s_setprio(0); } while (0)
#define PG8_WAIT_V(n) asm volatile("s_waitcnt vmcnt(" #n ")" ::: "memory")
#define PG8_WAIT_L(n) asm volatile("s_waitcnt lgkmcnt(" #n ")" ::: "memory")
#define PG8_BAR __builtin_amdgcn_s_barrier()
#define PG8_SCHED __builtin_amdgcn_sched_barrier(0)
    Unit cur, nxt; int ui = 0;
    if (!S.next(0, cur)) return;
    f32x4 acc[2][2][4][2];
#pragma unroll
    for (int a = 0; a < 2; ++a)
#pragma unroll
        for (int b = 0; b < 2; ++b)
#pragma unroll
            for (int m = 0; m < 4; ++m)
#pragma unroll
                for (int n = 0; n < 2; ++n) acc[a][b][m][n] = (f32x4){0.f, 0.f, 0.f, 0.f};
    bf16x8 At[4][2], B0[2][2], B1[2][2];
    const char* cA; const char* cB; S.ptrs(cur, cA, cB);
    PG8_STAGE(PG8_SB(0, 0), cB, voffB); PG8_STAGE(PG8_SB(0, 1), cB + hsB, voffB); PG8_STAGE(PG8_SA(0, 0), cA, voffA); PG8_STAGE(PG8_SA(0, 1), cA + hsA, voffA);
    if (wr == 1) PG8_BAR;
    PG8_WAIT_V(2); PG8_BAR;
    PG8_STAGE(PG8_SB(1, 0), cB + kstep, voffB); PG8_STAGE(PG8_SA(1, 0), cA + kstep, voffA); PG8_STAGE(PG8_SB(1, 1), cB + hsB + kstep, voffB);
    PG8_WAIT_V(6); PG8_BAR;
    if constexpr (Epi::PREFETCH) E.prefetch(cur, lds + STAGE_BYTES, wid, lane);
    for (;;) {
        const bool has_next = S.next(ui + 1, nxt);
        const char* nA = cA; const char* nB = cB; if (has_next) S.ptrs(nxt, nA, nB);
#pragma nounroll
        for (int t = 0; t < nt; t += 2) {
            const bool last = (t == nt - 2);
            const char* a1 = cA + (size_t)(t + 1) * kstep;
            const char* a2 = last ? nA : cA + (size_t)(t + 2) * kstep; const char* b2 = last ? nB : cB + (size_t)(t + 2) * kstep;
            const char* a3 = a2 + kstep; const char* b3 = b2 + kstep;
            PG8_LDB(B0, 0, 0); PG8_LDB(B1, 0, 1); PG8_SCHED; PG8_LDA(At, 0, 0); PG8_STAGE(PG8_SA(1, 1), a1 + hsA, voffA);
            PG8_WAIT_V(8); PG8_WAIT_L(0); PG8_BAR; PG8_MMA(0, 0, At, B0); PG8_MMA(0, 1, At, B1); PG8_BAR; PG8_SCHED;
            PG8_LDA(At, 0, 1); PG8_STAGE(PG8_SB(0, 0), b2, voffB); PG8_STAGE(PG8_SB(0, 1), b2 + hsB, voffB); PG8_STAGE(PG8_SA(0, 0), a2, voffA);
            PG8_WAIT_V(8); PG8_WAIT_L(0); PG8_BAR; PG8_MMA(1, 0, At, B0); PG8_MMA(1, 1, At, B1); PG8_BAR; PG8_SCHED;
            PG8_LDB(B0, 1, 0); PG8_LDB(B1, 1, 1); PG8_SCHED; PG8_LDA(At, 1, 0); PG8_STAGE(PG8_SA(0, 1), a2 + hsA, voffA);
            PG8_WAIT_V(8); PG8_WAIT_L(0); PG8_BAR; PG8_MMA(0, 0, At, B0); PG8_MMA(0, 1, At, B1); PG8_BAR; PG8_SCHED;
            PG8_LDA(At, 1, 1); PG8_STAGE(PG8_SB(1, 0), b3, voffB); PG8_STAGE(PG8_SB(1, 1), b3 + hsB, voffB); PG8_STAGE(PG8_SA(1, 0), a3, voffA);
            PG8_WAIT_V(8); PG8_WAIT_L(0); PG8_BAR; PG8_MMA(1, 0, At, B0); PG8_MMA(1, 1, At, B1); PG8_BAR; PG8_SCHED;
        }
        if (wr == 0) PG8_BAR;
        E(acc, cur, wr, wc, fr, fq);
        if (!has_next) break;
#pragma unroll
        for (int a = 0; a < 2; ++a)
#pragma unroll
            for (int b = 0; b < 2; ++b)
#pragma unroll
                for (int m = 0; m < 4; ++m)
#pragma unroll
                    for (int n = 0; n < 2; ++n) acc[a][b][m][n] = (f32x4){0.f, 0.f, 0.f, 0.f};
        cur = nxt; cA = nA; cB = nB; ++ui;
        if (wr == 1) PG8_BAR;
    }
    PG8_WAIT_V(0);
    PG8_BAR;
#undef PG8_SA
#undef PG8_SB
#undef PG8_STAGE
#undef PG8_LDA
#undef PG8_LDB
#undef PG8_MMA
#undef PG8_WAIT_V
#undef PG8_WAIT_L
#undef PG8_BAR
#undef PG8_SCHED
}


struct EpiRes {
    static constexpr bool PERM = true, PREFETCH = false;
    const float* base; float* out; const float* gate;
    __device__ __forceinline__ void prefetch(const Unit& u, LAS unsigned char* dummy, int wid, int lane) const {
        const float* p = base + (size_t)(u.pm * BM + wid * 32) * DM + u.pn * BM + lane * 4;
#pragma unroll 8
        for (int r = 0; r < 32; ++r) __builtin_amdgcn_global_load_lds((const unsigned*)(p + (size_t)r * DM), (LAS unsigned*)(dummy + wid * 1024), 16, 0, 0);
    }
    __device__ __forceinline__ void operator()(const f32x4 (&acc)[2][2][4][2], const Unit& u, int wr, int wc, int fr, int fq) const {
        const int row0 = u.pm * BM + wr * 64 + fr, col0 = u.pn * BM + wc * 32 + 8 * fq;
        const int b = (u.pm * BM) / T;
        f32x4 gv[2][2];
#pragma unroll
        for (int bj = 0; bj < 2; ++bj)
#pragma unroll
            for (int n = 0; n < 2; ++n) gv[bj][n] = *(const f32x4*)(gate + (size_t)b * 6 * DM + col0 + bj * HALF + 4 * n);
#pragma unroll
        for (int ai = 0; ai < 2; ++ai)
#pragma unroll
            for (int m = 0; m < 4; ++m) { const size_t off = (size_t)(row0 + ai * HALF + m * 16) * DM + col0;
#pragma unroll
                for (int bj = 0; bj < 2; ++bj)
#pragma unroll
                    for (int n = 0; n < 2; ++n) { const f32x4 bs = *(const f32x4*)(base + off + bj * HALF + 4 * n);
                        *(f32x4*)(out + off + bj * HALF + 4 * n) = bs + gv[bj][n] * acc[ai][bj][m][n]; } }
    }
};

struct EpiResNorm {
    static constexpr bool PERM = true, PREFETCH = false;
    const float* base; float* out; const float* mod; const float* g2; bf16_t* XN; float* slots; unsigned* cnt; LAS float* tab;
    __device__ __forceinline__ void prefetch(const Unit& u, LAS unsigned char* dummy, int wid, int lane) const {
        const float* p = base + (size_t)(u.pm * BM + wid * 32) * DM + u.pn * BM + lane * 4;
#pragma unroll 8
        for (int r = 0; r < 32; ++r) __builtin_amdgcn_global_load_lds((const unsigned*)(p + (size_t)r * DM), (LAS unsigned*)(dummy + wid * 1024), 16, 0, 0);
    }
    __device__ __forceinline__ void operator()(f32x4 (&acc)[2][2][4][2], const Unit& u, int wr, int wc, int fr, int fq) const {
        const int row0 = u.pm * BM + wr * 64 + fr, col0 = u.pn * BM + wc * 32 + 8 * fq;
        const int b = (u.pm * BM) / T; const int wid = wr * 4 + wc, lane = fr + 16 * fq;
        const float* mb = mod + (size_t)b * 6 * DM;
        {   f32x4 gv[2][2];
#pragma unroll
            for (int bj = 0; bj < 2; ++bj)
#pragma unroll
                for (int n = 0; n < 2; ++n) gv[bj][n] = *(const f32x4*)(mb + 2 * DM + col0 + bj * HALF + 4 * n);
            f32x4 bs[NF_ERN][2][2];
#define ER_LD(g) do { const size_t off_ = (size_t)(row0 + ((g) >> 2) * HALF + ((g) & 3) * 16) * DM + col0; _Pragma("unroll") for (int bj = 0; bj < 2; ++bj) _Pragma("unroll") for (int n = 0; n < 2; ++n) \
            bs[(g) % NF_ERN][bj][n] = *(const f32x4*)(base + off_ + bj * HALF + 4 * n); } while (0)
            _Pragma("unroll") for (int g = 0; g < NF_ERN; ++g) ER_LD(g);
            asm volatile("" ::: "memory");
#pragma unroll
            for (int g = 0; g < 8; ++g) { const int ai = g >> 2, m = g & 3; float ss = 0.f;
#pragma unroll
                for (int bj = 0; bj < 2; ++bj)
#pragma unroll
                    for (int n = 0; n < 2; ++n) { const f32x4 v = bs[g % NF_ERN][bj][n] + gv[bj][n] * acc[ai][bj][m][n];
                        acc[ai][bj][m][n] = v; ss += (v[0] * v[0] + v[1] * v[1]) + (v[2] * v[2] + v[3] * v[3]); }
                if (g + NF_ERN < 8) ER_LD(g + NF_ERN);
                ss += __shfl_xor(ss, 16); ss += __shfl_xor(ss, 32);
                if (fq == 0) tab[(ai * HALF + wr * 64 + m * 16 + fr) * 4 + wc] = ss;
                asm volatile("" ::: "memory"); }
#undef ER_LD
        }
        asm volatile("s_waitcnt lgkmcnt(0)" ::: "memory"); __builtin_amdgcn_s_barrier(); asm volatile("" ::: "memory");
        const int prow = wid * 32 + (lane & 31);
        if (lane < 32) { const f32x4 q = *(const LAS f32x4*)(tab + prow * 4);
            __hip_atomic_store((unsigned*)slots + ((size_t)(u.pm * BM + prow) * 8 + u.pn), __float_as_uint((q[0] + q[1]) + (q[2] + q[3])), __ATOMIC_RELAXED, __HIP_MEMORY_SCOPE_AGENT); }
        asm volatile("s_waitcnt vmcnt(0)" ::: "memory");
        if (lane == 0) __hip_atomic_fetch_add(cnt + 64 * u.pm, 1u, __ATOMIC_RELAXED, __HIP_MEMORY_SCOPE_AGENT);
        f32x4 av[2][2], sv[2][2];
#pragma unroll
        for (int bj = 0; bj < 2; ++bj)
#pragma unroll
            for (int n = 0; n < 2; ++n) { const int c = col0 + bj * HALF + 4 * n; const f32x4 gg = *(const f32x4*)(g2 + c), sc = *(const f32x4*)(mb + 4 * DM + c);
                av[bj][n] = gg * (sc + 1.f); sv[bj][n] = *(const f32x4*)(mb + 3 * DM + c); }
        if (wid == 0) { unsigned sp = 0;
            while ((unsigned)__builtin_amdgcn_readfirstlane(__hip_atomic_load(cnt + 64 * u.pm, __ATOMIC_RELAXED, __HIP_MEMORY_SCOPE_AGENT)) < 64u) { __builtin_amdgcn_s_sleep(2); if (++sp > (1u << 22)) break; }
            __builtin_amdgcn_fence(__ATOMIC_ACQUIRE, "agent"); }
        asm volatile("s_waitcnt vmcnt(0) lgkmcnt(0)" ::: "memory"); __builtin_amdgcn_s_barrier(); asm volatile("" ::: "memory");
        if (lane < 32) { const unsigned* sl = (const unsigned*)slots + (size_t)(u.pm * BM + prow) * 8; float tot = 0.f;
#pragma unroll
            for (int t = 0; t < 8; ++t) tot += __uint_as_float(__hip_atomic_load(sl + t, __ATOMIC_RELAXED, __HIP_MEMORY_SCOPE_AGENT));
            tab[1024 + prow] = __builtin_amdgcn_rsqf(tot * (1.f / DM) + EPS); }
        asm volatile("s_waitcnt vmcnt(0) lgkmcnt(0)" ::: "memory"); __builtin_amdgcn_s_barrier(); asm volatile("" ::: "memory");
#pragma unroll
        for (int ai = 0; ai < 2; ++ai)
#pragma unroll
            for (int m = 0; m < 4; ++m) { const int rl = ai * HALF + wr * 64 + m * 16 + fr; const float rstd = tab[1024 + rl]; const size_t off = (size_t)(u.pm * BM + rl) * DM + col0;
#pragma unroll
                for (int bj = 0; bj < 2; ++bj) {
                    *(f32x4*)(out + off + bj * HALF) = acc[ai][bj][m][0]; *(f32x4*)(out + off + bj * HALF + 4) = acc[ai][bj][m][1];
                    const f32x4 h0 = acc[ai][bj][m][0] * rstd * av[bj][0] + sv[bj][0], h1 = acc[ai][bj][m][1] * rstd * av[bj][1] + sv[bj][1];
                    u32x4 w; w.x = cvt_pk_bf16(h0[0], h0[1]); w.y = cvt_pk_bf16(h0[2], h0[3]); w.z = cvt_pk_bf16(h1[0], h1[1]); w.w = cvt_pk_bf16(h1[2], h1[3]);
                    *(u32x4*)(XN + off + bj * HALF) = w; }
                asm volatile("" ::: "memory"); }
    }
};
struct EpiUp {
    static constexpr bool PERM = true, PREFETCH = false;
    bf16_t* O; int ldc;
    __device__ __forceinline__ void operator()(const f32x4 (&acc)[2][2][4][2], const Unit& u, int wr, int wc, int fr, int fq) const {
        const int row0 = u.pm * BM + wr * 64 + fr, col0 = u.pn * BM + wc * 32 + 8 * fq;
#pragma unroll
        for (int ai = 0; ai < 2; ++ai)
#pragma unroll
            for (int m = 0; m < 4; ++m) { bf16_t* rowp = O + (size_t)(row0 + ai * HALF + m * 16) * ldc + col0;
#pragma unroll
                for (int bj = 0; bj < 2; ++bj) { f32x4 v0 = acc[ai][bj][m][0], v1 = acc[ai][bj][m][1];
                    v0 = __builtin_elementwise_max(v0, (f32x4){0.f, 0.f, 0.f, 0.f}); v1 = __builtin_elementwise_max(v1, (f32x4){0.f, 0.f, 0.f, 0.f}); v0 = v0 * v0; v1 = v1 * v1;
                    u32x4 w; w.x = cvt_pk_bf16(v0[0], v0[1]); w.y = cvt_pk_bf16(v0[2], v0[3]); w.z = cvt_pk_bf16(v1[0], v1[1]); w.w = cvt_pk_bf16(v1[2], v1[3]);
                    *(u32x4*)(rowp + bj * HALF) = w; } }
    }
};
struct EpiIn {
    static constexpr bool PERM = true, PREFETCH = false;
    unsigned char* wsb;
    const float *g_fq, *g_fk, *g_nq, *g_slc, *g_win, *b_forget; LAS float* stats; unsigned* kcvc_cnt; unsigned* gate_cnt;
    __device__ __forceinline__ void operator()(const f32x4 (&acc)[2][2][4][2], const Unit& u, int wr, int wc, int fr, int fq) const {
        const int pn = u.pn;
        unsigned char* w_ = wsb; asm volatile("" : "+s"(w_));
        GAS bf16_t* const FQ = (GAS bf16_t*)(w_ + WS_FQ); GAS bf16_t* const FK = (GAS bf16_t*)(w_ + WS_FK); GAS bf16_t* const FV = (GAS bf16_t*)(w_ + WS_FV); GAS bf16_t* const NQ = (GAS bf16_t*)(w_ + WS_NQ); GAS bf16_t* const NQR = (GAS bf16_t*)(w_ + WS_NQR);
        GAS bf16_t* const KC = (GAS bf16_t*)(w_ + WS_KC); GAS bf16_t* const VC = (GAS bf16_t*)(w_ + WS_VC); GAS bf16_t* const KSL = (GAS bf16_t*)(w_ + WS_KSL); GAS bf16_t* const VSL = (GAS bf16_t*)(w_ + WS_VSL); GAS bf16_t* const KW = (GAS bf16_t*)(w_ + WS_KW); GAS bf16_t* const VW = (GAS bf16_t*)(w_ + WS_VW);
        GAS float* const LOGF = (GAS float*)(w_ + WS_LOGF); GAS float* const GATES = (GAS float*)(w_ + WS_GATES); const GAS float* const rope = (const GAS float*)(w_ + WS_ROPE);
        const int b = u.pm >> 4, t0 = (u.pm & 15) * BM + wr * 64 + fr;
        if (pn == 12) {
            if (wc == 0) {
#pragma unroll
                for (int ai = 0; ai < 2; ++ai)
#pragma unroll
                    for (int m = 0; m < 4; ++m) { const int t = t0 + ai * HALF + m * 16;
#pragma unroll
                        for (int n = 0; n < 2; ++n)
#pragma unroll
                            for (int e = 0; e < 4; ++e) { const int p = 8 * fq + 4 * n + e; const float v = acc[ai][0][m][n][e];
                                if (p < 8) { const float z = v + b_forget[p]; __hip_atomic_store((GAS unsigned*)(LOGF + ((size_t)b * 8 + p) * T + t), __float_as_uint(fminf(z, 0.f) - __logf(1.f + __expf(-fabsf(z)))), __ATOMIC_RELAXED, __HIP_MEMORY_SCOPE_AGENT); }
                                else { GATES[((size_t)b * T + t) * 24 + (p - 8)] = 1.f / (1.f + __expf(-v)); } } }
            }
            handoff_signal(gate_cnt, fr + 16 * fq);
            return;
        }
        if (pn < 4) body<true, true, false, false>(acc, u, wr, wc, fr, fq, FQ, nullptr, g_fq, rope, 8, 2 * pn);
        else if (pn < 8) body<true, true, false, false>(acc, u, wr, wc, fr, fq, FK, nullptr, g_fk, rope, 8, 2 * (pn - 4));
        else if (pn < 12) body<false, true, false, false>(acc, u, wr, wc, fr, fq, FV, nullptr, nullptr, rope, 8, 2 * (pn - 8));
        else if (pn < 17) body<true, true, true, false>(acc, u, wr, wc, fr, fq, NQ, NQR, g_nq, rope, 8, 2 * (pn - 13));
        else if (pn < 19) body<false, true, false, true>(acc, u, wr, wc, fr, fq, pn == 17 ? KC : VC, nullptr, nullptr, rope, 2, 0);
        else if (pn < 21) body<true, false, true, false>(acc, u, wr, wc, fr, fq, nullptr, pn == 19 ? KSL : KW, pn == 19 ? g_slc : g_win, rope, 2, 0);
        else body<false, true, false, false>(acc, u, wr, wc, fr, fq, pn == 21 ? VSL : VW, nullptr, nullptr, rope, 2, 0);
    }
    template <bool NORM, bool D1, bool D2, bool WT>
    __device__ __forceinline__ void body(const f32x4 (&acc)[2][2][4][2], const Unit& u, int wr, int wc, int fr, int fq, GAS bf16_t* d1, GAS bf16_t* d2, const float* gain, const GAS float* rope, int nh, int h0) const {
        const int b = u.pm >> 4, t0 = (u.pm & 15) * BM + wr * 64 + fr;
        const int dlo = 16 * wc + 4 * fq;
        f32x4 g0 = (f32x4){1.f, 1.f, 1.f, 1.f}, g1 = g0;
        if (NORM) { g0 = *(const f32x4*)(gain + dlo); g1 = *(const f32x4*)(gain + 64 + dlo); }
        f32x4 cs[NF_IN][2];
#define EI_LD(g) do { const int tn_ = t0 + ((g) >> 2) * HALF + ((g) & 3) * 16; const GAS float* rp_ = rope + ((size_t)tn_ * 64 + dlo) * 2; cs[(g) % NF_IN][0] = *(const GAS f32x4*)rp_; cs[(g) % NF_IN][1] = *(const GAS f32x4*)(rp_ + 4); } while (0)
        if (D2) { _Pragma("unroll") for (int g = 0; g < NF_IN; ++g) EI_LD(g); }
        if (NORM) {
#pragma unroll
            for (int ai = 0; ai < 2; ++ai)
#pragma unroll
                for (int m = 0; m < 4; ++m)
#pragma unroll
                    for (int bj = 0; bj < 2; ++bj) { const f32x4 a = acc[ai][bj][m][0], c = acc[ai][bj][m][1];
                        float s = (a[0] * a[0] + a[1] * a[1]) + (a[2] * a[2] + a[3] * a[3]) + (c[0] * c[0] + c[1] * c[1]) + (c[2] * c[2] + c[3] * c[3]);
                        { const unsigned x = __float_as_uint(s); const auto r = __builtin_amdgcn_permlane32_swap(x, x, false, false); s = __uint_as_float(r[0]) + __uint_as_float(r[1]); }
                        { const unsigned x = __float_as_uint(s); const auto r = __builtin_amdgcn_permlane16_swap(x, x, false, false); s = __uint_as_float(r[0]) + __uint_as_float(r[1]); }
                        if (fq == 0) stats[(ai * HALF + wr * 64 + m * 16 + fr) * 8 + bj * 4 + wc] = s; }
            asm volatile("s_waitcnt lgkmcnt(0)" ::: "memory"); __builtin_amdgcn_s_barrier(); asm volatile("" ::: "memory");
        }
#pragma unroll
        for (int g = 0; g < 8; ++g) { const int ai = g >> 2, m = g & 3; const int t = t0 + ai * HALF + m * 16;
            float rsv[2] = {1.f, 1.f};
            if (NORM) {
#pragma unroll
                for (int bj = 0; bj < 2; ++bj) { const f32x4 q = *(const LAS f32x4*)(stats + (ai * HALF + wr * 64 + m * 16 + fr) * 8 + bj * 4);
                    rsv[bj] = __builtin_amdgcn_rsqf(((q[0] + q[1]) + (q[2] + q[3])) * (1.f / 128.f) + EPS); } }
            f32x4 c = g0, sn = g0;
            if (D2) { c = (f32x4){cs[g % NF_IN][0][0], cs[g % NF_IN][0][2], cs[g % NF_IN][1][0], cs[g % NF_IN][1][2]}; sn = (f32x4){cs[g % NF_IN][0][1], cs[g % NF_IN][0][3], cs[g % NF_IN][1][1], cs[g % NF_IN][1][3]}; }
            if (D2 && g + NF_IN < 8) EI_LD(g + NF_IN);
#pragma unroll
            for (int bj = 0; bj < 2; ++bj) { f32x4 v0 = acc[ai][bj][m][0], v1 = acc[ai][bj][m][1];
                if (NORM) { const float r = rsv[bj]; v0 = v0 * r * g0; v1 = v1 * r * g1; }
                const size_t off = (((size_t)b * nh + h0 + bj) * T + t) * 128 + dlo;
                if (D1) { u32x2 w0, w1; w0.x = cvt_pk_bf16(v0[0], v0[1]); w0.y = cvt_pk_bf16(v0[2], v0[3]); w1.x = cvt_pk_bf16(v1[0], v1[1]); w1.y = cvt_pk_bf16(v1[2], v1[3]);
                    if (WT) { __hip_atomic_store((GAS unsigned long long*)(d1 + off), ((unsigned long long)w0.y << 32) | w0.x, __ATOMIC_RELAXED, __HIP_MEMORY_SCOPE_AGENT);
                        __hip_atomic_store((GAS unsigned long long*)(d1 + off + 64), ((unsigned long long)w1.y << 32) | w1.x, __ATOMIC_RELAXED, __HIP_MEMORY_SCOPE_AGENT); }
                    else { *(GAS u32x2*)(d1 + off) = w0; *(GAS u32x2*)(d1 + off + 64) = w1; } }
                if (D2) { const f32x4 r0 = v0 * c - v1 * sn, r1 = v1 * c + v0 * sn;
                    u32x2 w0, w1; w0.x = cvt_pk_bf16(r0[0], r0[1]); w0.y = cvt_pk_bf16(r0[2], r0[3]); w1.x = cvt_pk_bf16(r1[0], r1[1]); w1.y = cvt_pk_bf16(r1[2], r1[3]);
                    *(GAS u32x2*)(d2 + off) = w0; *(GAS u32x2*)(d2 + off + 64) = w1; } }
            asm volatile("" ::: "memory"); }
#undef EI_LD
        if (WT) handoff_signal(kcvc_cnt, fr + 16 * fq);
    }
};

struct EpiPart {
    static constexpr bool PERM = true, PREFETCH = false;
    float* P; unsigned* done_cnt;
    __device__ __forceinline__ void operator()(const f32x4 (&acc)[2][2][4][2], const Unit& u, int wr, int wc, int fr, int fq) const {
        const __amdgpu_buffer_rsrc_t rsrc = __builtin_amdgcn_make_buffer_rsrc(P, 0, 128 * 65536 * 4, 0x00020000);
        const unsigned base = ((unsigned)u.aux * 65536u + (unsigned)(wr * 64 + fr) * 256u + (unsigned)(wc * 32 + 8 * fq)) * 4u;
#pragma unroll
        for (int ai = 0; ai < 2; ++ai)
#pragma unroll
            for (int m = 0; m < 4; ++m) { const unsigned rp = base + (unsigned)(ai * HALF + m * 16) * 1024u;
#pragma unroll
                for (int bj = 0; bj < 2; ++bj)
#pragma unroll
                    for (int n = 0; n < 2; ++n) __builtin_amdgcn_raw_buffer_store_b128(__builtin_bit_cast(u32x4, acc[ai][bj][m][n]), rsrc, rp + (unsigned)(bj * HALF + 4 * n) * 4u, 0, 16);
                asm volatile("" ::: "memory"); }
        handoff_signal(done_cnt, fr + 16 * fq);
    }
};
struct CmpOrder {
    int G, c; const char* KC; const char* VC; const char* W1T;
    __device__ __forceinline__ bool next(int i, Unit& u) const { const int L = i * G + c; if (L >= 32) return false; u.pm = 0; u.pn = 0; u.aux = L; return true; }
    __device__ __forceinline__ void ptrs(const Unit& u, const char*& a, const char*& b) const { const int L = u.aux, kv = L >> 4, bg = (L >> 2) & 3, ks = L & 3;
        a = (kv ? VC : KC) + ((size_t)bg * T * 128 + ks * 1024) * 2; b = W1T + ((size_t)kv * 256 * 4096 + ks * 1024) * 2; }
};
}


struct Args {
    const float *x, *c, *w_ada, *b_ada, *norm1_g, *w_in, *b_forget, *fox_q_norm, *fox_k_norm, *nsa_q_norm, *cmp_k_norm, *slc_k_norm, *win_k_norm,
        *cmp_pe_k, *cmp_w1_k, *cmp_w2_k, *cmp_pe_v, *cmp_w1_v, *cmp_w2_v, *w_out, *norm2_g, *w_up, *w_down;
    float* out; unsigned char* ws; int ph_lo, ph_hi;
};

#ifndef DEV_ATT
#define DEV_ATT 3
#endif
namespace att {
typedef float f32x16 __attribute__((ext_vector_type(16)));
typedef short s16x4 __attribute__((ext_vector_type(4)));
constexpr int NW = 8, QBLK = 32, KVBLK = 64, D = 128;
constexpr int SHM_V = KVBLK * D * 2, SHM_K = KVBLK * D * 2;
constexpr int L_V = 0, L_K = 2 * SHM_V, L_WS = 2 * SHM_V + 2 * SHM_K, L_Q = L_WS + 2048;
constexpr int LC_V = 0, LC_K = 65536, LC_WS = 131072, LC_IMP = 133120;
constexpr int L_KB = 133120;
constexpr int L_SEL = 149504;
constexpr float THR = 8.f;
constexpr float C2 = 1.4426950408889634f * SCALE;
enum { M_FOX = 0, M_WIN = 1, M_SLC = 2 };
#define KSWZ(row, colB) ((row) * 256 + ((colB) ^ (((row) & 7) << 4)))
#define SBAR() __builtin_amdgcn_sched_barrier(0)
__device__ __forceinline__ int v_st(int k, int c) { const int kk = (k & ~0xC) | ((k & 4) << 1) | ((k & 8) >> 1); return ((kk >> 3) * 4 + (c >> 5)) * 512 + ((kk & 7) * 32 + (c & 31)) * 2; }
__device__ __forceinline__ int v_rd_base(int lane) { return ((lane & 3) << 3) | (((lane >> 2) & 3) << 6) | (((lane >> 4) & 1) << 5) | (((lane >> 5) & 1) << 8); }
constexpr int v_rd_off(int d0, int ks, int half) { return d0 * 512 + ks * 4096 + half * 2048; }
__device__ __forceinline__ int crow(int r, int hi) { return (r & 3) + 8 * (r >> 2) + 4 * hi; }
__device__ __forceinline__ bf16x8 load8(const bf16_t* p) { return *(const GAS bf16x8*)p; }
__device__ __forceinline__ void mask_tile(f32x16& p0, f32x16& p1, int dq, unsigned W) {
    const float NEG = -__builtin_inff();
#pragma unroll
    for (int r = 0; r < 16; ++r) { const int c = (r & 3) + 8 * (r >> 2);
        if ((unsigned)(dq - c) >= W) p0[r] = NEG;
        if ((unsigned)(dq - c - 32) >= W) p1[r] = NEG; }
}
__device__ __forceinline__ void partialSM(f32x16& p0, f32x16& p1, float& m_reg, float& mn, float& alpha) {
    float pmax = p0[0];
#pragma unroll
    for (int r = 1; r < 16; ++r) pmax = fmaxf(pmax, p0[r]);
#pragma unroll
    for (int r = 0; r < 16; ++r) pmax = fmaxf(pmax, p1[r]);
    { auto rr = __builtin_amdgcn_permlane32_swap(__float_as_uint(pmax), __float_as_uint(pmax), false, false);
      pmax = fmaxf(__uint_as_float(rr[0]), __uint_as_float(rr[1])); }
    if (__builtin_expect(__all((pmax - m_reg) * SCALE <= THR), 1)) { mn = m_reg; alpha = 1.f; }
    else { mn = fmaxf(m_reg, pmax); alpha = __builtin_amdgcn_exp2f((m_reg - mn) * C2); m_reg = mn; }
    const float mnL = -mn * C2;
#pragma unroll
    for (int r = 0; r < 16; ++r) p0[r] = fmaf(p0[r], C2, mnL);
#pragma unroll
    for (int r = 0; r < 16; ++r) p1[r] = fmaf(p1[r], C2, mnL);
#pragma unroll
    for (int r = 0; r < 16; ++r) p0[r] = __builtin_amdgcn_exp2f(p0[r]);
}
#define PK4(P, B_, OUT) do { unsigned a0 = cvt_pk_bf16(P[B_+0], P[B_+1]), a1 = cvt_pk_bf16(P[B_+2], P[B_+3]);                          \
        unsigned b0 = cvt_pk_bf16(P[B_+4], P[B_+5]), b1 = cvt_pk_bf16(P[B_+6], P[B_+7]);                                             \
        auto r0 = __builtin_amdgcn_permlane32_swap(a0, b0, false, false); auto r1 = __builtin_amdgcn_permlane32_swap(a1, b1, false, false); \
        u32x4 w = {r0[0], r1[0], r0[1], r1[1]}; OUT = *reinterpret_cast<bf16x8*>(&w); } while (0)
__device__ __forceinline__ void finishSM(f32x16& p0, f32x16& p1, float alpha, float& l_reg, bf16x8& pa0, bf16x8& pa1, bf16x8& pa2, bf16x8& pa3, bool on = true) {
#pragma unroll
    for (int r = 0; r < 16; ++r) p1[r] = __builtin_amdgcn_exp2f(p1[r]);
    float ps = 0;
#pragma unroll
    for (int r = 0; r < 16; ++r) ps += p0[r];
#pragma unroll
    for (int r = 0; r < 16; ++r) ps += p1[r];
    { auto rr = __builtin_amdgcn_permlane32_swap(__float_as_uint(ps), __float_as_uint(ps), false, false);
      ps = __uint_as_float(rr[0]) + __uint_as_float(rr[1]); }
    l_reg = l_reg * alpha + (on ? ps : 0.f);
    PK4(p0, 0, pa0); PK4(p0, 8, pa1); PK4(p1, 0, pa2); PK4(p1, 8, pa3);
    if (!on) { const bf16x8 z = {0, 0, 0, 0, 0, 0, 0, 0}; pa0 = z; pa1 = z; pa2 = z; pa3 = z; }
}
template <int KB>
__device__ __forceinline__ void qkt(f32x16& p0, f32x16& p1, const LAS char* K_lds, int r32, int hi, const LAS char* qs) {
    const LAS char* kb[4];
#pragma unroll
    for (int dd = 0; dd < 4; ++dd) kb[dd] = K_lds + KB * SHM_K + KSWZ(r32, (dd * 16 + hi * 8) * 2);
#pragma unroll
    for (int d0 = 0; d0 < 8; ++d0) { const LAS char* a = kb[d0 & 3] + (d0 >> 2) * 128;
        const bf16x8 q = *reinterpret_cast<const LAS bf16x8*>(qs + d0 * 1024);
        bf16x8 b0 = *reinterpret_cast<const LAS bf16x8*>(a);
        bf16x8 b1 = *reinterpret_cast<const LAS bf16x8*>(a + 32 * 256);
        p0 = __builtin_amdgcn_mfma_f32_32x32x16_bf16(b0, q, p0, 0, 0, 0);
        p1 = __builtin_amdgcn_mfma_f32_32x32x16_bf16(b1, q, p1, 0, 0, 0); }
}
template <int KB>
__device__ __forceinline__ void qkt_r(f32x16& p0, f32x16& p1, const LAS char* K_lds, int r32, int hi, const bf16x8* qr) {
    const LAS char* kb[4];
#pragma unroll
    for (int dd = 0; dd < 4; ++dd) kb[dd] = K_lds + KB * SHM_K + KSWZ(r32, (dd * 16 + hi * 8) * 2);
#pragma unroll
    for (int d0 = 0; d0 < 8; ++d0) { const LAS char* a = kb[d0 & 3] + (d0 >> 2) * 128;
        bf16x8 b0 = *reinterpret_cast<const LAS bf16x8*>(a);
        bf16x8 b1 = *reinterpret_cast<const LAS bf16x8*>(a + 32 * 256);
        p0 = __builtin_amdgcn_mfma_f32_32x32x16_bf16(b0, qr[d0], p0, 0, 0, 0);
        p1 = __builtin_amdgcn_mfma_f32_32x32x16_bf16(b1, qr[d0], p1, 0, 0, 0); }
}
template <int VB>
__device__ __forceinline__ void pv_tile(f32x16* o, int vb0, bf16x8 pa0, bf16x8 pa1, bf16x8 pa2, bf16x8 pa3) {
#define TRRD(dst, off) asm volatile("ds_read_b64_tr_b16 %0, %1 offset:%2" : "=&v"(dst) : "v"(vb0), "i"(off) : "memory")
#define PV_D0(d0) do { s16x4 l0, l1, l2, l3, h0, h1, h2, h3; constexpr int b_ = VB * SHM_V + v_rd_off(d0, 0, 0); \
        TRRD(l0, b_); TRRD(h0, b_ + 2048); TRRD(l1, b_ + 4096); TRRD(h1, b_ + 6144); TRRD(l2, b_ + 8192); TRRD(h2, b_ + 10240); TRRD(l3, b_ + 12288); TRRD(h3, b_ + 14336); \
        asm volatile("s_waitcnt lgkmcnt(0)" ::: "memory"); SBAR(); \
        o[d0] = __builtin_amdgcn_mfma_f32_32x32x16_bf16(pa0, (bf16x8){l0[0], l0[1], l0[2], l0[3], h0[0], h0[1], h0[2], h0[3]}, o[d0], 0, 0, 0);   \
        o[d0] = __builtin_amdgcn_mfma_f32_32x32x16_bf16(pa1, (bf16x8){l1[0], l1[1], l1[2], l1[3], h1[0], h1[1], h1[2], h1[3]}, o[d0], 0, 0, 0);   \
        o[d0] = __builtin_amdgcn_mfma_f32_32x32x16_bf16(pa2, (bf16x8){l2[0], l2[1], l2[2], l2[3], h2[0], h2[1], h2[2], h2[3]}, o[d0], 0, 0, 0);   \
        o[d0] = __builtin_amdgcn_mfma_f32_32x32x16_bf16(pa3, (bf16x8){l3[0], l3[1], l3[2], l3[3], h3[0], h3[1], h3[2], h3[3]}, o[d0], 0, 0, 0); } while (0)
    PV_D0(0); PV_D0(1); PV_D0(2); PV_D0(3);
#undef PV_D0
#undef TRRD
}

struct Blk {
    const bf16_t* Q;
    const bf16_t* K; const bf16_t* V;
    const float* KB;
    int mode, P0, j_lo, j_hi, b, hb;
};
struct Seam { bf16x8 st_v0, st_v1, st_k0, st_k1; };
__device__ __forceinline__ int q_lane_off(int mode, int wid, int r32) { return mode == M_FOX ? (wid * 32 + r32) * 128 : ((r32 >> 3) * T + wid * 8 + (r32 & 7)) * 128; }
#define ROW(p, k0, rr) ((p) + (size_t)((k0) + (rr)) * D + sc)
#define VMW() asm volatile("s_waitcnt vmcnt(0)" ::: "memory")
#define VMWN(n) asm volatile("s_waitcnt vmcnt(%0)" :: "i"(n) : "memory")
#define SLOAD_H(Kp, Vp, k0) do { S.st_v0 = load8(ROW(Vp, k0, sr)); S.st_v1 = load8(ROW(Vp, k0, 32 + sr)); S.st_k0 = load8(ROW(Kp, k0, sr)); S.st_k1 = load8(ROW(Kp, k0, 32 + sr)); } while (0)
#define SWRITE_HK(bf) do { *(LAS bf16x8*)(K_lds + (bf) * SHM_K + kws) = S.st_k0; *(LAS bf16x8*)(K_lds + (bf) * SHM_K + kws + 32 * 256) = S.st_k1; } while (0)
#define SWRITE_HV(bf) do { *(LAS bf16x8*)(V_lds + (bf) * SHM_V + vst0) = S.st_v0; *(LAS bf16x8*)(V_lds + (bf) * SHM_V + vst1) = S.st_v1; } while (0)
#define SWRITE_H(bf) do { SWRITE_HV(bf); SWRITE_HK(bf); } while (0)
__device__ __forceinline__ void attn_prime(const Blk& cur, LAS char* lds, Seam& S) {
    const int tid = threadIdx.x;
    const int sr = tid >> 4, sc = (tid & 15) * 8, kws = KSWZ(sr, sc * 2); LAS char* K_lds = lds + L_K;
    const int kb0 = cur.j_lo * KVBLK;
    SLOAD_H(cur.K, cur.V, kb0); VMW(); SWRITE_HK(0);
    __syncthreads();
}
struct EpiCtx { bf16_t* AO; float* NSAO; const float* GATES; unsigned* panel_cnt; };
__device__ __forceinline__ void attn_block(const Blk& cur, const Blk& nxt, LAS char* lds, Seam& S, const EpiCtx& ec) {
    int tid = threadIdx.x; asm volatile("" : "+v"(tid));
    const int wid = __builtin_amdgcn_readfirstlane(tid >> 6), lane = tid & 63, r32 = lane & 31, hi = lane >> 5;
    const int mode = cur.mode;
    const int j_lo = cur.j_lo, NT = cur.j_hi - cur.j_lo;
    const int kbn = nxt.j_lo * KVBLK;
    const bool fox = mode == M_FOX;
    const int wlo = cur.P0 + (fox ? wid * 32 : wid * 8), whi = wlo + (fox ? 31 : 7);
    const int pos = cur.P0 + (fox ? wid * 32 + r32 : wid * 8 + (r32 & 7)), qm = pos - 4 * hi;
    const unsigned Wu = (mode == M_WIN) ? 512u : (1u << 30);
    LAS char* V_lds = lds + L_V; LAS char* K_lds = lds + L_K;
    LAS float* ws = (LAS float*)(lds + L_WS) + wid * 64; LAS float* li_l = ws; LAS float* al_l = ws + 32;
    float m_reg = -1e30f, l_reg = 0; f32x16 o[4] = {};
    const int sr = tid >> 4, sc = (tid & 15) * 8, vst0 = v_st(sr, sc), vst1 = v_st(32 + sr, sc), kws = KSWZ(sr, sc * 2);
    const int vb0 = (int)(unsigned)(uintptr_t)V_lds + v_rd_base(lane);
    const bf16_t* Kh = cur.K; const bf16_t* Vh = cur.V;
    unsigned long long sel = ~0ull;
    if (mode == M_SLC) sel = *(const LAS unsigned long long*)(lds + L_SEL + (wid * 8 + (r32 & 7)) * 8);
#define RESC(a_) do { if (__any((a_) < 1.f)) { if (hi == 0) al_l[r32] = (a_); asm volatile("s_waitcnt lgkmcnt(0)" ::: "memory");              \
                     _Pragma("unroll") for (int d_ = 0; d_ < 4; ++d_) _Pragma("unroll") for (int r = 0; r < 16; ++r) o[d_][r] *= al_l[crow(r, hi)]; } } while (0)
#define KBASE(t) ((j_lo + (t)) * KVBLK)
#define PRELOAD(P0_, P1_, t) do { if (fox) { const LAS float* kbp_ = (const LAS float*)(lds + L_KB) + KBASE(t) + 4 * hi; \
            _Pragma("unroll") for (int q_ = 0; q_ < 4; ++q_) { const f32x4 a_ = *(const LAS f32x4*)(kbp_ + 8 * q_), b_ = *(const LAS f32x4*)(kbp_ + 32 + 8 * q_); \
                P0_[4*q_] = a_[0]; P0_[4*q_+1] = a_[1]; P0_[4*q_+2] = a_[2]; P0_[4*q_+3] = a_[3]; P1_[4*q_] = b_[0]; P1_[4*q_+1] = b_[1]; P1_[4*q_+2] = b_[2]; P1_[4*q_+3] = b_[3]; } } \
        else { P0_ = f32x16{}; P1_ = f32x16{}; } } while (0)
#define MASKT(P0_, P1_, t) do { const int kb_ = KBASE(t); \
        if (kb_ + KVBLK - 1 > wlo || kb_ + (int)Wu <= whi) mask_tile(P0_, P1_, qm - kb_, Wu); } while (0)
#define ONT(t) (mode != M_SLC || ((sel >> (j_lo + (t))) & 1ull) != 0ull)
    if (wid >= 4) __builtin_amdgcn_s_setprio(1);
    f32x16 pA0, pA1, pB0, pB1; float mnA, mnB, alA, alB; bf16x8 pa0, pa1, pa2, pa3;
    LAS char* qs = lds + L_Q + wid * 8192 + lane * 16;
    if (mode != M_SLC)
    { const bf16_t* qp = cur.Q + q_lane_off(mode, wid, r32) + hi * 8; bf16x8 tq[8];
#pragma unroll
      for (int d0 = 0; d0 < 8; ++d0) tq[d0] = load8(qp + d0 * 16);
#pragma unroll
      for (int d0 = 0; d0 < 8; ++d0) *(LAS bf16x8*)(qs + d0 * 1024) = tq[d0]; }
    PRELOAD(pA0, pA1, 0);
    SWRITE_HV(0); SBAR();
    if (NT > 1) SLOAD_H(Kh, Vh, KBASE(1));
    SBAR(); qkt<0>(pA0, pA1, K_lds, r32, hi, qs);
    if (NT > 1) PRELOAD(pB0, pB1, 1); else { pB0 = f32x16{}; pB1 = f32x16{}; }
    MASKT(pA0, pA1, 0); partialSM(pA0, pA1, m_reg, mnA, alA);
    if (NT > 1) { VMW(); SWRITE_H(1); }
    __syncthreads();
#define HALF_STEP(PX0, PX1, mnX, alX, PY0, PY1, alY, t, KB_, VB_, SB_) do {                                                      \
        SBAR(); if ((t) + 1 < NT) { SLOAD_H(Kh, Vh, KBASE((t) + 1)); SBAR(); }         \
        qkt<KB_>(PX0, PX1, K_lds, r32, hi, qs);                                             \
        finishSM(PY0, PY1, alY, l_reg, pa0, pa1, pa2, pa3, ONT((t) - 1)); SBAR();                                                           \
        if ((t) + 1 < NT) { PRELOAD(PY0, PY1, (t) + 1); SBAR(); }                                               \
        pv_tile<VB_>(o, vb0, pa0, pa1, pa2, pa3); MASKT(PX0, PX1, (t)); partialSM(PX0, PX1, m_reg, mnX, alX);                                        \
        __syncthreads();                                                                                                      \
        if ((t) + 1 < NT) { VMW(); SWRITE_H(SB_); }                                                                          \
        RESC(alX); __syncthreads(); } while (0)
    for (int t = 1; t + 1 < NT; t += 2) {
        HALF_STEP(pB0, pB1, mnB, alB, pA0, pA1, alA, t, 1, 0, 0);
        HALF_STEP(pA0, pA1, mnA, alA, pB0, pB1, alB, t + 1, 0, 1, 1);
    }
    const bool even = (NT & 1) == 0;
    if (even) { SBAR(); qkt<1>(pB0, pB1, K_lds, r32, hi, qs); SBAR(); }
    SLOAD_H(nxt.K, nxt.V, kbn); SBAR();
    SBAR();
    finishSM(pA0, pA1, alA, l_reg, pa0, pa1, pa2, pa3, ONT(even ? NT - 2 : NT - 1)); SBAR();
    pv_tile<0>(o, vb0, pa0, pa1, pa2, pa3);
    if (even) { MASKT(pB0, pB1, NT - 1); partialSM(pB0, pB1, m_reg, mnB, alB); __syncthreads(); RESC(alB);
        finishSM(pB0, pB1, alB, l_reg, pa0, pa1, pa2, pa3, ONT(NT - 1)); SBAR(); pv_tile<1>(o, vb0, pa0, pa1, pa2, pa3); }
    SBAR(); VMW(); SWRITE_HK(0); SBAR();
    if (hi == 0) li_l[r32] = l_reg; asm volatile("s_waitcnt lgkmcnt(0)" ::: "memory");
    if (fox) {
        bf16_t* Ow = ec.AO + ((size_t)cur.b * T + cur.P0 + wid * QBLK) * DM + cur.hb * 128;
#pragma unroll
        for (int r = 0; r < 16; ++r) { const int orow = crow(r, hi); const float li = li_l[orow]; const float rl = li > 0.f ? __builtin_amdgcn_rcpf(li) : 0.f;
#pragma unroll
            for (int d0 = 0; d0 < 4; ++d0) { const float v = o[d0][r] * rl; const float vn = __shfl_xor(v, 1);
                if ((r32 & 1) == 0) *(GAS unsigned*)(Ow + (size_t)orow * DM + d0 * 32 + r32) = cvt_pk_bf16(v, vn); } }
    } else {
        const int br = (mode == M_WIN) ? 2 : 1;
#pragma unroll
        for (int h8 = 0; h8 < 2; ++h8) {
            float gv[8]; float av[8][4], bv[8][4];
#pragma unroll
            for (int q = 0; q < 8; ++q) { const int rho = crow(h8 * 8 + q, hi);
                const int tok = cur.P0 + wid * 8 + (rho & 7), head = cur.hb + (rho >> 3); const size_t trow = (size_t)cur.b * T + tok;
                gv[q] = ((const GAS float*)ec.GATES)[trow * 24 + head * 3 + br];
                if (mode == M_SLC) { const GAS float* np = (const GAS float*)(ec.NSAO + trow * 1024 + head * 128 + r32); const GAS float* np2 = np + (ptrdiff_t)((WS_PART - WS_NSAO) / 4);
#pragma unroll
                    for (int d0 = 0; d0 < 4; ++d0) { av[q][d0] = np[d0 * 32]; bv[q][d0] = np2[d0 * 32]; } }
                else {
#pragma unroll
                    for (int d0 = 0; d0 < 4; ++d0) { av[q][d0] = 0.f; bv[q][d0] = 0.f; } } }
#pragma unroll
            for (int q = 0; q < 8; ++q) { const int r = h8 * 8 + q; const int rho = crow(r, hi); const float li = li_l[rho]; const float rl = li > 0.f ? __builtin_amdgcn_rcpf(li) : 0.f;
                const int tok = cur.P0 + wid * 8 + (rho & 7), head = cur.hb + (rho >> 3); const size_t trow = (size_t)cur.b * T + tok;
                const float gt = gv[q] * rl;
                GAS float* np2 = (GAS float*)(ec.NSAO + trow * 1024 + head * 128 + r32 + (ptrdiff_t)((WS_PART - WS_NSAO) / 4));
#pragma unroll
                for (int d0 = 0; d0 < 4; ++d0) {
                    if (mode == M_WIN) np2[d0 * 32] = gt * o[d0][r];
                    else { const float v = av[q][d0] + bv[q][d0] + gt * o[d0][r]; const float vn = __shfl_xor(v, 1); if ((r32 & 1) == 0) *(GAS unsigned*)(ec.AO + trow * DM + 1024 + head * 128 + d0 * 32 + r32) = cvt_pk_bf16(v, vn); } } }
            asm volatile("" ::: "memory"); }
    }
    __builtin_amdgcn_s_setprio(0);
    __syncthreads();
#undef RESC
#undef KBASE
#undef PRELOAD
#undef MASKT
#undef ONT
#undef HALF_STEP
}
#undef ROW
#undef SLOAD_H
#undef SWRITE_HK
#undef SWRITE_HV
#undef SWRITE_H

__device__ __forceinline__ bf16x8 ovfrag(int n0, int J) {
    asm volatile("" : "+v"(n0));
    unsigned w[4];
#pragma unroll
    for (int q = 0; q < 4; ++q) { unsigned lohi[2];
#pragma unroll
        for (int e = 0; e < 2; ++e) { const int dl = n0 + 2 * q + e - 4 * J; lohi[e] = (dl >= 0 && dl <= 2) ? 0x3F80u : ((dl == 3 || dl == -1) ? 0x3F00u : 0u); }
        w[q] = lohi[0] | (lohi[1] << 16); }
    u32x4 v = {w[0], w[1], w[2], w[3]}; return *reinterpret_cast<bf16x8*>(&v);
}
__device__ __forceinline__ void nsa_cmp_item(int b, int g, int qb, const bf16_t* NQ, const bf16_t* KCMP, const bf16_t* VCMP, const float* GATES, const float* mbound, float* NSAO, LAS char* lds) {
    int tid = threadIdx.x; asm volatile("" : "+v"(tid));
    const int wid = __builtin_amdgcn_readfirstlane(tid >> 6), lane = tid & 63, r32 = lane & 31, hi = lane >> 5;
    LAS char* V_lds = lds + LC_V; LAS char* K_lds = lds + LC_K;
    LAS float* ws = (LAS float*)(lds + LC_WS) + wid * 64; LAS float* li_l = ws;
    LAS float* impL = (LAS float*)(lds + LC_IMP);
    const int sr = tid >> 4, sc = (tid & 15) * 8, vst0 = v_st(sr, sc), vst1 = v_st(32 + sr, sc), kws = KSWZ(sr, sc * 2);
    const bf16_t* Kc = KCMP + (size_t)(b * 2 + g) * 256 * 128; const bf16_t* Vc = VCMP + (size_t)(b * 2 + g) * 256 * 128;
    const int ntile = ((4 * qb + 2) >> 6) + 1;
    bf16x8 qr[8];
    { const bf16_t* qp = NQ + (((size_t)b * 8 + g * 4) * T + qb * 64) * 128 + q_lane_off(M_WIN, wid, r32) + hi * 8;
#pragma unroll
      for (int d0 = 0; d0 < 8; ++d0) qr[d0] = load8(qp + d0 * 16); }
    {
        bf16x8 kk[4][2], vv[4][2];
#pragma unroll
        for (int tl = 0; tl < 4; ++tl) { kk[tl][0] = load8(Kc + (size_t)(tl * 64 + sr) * 128 + sc); kk[tl][1] = load8(Kc + (size_t)(tl * 64 + 32 + sr) * 128 + sc); }
#pragma unroll
        for (int tl = 0; tl < 4; ++tl) { vv[tl][0] = load8(Vc + (size_t)(tl * 64 + sr) * 128 + sc); vv[tl][1] = load8(Vc + (size_t)(tl * 64 + 32 + sr) * 128 + sc); }
#pragma unroll
        for (int tl = 0; tl < 4; ++tl) { *(LAS bf16x8*)(K_lds + tl * SHM_K + kws) = kk[tl][0]; *(LAS bf16x8*)(K_lds + tl * SHM_K + kws + 32 * 256) = kk[tl][1]; }
#pragma unroll
        for (int tl = 0; tl < 4; ++tl) { *(LAS bf16x8*)(V_lds + tl * SHM_V + vst0) = vv[tl][0]; *(LAS bf16x8*)(V_lds + tl * SHM_V + vst1) = vv[tl][1]; }
        asm volatile("" ::: "memory");
    }
    __syncthreads();
    const int pos = qb * 64 + wid * 8 + (r32 & 7);
    const int nmax = (pos - 31) >> 4;
    const float NEG = -__builtin_inff();
#define CMASK(P0_, P1_, tl) do { _Pragma("unroll") for (int r = 0; r < 16; ++r) { const int n_ = (tl) * 64 + crow(r, hi); if (n_ > nmax) P0_[r] = NEG; if (n_ + 32 > nmax) P1_[r] = NEG; } } while (0)
    const float mL = -(*(const GAS float*)mbound) * C2;
    float l_reg = 0.f;
    const int vb0 = (int)(unsigned)(uintptr_t)V_lds + v_rd_base(lane);
    f32x16 o[4] = {}; f32x16 io[2] = {};
#pragma nounroll
    for (int tl = 0; tl < ntile; ++tl) { f32x16 p0 = f32x16{}, p1 = f32x16{}; qkt_r<0>(p0, p1, K_lds + tl * SHM_K, r32, hi, qr); CMASK(p0, p1, tl);
        float ps = 0.f;
#pragma unroll
        for (int r = 0; r < 16; ++r) { p0[r] = __builtin_amdgcn_exp2f(fmaf(p0[r], C2, mL)); p1[r] = __builtin_amdgcn_exp2f(fmaf(p1[r], C2, mL)); ps += p0[r] + p1[r]; }
        l_reg += ps; bf16x8 pa0, pa1, pa2, pa3; PK4(p0, 0, pa0); PK4(p0, 8, pa1); PK4(p1, 0, pa2); PK4(p1, 8, pa3);
        pv_tile<0>(o, vb0 + tl * SHM_V, pa0, pa1, pa2, pa3); SBAR();
#pragma unroll
        for (int d0 = 0; d0 < 2; ++d0) { const int J = d0 * 32 + r32;
            io[d0] = __builtin_amdgcn_mfma_f32_32x32x16_bf16(pa0, ovfrag(tl * 64 + 0 + 8 * hi, J), io[d0], 0, 0, 0);
            io[d0] = __builtin_amdgcn_mfma_f32_32x32x16_bf16(pa1, ovfrag(tl * 64 + 16 + 8 * hi, J), io[d0], 0, 0, 0);
            io[d0] = __builtin_amdgcn_mfma_f32_32x32x16_bf16(pa2, ovfrag(tl * 64 + 32 + 8 * hi, J), io[d0], 0, 0, 0);
            io[d0] = __builtin_amdgcn_mfma_f32_32x32x16_bf16(pa3, ovfrag(tl * 64 + 48 + 8 * hi, J), io[d0], 0, 0, 0); } SBAR(); }
    { auto rr = __builtin_amdgcn_permlane32_swap(__float_as_uint(l_reg), __float_as_uint(l_reg), false, false); l_reg = __uint_as_float(rr[0]) + __uint_as_float(rr[1]); }
    if (hi == 0) li_l[r32] = l_reg; asm volatile("s_waitcnt lgkmcnt(0)" ::: "memory");
    {
        float gv[16];
#pragma unroll
        for (int r = 0; r < 16; ++r) { const int rho = crow(r, hi); gv[r] = ((const GAS float*)GATES)[((size_t)b * T + qb * 64 + wid * 8 + (rho & 7)) * 24 + (g * 4 + (rho >> 3)) * 3 + 0]; }
        float imps[2][4] = {};
#pragma unroll
        for (int r = 0; r < 16; ++r) { const int rho = crow(r, hi); const float li = li_l[rho]; const float rl = li > 0.f ? __builtin_amdgcn_rcpf(li) : 0.f;
            const int tok = qb * 64 + wid * 8 + (rho & 7), head = g * 4 + (rho >> 3);
            const size_t trow = (size_t)b * T + tok;
            const float gt = gv[r] * rl;
            GAS float* np = (GAS float*)(NSAO + trow * 1024 + head * 128 + r32);
#pragma unroll
            for (int d0 = 0; d0 < 4; ++d0) np[d0 * 32] = gt * o[d0][r];
            imps[0][r & 3] += io[0][r] * rl; imps[1][r & 3] += io[1][r] * rl; }
#pragma unroll
        for (int d0 = 0; d0 < 2; ++d0)
#pragma unroll
            for (int e = 0; e < 4; ++e) impL[(wid * 8 + e + 4 * hi) * 64 + d0 * 32 + r32] = imps[d0][e];
    }
#undef CMASK
    __syncthreads();
#pragma nounroll
    for (int tk = 0; tk < 8; ++tk) { const int tl = wid * 8 + tk; const int J = lane;
        const float im = impL[tl * 64 + J];
        const bool forced = (J == 0) || (J == qb) || (J == qb - 1);
        const float v = forced ? __builtin_inff() : (J <= qb ? im : NEG);
        impL[tl * 64 + J] = v; asm volatile("s_waitcnt lgkmcnt(0)" ::: "memory");
        f32x4 uv[16];
#pragma unroll
        for (int q = 0; q < 16; ++q) uv[q] = *(const LAS f32x4*)(impL + tl * 64 + 4 * q);
        int rank = 0;
#pragma unroll
        for (int q = 0; q < 16; ++q)
#pragma unroll
            for (int e = 0; e < 4; ++e) { const float u = uv[q][e]; const int jj = 4 * q + e; rank += (u > v || (u == v && jj < J)) ? 1 : 0; }
        const unsigned long long mk = __ballot(rank < 16 && J <= qb);
        if (lane == 0) *(LAS unsigned long long*)(lds + L_SEL + tl * 8) = mk; }
    __syncthreads();
}
#undef PK4
#undef VMW
#undef VMWN

template <class P> __device__ __forceinline__ P* uptr(P* p) { const unsigned long long v = (unsigned long long)p;
    const unsigned lo = __builtin_amdgcn_readfirstlane((unsigned)v), hi = __builtin_amdgcn_readfirstlane((unsigned)(v >> 32)); return (P*)(((unsigned long long)hi << 32) | lo); }
__device__ __forceinline__ Blk make_blk(unsigned char* ws, int i, int st) {
    const int bg = i >> 6, qb = i & 63, b = bg >> 1, g = bg & 1; Blk k;
    if (st < 2) {
        k.Q = uptr((const bf16_t*)(ws + WS_NQR) + (((size_t)b * 8 + g * 4) * T + qb * 64) * 128);
        k.K = uptr((const bf16_t*)(ws + (st == 0 ? WS_KW : WS_KSL)) + (size_t)bg * T * 128); k.V = uptr((const bf16_t*)(ws + (st == 0 ? WS_VW : WS_VSL)) + (size_t)bg * T * 128);
        k.KB = nullptr; k.mode = st == 0 ? M_WIN : M_SLC; k.P0 = qb * 64; k.j_lo = (st == 0 && qb >= 8) ? qb - 8 : 0; k.j_hi = qb + 1; k.b = b; k.hb = g * 4;
    } else {
        const int bh = bg * 4 + (qb & 3), qf = 15 - (qb >> 2);
        k.Q = uptr((const bf16_t*)(ws + WS_FQ) + ((size_t)bh * T + qf * 256) * 128); k.K = uptr((const bf16_t*)(ws + WS_FK) + (size_t)bh * T * 128); k.V = uptr((const bf16_t*)(ws + WS_FV) + (size_t)bh * T * 128);
        k.KB = uptr((const float*)(ws + WS_KBIAS) + (size_t)bh * T); k.mode = M_FOX; k.P0 = qf * 256; k.j_lo = 0; k.j_hi = 4 * qf + 4; k.b = bh >> 3; k.hb = bh & 7;
    }
    k.mode = __builtin_amdgcn_readfirstlane(k.mode); k.P0 = __builtin_amdgcn_readfirstlane(k.P0); k.j_lo = __builtin_amdgcn_readfirstlane(k.j_lo); k.j_hi = __builtin_amdgcn_readfirstlane(k.j_hi);
    k.b = __builtin_amdgcn_readfirstlane(k.b); k.hb = __builtin_amdgcn_readfirstlane(k.hb);
    return k;
}
__device__ __forceinline__ void compute_kb(unsigned char* ws, int bh, LAS char* lds) {
    int tid = threadIdx.x; asm volatile("" : "+v"(tid));
    LAS double* part = (LAS double*)(lds + LC_IMP);
    const float* lf = (const float*)(ws + WS_LOGF) + (size_t)bh * T + tid * 8; float* kb = (float*)(ws + WS_KBIAS) + (size_t)bh * T + tid * 8;
    const f32x4 v0 = *(const f32x4*)lf, v1 = *(const f32x4*)(lf + 4);
    double loc[8]; double run = 0.0;
    { const float vv[8] = {v0[0], v0[1], v0[2], v0[3], v1[0], v1[1], v1[2], v1[3]};
#pragma unroll
      for (int i = 0; i < 8; ++i) { run += (double)vv[i]; loc[i] = run; } }
    const int lane = tid & 63, wv = tid >> 6; double inc = run;
#pragma unroll
    for (int o = 1; o < 64; o <<= 1) { const double up = __shfl_up(inc, o); if (lane >= o) inc += up; }
    if (lane == 63) part[wv] = inc;
    __syncthreads();
    double off = inc - run;
    for (int w = 0; w < wv; ++w) off += part[w];
    f32x4 o0, o1;
#pragma unroll
    for (int i = 0; i < 4; ++i) { o0[i] = (float)(-(off + loc[i]) * (double)(1.0f / SCALE)); o1[i] = (float)(-(off + loc[4 + i]) * (double)(1.0f / SCALE)); }
    *(f32x4*)kb = o0; *(f32x4*)(kb + 4) = o1;
    asm volatile("s_waitcnt vmcnt(0)" ::: "memory");
    __syncthreads();
}
__device__ __forceinline__ void stage_kb(const float* kbg, LAS char* lds) {
    int tid = threadIdx.x; asm volatile("" : "+v"(tid));
    const f32x4 v0 = *(const GAS f32x4*)(kbg + tid * 8), v1 = *(const GAS f32x4*)(kbg + tid * 8 + 4);
    LAS float* kl = (LAS float*)(lds + L_KB) + tid * 8;
    *(LAS f32x4*)kl = v0; *(LAS f32x4*)(kl + 4) = v1;
    __syncthreads();
}
__device__ __forceinline__ void attn_phase(const Args& a, LAS char* lds, int vcu, int G) {
    unsigned char* ws = a.ws;
    EpiCtx ec{(bf16_t*)(ws + WS_AO), (float*)(ws + WS_NSAO), (const float*)(ws + WS_GATES), (unsigned*)(ws + CTL_CNT_ATTN)};
    Seam S;
    constexpr int ST0 = (DEV_ATT == 1) ? 2 : 0, ST1 = (DEV_ATT == 2) ? 2 : 3;
    for (int i = vcu; i < 256; i += G) {
#ifndef NO_CMP
        if (DEV_ATT & 2) { const int bg = i >> 6, qb = i & 63; nsa_cmp_item(bg >> 1, bg & 1, qb, (const bf16_t*)(ws + WS_NQ), (const bf16_t*)(ws + WS_KCMP), (const bf16_t*)(ws + WS_VCMP), ec.GATES, (const float*)(ws + WS_MBOUND), ec.NSAO, lds); }
#endif
#ifndef NO_BLK
        Blk cur = make_blk(ws, i, ST0);
        attn_prime(cur, lds, S);
        for (int st = ST0; st < ST1; ++st) { const Blk nxt = make_blk(ws, i, st + 1 < ST1 ? st + 1 : st);
            if (st == 2) stage_kb(cur.KB, lds);
            attn_block(cur, nxt, lds, S, ec); cur = nxt; }
#endif
    }
}
#undef KSWZ
#undef SBAR
}


__device__ __forceinline__ int win_src_col(int pg) {
    const int pn = pg >> 8, p = pg & 255;
    if (pn == 12) { if (p < 8) return C_FZ + p; if (p < 32) return C_GZ + p - 8; return -1; }
    const int bj = p >> 7, q = p & 127;
    const int d = 16 * (q >> 5) + 4 * ((q >> 3) & 3) + (q & 3) + 64 * ((q >> 2) & 1);
    int base;
    if (pn < 4) base = C_FQ + pn * 256; else if (pn < 8) base = C_FK + (pn - 4) * 256; else if (pn < 12) base = C_FV + (pn - 8) * 256;
    else if (pn < 17) base = C_NQ + (pn - 13) * 256; else if (pn == 17) base = C_KC; else if (pn == 18) base = C_VC; else if (pn == 19) base = C_KSL;
    else if (pn == 20) base = C_KW; else if (pn == 21) base = C_VSL; else base = C_VW;
    return base + bj * 128 + d;
}
template <int SRC>
__device__ __forceinline__ void transpose_item(const float* W, int K, int N, bf16_t* WT, LAS float* scr, int item, int nblk, int lane) {
    const int kb = item / nblk, nb = item % nblk, k0 = 64 * kb, n0 = 32 * nb;
    int sc = n0 + (lane & 31); if (SRC == 1) sc = win_src_col(sc);
    float tv[32];
    const float* wp = W + (size_t)(k0 + (lane >> 5)) * N + (sc >= 0 ? sc : 0);
#pragma unroll
    for (int i = 0; i < 32; ++i) tv[i] = wp[(size_t)(2 * i) * N];
#pragma unroll
    for (int i = 0; i < 32; ++i) { const int kk = 2 * i + (lane >> 5); scr[kk * 33 + (lane & 31)] = sc >= 0 ? tv[i] : 0.f; }
    asm volatile("s_waitcnt lgkmcnt(0)" ::: "memory");
    const int cch = lane & 7;
#pragma unroll
    for (int j = 0; j < 4; ++j) { const int n = (lane >> 3) + 8 * j; const LAS float* s = scr + (8 * cch) * 33 + n;
        u32x4 o; o.x = cvt_pk_bf16(s[0 * 33], s[1 * 33]); o.y = cvt_pk_bf16(s[2 * 33], s[3 * 33]); o.z = cvt_pk_bf16(s[4 * 33], s[5 * 33]); o.w = cvt_pk_bf16(s[6 * 33], s[7 * 33]);
        *(u32x4*)(WT + (size_t)(n0 + n) * K + k0 + 8 * cch) = o; }
    asm volatile("s_waitcnt lgkmcnt(0)" ::: "memory");
}

__device__ __forceinline__ void p0_prologue(const Args& a, LAS unsigned char* lds, int vcu, int G) {
    int tid = threadIdx.x; asm volatile("" : "+v"(tid)); const int lane = tid & 63, wave = __builtin_amdgcn_readfirstlane(tid >> 6);
    LAS float* ca = (LAS float*)lds;
    for (int i = tid; i < 2 * DM; i += NTHR) { const float v = a.c[i]; ca[i] = v / (1.f + __expf(-v)); }
    __syncthreads();
    const int gw = vcu * NWAVES + wave, NGW = G * NWAVES;
    float* modp = (float*)(a.ws + WS_MODP);
    if (wave < 3) { const int it = vcu * 3 + wave;
        if (it < 16 * 48) { const int kc = it / 48, cq = (it % 48) * 64 + lane;
            f32x4 a0 = (f32x4){0.f, 0.f, 0.f, 0.f}, a1 = a0;
            const float* wp = a.w_ada + (size_t)(kc * 128) * (6 * DM) + 4 * cq;
#pragma unroll 16
            for (int k = 0; k < 128; ++k) { const f32x4 w = *(const f32x4*)(wp + (size_t)k * (6 * DM)); a0 += w * ca[kc * 128 + k]; a1 += w * ca[DM + kc * 128 + k]; }
            const __amdgpu_buffer_rsrc_t rsrc = __builtin_amdgcn_make_buffer_rsrc(modp, 0, 16 * 2 * 6 * DM * 4, 0x00020000);
            __builtin_amdgcn_raw_buffer_store_b128(__builtin_bit_cast(u32x4, a0), rsrc, (unsigned)((((size_t)kc * 2 + 0) * (6 * DM) + 4 * cq) * 4), 0, 16);
            __builtin_amdgcn_raw_buffer_store_b128(__builtin_bit_cast(u32x4, a1), rsrc, (unsigned)((((size_t)kc * 2 + 1) * (6 * DM) + 4 * cq) * 4), 0, 16);
            handoff_signal((unsigned*)(a.ws + CTL_CNT_ADALN), lane); } }
    LAS float* scr = (LAS float*)(lds + 16384 + wave * 16384);
    constexpr int I_IN = 32 * (NPAD / 32), I_OUT = 32 * 64, I_UP = 32 * 256, I_DN = 128 * 64, I_W1 = 64 * 8, I_W2 = 4 * 4;
    constexpr int NIT = I_IN + I_OUT + I_UP + I_DN + 2 * I_W1 + 2 * I_W2;
    const int nslot = (NIT + G - 1) / G;
    for (int m = 0;; ++m) { int j; if (wave < 3) { if (m >= 6) break; j = wave * 6 + m; } else { j = 18 + (wave - 3) + 5 * m; }
        if (j >= nslot) break; const int it = vcu + G * j; if (it >= NIT) break; int r = it;
        if (r < I_IN) { transpose_item<1>(a.w_in, DM, DIN, (bf16_t*)(a.ws + WS_WIN), scr, r, NPAD / 32, lane); continue; } r -= I_IN;
        if (r < I_OUT) { transpose_item<0>(a.w_out, DM, DM, (bf16_t*)(a.ws + WS_WOUT), scr, r, 64, lane); continue; } r -= I_OUT;
        if (r < I_UP) { transpose_item<0>(a.w_up, DM, DFF, (bf16_t*)(a.ws + WS_WUP), scr, r, 256, lane); continue; } r -= I_UP;
        if (r < I_DN) { transpose_item<0>(a.w_down, DFF, DM, (bf16_t*)(a.ws + WS_WDN), scr, r, 64, lane); continue; } r -= I_DN;
        if (r < I_W1) { transpose_item<0>(a.cmp_w1_k, 4096, 256, (bf16_t*)(a.ws + WS_W1T), scr, r, 8, lane); continue; } r -= I_W1;
        if (r < I_W1) { transpose_item<0>(a.cmp_w1_v, 4096, 256, (bf16_t*)(a.ws + WS_W1T) + 256 * 4096, scr, r, 8, lane); continue; } r -= I_W1;
        if (r < I_W2) { transpose_item<0>(a.cmp_w2_k, 256, 128, (bf16_t*)(a.ws + WS_W2T), scr, r, 4, lane); continue; } r -= I_W2;
        transpose_item<0>(a.cmp_w2_v, 256, 128, (bf16_t*)(a.ws + WS_W2T) + 128 * 256, scr, r, 4, lane);
    }
    if (vcu == 255 && wave == 7) { const float gk = fmaxf(fabsf(a.cmp_k_norm[lane]), fabsf(a.cmp_k_norm[64 + lane])), gq = fmaxf(fabsf(a.nsa_q_norm[lane]), fabsf(a.nsa_q_norm[64 + lane]));
        const float mb = wave_max(gk) * wave_max(gq) * (128.f * 1.02f); if (lane == 0) *(float*)(a.ws + WS_MBOUND) = mb; }
    float* rope = (float*)(a.ws + WS_ROPE);
    for (int e = (vcu * NTHR + tid); e < T * 64; e += G * NTHR) { const int t = e >> 6, i = e & 63;
        const float inv_freq = (float)pow(10000.0, -(double)i / 64.0); const float ang = (float)t * inv_freq;
        rope[2 * e] = (float)cos((double)ang); rope[2 * e + 1] = (float)sin((double)ang); }
    float* pebp = (float*)(a.ws + WS_PEBP);
    for (int it = gw; it < 2 * 4 * 64; it += NGW) { const int kv = it >> 8, cg_ = (it >> 6) & 3, ch = it & 63, col = cg_ * 64 + lane;
        const float* pe = kv ? a.cmp_pe_v : a.cmp_pe_k; const float* w1 = kv ? a.cmp_w1_v : a.cmp_w1_k; float s = 0.f;
#pragma unroll
        for (int i = 0; i < 64; ++i) s += pe[ch * 64 + i] * w1[(size_t)(ch * 64 + i) * 256 + col];
        pebp[((size_t)kv * 64 + ch) * 256 + col] = s; }
}

template <bool FIRST>
__device__ __forceinline__ void norm_phase(const Args& a, LAS unsigned char* lds, const float* xsrc, const float* gain, int shift_off, int scale_off, int bid, int G) {
    int tid = threadIdx.x; asm volatile("" : "+v"(tid)); const int lane = tid & 63, wave = __builtin_amdgcn_readfirstlane(tid >> 6);
    LAS float* AS = (LAS float*)lds; LAS float* SH = AS + DM;
    const float* modp = (const float*)(a.ws + WS_MODP); float* mod = (float*)(a.ws + WS_MOD);
    const int rows_per = M / G, b = (bid * rows_per) / T;
    f32x4 v[4][8];
#pragma unroll
    for (int rr = 0; rr < 4; ++rr) { const f32x4* xr = (const f32x4*)(xsrc + (size_t)(bid * rows_per + wave + 8 * rr) * DM) + lane;
#pragma unroll
        for (int j = 0; j < 8; ++j) v[rr][j] = xr[64 * j]; }
    if (FIRST) handoff_wait((unsigned*)(a.ws + CTL_CNT_ADALN), 16u * 48u);
    for (int d = tid; d < DM; d += NTHR) { float sc, sh;
        if (FIRST) { sc = a.b_ada[scale_off + d]; sh = a.b_ada[shift_off + d];
#pragma unroll
            for (int kc = 0; kc < 16; ++kc) { sc += modp[((size_t)kc * 2 + b) * (6 * DM) + scale_off + d]; sh += modp[((size_t)kc * 2 + b) * (6 * DM) + shift_off + d]; } }
        else { sc = mod[b * 6 * DM + scale_off + d]; sh = mod[b * 6 * DM + shift_off + d]; }
        AS[d] = gain[d] * (1.f + sc); SH[d] = sh; }
    if (FIRST) {
        for (int e = bid * NTHR + tid; e < 2 * 6 * DM; e += G * NTHR) { const int bb = e / (6 * DM), j = e % (6 * DM); float s = a.b_ada[j];
#pragma unroll
            for (int kc = 0; kc < 16; ++kc) s += modp[((size_t)kc * 2 + bb) * (6 * DM) + j];
            mod[e] = s; }
    }
    __syncthreads();
    bf16_t* XN = (bf16_t*)(a.ws + WS_XN);
    for (int r0 = 0; r0 < rows_per; r0 += 32) {
        if (r0 > 0) {
#pragma unroll
            for (int rr = 0; rr < 4; ++rr) { const f32x4* xr = (const f32x4*)(xsrc + (size_t)(bid * rows_per + r0 + wave + 8 * rr) * DM) + lane;
#pragma unroll
                for (int j = 0; j < 8; ++j) v[rr][j] = xr[64 * j]; } }
#pragma unroll
        for (int rr = 0; rr < 4; ++rr) { const int row = bid * rows_per + r0 + wave + 8 * rr; float ss = 0.f;
#pragma unroll
            for (int j = 0; j < 8; ++j) ss += (v[rr][j][0] * v[rr][j][0] + v[rr][j][1] * v[rr][j][1]) + (v[rr][j][2] * v[rr][j][2] + v[rr][j][3] * v[rr][j][3]);
            const float rstd = 1.0f / sqrtf(wave_sum(ss) * (1.f / DM) + EPS);
            u32x2* o8 = (u32x2*)(XN + (size_t)row * DM) + lane;
#pragma unroll
            for (int j = 0; j < 8; ++j) { const f32x4 as = *(const LAS f32x4*)(AS + 4 * lane + 256 * j), sh = *(const LAS f32x4*)(SH + 4 * lane + 256 * j);
                const f32x4 h = v[rr][j] * rstd * as + sh; u32x2 w; w.x = cvt_pk_bf16(h[0], h[1]); w.y = cvt_pk_bf16(h[2], h[3]); o8[64 * j] = w; } }
    }
    __syncthreads();
}


__device__ __forceinline__ void cmp2_phase(const Args& a, LAS unsigned char* lds, int L0, int Lstride) {
    int tid = threadIdx.x; asm volatile("" : "+v"(tid)); const int lane = tid & 63, wave = __builtin_amdgcn_readfirstlane(tid >> 6);
    unsigned char* ws = a.ws;
    for (int L = L0; L < 64; L += Lstride) {
        {
            const int kv = L >> 5, bg = (L >> 3) & 3, rt = L & 7;
            LAS bf16_t* hidL = (LAS bf16_t*)lds;
            LAS float* red = (LAS float*)(lds + 32768);
            LAS float* pebL = (LAS float*)(lds + 36864);
            if (tid < 256) { const float* pebp = (const float*)(ws + WS_PEBP) + (size_t)kv * 64 * 256 + tid; float sp = 0.f;
#pragma unroll
                for (int ch = 0; ch < 64; ++ch) sp += pebp[ch * 256];
                pebL[tid] = sp; }
            __syncthreads();
            { const int row = tid >> 4, c0 = (tid & 15) * 16;
              const float* pp = (const float*)(ws + WS_PART) + ((size_t)(kv * 4 + bg) * 4) * 65536 + (size_t)(rt * 32 + row) * 256 + c0;
              const LAS float* peb = pebL + c0;
              f32x4 s0 = *(const LAS f32x4*)peb, s1 = *(const LAS f32x4*)(peb + 4), s2 = *(const LAS f32x4*)(peb + 8), s3 = *(const LAS f32x4*)(peb + 12);
#pragma unroll 4
              for (int ks = 0; ks < 4; ++ks) { const float* q = pp + (size_t)ks * 65536; s0 += *(const f32x4*)q; s1 += *(const f32x4*)(q + 4); s2 += *(const f32x4*)(q + 8); s3 += *(const f32x4*)(q + 12); }
              f32x4 sv[4] = {s0, s1, s2, s3}; unsigned w[8];
#pragma unroll
              for (int i = 0; i < 4; ++i) { f32x4 v = sv[i];
#pragma unroll
                  for (int e = 0; e < 4; ++e) v[e] = v[e] / (1.f + __expf(-v[e]));
                  w[2 * i] = cvt_pk_bf16(v[0], v[1]); w[2 * i + 1] = cvt_pk_bf16(v[2], v[3]); }
              *(LAS u32x4*)(hidL + row * 264 + c0) = (u32x4){w[0], w[1], w[2], w[3]}; *(LAS u32x4*)(hidL + row * 264 + c0 + 8) = (u32x4){w[4], w[5], w[6], w[7]}; }
            __syncthreads();
            const int fr = lane & 15, fq = lane >> 4;
            f32x4 acc[2] = {(f32x4){0.f, 0.f, 0.f, 0.f}, (f32x4){0.f, 0.f, 0.f, 0.f}};
            const bf16_t* w2 = (const bf16_t*)(ws + WS_W2T) + (size_t)kv * 128 * 256 + (size_t)(16 * wave + fr) * 256 + 8 * fq;
#pragma unroll
            for (int ks = 0; ks < 8; ++ks) { const bf16x8 bf = *(const bf16x8*)(w2 + ks * 32);
#pragma unroll
                for (int rg = 0; rg < 2; ++rg) { const bf16x8 af = *(const LAS bf16x8*)(hidL + (rg * 16 + fr) * 264 + ks * 32 + 8 * fq);
                    acc[rg] = __builtin_amdgcn_mfma_f32_16x16x32_bf16(af, bf, acc[rg], 0, 0, 0); } }
            float rstd[2][4];
            if (kv == 0) {
#pragma unroll
                for (int rg = 0; rg < 2; ++rg)
#pragma unroll
                    for (int e = 0; e < 4; ++e) { float q = acc[rg][e] * acc[rg][e]; q += __shfl_xor(q, 1); q += __shfl_xor(q, 2); q += __shfl_xor(q, 4); q += __shfl_xor(q, 8);
                        if (fr == 0) red[(rg * 16 + 4 * fq + e) * 8 + wave] = q; }
                __syncthreads();
#pragma unroll
                for (int rg = 0; rg < 2; ++rg)
#pragma unroll
                    for (int e = 0; e < 4; ++e) { const LAS float* rp = red + (rg * 16 + 4 * fq + e) * 8; const float tot = ((rp[0] + rp[1]) + (rp[2] + rp[3])) + ((rp[4] + rp[5]) + (rp[6] + rp[7]));
                        rstd[rg][e] = 1.0f / sqrtf(tot * (1.f / 128.f) + EPS) * a.cmp_k_norm[16 * wave + fr]; }
            } else {
#pragma unroll
                for (int rg = 0; rg < 2; ++rg)
#pragma unroll
                    for (int e = 0; e < 4; ++e) rstd[rg][e] = 1.f;
            }
            bf16_t* dst = (bf16_t*)(ws + (kv ? WS_VCMP : WS_KCMP)) + (size_t)bg * 256 * 128;
#pragma unroll
            for (int rg = 0; rg < 2; ++rg)
#pragma unroll
                for (int e = 0; e < 4; ++e) { const int n = rt * 32 + rg * 16 + 4 * fq + e; const float v = (n == 255) ? 0.f : acc[rg][e] * rstd[rg][e];
                    dst[(size_t)n * 128 + 16 * wave + fr] = (bf16_t)(cvt_pk_bf16(v, 0.f) & 0xffffu); }
            __syncthreads();
        }
    }
}


#define XB_TMO      128
#define XB_XCNT(j)  (256  + 64 * (j))
#define XB_XSUB(j)  (1280 + 64 * (j))
#define XB_XGEN(j)  (2304 + 64 * (j))
#define XB_TOP      3328
#define XB_TOPGEN   3392
#define XCD_BAR_WORDS 3456
#define XB_SPIN_CAP (1u << 22)
__device__ __forceinline__ unsigned xb_ld(unsigned* p)              { return __hip_atomic_load(p, __ATOMIC_RELAXED, __HIP_MEMORY_SCOPE_AGENT); }
__device__ __forceinline__ unsigned xb_add(unsigned* p, unsigned v) { return __hip_atomic_fetch_add(p, v, __ATOMIC_RELAXED, __HIP_MEMORY_SCOPE_AGENT); }
__device__ __forceinline__ unsigned xb_xcc_id() { return (unsigned)__builtin_amdgcn_s_getreg((3 << 11) | 20) & 0xFu; }
#define XB_SPIN(cond, bar) do { unsigned _sp = 0; while (cond) { __builtin_amdgcn_s_sleep(1); \
    if ((++_sp & 255u) == 0u) { if (xb_ld(&(bar)[XB_TMO])) break; if (_sp > XB_SPIN_CAP) { atomicAdd(&(bar)[XB_TMO], 1u); break; } } } } while (0)
struct XcdBarrier { unsigned* bar; unsigned x; volatile LAS unsigned* st; };
__device__ __forceinline__ XcdBarrier xcd_barrier_post(unsigned* bar, volatile LAS unsigned* st) {
    XcdBarrier b; b.bar = bar; b.x = xb_xcc_id(); b.st = st;
    if (threadIdx.x == 0) (void)xb_add(&bar[XB_XCNT(b.x)], 1u);
    return b;
}
__device__ __forceinline__ void xcd_barrier_complete(unsigned* bar, unsigned x, unsigned& nloc, unsigned& nx) {
    const unsigned G = gridDim.x * gridDim.y * gridDim.z;
    unsigned sum, cnt, mine, sp = 0u;
    for (;;) {
        sum = 0u; cnt = 0u; mine = 0u;
#pragma unroll
        for (unsigned j = 0; j < 16; ++j) { const unsigned c = xb_ld(&bar[XB_XCNT(j)]); sum += c; cnt += (c > 0u) ? 1u : 0u; mine = (j == x) ? c : mine; }
        if (sum == G) break;
        __builtin_amdgcn_s_sleep(1);
        if ((++sp & 255u) == 0u) { if (xb_ld(&bar[XB_TMO])) break; if (sp > XB_SPIN_CAP) { atomicAdd(&bar[XB_TMO], 1u); break; } }
    }
    nloc = mine > 0u ? mine : 1u; nx = cnt > 0u ? cnt : 1u;
}
__device__ __forceinline__ void xcd_barrier(const XcdBarrier& b) {
    asm volatile("s_waitcnt vmcnt(0)" ::: "memory");
    __syncthreads();
    if (threadIdx.x == 0) {
        unsigned* bar = b.bar;
        __builtin_amdgcn_s_waitcnt(0);
        unsigned nloc = b.st[0], nx = b.st[1];
        if (nloc == 0u) { xcd_barrier_complete(bar, b.x, nloc, nx); b.st[0] = nloc; b.st[1] = nx; }
        const unsigned old = xb_add(&bar[XB_XSUB(b.x)], 1u);
        const unsigned gen = old / nloc;
        if (old + 1u == (gen + 1u) * nloc) {
            __builtin_amdgcn_fence(__ATOMIC_RELEASE, "agent");
            asm volatile("s_waitcnt vmcnt(0)" ::: "memory");
            const unsigned og = xb_add(&bar[XB_TOP], 1u);
            const unsigned tg = og / nx;
            if (og + 1u == (tg + 1u) * nx) xb_add(&bar[XB_TOPGEN], 1u);
            else XB_SPIN(xb_ld(&bar[XB_TOPGEN]) == tg, bar);
            __builtin_amdgcn_fence(__ATOMIC_ACQUIRE, "agent");
            xb_add(&bar[XB_XGEN(b.x)], 1u);
            asm volatile("s_waitcnt vmcnt(0)" ::: "memory");
        } else {
            XB_SPIN(xb_ld(&bar[XB_XGEN(b.x)]) == gen, bar);
            __builtin_amdgcn_fence(__ATOMIC_ACQUIRE, "agent");
            asm volatile("s_waitcnt vmcnt(0)" ::: "memory");
        }
    }
    __syncthreads();
}

enum { PH_PRO = 0, PH_INPROJ = 1, PH_ATTN = 2, PH_OUTPROJ = 3, PH_UP = 4, PH_DOWN = 5, PH_END = 6 };

__global__ void __launch_bounds__(NTHR, 2) mega_kernel(Args a) {
    extern __shared__ __attribute__((aligned(16))) unsigned char lds_raw[];
    LAS unsigned char* lds = (LAS unsigned char*)lds_raw;
    const int G = gridDim.x, bid = blockIdx.x;
    const int vcu = (G % 8 == 0) ? (bid % 8) * (G / 8) + bid / 8 : bid;
    unsigned char* ws = a.ws;
    volatile LAS unsigned* bst = (volatile LAS unsigned*)(lds + LDS_BYTES - 64);
    if (threadIdx.x < 2) bst[threadIdx.x] = 0u;
    __syncthreads();
    const XcdBarrier gbar = xcd_barrier_post((unsigned*)(ws + WS_CTL) + 1024, bst);
#ifndef PHMASK
#define PHMASK 0xffff
#endif
#define IN(k) (((PHMASK >> (k)) & 1) && a.ph_lo <= (k) && (k) < a.ph_hi)
#ifdef PROBE_PHASE
#define STAMP(k) do { if (bid == 0 && threadIdx.x == 0) ((unsigned long long*)(ws + WS_CTL + 24576))[(k)] = __builtin_amdgcn_s_memrealtime(); } while (0)
#else
#define STAMP(k) do { } while (0)
#endif
#define SEAM(k) do { if (IN(k) && IN((k) + 1)) xcd_barrier(gbar); STAMP((k) + 1); } while (0)
    STAMP(0);
    if (IN(PH_PRO)) { p0_prologue(a, lds, vcu, G); __syncthreads(); norm_phase<true>(a, lds, a.x, a.norm1_g, 0, DM, bid, G); } SEAM(PH_PRO);
    if (IN(PH_INPROJ)) {
        pg8::StaticOrder S; S.init(M, NPAD, G, bid, ws + WS_XN, ws + WS_WIN, DM, DM); S.rm = 1;
        pg8::EpiIn E{ws, a.fox_q_norm, a.fox_k_norm, a.nsa_q_norm, a.slc_k_norm, a.win_k_norm, a.b_forget, (LAS float*)(lds + LDS_STATS), (unsigned*)(ws + CTL_CNT_KCVC), (unsigned*)(ws + CTL_CNT_GATE)};
        pg8::gemm_phase(lds, DM, DM, DM, S, E);
        if (bid >= 224) {
            handoff_wait((unsigned*)(ws + CTL_CNT_KCVC), 64u * 8u);
            pg8::CmpOrder S2{32, bid - 224, (const char*)(ws + WS_KC), (const char*)(ws + WS_VC), (const char*)(ws + WS_W1T)};
            pg8::EpiPart E2{(float*)(ws + WS_PART), (unsigned*)(ws + CTL_CNT_PART)};
            pg8::gemm_phase(lds, 2048, 4096, 1024, S2, E2);
        }
        else if ((bid & 1) == 0 && (bid >> 3) < 16) {
            handoff_wait((unsigned*)(ws + CTL_CNT_PART), 32u * 8u);
            cmp2_phase(a, lds, (bid >> 3) * 4 + ((bid & 7) >> 1), 64);
        }
        else if ((bid & 1) == 0 && (bid >> 3) < 20) {
            handoff_wait((unsigned*)(ws + CTL_CNT_GATE), 32u * 8u);
            att::compute_kb(ws, ((bid >> 3) - 16) * 4 + ((bid & 7) >> 1), (LAS char*)lds);
        }
    } SEAM(PH_INPROJ);
#ifdef PROBE_PHASE
    unsigned long long tA0 = __builtin_amdgcn_s_memrealtime();
#endif
    if (IN(PH_ATTN)) { att::attn_phase(a, (LAS char*)lds, vcu, G); }
#ifdef PROBE_PHASE
    if (threadIdx.x == 0) { const unsigned d = (unsigned)(__builtin_amdgcn_s_memrealtime() - tA0); atomicMax((unsigned*)(ws + WS_CTL + 24576 + 256), d); atomicMax((unsigned*)(ws + WS_CTL + 24576 + 260), 0xffffffffu - d); }
#endif
    SEAM(PH_ATTN);
    if (IN(PH_OUTPROJ)) {
        pg8::StaticOrder S; S.init(M, DM, G, bid, ws + WS_AO, ws + WS_WOUT, DM, DM);
        pg8::EpiResNorm E{a.x, a.out, (const float*)(ws + WS_MOD), a.norm2_g, (bf16_t*)(ws + WS_XN), (float*)(ws + WS_SLOTS), (unsigned*)(ws + CTL_CNT_PANEL), (LAS float*)(lds + LDS_STATS)};
        pg8::gemm_phase(lds, DM, DM, DM, S, E);
    } SEAM(PH_OUTPROJ);
    if (IN(PH_UP)) {
        pg8::StaticOrder S; S.init(M, DFF, G, bid, ws + WS_XN, ws + WS_WUP, DM, DM);
        pg8::EpiUp E{(bf16_t*)(ws + WS_U), DFF};
        pg8::gemm_phase(lds, DM, DM, DM, S, E);
    } SEAM(PH_UP);
    if (IN(PH_DOWN)) {
        pg8::StaticOrder S; S.init(M, DM, G, bid, ws + WS_U, ws + WS_WDN, DFF, DFF);
        pg8::EpiRes E{a.out, a.out, (const float*)(ws + WS_MOD) + 5 * DM};
        pg8::gemm_phase(lds, DFF, DFF, DFF, S, E);
    }
    STAMP(PH_END);
#undef IN
#undef SEAM
}

#ifdef PROBE_PHASE
__global__ void probe_kernel(const unsigned long long* tsp, float* out) {
#if PROBE_PHASE == 98
    out[0] = (float)(((const unsigned*)tsp)[64]) * 1e-3f;
#elif PROBE_PHASE == 97
    out[0] = (float)(0xffffffffu - ((const unsigned*)tsp)[65]) * 1e-3f;
#elif PROBE_PHASE == 99
    out[0] = (float)(tsp[PH_END] - tsp[0]) * 5e-4f;
#else
    const unsigned long long t1 = tsp[PROBE_PHASE + 1], t0 = tsp[PROBE_PHASE]; out[0] = (float)(t1 - t0) * 1e-2f;
#endif
}
#endif
static void launch_phases(const Args& a0, int lo, int hi, int grid, hipStream_t stream) {
    Args a = a0; a.ph_lo = lo; a.ph_hi = hi; void* args[] = {&a};
    (void)args; hipLaunchKernelGGL(mega_kernel, dim3(grid), dim3(NTHR), LDS_BYTES, stream, a);
    hipError_t e = hipPeekAtLastError();
    if (e != hipSuccess) fprintf(stderr, "launch failed: %s (grid %d)\n", hipGetErrorString(e), grid);
}

extern "C" void kernel_launch(void* const* d_in, const int* in_sizes, int n_in, void* d_out, int out_size, void* d_ws, size_t ws_size, hipStream_t stream) {
    static int grid = 0;
    if (grid == 0) {
        int dev = 0, cus = 0, per_cu = 0; hipGetDevice(&dev); hipDeviceGetAttribute(&cus, hipDeviceAttributeMultiprocessorCount, dev);
        hipFuncSetAttribute((const void*)mega_kernel, hipFuncAttributeMaxDynamicSharedMemorySize, LDS_BYTES);
        hipOccupancyMaxActiveBlocksPerMultiprocessor(&per_cu, (const void*)mega_kernel, NTHR, LDS_BYTES);
        if (per_cu < 1) { fprintf(stderr, "occupancy query says %d blocks/CU\n", per_cu); per_cu = 1; }
        grid = 256;
        if (cus < 256) fprintf(stderr, "this kernel needs >= 256 CUs for a resident grid (device has %d)\n", cus);
        if (ws_size < WS_END + 24 * MiB) fprintf(stderr, "workspace too small: %zu\n", ws_size);
    }
    hipMemsetAsync((char*)d_ws + WS_CTL, 0, 49152, stream);
    Args a{};
    const float** ap = (const float**)&a;
    for (int i = 0; i < 23; ++i) ap[i] = (const float*)d_in[i];
    a.out = (float*)d_out; a.ws = (unsigned char*)d_ws;
    unsigned char* ws = a.ws;
    launch_phases(a, PH_PRO, PH_END, grid, stream);
#ifdef PROBE_PHASE
    probe_kernel<<<1, 1, 0, stream>>>((const unsigned long long*)(ws + WS_CTL + 24576), a.out);
#endif
}
```

```cpp
#include <hip/hip_runtime.h>
#include <hip/hip_cooperative_groups.h>
#include <stdint.h>
#include <math.h>
#include <cstdio>
namespace cg = cooperative_groups;
#define NF_IN 3

constexpr int DM = 2048, NB = 2, T = 4096, M = NB * T, HD = 128;
constexpr int DIN = 5664, DFF = 8192, NPAD = 5888;
constexpr int C_FQ = 0, C_FK = 1024, C_FV = 2048, C_FZ = 3072, C_NQ = 3080, C_KC = 4104, C_VC = 4360, C_KSL = 4616, C_VSL = 4872,
              C_KW = 5128, C_VW = 5384, C_GZ = 5640;
constexpr int NCMP = 255;
constexpr float SCALE = 0.08838834764831845f;
constexpr float EPS = 1e-6f;
constexpr int NWAVES = 8, NTHR = 512;

constexpr size_t MiB = 1u << 20;
constexpr size_t WS_CTL = 0;
constexpr size_t CTL_CNT_GATE = 21504;
constexpr size_t CTL_CNT_KCVC = 20480, CTL_CNT_PART = 20736, CTL_CNT_ADALN = 20992, CTL_CNT_PANEL = 32768, CTL_CNT_ATTN = 40960;
constexpr size_t WS_SLOTS = 64 * 1024;
constexpr size_t WS_MODP = 384 * 1024;
constexpr size_t WS_MOD = 2 * MiB;
constexpr size_t WS_ROPE = 3 * MiB;
constexpr size_t WS_PEBP = 5 * MiB;
constexpr size_t WS_PEB = 5 * MiB + 256 * 1024;
constexpr size_t WS_MBOUND = 5 * MiB + 300 * 1024;
constexpr size_t WS_LOGF = 5 * MiB + 320 * 1024;
constexpr size_t WS_KBIAS = 5 * MiB + 640 * 1024;
constexpr size_t WS_GATES = 6 * MiB;
constexpr size_t WS_W2T = 7 * MiB;
constexpr size_t WS_W1T = 8 * MiB;
constexpr size_t WS_WIN = 12 * MiB;
constexpr size_t WS_WOUT = 36 * MiB;
constexpr size_t WS_WUP = 44 * MiB;
constexpr size_t WS_WDN = 76 * MiB;
constexpr size_t WS_XN = 108 * MiB;
constexpr size_t WS_FQ = 140 * MiB, WS_FK = 156 * MiB, WS_FV = 172 * MiB, WS_NQ = 188 * MiB, WS_NQR = 204 * MiB;
constexpr size_t WS_KC = 220 * MiB, WS_VC = 224 * MiB, WS_KSL = 228 * MiB, WS_VSL = 232 * MiB, WS_KW = 236 * MiB, WS_VW = 240 * MiB;
constexpr size_t WS_KCMP = 244 * MiB, WS_VCMP = 244 * MiB + 512 * 1024;
constexpr size_t WS_PART = 245 * MiB;
constexpr size_t WS_NSAO = 277 * MiB;
constexpr size_t WS_AO = 309 * MiB;
constexpr size_t WS_U = 140 * MiB;
constexpr size_t WS_END = 341 * MiB;
constexpr size_t WS_DEV_CUM = 341 * MiB;
constexpr size_t WS_DEV_XB = 342 * MiB;
constexpr size_t WS_DEV_HID = 358 * MiB;
constexpr size_t WS_DEV_KC = 360 * MiB;

constexpr int LDS_STATS = 131072;
constexpr int LDS_BYTES = 155648;

#define LAS __attribute__((address_space(3)))
#define GAS __attribute__((address_space(1)))
typedef unsigned short bf16_t;
typedef short bf16x8 __attribute__((ext_vector_type(8)));
typedef float f32x4 __attribute__((ext_vector_type(4)));
typedef float f32x2 __attribute__((ext_vector_type(2)));
typedef unsigned u32x4 __attribute__((ext_vector_type(4)));
typedef unsigned u32x2 __attribute__((ext_vector_type(2)));

typedef __bf16 bf16x2_t __attribute__((ext_vector_type(2)));
__device__ __forceinline__ unsigned cvt_pk_bf16(float lo, float hi) { f32x2 v = {lo, hi}; bf16x2_t b = __builtin_convertvector(v, bf16x2_t); return __builtin_bit_cast(unsigned, b); }
__device__ __forceinline__ float bf2f(bf16_t v) { return __uint_as_float(((unsigned)v) << 16); }
__device__ __forceinline__ float wave_sum(float v) {
#pragma unroll
    for (int o = 1; o < 64; o <<= 1) v += __shfl_xor(v, o);
    return v;
}
__device__ __forceinline__ float wave_max(float v) {
#pragma unroll
    for (int o = 1; o < 64; o <<= 1) v = fmaxf(v, __shfl_xor(v, o));
    return v;
}


__device__ __forceinline__ void handoff_signal(unsigned* cnt, int lane) {
    asm volatile("s_waitcnt vmcnt(0)" ::: "memory");
    if (lane == 0) __hip_atomic_fetch_add(cnt, 1u, __ATOMIC_RELAXED, __HIP_MEMORY_SCOPE_AGENT);
}
__device__ __forceinline__ void handoff_wait(unsigned* cnt, unsigned target) {
    if (threadIdx.x < 64) { unsigned sp = 0;
        while ((unsigned)__builtin_amdgcn_readfirstlane(__hip_atomic_load(cnt, __ATOMIC_RELAXED, __HIP_MEMORY_SCOPE_AGENT)) < target) { __builtin_amdgcn_s_sleep(4); if (++sp > (1u << 24)) break; }
        __builtin_amdgcn_fence(__ATOMIC_ACQUIRE, "agent"); asm volatile("s_waitcnt vmcnt(0)" ::: "memory"); }
    __syncthreads();
}

namespace pg8 {
constexpr int BM = 256, BK = 64, HALF = 128, HTB = HALF * BK * 2, STAGE_BYTES = 8 * HTB, NXCD = 8, WGM = 8;
__host__ __device__ __forceinline__ int lds_byte(int r, int c) { const int st = (r >> 4) * 2 + (c >> 5), rr = r & 15, cc = c & 31, ob = rr * 64 + cc * 2; return st * 1024 + (ob ^ (((ob >> 9) & 1) << 5)); }
__host__ __device__ __forceinline__ void stage_rc(int b, int& R, int& C) { const int st = b / 1024, sb = b % 1024, swz = sb ^ (((sb >> 9) & 1) << 5); R = (st >> 1) * 16 + swz / 64; C = (st & 1) * 32 + (swz % 64) / 2; }
__host__ __device__ __forceinline__ int perm32(int rho) { const int n = rho >> 4, i = rho & 15; return 8 * (i >> 2) + 4 * n + (i & 3); }

struct Unit { int pm, pn, aux; };
#define NF_ERN 3
#ifndef NF_IN
#define NF_IN 2
#endif

struct StaticOrder {
    int nM, nN, nwg, G, c; const char* A; const char* Bt; size_t tsA, tsB; int rm = 0;
    __device__ __forceinline__ void init(int M_, int N_, int G_, int c_, const void* A_, const void* Bt_, int lda, int ldb) { nM = M_ / BM; nN = N_ / BM; nwg = nM * nN; G = G_; c = c_; A = (const char*)A_; Bt = (const char*)Bt_; tsA = (size_t)BM * lda * 2; tsB = (size_t)BM * ldb * 2; }
    __device__ __forceinline__ bool next(int i, Unit& u) const {
        const long L = (long)i * G + c; if (L >= nwg) return false;
        int wgid = (int)L; { const int q = nwg / NXCD, r = nwg % NXCD, xcd = wgid % NXCD, off = wgid / NXCD; wgid = (xcd < r ? xcd * (q + 1) : r * (q + 1) + (xcd - r) * q) + off; }
        const int nig = WGM * nN, gid = wgid / nig, fm = gid * WGM, gsz = (nM - fm) < WGM ? (nM - fm) : WGM;
        u.pm = fm + ((wgid % nig) % gsz); u.pn = (wgid % nig) / gsz; u.aux = 0;
        if (rm) { const int p = u.pn; u.pn = (int)(((p < 12 ? 0x4a0e6734a418820ull : 0x5ab49ad507b251ull) >> (5 * (p < 12 ? p : p - 12))) & 31ull); }
        return true;
    }
    __device__ __forceinline__ void ptrs(const Unit& u, const char*& a, const char*& b) const { a = A + (size_t)u.pm * tsA; b = Bt + (size_t)u.pn * tsB; }
};

template <class Epi, class Sched>
__device__ __forceinline__ void gemm_phase(LAS unsigned char* lds, const int lda, const int ldb, const int K, const Sched& S, const Epi& E) {
    int tid = threadIdx.x; asm volatile("" : "+v"(tid));
    const int wid = __builtin_amdgcn_readfirstlane(tid >> 6), lane = tid & 63, wr = wid >> 2, wc = wid & 3, fr = lane & 15, fq = lane >> 4;
    const int nt = K / BK;
    unsigned voffA[2], voffB[2];
#pragma unroll
    for (int i = 0; i < 2; ++i) { int R, C; stage_rc(tid * 16 + i * 8192, R, C); const int Rb = Epi::PERM ? ((R & ~31) + perm32(R & 31)) : R;
        voffA[i] = (unsigned)(R * lda + C) * 2u; voffB[i] = (unsigned)(Rb * ldb + C) * 2u; }
    const size_t kstep = (size_t)(BK * 2);
    const size_t hsA = (size_t)HALF * lda * 2, hsB = (size_t)HALF * ldb * 2;
    const unsigned ldsw = (unsigned)wid * 1024u;
    const int aoff = lds_byte(wr * 64 + fr, fq * 8), boff = lds_byte(wc * 32 + fr, fq * 8);
#define PG8_SA(b, h) (((b) * 2 + (h)) * HTB)
#define PG8_SB(b, h) ((4 + (b) * 2 + (h)) * HTB)
#define PG8_STAGE(bufoff, gbase, voff) do { _Pragma("unroll") for (int _i = 0; _i < 2; ++_i) \
        __builtin_amdgcn_global_load_lds((const unsigned*)((const char*)(gbase) + (voff)[_i]), (LAS unsigned*)(lds + (bufoff) + ldsw + _i * 8192), 16, 0, 0); } while (0)
#define PG8_LDA(dst, b, h) do { _Pragma("unroll") for (int m = 0; m < 4; ++m) _Pragma("unroll") for (int k = 0; k < 2; ++k) dst[m][k] = *(const LAS bf16x8*)(lds + PG8_SA(b, h) + aoff + m * 2048 + k * 1024); } while (0)
#define PG8_LDB(dst, b, h) do { _Pragma("unroll") for (int n = 0; n < 2; ++n) _Pragma("unroll") for (int k = 0; k < 2; ++k) dst[n][k] = *(const LAS bf16x8*)(lds + PG8_SB(b, h) + boff + n * 2048 + k * 1024); } while (0)
#define PG8_MMA(ai, bj, At, Bt) do { __builtin_amdgcn_s_setprio(1); _Pragma("unroll") for (int m = 0; m < 4; ++m) _Pragma("unroll") for (int n = 0; n < 2; ++n) _Pragma("unroll") for (int k = 0; k < 2; ++k) \
        acc[ai][bj][m][n] = __builtin_amdgcn_mfma_f32_16x16x32_bf16(Bt[n][k], At[m][k], acc[ai][bj][m][n], 0, 0, 0); __builtin_amdgcn_s_setprio(0); } while (0)
#define PG8_WAIT_V(n) asm volatile("s_waitcnt vmcnt(" #n ")" ::: "memory")
#define PG8_WAIT_L(n) asm volatile("s_waitcnt lgkmcnt(" #n ")" ::: "memory")
#define PG8_BAR __builtin_amdgcn_s_barrier()
#define PG8_SCHED __builtin_amdgcn_sched_barrier(0)
    Unit cur, nxt; int ui = 0;
    if (!S.next(0, cur)) return;
    f32x4 acc[2][2][4][2];
#pragma unroll
    for (int a = 0; a < 2; ++a)
#pragma unroll
        for (int b = 0; b < 2; ++b)
#pragma unroll
            for (int m = 0; m < 4; ++m)
#pragma unroll
                for (int n = 0; n < 2; ++n) acc[a][b][m][n] = (f32x4){0.f, 0.f, 0.f, 0.f};
    bf16x8 At[4][2], B0[2][2], B1[2][2];
    const char* cA; const char* cB; S.ptrs(cur, cA, cB);
    PG8_STAGE(PG8_SB(0, 0), cB, voffB); PG8_STAGE(PG8_SB(0, 1), cB + hsB, voffB); PG8_STAGE(PG8_SA(0, 0), cA, voffA); PG8_STAGE(PG8_SA(0, 1), cA + hsA, voffA);
    if (wr == 1) PG8_BAR;
    PG8_WAIT_V(2); PG8_BAR;
    PG8_STAGE(PG8_SB(1, 0), cB + kstep, voffB); PG8_STAGE(PG8_SA(1, 0), cA + kstep, voffA); PG8_STAGE(PG8_SB(1, 1), cB + hsB + kstep, voffB);
    PG8_WAIT_V(6); PG8_BAR;
    if constexpr (Epi::PREFETCH) E.prefetch(cur, lds + STAGE_BYTES, wid, lane);
    for (;;) {
        const bool has_next = S.next(ui + 1, nxt);
        const char* nA = cA; const char* nB = cB; if (has_next) S.ptrs(nxt, nA, nB);
#pragma nounroll
        for (int t = 0; t < nt; t += 2) {
            const bool last = (t == nt - 2);
            const char* a1 = cA + (size_t)(t + 1) * kstep;
            const char* a2 = last ? nA : cA + (size_t)(t + 2) * kstep; const char* b2 = last ? nB : cB + (size_t)(t + 2) * kstep;
            const char* a3 = a2 + kstep; const char* b3 = b2 + kstep;
            PG8_LDB(B0, 0, 0); PG8_LDB(B1, 0, 1); PG8_SCHED; PG8_LDA(At, 0, 0); PG8_STAGE(PG8_SA(1, 1), a1 + hsA, voffA);
            PG8_WAIT_V(8); PG8_WAIT_L(0); PG8_BAR; PG8_MMA(0, 0, At, B0); PG8_MMA(0, 1, At, B1); PG8_BAR; PG8_SCHED;
            PG8_LDA(At, 0, 1); PG8_STAGE(PG8_SB(0, 0), b2, voffB); PG8_STAGE(PG8_SB(0, 1), b2 + hsB, voffB); PG8_STAGE(PG8_SA(0, 0), a2, voffA);
            PG8_WAIT_V(8); PG8_WAIT_L(0); PG8_BAR; PG8_MMA(1, 0, At, B0); PG8_MMA(1, 1, At, B1); PG8_BAR; PG8_SCHED;
            PG8_LDB(B0, 1, 0); PG8_LDB(B1, 1, 1); PG8_SCHED; PG8_LDA(At, 1, 0); PG8_STAGE(PG8_SA(0, 1), a2 + hsA, voffA);
            PG8_WAIT_V(8); PG8_WAIT_L(0); PG8_BAR; PG8_MMA(0, 0, At, B0); PG8_MMA(0, 1, At, B1); PG8_BAR; PG8_SCHED;
            PG8_LDA(At, 1, 1); PG8_STAGE(PG8_SB(1, 0), b3, voffB); PG8_STAGE(PG8_SB(1, 1), b3 + hsB, voffB); PG8_STAGE(PG8_SA(1, 0), a3, voffA);
            PG8_WAIT_V(8); PG8_WAIT_L(0); PG8_BAR; PG8_MMA(1, 0, At, B0); PG8_MMA(1, 1, At, B1); PG8_BAR; PG8_SCHED;
        }
        if (wr == 0) PG8_BAR;
        E(acc, cur, wr, wc, fr, fq);
        if (!has_next) break;
#pragma unroll
        for (int a = 0; a < 2; ++a)
#pragma unroll
            for (int b = 0; b < 2; ++b)
#pragma unroll
                for (int m = 0; m < 4; ++m)
#pragma unroll
                    for (int n = 0; n < 2; ++n) acc[a][b][m][n] = (f32x4){0.f, 0.f, 0.f, 0.f};
        cur = nxt; cA = nA; cB = nB; ++ui;
        if (wr == 1) PG8_BAR;
    }
    PG8_WAIT_V(0);
    PG8_BAR;
#undef PG8_SA
#undef PG8_SB
#undef PG8_STAGE
#undef PG8_LDA
#undef PG8_LDB
#undef PG8_MMA
#undef PG8_WAIT_V
#undef PG8_WAIT_L
#undef PG8_BAR
#undef PG8_SCHED
}


struct EpiRes {
    static constexpr bool PERM = true, PREFETCH = false;
    const float* base; float* out; const float* gate;
    __device__ __forceinline__ void prefetch(const Unit& u, LAS unsigned char* dummy, int wid, int lane) const {
        const float* p = base + (size_t)(u.pm * BM + wid * 32) * DM + u.pn * BM + lane * 4;
#pragma unroll 8
        for (int r = 0; r < 32; ++r) __builtin_amdgcn_global_load_lds((const unsigned*)(p + (size_t)r * DM), (LAS unsigned*)(dummy + wid * 1024), 16, 0, 0);
    }
    __device__ __forceinline__ void operator()(const f32x4 (&acc)[2][2][4][2], const Unit& u, int wr, int wc, int fr, int fq) const {
        const int row0 = u.pm * BM + wr * 64 + fr, col0 = u.pn * BM + wc * 32 + 8 * fq;
        const int b = (u.pm * BM) / T;
        f32x4 gv[2][2];
#pragma unroll
        for (int bj = 0; bj < 2; ++bj)
#pragma unroll
            for (int n = 0; n < 2; ++n) gv[bj][n] = *(const f32x4*)(gate + (size_t)b * 6 * DM + col0 + bj * HALF + 4 * n);
#pragma unroll
        for (int ai = 0; ai < 2; ++ai)
#pragma unroll
            for (int m = 0; m < 4; ++m) { const size_t off = (size_t)(row0 + ai * HALF + m * 16) * DM + col0;
#pragma unroll
                for (int bj = 0; bj < 2; ++bj)
#pragma unroll
                    for (int n = 0; n < 2; ++n) { const f32x4 bs = *(const f32x4*)(base + off + bj * HALF + 4 * n);
                        *(f32x4*)(out + off + bj * HALF + 4 * n) = bs + gv[bj][n] * acc[ai][bj][m][n]; } }
    }
};

struct EpiResNorm {
    static constexpr bool PERM = true, PREFETCH = false;
    const float* base; float* out; const float* mod; const float* g2; bf16_t* XN; float* slots; unsigned* cnt; LAS float* tab;
    __device__ __forceinline__ void prefetch(const Unit& u, LAS unsigned char* dummy, int wid, int lane) const {
        const float* p = base + (size_t)(u.pm * BM + wid * 32) * DM + u.pn * BM + lane * 4;
#pragma unroll 8
        for (int r = 0; r < 32; ++r) __builtin_amdgcn_global_load_lds((const unsigned*)(p + (size_t)r * DM), (LAS unsigned*)(dummy + wid * 1024), 16, 0, 0);
    }
    __device__ __forceinline__ void operator()(f32x4 (&acc)[2][2][4][2], const Unit& u, int wr, int wc, int fr, int fq) const {
        const int row0 = u.pm * BM + wr * 64 + fr, col0 = u.pn * BM + wc * 32 + 8 * fq;
        const int b = (u.pm * BM) / T; const int wid = wr * 4 + wc, lane = fr + 16 * fq;
        const float* mb = mod + (size_t)b * 6 * DM;
        {   f32x4 gv[2][2];
#pragma unroll
            for (int bj = 0; bj < 2; ++bj)
#pragma unroll
                for (int n = 0; n < 2; ++n) gv[bj][n] = *(const f32x4*)(mb + 2 * DM + col0 + bj * HALF + 4 * n);
            f32x4 bs[NF_ERN][2][2];
#define ER_LD(g) do { const size_t off_ = (size_t)(row0 + ((g) >> 2) * HALF + ((g) & 3) * 16) * DM + col0; _Pragma("unroll") for (int bj = 0; bj < 2; ++bj) _Pragma("unroll") for (int n = 0; n < 2; ++n) \
            bs[(g) % NF_ERN][bj][n] = *(const f32x4*)(base + off_ + bj * HALF + 4 * n); } while (0)
            _Pragma("unroll") for (int g = 0; g < NF_ERN; ++g) ER_LD(g);
            asm volatile("" ::: "memory");
#pragma unroll
            for (int g = 0; g < 8; ++g) { const int ai = g >> 2, m = g & 3; float ss = 0.f;
#pragma unroll
                for (int bj = 0; bj < 2; ++bj)
#pragma unroll
                    for (int n = 0; n < 2; ++n) { const f32x4 v = bs[g % NF_ERN][bj][n] + gv[bj][n] * acc[ai][bj][m][n];
                        acc[ai][bj][m][n] = v; ss += (v[0] * v[0] + v[1] * v[1]) + (v[2] * v[2] + v[3] * v[3]); }
                if (g + NF_ERN < 8) ER_LD(g + NF_ERN);
                ss += __shfl_xor(ss, 16); ss += __shfl_xor(ss, 32);
                if (fq == 0) tab[(ai * HALF + wr * 64 + m * 16 + fr) * 4 + wc] = ss;
                asm volatile("" ::: "memory"); }
#undef ER_LD
        }
        asm volatile("s_waitcnt lgkmcnt(0)" ::: "memory"); __builtin_amdgcn_s_barrier(); asm volatile("" ::: "memory");
        const int prow = wid * 32 + (lane & 31);
        if (lane < 32) { const f32x4 q = *(const LAS f32x4*)(tab + prow * 4);
            __hip_atomic_store((unsigned*)slots + ((size_t)(u.pm * BM + prow) * 8 + u.pn), __float_as_uint((q[0] + q[1]) + (q[2] + q[3])), __ATOMIC_RELAXED, __HIP_MEMORY_SCOPE_AGENT); }
        asm volatile("s_waitcnt vmcnt(0)" ::: "memory");
        if (lane == 0) __hip_atomic_fetch_add(cnt + 64 * u.pm, 1u, __ATOMIC_RELAXED, __HIP_MEMORY_SCOPE_AGENT);
        f32x4 av[2][2], sv[2][2];
#pragma unroll
        for (int bj = 0; bj < 2; ++bj)
#pragma unroll
            for (int n = 0; n < 2; ++n) { const int c = col0 + bj * HALF + 4 * n; const f32x4 gg = *(const f32x4*)(g2 + c), sc = *(const f32x4*)(mb + 4 * DM + c);
                av[bj][n] = gg * (sc + 1.f); sv[bj][n] = *(const f32x4*)(mb + 3 * DM + c); }
        if (wid == 0) { unsigned sp = 0;
            while ((unsigned)__builtin_amdgcn_readfirstlane(__hip_atomic_load(cnt + 64 * u.pm, __ATOMIC_RELAXED, __HIP_MEMORY_SCOPE_AGENT)) < 64u) { __builtin_amdgcn_s_sleep(2); if (++sp > (1u << 22)) break; }
            __builtin_amdgcn_fence(__ATOMIC_ACQUIRE, "agent"); }
        asm volatile("s_waitcnt vmcnt(0) lgkmcnt(0)" ::: "memory"); __builtin_amdgcn_s_barrier(); asm volatile("" ::: "memory");
        if (lane < 32) { const unsigned* sl = (const unsigned*)slots + (size_t)(u.pm * BM + prow) * 8; float tot = 0.f;
#pragma unroll
            for (int t = 0; t < 8; ++t) tot += __uint_as_float(__hip_atomic_load(sl + t, __ATOMIC_RELAXED, __HIP_MEMORY_SCOPE_AGENT));
            tab[1024 + prow] = __builtin_amdgcn_rsqf(tot * (1.f / DM) + EPS); }
        asm volatile("s_waitcnt vmcnt(0) lgkmcnt(0)" ::: "memory"); __builtin_amdgcn_s_barrier(); asm volatile("" ::: "memory");
#pragma unroll
        for (int ai = 0; ai < 2; ++ai)
#pragma unroll
            for (int m = 0; m < 4; ++m) { const int rl = ai * HALF + wr * 64 + m * 16 + fr; const float rstd = tab[1024 + rl]; const size_t off = (size_t)(u.pm * BM + rl) * DM + col0;
#pragma unroll
                for (int bj = 0; bj < 2; ++bj) {
                    *(f32x4*)(out + off + bj * HALF) = acc[ai][bj][m][0]; *(f32x4*)(out + off + bj * HALF + 4) = acc[ai][bj][m][1];
                    const f32x4 h0 = acc[ai][bj][m][0] * rstd * av[bj][0] + sv[bj][0], h1 = acc[ai][bj][m][1] * rstd * av[bj][1] + sv[bj][1];
                    u32x4 w; w.x = cvt_pk_bf16(h0[0], h0[1]); w.y = cvt_pk_bf16(h0[2], h0[3]); w.z = cvt_pk_bf16(h1[0], h1[1]); w.w = cvt_pk_bf16(h1[2], h1[3]);
                    *(u32x4*)(XN + off + bj * HALF) = w; }
                asm volatile("" ::: "memory"); }
    }
};
struct EpiUp {
    static constexpr bool PERM = true, PREFETCH = false;
    bf16_t* O; int ldc;
    __device__ __forceinline__ void operator()(const f32x4 (&acc)[2][2][4][2], const Unit& u, int wr, int wc, int fr, int fq) const {
        const int row0 = u.pm * BM + wr * 64 + fr, col0 = u.pn * BM + wc * 32 + 8 * fq;
#pragma unroll
        for (int ai = 0; ai < 2; ++ai)
#pragma unroll
            for (int m = 0; m < 4; ++m) { bf16_t* rowp = O + (size_t)(row0 + ai * HALF + m * 16) * ldc + col0;
#pragma unroll
                for (int bj = 0; bj < 2; ++bj) { f32x4 v0 = acc[ai][bj][m][0], v1 = acc[ai][bj][m][1];
                    v0 = __builtin_elementwise_max(v0, (f32x4){0.f, 0.f, 0.f, 0.f}); v1 = __builtin_elementwise_max(v1, (f32x4){0.f, 0.f, 0.f, 0.f}); v0 = v0 * v0; v1 = v1 * v1;
                    u32x4 w; w.x = cvt_pk_bf16(v0[0], v0[1]); w.y = cvt_pk_bf16(v0[2], v0[3]); w.z = cvt_pk_bf16(v1[0], v1[1]); w.w = cvt_pk_bf16(v1[2], v1[3]);
                    *(u32x4*)(rowp + bj * HALF) = w; } }
    }
};
struct EpiIn {
    static constexpr bool PERM = true, PREFETCH = false;
    unsigned char* wsb;
    const float *g_fq, *g_fk, *g_nq, *g_slc, *g_win, *b_forget; LAS float* stats; unsigned* kcvc_cnt; unsigned* gate_cnt;
    __device__ __forceinline__ void operator()(const f32x4 (&acc)[2][2][4][2], const Unit& u, int wr, int wc, int fr, int fq) const {
        const int pn = u.pn;
        unsigned char* w_ = wsb; asm volatile("" : "+s"(w_));
        GAS bf16_t* const FQ = (GAS bf16_t*)(w_ + WS_FQ); GAS bf16_t* const FK = (GAS bf16_t*)(w_ + WS_FK); GAS bf16_t* const FV = (GAS bf16_t*)(w_ + WS_FV); GAS bf16_t* const NQ = (GAS bf16_t*)(w_ + WS_NQ); GAS bf16_t* const NQR = (GAS bf16_t*)(w_ + WS_NQR);
        GAS bf16_t* const KC = (GAS bf16_t*)(w_ + WS_KC); GAS bf16_t* const VC = (GAS bf16_t*)(w_ + WS_VC); GAS bf16_t* const KSL = (GAS bf16_t*)(w_ + WS_KSL); GAS bf16_t* const VSL = (GAS bf16_t*)(w_ + WS_VSL); GAS bf16_t* const KW = (GAS bf16_t*)(w_ + WS_KW); GAS bf16_t* const VW = (GAS bf16_t*)(w_ + WS_VW);
        GAS float* const LOGF = (GAS float*)(w_ + WS_LOGF); GAS float* const GATES = (GAS float*)(w_ + WS_GATES); const GAS float* const rope = (const GAS float*)(w_ + WS_ROPE);
        const int b = u.pm >> 4, t0 = (u.pm & 15) * BM + wr * 64 + fr;
        if (pn == 12) {
            if (wc == 0) {
#pragma unroll
                for (int ai = 0; ai < 2; ++ai)
#pragma unroll
                    for (int m = 0; m < 4; ++m) { const int t = t0 + ai * HALF + m * 16;
#pragma unroll
                        for (int n = 0; n < 2; ++n)
#pragma unroll
                            for (int e = 0; e < 4; ++e) { const int p = 8 * fq + 4 * n + e; const float v = acc[ai][0][m][n][e];
                                if (p < 8) { const float z = v + b_forget[p]; __hip_atomic_store((GAS unsigned*)(LOGF + ((size_t)b * 8 + p) * T + t), __float_as_uint(fminf(z, 0.f) - __logf(1.f + __expf(-fabsf(z)))), __ATOMIC_RELAXED, __HIP_MEMORY_SCOPE_AGENT); }
                                else { GATES[((size_t)b * T + t) * 24 + (p - 8)] = 1.f / (1.f + __expf(-v)); } } }
            }
            handoff_signal(gate_cnt, fr + 16 * fq);
            return;
        }
        if (pn < 4) body<true, true, false, false>(acc, u, wr, wc, fr, fq, FQ, nullptr, g_fq, rope, 8, 2 * pn);
        else if (pn < 8) body<true, true, false, false>(acc, u, wr, wc, fr, fq, FK, nullptr, g_fk, rope, 8, 2 * (pn - 4));
        else if (pn < 12) body<false, true, false, false>(acc, u, wr, wc, fr, fq, FV, nullptr, nullptr, rope, 8, 2 * (pn - 8));
        else if (pn < 17) body<true, true, true, false>(acc, u, wr, wc, fr, fq, NQ, NQR, g_nq, rope, 8, 2 * (pn - 13));
        else if (pn < 19) body<false, true, false, true>(acc, u, wr, wc, fr, fq, pn == 17 ? KC : VC, nullptr, nullptr, rope, 2, 0);
        else if (pn < 21) body<true, false, true, false>(acc, u, wr, wc, fr, fq, nullptr, pn == 19 ? KSL : KW, pn == 19 ? g_slc : g_win, rope, 2, 0);
        else body<false, true, false, false>(acc, u, wr, wc, fr, fq, pn == 21 ? VSL : VW, nullptr, nullptr, rope, 2, 0);
    }
    template <bool NORM, bool D1, bool D2, bool WT>
    __device__ __forceinline__ void body(const f32x4 (&acc)[2][2][4][2], const Unit& u, int wr, int wc, int fr, int fq, GAS bf16_t* d1, GAS bf16_t* d2, const float* gain, const GAS float* rope, int nh, int h0) const {
        const int b = u.pm >> 4, t0 = (u.pm & 15) * BM + wr * 64 + fr;
        const int dlo = 16 * wc + 4 * fq;
        f32x4 g0 = (f32x4){1.f, 1.f, 1.f, 1.f}, g1 = g0;
        if (NORM) { g0 = *(const f32x4*)(gain + dlo); g1 = *(const f32x4*)(gain + 64 + dlo); }
        f32x4 cs[NF_IN][2];
#define EI_LD(g) do { const int tn_ = t0 + ((g) >> 2) * HALF + ((g) & 3) * 16; const GAS float* rp_ = rope + ((size_t)tn_ * 64 + dlo) * 2; cs[(g) % NF_IN][0] = *(const GAS f32x4*)rp_; cs[(g) % NF_IN][1] = *(const GAS f32x4*)(rp_ + 4); } while (0)
        if (D2) { _Pragma("unroll") for (int g = 0; g < NF_IN; ++g) EI_LD(g); }
        if (NORM) {
#pragma unroll
            for (int ai = 0; ai < 2; ++ai)
#pragma unroll
                for (int m = 0; m < 4; ++m)
#pragma unroll
                    for (int bj = 0; bj < 2; ++bj) { const f32x4 a = acc[ai][bj][m][0], c = acc[ai][bj][m][1];
                        float s = (a[0] * a[0] + a[1] * a[1]) + (a[2] * a[2] + a[3] * a[3]) + (c[0] * c[0] + c[1] * c[1]) + (c[2] * c[2] + c[3] * c[3]);
                        { const unsigned x = __float_as_uint(s); const auto r = __builtin_amdgcn_permlane32_swap(x, x, false, false); s = __uint_as_float(r[0]) + __uint_as_float(r[1]); }
                        { const unsigned x = __float_as_uint(s); const auto r = __builtin_amdgcn_permlane16_swap(x, x, false, false); s = __uint_as_float(r[0]) + __uint_as_float(r[1]); }
                        if (fq == 0) stats[(ai * HALF + wr * 64 + m * 16 + fr) * 8 + bj * 4 + wc] = s; }
            asm volatile("s_waitcnt lgkmcnt(0)" ::: "memory"); __builtin_amdgcn_s_barrier(); asm volatile("" ::: "memory");
        }
#pragma unroll
        for (int g = 0; g < 8; ++g) { const int ai = g >> 2, m = g & 3; const int t = t0 + ai * HALF + m * 16;
            float rsv[2] = {1.f, 1.f};
            if (NORM) {
#pragma unroll
                for (int bj = 0; bj < 2; ++bj) { const f32x4 q = *(const LAS f32x4*)(stats + (ai * HALF + wr * 64 + m * 16 + fr) * 8 + bj * 4);
                    rsv[bj] = __builtin_amdgcn_rsqf(((q[0] + q[1]) + (q[2] + q[3])) * (1.f / 128.f) + EPS); } }
            f32x4 c = g0, sn = g0;
            if (D2) { c = (f32x4){cs[g % NF_IN][0][0], cs[g % NF_IN][0][2], cs[g % NF_IN][1][0], cs[g % NF_IN][1][2]}; sn = (f32x4){cs[g % NF_IN][0][1], cs[g % NF_IN][0][3], cs[g % NF_IN][1][1], cs[g % NF_IN][1][3]}; }
            if (D2 && g + NF_IN < 8) EI_LD(g + NF_IN);
#pragma unroll
            for (int bj = 0; bj < 2; ++bj) { f32x4 v0 = acc[ai][bj][m][0], v1 = acc[ai][bj][m][1];
                if (NORM) { const float r = rsv[bj]; v0 = v0 * r * g0; v1 = v1 * r * g1; }
                const size_t off = (((size_t)b * nh + h0 + bj) * T + t) * 128 + dlo;
                if (D1) { u32x2 w0, w1; w0.x = cvt_pk_bf16(v0[0], v0[1]); w0.y = cvt_pk_bf16(v0[2], v0[3]); w1.x = cvt_pk_bf16(v1[0], v1[1]); w1.y = cvt_pk_bf16(v1[2], v1[3]);
                    if (WT) { __hip_atomic_store((GAS unsigned long long*)(d1 + off), ((unsigned long long)w0.y << 32) | w0.x, __ATOMIC_RELAXED, __HIP_MEMORY_SCOPE_AGENT);
                        __hip_atomic_store((GAS unsigned long long*)(d1 + off + 64), ((unsigned long long)w1.y << 32) | w1.x, __ATOMIC_RELAXED, __HIP_MEMORY_SCOPE_AGENT); }
                    else { *(GAS u32x2*)(d1 + off) = w0; *(GAS u32x2*)(d1 + off + 64) = w1; } }
                if (D2) { const f32x4 r0 = v0 * c - v1 * sn, r1 = v1 * c + v0 * sn;
                    u32x2 w0, w1; w0.x = cvt_pk_bf16(r0[0], r0[1]); w0.y = cvt_pk_bf16(r0[2], r0[3]); w1.x = cvt_pk_bf16(r1[0], r1[1]); w1.y = cvt_pk_bf16(r1[2], r1[3]);
                    *(GAS u32x2*)(d2 + off) = w0; *(GAS u32x2*)(d2 + off + 64) = w1; } }
            asm volatile("" ::: "memory"); }
#undef EI_LD
        if (WT) handoff_signal(kcvc_cnt, fr + 16 * fq);
    }
};

struct EpiPart {
    static constexpr bool PERM = true, PREFETCH = false;
    float* P; unsigned* done_cnt;
    __device__ __forceinline__ void operator()(const f32x4 (&acc)[2][2][4][2], const Unit& u, int wr, int wc, int fr, int fq) const {
        const __amdgpu_buffer_rsrc_t rsrc = __builtin_amdgcn_make_buffer_rsrc(P, 0, 128 * 65536 * 4, 0x00020000);
        const unsigned base = ((unsigned)u.aux * 65536u + (unsigned)(wr * 64 + fr) * 256u + (unsigned)(wc * 32 + 8 * fq)) * 4u;
#pragma unroll
        for (int ai = 0; ai < 2; ++ai)
#pragma unroll
            for (int m = 0; m < 4; ++m) { const unsigned rp = base + (unsigned)(ai * HALF + m * 16) * 1024u;
#pragma unroll
                for (int bj = 0; bj < 2; ++bj)
#pragma unroll
                    for (int n = 0; n < 2; ++n) __builtin_amdgcn_raw_buffer_store_b128(__builtin_bit_cast(u32x4, acc[ai][bj][m][n]), rsrc, rp + (unsigned)(bj * HALF + 4 * n) * 4u, 0, 16);
                asm volatile("" ::: "memory"); }
        handoff_signal(done_cnt, fr + 16 * fq);
    }
};
struct CmpOrder {
    int G, c; const char* KC; const char* VC; const char* W1T;
    __device__ __forceinline__ bool next(int i, Unit& u) const { const int L = i * G + c; if (L >= 32) return false; u.pm = 0; u.pn = 0; u.aux = L; return true; }
    __device__ __forceinline__ void ptrs(const Unit& u, const char*& a, const char*& b) const { const int L = u.aux, kv = L >> 4, bg = (L >> 2) & 3, ks = L & 3;
        a = (kv ? VC : KC) + ((size_t)bg * T * 128 + ks * 1024) * 2; b = W1T + ((size_t)kv * 256 * 4096 + ks * 1024) * 2; }
};
}


struct Args {
    const float *x, *c, *w_ada, *b_ada, *norm1_g, *w_in, *b_forget, *fox_q_norm, *fox_k_norm, *nsa_q_norm, *cmp_k_norm, *slc_k_norm, *win_k_norm,
        *cmp_pe_k, *cmp_w1_k, *cmp_w2_k, *cmp_pe_v, *cmp_w1_v, *cmp_w2_v, *w_out, *norm2_g, *w_up, *w_down;
    float* out; unsigned char* ws; int ph_lo, ph_hi;
};

#ifndef DEV_ATT
#define DEV_ATT 3
#endif
namespace att {
typedef float f32x16 __attribute__((ext_vector_type(16)));
typedef short s16x4 __attribute__((ext_vector_type(4)));
constexpr int NW = 8, QBLK = 32, KVBLK = 64, D = 128;
constexpr int SHM_V = KVBLK * D * 2, SHM_K = KVBLK * D * 2;
constexpr int L_V = 0, L_K = 2 * SHM_V, L_WS = 2 * SHM_V + 2 * SHM_K, L_Q = L_WS + 2048;
constexpr int LC_V = 0, LC_K = 65536, LC_WS = 131072, LC_IMP = 133120;
constexpr int L_KB = 133120;
constexpr int L_SEL = 149504;
constexpr float THR = 8.f;
constexpr float C2 = 1.4426950408889634f * SCALE;
enum { M_FOX = 0, M_WIN = 1, M_SLC = 2 };
#define KSWZ(row, colB) ((row) * 256 + ((colB) ^ (((row) & 7) << 4)))
#define SBAR() __builtin_amdgcn_sched_barrier(0)
__device__ __forceinline__ int v_st(int k, int c) { const int kk = (k & ~0xC) | ((k & 4) << 1) | ((k & 8) >> 1); return ((kk >> 3) * 4 + (c >> 5)) * 512 + ((kk & 7) * 32 + (c & 31)) * 2; }
__device__ __forceinline__ int v_rd_base(int lane) { return ((lane & 3) << 3) | (((lane >> 2) & 3) << 6) | (((lane >> 4) & 1) << 5) | (((lane >> 5) & 1) << 8); }
constexpr int v_rd_off(int d0, int ks, int half) { return d0 * 512 + ks * 4096 + half * 2048; }
__device__ __forceinline__ int crow(int r, int hi) { return (r & 3) + 8 * (r >> 2) + 4 * hi; }
__device__ __forceinline__ bf16x8 load8(const bf16_t* p) { return *(const GAS bf16x8*)p; }
__device__ __forceinline__ void mask_tile(f32x16& p0, f32x16& p1, int dq, unsigned W) {
    const float NEG = -__builtin_inff();
#pragma unroll
    for (int r = 0; r < 16; ++r) { const int c = (r & 3) + 8 * (r >> 2);
        if ((unsigned)(dq - c) >= W) p0[r] = NEG;
        if ((unsigned)(dq - c - 32) >= W) p1[r] = NEG; }
}
__device__ __forceinline__ void partialSM(f32x16& p0, f32x16& p1, float& m_reg, float& mn, float& alpha) {
    float pmax = p0[0];
#pragma unroll
    for (int r = 1; r < 16; ++r) pmax = fmaxf(pmax, p0[r]);
#pragma unroll
    for (int r = 0; r < 16; ++r) pmax = fmaxf(pmax, p1[r]);
    { auto rr = __builtin_amdgcn_permlane32_swap(__float_as_uint(pmax), __float_as_uint(pmax), false, false);
      pmax = fmaxf(__uint_as_float(rr[0]), __uint_as_float(rr[1])); }
    if (__builtin_expect(__all((pmax - m_reg) * SCALE <= THR), 1)) { mn = m_reg; alpha = 1.f; }
    else { mn = fmaxf(m_reg, pmax); alpha = __builtin_amdgcn_exp2f((m_reg - mn) * C2); m_reg = mn; }
    const float mnL = -mn * C2;
#pragma unroll
    for (int r = 0; r < 16; ++r) p0[r] = fmaf(p0[r], C2, mnL);
#pragma unroll
    for (int r = 0; r < 16; ++r) p1[r] = fmaf(p1[r], C2, mnL);
#pragma unroll
    for (int r = 0; r < 16; ++r) p0[r] = __builtin_amdgcn_exp2f(p0[r]);
}
#define PK4(P, B_, OUT) do { unsigned a0 = cvt_pk_bf16(P[B_+0], P[B_+1]), a1 = cvt_pk_bf16(P[B_+2], P[B_+3]);                          \
        unsigned b0 = cvt_pk_bf16(P[B_+4], P[B_+5]), b1 = cvt_pk_bf16(P[B_+6], P[B_+7]);                                             \
        auto r0 = __builtin_amdgcn_permlane32_swap(a0, b0, false, false); auto r1 = __builtin_amdgcn_permlane32_swap(a1, b1, false, false); \
        u32x4 w = {r0[0], r1[0], r0[1], r1[1]}; OUT = *reinterpret_cast<bf16x8*>(&w); } while (0)
__device__ __forceinline__ void finishSM(f32x16& p0, f32x16& p1, float alpha, float& l_reg, bf16x8& pa0, bf16x8& pa1, bf16x8& pa2, bf16x8& pa3, bool on = true) {
#pragma unroll
    for (int r = 0; r < 16; ++r) p1[r] = __builtin_amdgcn_exp2f(p1[r]);
    float ps = 0;
#pragma unroll
    for (int r = 0; r < 16; ++r) ps += p0[r];
#pragma unroll
    for (int r = 0; r < 16; ++r) ps += p1[r];
    { auto rr = __builtin_amdgcn_permlane32_swap(__float_as_uint(ps), __float_as_uint(ps), false, false);
      ps = __uint_as_float(rr[0]) + __uint_as_float(rr[1]); }
    l_reg = l_reg * alpha + (on ? ps : 0.f);
    PK4(p0, 0, pa0); PK4(p0, 8, pa1); PK4(p1, 0, pa2); PK4(p1, 8, pa3);
    if (!on) { const bf16x8 z = {0, 0, 0, 0, 0, 0, 0, 0}; pa0 = z; pa1 = z; pa2 = z; pa3 = z; }
}
template <int KB>
__device__ __forceinline__ void qkt(f32x16& p0, f32x16& p1, const LAS char* K_lds, int r32, int hi, const LAS char* qs) {
    const LAS char* kb[4];
#pragma unroll
    for (int dd = 0; dd < 4; ++dd) kb[dd] = K_lds + KB * SHM_K + KSWZ(r32, (dd * 16 + hi * 8) * 2);
#pragma unroll
    for (int d0 = 0; d0 < 8; ++d0) { const LAS char* a = kb[d0 & 3] + (d0 >> 2) * 128;
        const bf16x8 q = *reinterpret_cast<const LAS bf16x8*>(qs + d0 * 1024);
        bf16x8 b0 = *reinterpret_cast<const LAS bf16x8*>(a);
        bf16x8 b1 = *reinterpret_cast<const LAS bf16x8*>(a + 32 * 256);
        p0 = __builtin_amdgcn_mfma_f32_32x32x16_bf16(b0, q, p0, 0, 0, 0);
        p1 = __builtin_amdgcn_mfma_f32_32x32x16_bf16(b1, q, p1, 0, 0, 0); }
}
template <int KB>
__device__ __forceinline__ void qkt_r(f32x16& p0, f32x16& p1, const LAS char* K_lds, int r32, int hi, const bf16x8* qr) {
    const LAS char* kb[4];
#pragma unroll
    for (int dd = 0; dd < 4; ++dd) kb[dd] = K_lds + KB * SHM_K + KSWZ(r32, (dd * 16 + hi * 8) * 2);
#pragma unroll
    for (int d0 = 0; d0 < 8; ++d0) { const LAS char* a = kb[d0 & 3] + (d0 >> 2) * 128;
        bf16x8 b0 = *reinterpret_cast<const LAS bf16x8*>(a);
        bf16x8 b1 = *reinterpret_cast<const LAS bf16x8*>(a + 32 * 256);
        p0 = __builtin_amdgcn_mfma_f32_32x32x16_bf16(b0, qr[d0], p0, 0, 0, 0);
        p1 = __builtin_amdgcn_mfma_f32_32x32x16_bf16(b1, qr[d0], p1, 0, 0, 0); }
}
template <int VB>
__device__ __forceinline__ void pv_tile(f32x16* o, int vb0, bf16x8 pa0, bf16x8 pa1, bf16x8 pa2, bf16x8 pa3) {
#define TRRD(dst, off) asm volatile("ds_read_b64_tr_b16 %0, %1 offset:%2" : "=&v"(dst) : "v"(vb0), "i"(off) : "memory")
#define PV_D0(d0) do { s16x4 l0, l1, l2, l3, h0, h1, h2, h3; constexpr int b_ = VB * SHM_V + v_rd_off(d0, 0, 0); \
        TRRD(l0, b_); TRRD(h0, b_ + 2048); TRRD(l1, b_ + 4096); TRRD(h1, b_ + 6144); TRRD(l2, b_ + 8192); TRRD(h2, b_ + 10240); TRRD(l3, b_ + 12288); TRRD(h3, b_ + 14336); \
        asm volatile("s_waitcnt lgkmcnt(0)" ::: "memory"); SBAR(); \
        o[d0] = __builtin_amdgcn_mfma_f32_32x32x16_bf16(pa0, (bf16x8){l0[0], l0[1], l0[2], l0[3], h0[0], h0[1], h0[2], h0[3]}, o[d0], 0, 0, 0);   \
        o[d0] = __builtin_amdgcn_mfma_f32_32x32x16_bf16(pa1, (bf16x8){l1[0], l1[1], l1[2], l1[3], h1[0], h1[1], h1[2], h1[3]}, o[d0], 0, 0, 0);   \
        o[d0] = __builtin_amdgcn_mfma_f32_32x32x16_bf16(pa2, (bf16x8){l2[0], l2[1], l2[2], l2[3], h2[0], h2[1], h2[2], h2[3]}, o[d0], 0, 0, 0);   \
        o[d0] = __builtin_amdgcn_mfma_f32_32x32x16_bf16(pa3, (bf16x8){l3[0], l3[1], l3[2], l3[3], h3[0], h3[1], h3[2], h3[3]}, o[d0], 0, 0, 0); } while (0)
    PV_D0(0); PV_D0(1); PV_D0(2); PV_D0(3);
#undef PV_D0
#undef TRRD
}

struct Blk {
    const bf16_t* Q;
    const bf16_t* K; const bf16_t* V;
    const float* KB;
    int mode, P0, j_lo, j_hi, b, hb;
};
struct Seam { bf16x8 st_v0, st_v1, st_k0, st_k1; };
__device__ __forceinline__ int q_lane_off(int mode, int wid, int r32) { return mode == M_FOX ? (wid * 32 + r32) * 128 : ((r32 >> 3) * T + wid * 8 + (r32 & 7)) * 128; }
#define ROW(p, k0, rr) ((p) + (size_t)((k0) + (rr)) * D + sc)
#define VMW() asm volatile("s_waitcnt vmcnt(0)" ::: "memory")
#define VMWN(n) asm volatile("s_waitcnt vmcnt(%0)" :: "i"(n) : "memory")
#define SLOAD_H(Kp, Vp, k0) do { S.st_v0 = load8(ROW(Vp, k0, sr)); S.st_v1 = load8(ROW(Vp, k0, 32 + sr)); S.st_k0 = load8(ROW(Kp, k0, sr)); S.st_k1 = load8(ROW(Kp, k0, 32 + sr)); } while (0)
#define SWRITE_HK(bf) do { *(LAS bf16x8*)(K_lds + (bf) * SHM_K + kws) = S.st_k0; *(LAS bf16x8*)(K_lds + (bf) * SHM_K + kws + 32 * 256) = S.st_k1; } while (0)
#define SWRITE_HV(bf) do { *(LAS bf16x8*)(V_lds + (bf) * SHM_V + vst0) = S.st_v0; *(LAS bf16x8*)(V_lds + (bf) * SHM_V + vst1) = S.st_v1; } while (0)
#define SWRITE_H(bf) do { SWRITE_HV(bf); SWRITE_HK(bf); } while (0)
__device__ __forceinline__ void attn_prime(const Blk& cur, LAS char* lds, Seam& S) {
    const int tid = threadIdx.x;
    const int sr = tid >> 4, sc = (tid & 15) * 8, kws = KSWZ(sr, sc * 2); LAS char* K_lds = lds + L_K;
    const int kb0 = cur.j_lo * KVBLK;
    SLOAD_H(cur.K, cur.V, kb0); VMW(); SWRITE_HK(0);
    __syncthreads();
}
struct EpiCtx { bf16_t* AO; float* NSAO; const float* GATES; unsigned* panel_cnt; };
__device__ __forceinline__ void attn_block(const Blk& cur, const Blk& nxt, LAS char* lds, Seam& S, const EpiCtx& ec) {
    int tid = threadIdx.x; asm volatile("" : "+v"(tid));
    const int wid = __builtin_amdgcn_readfirstlane(tid >> 6), lane = tid & 63, r32 = lane & 31, hi = lane >> 5;
    const int mode = cur.mode;
    const int j_lo = cur.j_lo, NT = cur.j_hi - cur.j_lo;
    const int kbn = nxt.j_lo * KVBLK;
    const bool fox = mode == M_FOX;
    const int wlo = cur.P0 + (fox ? wid * 32 : wid * 8), whi = wlo + (fox ? 31 : 7);
    const int pos = cur.P0 + (fox ? wid * 32 + r32 : wid * 8 + (r32 & 7)), qm = pos - 4 * hi;
    const unsigned Wu = (mode == M_WIN) ? 512u : (1u << 30);
    LAS char* V_lds = lds + L_V; LAS char* K_lds = lds + L_K;
    LAS float* ws = (LAS float*)(lds + L_WS) + wid * 64; LAS float* li_l = ws; LAS float* al_l = ws + 32;
    float m_reg = -1e30f, l_reg = 0; f32x16 o[4] = {};
    const int sr = tid >> 4, sc = (tid & 15) * 8, vst0 = v_st(sr, sc), vst1 = v_st(32 + sr, sc), kws = KSWZ(sr, sc * 2);
    const int vb0 = (int)(unsigned)(uintptr_t)V_lds + v_rd_base(lane);
    const bf16_t* Kh = cur.K; const bf16_t* Vh = cur.V;
    unsigned long long sel = ~0ull;
    if (mode == M_SLC) sel = *(const LAS unsigned long long*)(lds + L_SEL + (wid * 8 + (r32 & 7)) * 8);
#define RESC(a_) do { if (__any((a_) < 1.f)) { if (hi == 0) al_l[r32] = (a_); asm volatile("s_waitcnt lgkmcnt(0)" ::: "memory");              \
                     _Pragma("unroll") for (int d_ = 0; d_ < 4; ++d_) _Pragma("unroll") for (int r = 0; r < 16; ++r) o[d_][r] *= al_l[crow(r, hi)]; } } while (0)
#define KBASE(t) ((j_lo + (t)) * KVBLK)
#define PRELOAD(P0_, P1_, t) do { if (fox) { const LAS float* kbp_ = (const LAS float*)(lds + L_KB) + KBASE(t) + 4 * hi; \
            _Pragma("unroll") for (int q_ = 0; q_ < 4; ++q_) { const f32x4 a_ = *(const LAS f32x4*)(kbp_ + 8 * q_), b_ = *(const LAS f32x4*)(kbp_ + 32 + 8 * q_); \
                P0_[4*q_] = a_[0]; P0_[4*q_+1] = a_[1]; P0_[4*q_+2] = a_[2]; P0_[4*q_+3] = a_[3]; P1_[4*q_] = b_[0]; P1_[4*q_+1] = b_[1]; P1_[4*q_+2] = b_[2]; P1_[4*q_+3] = b_[3]; } } \
        else { P0_ = f32x16{}; P1_ = f32x16{}; } } while (0)
#define MASKT(P0_, P1_, t) do { const int kb_ = KBASE(t); \
        if (kb_ + KVBLK - 1 > wlo || kb_ + (int)Wu <= whi) mask_tile(P0_, P1_, qm - kb_, Wu); } while (0)
#define ONT(t) (mode != M_SLC || ((sel >> (j_lo + (t))) & 1ull) != 0ull)
    if (wid >= 4) __builtin_amdgcn_s_setprio(1);
    f32x16 pA0, pA1, pB0, pB1; float mnA, mnB, alA, alB; bf16x8 pa0, pa1, pa2, pa3;
    LAS char* qs = lds + L_Q + wid * 8192 + lane * 16;
    if (mode != M_SLC)
    { const bf16_t* qp = cur.Q + q_lane_off(mode, wid, r32) + hi * 8; bf16x8 tq[8];
#pragma unroll
      for (int d0 = 0; d0 < 8; ++d0) tq[d0] = load8(qp + d0 * 16);
#pragma unroll
      for (int d0 = 0; d0 < 8; ++d0) *(LAS bf16x8*)(qs + d0 * 1024) = tq[d0]; }
    PRELOAD(pA0, pA1, 0);
    SWRITE_HV(0); SBAR();
    if (NT > 1) SLOAD_H(Kh, Vh, KBASE(1));
    SBAR(); qkt<0>(pA0, pA1, K_lds, r32, hi, qs);
    if (NT > 1) PRELOAD(pB0, pB1, 1); else { pB0 = f32x16{}; pB1 = f32x16{}; }
    MASKT(pA0, pA1, 0); partialSM(pA0, pA1, m_reg, mnA, alA);
    if (NT > 1) { VMW(); SWRITE_H(1); }
    __syncthreads();
#define HALF_STEP(PX0, PX1, mnX, alX, PY0, PY1, alY, t, KB_, VB_, SB_) do {                                                      \
        SBAR(); if ((t) + 1 < NT) { SLOAD_H(Kh, Vh, KBASE((t) + 1)); SBAR(); }         \
        qkt<KB_>(PX0, PX1, K_lds, r32, hi, qs);                                             \
        finishSM(PY0, PY1, alY, l_reg, pa0, pa1, pa2, pa3, ONT((t) - 1)); SBAR();                                                           \
        if ((t) + 1 < NT) { PRELOAD(PY0, PY1, (t) + 1); SBAR(); }                                               \
        pv_tile<VB_>(o, vb0, pa0, pa1, pa2, pa3); MASKT(PX0, PX1, (t)); partialSM(PX0, PX1, m_reg, mnX, alX);                                        \
        __syncthreads();                                                                                                      \
        if ((t) + 1 < NT) { VMW(); SWRITE_H(SB_); }                                                                          \
        RESC(alX); __syncthreads(); } while (0)
    for (int t = 1; t + 1 < NT; t += 2) {
        HALF_STEP(pB0, pB1, mnB, alB, pA0, pA1, alA, t, 1, 0, 0);
        HALF_STEP(pA0, pA1, mnA, alA, pB0, pB1, alB, t + 1, 0, 1, 1);
    }
    const bool even = (NT & 1) == 0;
    if (even) { SBAR(); qkt<1>(pB0, pB1, K_lds, r32, hi, qs); SBAR(); }
    SLOAD_H(nxt.K, nxt.V, kbn); SBAR();
    SBAR();
    finishSM(pA0, pA1, alA, l_reg, pa0, pa1, pa2, pa3, ONT(even ? NT - 2 : NT - 1)); SBAR();
    pv_tile<0>(o, vb0, pa0, pa1, pa2, pa3);
    if (even) { MASKT(pB0, pB1, NT - 1); partialSM(pB0, pB1, m_reg, mnB, alB); __syncthreads(); RESC(alB);
        finishSM(pB0, pB1, alB, l_reg, pa0, pa1, pa2, pa3, ONT(NT - 1)); SBAR(); pv_tile<1>(o, vb0, pa0, pa1, pa2, pa3); }
    SBAR(); VMW(); SWRITE_HK(0); SBAR();
    if (hi == 0) li_l[r32] = l_reg; asm volatile("s_waitcnt lgkmcnt(0)" ::: "memory");
    if (fox) {
        bf16_t* Ow = ec.AO + ((size_t)cur.b * T + cur.P0 + wid * QBLK) * DM + cur.hb * 128;
#pragma unroll
        for (int r = 0; r < 16; ++r) { const int orow = crow(r, hi); const float li = li_l[orow]; const float rl = li > 0.f ? __builtin_amdgcn_rcpf(li) : 0.f;
#pragma unroll
            for (int d0 = 0; d0 < 4; ++d0) { const float v = o[d0][r] * rl; const float vn = __shfl_xor(v, 1);
                if ((r32 & 1) == 0) *(GAS unsigned*)(Ow + (size_t)orow * DM + d0 * 32 + r32) = cvt_pk_bf16(v, vn); } }
    } else {
        const int br = (mode == M_WIN) ? 2 : 1;
#pragma unroll
        for (int h8 = 0; h8 < 2; ++h8) {
            float gv[8]; float av[8][4], bv[8][4];
#pragma unroll
            for (int q = 0; q < 8; ++q) { const int rho = crow(h8 * 8 + q, hi);
                const int tok = cur.P0 + wid * 8 + (rho & 7), head = cur.hb + (rho >> 3); const size_t trow = (size_t)cur.b * T + tok;
                gv[q] = ((const GAS float*)ec.GATES)[trow * 24 + head * 3 + br];
                if (mode == M_SLC) { const GAS float* np = (const GAS float*)(ec.NSAO + trow * 1024 + head * 128 + r32); const GAS float* np2 = np + (ptrdiff_t)((WS_PART - WS_NSAO) / 4);
#pragma unroll
                    for (int d0 = 0; d0 < 4; ++d0) { av[q][d0] = np[d0 * 32]; bv[q][d0] = np2[d0 * 32]; } }
                else {
#pragma unroll
                    for (int d0 = 0; d0 < 4; ++d0) { av[q][d0] = 0.f; bv[q][d0] = 0.f; } } }
#pragma unroll
            for (int q = 0; q < 8; ++q) { const int r = h8 * 8 + q; const int rho = crow(r, hi); const float li = li_l[rho]; const float rl = li > 0.f ? __builtin_amdgcn_rcpf(li) : 0.f;
                const int tok = cur.P0 + wid * 8 + (rho & 7), head = cur.hb + (rho >> 3); const size_t trow = (size_t)cur.b * T + tok;
                const float gt = gv[q] * rl;
                GAS float* np2 = (GAS float*)(ec.NSAO + trow * 1024 + head * 128 + r32 + (ptrdiff_t)((WS_PART - WS_NSAO) / 4));
#pragma unroll
                for (int d0 = 0; d0 < 4; ++d0) {
                    if (mode == M_WIN) np2[d0 * 32] = gt * o[d0][r];
                    else { const float v = av[q][d0] + bv[q][d0] + gt * o[d0][r]; const float vn = __shfl_xor(v, 1); if ((r32 & 1) == 0) *(GAS unsigned*)(ec.AO + trow * DM + 1024 + head * 128 + d0 * 32 + r32) = cvt_pk_bf16(v, vn); } } }
            asm volatile("" ::: "memory"); }
    }
    __builtin_amdgcn_s_setprio(0);
    __syncthreads();
#undef RESC
#undef KBASE
#undef PRELOAD
#undef MASKT
#undef ONT
#undef HALF_STEP
}
#undef ROW
#undef SLOAD_H
#undef SWRITE_HK
#undef SWRITE_HV
#undef SWRITE_H

__device__ __forceinline__ bf16x8 ovfrag(int n0, int J) {
    asm volatile("" : "+v"(n0));
    unsigned w[4];
#pragma unroll
    for (int q = 0; q < 4; ++q) { unsigned lohi[2];
#pragma unroll
        for (int e = 0; e < 2; ++e) { const int dl = n0 + 2 * q + e - 4 * J; lohi[e] = (dl >= 0 && dl <= 2) ? 0x3F80u : ((dl == 3 || dl == -1) ? 0x3F00u : 0u); }
        w[q] = lohi[0] | (lohi[1] << 16); }
    u32x4 v = {w[0], w[1], w[2], w[3]}; return *reinterpret_cast<bf16x8*>(&v);
}
__device__ __forceinline__ void nsa_cmp_item(int b, int g, int qb, const bf16_t* NQ, const bf16_t* KCMP, const bf16_t* VCMP, const float* GATES, const float* mbound, float* NSAO, LAS char* lds) {
    int tid = threadIdx.x; asm volatile("" : "+v"(tid));
    const int wid = __builtin_amdgcn_readfirstlane(tid >> 6), lane = tid & 63, r32 = lane & 31, hi = lane >> 5;
    LAS char* V_lds = lds + LC_V; LAS char* K_lds = lds + LC_K;
    LAS float* ws = (LAS float*)(lds + LC_WS) + wid * 64; LAS float* li_l = ws;
    LAS float* impL = (LAS float*)(lds + LC_IMP);
    const int sr = tid >> 4, sc = (tid & 15) * 8, vst0 = v_st(sr, sc), vst1 = v_st(32 + sr, sc), kws = KSWZ(sr, sc * 2);
    const bf16_t* Kc = KCMP + (size_t)(b * 2 + g) * 256 * 128; const bf16_t* Vc = VCMP + (size_t)(b * 2 + g) * 256 * 128;
    const int ntile = ((4 * qb + 2) >> 6) + 1;
    bf16x8 qr[8];
    { const bf16_t* qp = NQ + (((size_t)b * 8 + g * 4) * T + qb * 64) * 128 + q_lane_off(M_WIN, wid, r32) + hi * 8;
#pragma unroll
      for (int d0 = 0; d0 < 8; ++d0) qr[d0] = load8(qp + d0 * 16); }
    {
        bf16x8 kk[4][2], vv[4][2];
#pragma unroll
        for (int tl = 0; tl < 4; ++tl) { kk[tl][0] = load8(Kc + (size_t)(tl * 64 + sr) * 128 + sc); kk[tl][1] = load8(Kc + (size_t)(tl * 64 + 32 + sr) * 128 + sc); }
#pragma unroll
        for (int tl = 0; tl < 4; ++tl) { vv[tl][0] = load8(Vc + (size_t)(tl * 64 + sr) * 128 + sc); vv[tl][1] = load8(Vc + (size_t)(tl * 64 + 32 + sr) * 128 + sc); }
#pragma unroll
        for (int tl = 0; tl < 4; ++tl) { *(LAS bf16x8*)(K_lds + tl * SHM_K + kws) = kk[tl][0]; *(LAS bf16x8*)(K_lds + tl * SHM_K + kws + 32 * 256) = kk[tl][1]; }
#pragma unroll
        for (int tl = 0; tl < 4; ++tl) { *(LAS bf16x8*)(V_lds + tl * SHM_V + vst0) = vv[tl][0]; *(LAS bf16x8*)(V_lds + tl * SHM_V + vst1) = vv[tl][1]; }
        asm volatile("" ::: "memory");
    }
    __syncthreads();
    const int pos = qb * 64 + wid * 8 + (r32 & 7);
    const int nmax = (pos - 31) >> 4;
    const float NEG = -__builtin_inff();
#define CMASK(P0_, P1_, tl) do { _Pragma("unroll") for (int r = 0; r < 16; ++r) { const int n_ = (tl) * 64 + crow(r, hi); if (n_ > nmax) P0_[r] = NEG; if (n_ + 32 > nmax) P1_[r] = NEG; } } while (0)
    const float mL = -(*(const GAS float*)mbound) * C2;
    float l_reg = 0.f;
    const int vb0 = (int)(unsigned)(uintptr_t)V_lds + v_rd_base(lane);
    f32x16 o[4] = {}; f32x16 io[2] = {};
#pragma nounroll
    for (int tl = 0; tl < ntile; ++tl) { f32x16 p0 = f32x16{}, p1 = f32x16{}; qkt_r<0>(p0, p1, K_lds + tl * SHM_K, r32, hi, qr); CMASK(p0, p1, tl);
        float ps = 0.f;
#pragma unroll
        for (int r = 0; r < 16; ++r) { p0[r] = __builtin_amdgcn_exp2f(fmaf(p0[r], C2, mL)); p1[r] = __builtin_amdgcn_exp2f(fmaf(p1[r], C2, mL)); ps += p0[r] + p1[r]; }
        l_reg += ps; bf16x8 pa0, pa1, pa2, pa3; PK4(p0, 0, pa0); PK4(p0, 8, pa1); PK4(p1, 0, pa2); PK4(p1, 8, pa3);
        pv_tile<0>(o, vb0 + tl * SHM_V, pa0, pa1, pa2, pa3); SBAR();
#pragma unroll
        for (int d0 = 0; d0 < 2; ++d0) { const int J = d0 * 32 + r32;
            io[d0] = __builtin_amdgcn_mfma_f32_32x32x16_bf16(pa0, ovfrag(tl * 64 + 0 + 8 * hi, J), io[d0], 0, 0, 0);
            io[d0] = __builtin_amdgcn_mfma_f32_32x32x16_bf16(pa1, ovfrag(tl * 64 + 16 + 8 * hi, J), io[d0], 0, 0, 0);
            io[d0] = __builtin_amdgcn_mfma_f32_32x32x16_bf16(pa2, ovfrag(tl * 64 + 32 + 8 * hi, J), io[d0], 0, 0, 0);
            io[d0] = __builtin_amdgcn_mfma_f32_32x32x16_bf16(pa3, ovfrag(tl * 64 + 48 + 8 * hi, J), io[d0], 0, 0, 0); } SBAR(); }
    { auto rr = __builtin_amdgcn_permlane32_swap(__float_as_uint(l_reg), __float_as_uint(l_reg), false, false); l_reg = __uint_as_float(rr[0]) + __uint_as_float(rr[1]); }
    if (hi == 0) li_l[r32] = l_reg; asm volatile("s_waitcnt lgkmcnt(0)" ::: "memory");
    {
        float gv[16];
#pragma unroll
        for (int r = 0; r < 16; ++r) { const int rho = crow(r, hi); gv[r] = ((const GAS float*)GATES)[((size_t)b * T + qb * 64 + wid * 8 + (rho & 7)) * 24 + (g * 4 + (rho >> 3)) * 3 + 0]; }
        float imps[2][4] = {};
#pragma unroll
        for (int r = 0; r < 16; ++r) { const int rho = crow(r, hi); const float li = li_l[rho]; const float rl = li > 0.f ? __builtin_amdgcn_rcpf(li) : 0.f;
            const int tok = qb * 64 + wid * 8 + (rho & 7), head = g * 4 + (rho >> 3);
            const size_t trow = (size_t)b * T + tok;
            const float gt = gv[r] * rl;
            GAS float* np = (GAS float*)(NSAO + trow * 1024 + head * 128 + r32);
#pragma unroll
            for (int d0 = 0; d0 < 4; ++d0) np[d0 * 32] = gt * o[d0][r];
            imps[0][r & 3] += io[0][r] * rl; imps[1][r & 3] += io[1][r] * rl; }
#pragma unroll
        for (int d0 = 0; d0 < 2; ++d0)
#pragma unroll
            for (int e = 0; e < 4; ++e) impL[(wid * 8 + e + 4 * hi) * 64 + d0 * 32 + r32] = imps[d0][e];
    }
#undef CMASK
    __syncthreads();
#pragma nounroll
    for (int tk = 0; tk < 8; ++tk) { const int tl = wid * 8 + tk; const int J = lane;
        const float im = impL[tl * 64 + J];
        const bool forced = (J == 0) || (J == qb) || (J == qb - 1);
        const float v = forced ? __builtin_inff() : (J <= qb ? im : NEG);
        impL[tl * 64 + J] = v; asm volatile("s_waitcnt lgkmcnt(0)" ::: "memory");
        f32x4 uv[16];
#pragma unroll
        for (int q = 0; q < 16; ++q) uv[q] = *(const LAS f32x4*)(impL + tl * 64 + 4 * q);
        int rank = 0;
#pragma unroll
        for (int q = 0; q < 16; ++q)
#pragma unroll
            for (int e = 0; e < 4; ++e) { const float u = uv[q][e]; const int jj = 4 * q + e; rank += (u > v || (u == v && jj < J)) ? 1 : 0; }
        const unsigned long long mk = __ballot(rank < 16 && J <= qb);
        if (lane == 0) *(LAS unsigned long long*)(lds + L_SEL + tl * 8) = mk; }
    __syncthreads();
}
#undef PK4
#undef VMW
#undef VMWN

template <class P> __device__ __forceinline__ P* uptr(P* p) { const unsigned long long v = (unsigned long long)p;
    const unsigned lo = __builtin_amdgcn_readfirstlane((unsigned)v), hi = __builtin_amdgcn_readfirstlane((unsigned)(v >> 32)); return (P*)(((unsigned long long)hi << 32) | lo); }
__device__ __forceinline__ Blk make_blk(unsigned char* ws, int i, int st) {
    const int bg = i >> 6, qb = i & 63, b = bg >> 1, g = bg & 1; Blk k;
    if (st < 2) {
        k.Q = uptr((const bf16_t*)(ws + WS_NQR) + (((size_t)b * 8 + g * 4) * T + qb * 64) * 128);
        k.K = uptr((const bf16_t*)(ws + (st == 0 ? WS_KW : WS_KSL)) + (size_t)bg * T * 128); k.V = uptr((const bf16_t*)(ws + (st == 0 ? WS_VW : WS_VSL)) + (size_t)bg * T * 128);
        k.KB = nullptr; k.mode = st == 0 ? M_WIN : M_SLC; k.P0 = qb * 64; k.j_lo = (st == 0 && qb >= 8) ? qb - 8 : 0; k.j_hi = qb + 1; k.b = b; k.hb = g * 4;
    } else {
        const int bh = bg * 4 + (qb & 3), qf = 15 - (qb >> 2);
        k.Q = uptr((const bf16_t*)(ws + WS_FQ) + ((size_t)bh * T + qf * 256) * 128); k.K = uptr((const bf16_t*)(ws + WS_FK) + (size_t)bh * T * 128); k.V = uptr((const bf16_t*)(ws + WS_FV) + (size_t)bh * T * 128);
        k.KB = uptr((const float*)(ws + WS_KBIAS) + (size_t)bh * T); k.mode = M_FOX; k.P0 = qf * 256; k.j_lo = 0; k.j_hi = 4 * qf + 4; k.b = bh >> 3; k.hb = bh & 7;
    }
    k.mode = __builtin_amdgcn_readfirstlane(k.mode); k.P0 = __builtin_amdgcn_readfirstlane(k.P0); k.j_lo = __builtin_amdgcn_readfirstlane(k.j_lo); k.j_hi = __builtin_amdgcn_readfirstlane(k.j_hi);
    k.b = __builtin_amdgcn_readfirstlane(k.b); k.hb = __builtin_amdgcn_readfirstlane(k.hb);
    return k;
}
__device__ __forceinline__ void compute_kb(unsigned char* ws, int bh, LAS char* lds) {
    int tid = threadIdx.x; asm volatile("" : "+v"(tid));
    LAS double* part = (LAS double*)(lds + LC_IMP);
    const float* lf = (const float*)(ws + WS_LOGF) + (size_t)bh * T + tid * 8; float* kb = (float*)(ws + WS_KBIAS) + (size_t)bh * T + tid * 8;
    const f32x4 v0 = *(const f32x4*)lf, v1 = *(const f32x4*)(lf + 4);
    double loc[8]; double run = 0.0;
    { const float vv[8] = {v0[0], v0[1], v0[2], v0[3], v1[0], v1[1], v1[2], v1[3]};
#pragma unroll
      for (int i = 0; i < 8; ++i) { run += (double)vv[i]; loc[i] = run; } }
    const int lane = tid & 63, wv = tid >> 6; double inc = run;
#pragma unroll
    for (int o = 1; o < 64; o <<= 1) { const double up = __shfl_up(inc, o); if (lane >= o) inc += up; }
    if (lane == 63) part[wv] = inc;
    __syncthreads();
    double off = inc - run;
    for (int w = 0; w < wv; ++w) off += part[w];
    f32x4 o0, o1;
#pragma unroll
    for (int i = 0; i < 4; ++i) { o0[i] = (float)(-(off + loc[i]) * (double)(1.0f / SCALE)); o1[i] = (float)(-(off + loc[4 + i]) * (double)(1.0f / SCALE)); }
    *(f32x4*)kb = o0; *(f32x4*)(kb + 4) = o1;
    asm volatile("s_waitcnt vmcnt(0)" ::: "memory");
    __syncthreads();
}
__device__ __forceinline__ void stage_kb(const float* kbg, LAS char* lds) {
    int tid = threadIdx.x; asm volatile("" : "+v"(tid));
    const f32x4 v0 = *(const GAS f32x4*)(kbg + tid * 8), v1 = *(const GAS f32x4*)(kbg + tid * 8 + 4);
    LAS float* kl = (LAS float*)(lds + L_KB) + tid * 8;
    *(LAS f32x4*)kl = v0; *(LAS f32x4*)(kl + 4) = v1;
    __syncthreads();
}
__device__ __forceinline__ void attn_phase(const Args& a, LAS char* lds, int vcu, int G) {
    unsigned char* ws = a.ws;
    EpiCtx ec{(bf16_t*)(ws + WS_AO), (float*)(ws + WS_NSAO), (const float*)(ws + WS_GATES), (unsigned*)(ws + CTL_CNT_ATTN)};
    Seam S;
    constexpr int ST0 = (DEV_ATT == 1) ? 2 : 0, ST1 = (DEV_ATT == 2) ? 2 : 3;
    for (int i = vcu; i < 256; i += G) {
#ifndef NO_CMP
        if (DEV_ATT & 2) { const int bg = i >> 6, qb = i & 63; nsa_cmp_item(bg >> 1, bg & 1, qb, (const bf16_t*)(ws + WS_NQ), (const bf16_t*)(ws + WS_KCMP), (const bf16_t*)(ws + WS_VCMP), ec.GATES, (const float*)(ws + WS_MBOUND), ec.NSAO, lds); }
#endif
#ifndef NO_BLK
        Blk cur = make_blk(ws, i, ST0);
        attn_prime(cur, lds, S);
        for (int st = ST0; st < ST1; ++st) { const Blk nxt = make_blk(ws, i, st + 1 < ST1 ? st + 1 : st);
            if (st == 1) { const int tid_ = threadIdx.x, w_ = __builtin_amdgcn_readfirstlane(tid_ >> 6), l_ = tid_ & 63; const float* kbg = (const float*)(ws + WS_KBIAS) + (size_t)((i >> 6) * 4 + (i & 3)) * T;
#pragma unroll
                for (int h_ = 0; h_ < 2; ++h_) __builtin_amdgcn_global_load_lds((const unsigned*)(kbg + (w_ * 2 + h_) * 256 + l_ * 4), (LAS unsigned*)(lds + L_KB + (w_ * 2 + h_) * 1024), 16, 0, 0); }
            if (st == 2) { asm volatile("s_waitcnt vmcnt(0)" ::: "memory"); __syncthreads(); }
            attn_block(cur, nxt, lds, S, ec); cur = nxt; }
#endif
    }
}
#undef KSWZ
#undef SBAR
}


__device__ __forceinline__ int win_src_col(int pg) {
    const int pn = pg >> 8, p = pg & 255;
    if (pn == 12) { if (p < 8) return C_FZ + p; if (p < 32) return C_GZ + p - 8; return -1; }
    const int bj = p >> 7, q = p & 127;
    const int d = 16 * (q >> 5) + 4 * ((q >> 3) & 3) + (q & 3) + 64 * ((q >> 2) & 1);
    int base;
    if (pn < 4) base = C_FQ + pn * 256; else if (pn < 8) base = C_FK + (pn - 4) * 256; else if (pn < 12) base = C_FV + (pn - 8) * 256;
    else if (pn < 17) base = C_NQ + (pn - 13) * 256; else if (pn == 17) base = C_KC; else if (pn == 18) base = C_VC; else if (pn == 19) base = C_KSL;
    else if (pn == 20) base = C_KW; else if (pn == 21) base = C_VSL; else base = C_VW;
    return base + bj * 128 + d;
}
template <int SRC>
__device__ __forceinline__ void transpose_item(const float* W, int K, int N, bf16_t* WT, LAS float* scr, int item, int nblk, int lane) {
    const int kb = item / nblk, nb = item % nblk, k0 = 64 * kb, n0 = 32 * nb;
    int sc = n0 + (lane & 31); if (SRC == 1) sc = win_src_col(sc);
    float tv[32];
    const float* wp = W + (size_t)(k0 + (lane >> 5)) * N + (sc >= 0 ? sc : 0);
#pragma unroll
    for (int i = 0; i < 32; ++i) tv[i] = wp[(size_t)(2 * i) * N];
#pragma unroll
    for (int i = 0; i < 32; ++i) { const int kk = 2 * i + (lane >> 5); scr[kk * 33 + (lane & 31)] = sc >= 0 ? tv[i] : 0.f; }
    asm volatile("s_waitcnt lgkmcnt(0)" ::: "memory");
    const int cch = lane & 7;
#pragma unroll
    for (int j = 0; j < 4; ++j) { const int n = (lane >> 3) + 8 * j; const LAS float* s = scr + (8 * cch) * 33 + n;
        u32x4 o; o.x = cvt_pk_bf16(s[0 * 33], s[1 * 33]); o.y = cvt_pk_bf16(s[2 * 33], s[3 * 33]); o.z = cvt_pk_bf16(s[4 * 33], s[5 * 33]); o.w = cvt_pk_bf16(s[6 * 33], s[7 * 33]);
        *(u32x4*)(WT + (size_t)(n0 + n) * K + k0 + 8 * cch) = o; }
    asm volatile("s_waitcnt lgkmcnt(0)" ::: "memory");
}

__device__ __forceinline__ void p0_prologue(const Args& a, LAS unsigned char* lds, int vcu, int G) {
    int tid = threadIdx.x; asm volatile("" : "+v"(tid)); const int lane = tid & 63, wave = __builtin_amdgcn_readfirstlane(tid >> 6);
    LAS float* ca = (LAS float*)lds;
    for (int i = tid; i < 2 * DM; i += NTHR) { const float v = a.c[i]; ca[i] = v / (1.f + __expf(-v)); }
    __syncthreads();
    const int gw = vcu * NWAVES + wave, NGW = G * NWAVES;
    float* modp = (float*)(a.ws + WS_MODP);
    if (wave < 3) { const int it = vcu * 3 + wave;
        if (it < 16 * 48) { const int kc = it / 48, cq = (it % 48) * 64 + lane;
            f32x4 a0 = (f32x4){0.f, 0.f, 0.f, 0.f}, a1 = a0;
            const float* wp = a.w_ada + (size_t)(kc * 128) * (6 * DM) + 4 * cq;
#pragma unroll 16
            for (int k = 0; k < 128; ++k) { const f32x4 w = *(const f32x4*)(wp + (size_t)k * (6 * DM)); a0 += w * ca[kc * 128 + k]; a1 += w * ca[DM + kc * 128 + k]; }
            const __amdgpu_buffer_rsrc_t rsrc = __builtin_amdgcn_make_buffer_rsrc(modp, 0, 16 * 2 * 6 * DM * 4, 0x00020000);
            __builtin_amdgcn_raw_buffer_store_b128(__builtin_bit_cast(u32x4, a0), rsrc, (unsigned)((((size_t)kc * 2 + 0) * (6 * DM) + 4 * cq) * 4), 0, 16);
            __builtin_amdgcn_raw_buffer_store_b128(__builtin_bit_cast(u32x4, a1), rsrc, (unsigned)((((size_t)kc * 2 + 1) * (6 * DM) + 4 * cq) * 4), 0, 16);
            handoff_signal((unsigned*)(a.ws + CTL_CNT_ADALN), lane); } }
    LAS float* scr = (LAS float*)(lds + 16384 + wave * 16384);
    constexpr int I_IN = 32 * (NPAD / 32), I_OUT = 32 * 64, I_UP = 32 * 256, I_DN = 128 * 64, I_W1 = 64 * 8, I_W2 = 4 * 4;
    constexpr int NIT = I_IN + I_OUT + I_UP + I_DN + 2 * I_W1 + 2 * I_W2;
    const int nslot = (NIT + G - 1) / G;
    for (int m = 0;; ++m) { int j; if (wave < 3) { if (m >= 6) break; j = wave * 6 + m; } else { j = 18 + (wave - 3) + 5 * m; }
        if (j >= nslot) break; const int it = vcu + G * j; if (it >= NIT) break; int r = it;
        if (r < I_IN) { transpose_item<1>(a.w_in, DM, DIN, (bf16_t*)(a.ws + WS_WIN), scr, r, NPAD / 32, lane); continue; } r -= I_IN;
        if (r < I_OUT) { transpose_item<0>(a.w_out, DM, DM, (bf16_t*)(a.ws + WS_WOUT), scr, r, 64, lane); continue; } r -= I_OUT;
        if (r < I_UP) { transpose_item<0>(a.w_up, DM, DFF, (bf16_t*)(a.ws + WS_WUP), scr, r, 256, lane); continue; } r -= I_UP;
        if (r < I_DN) { transpose_item<0>(a.w_down, DFF, DM, (bf16_t*)(a.ws + WS_WDN), scr, r, 64, lane); continue; } r -= I_DN;
        if (r < I_W1) { transpose_item<0>(a.cmp_w1_k, 4096, 256, (bf16_t*)(a.ws + WS_W1T), scr, r, 8, lane); continue; } r -= I_W1;
        if (r < I_W1) { transpose_item<0>(a.cmp_w1_v, 4096, 256, (bf16_t*)(a.ws + WS_W1T) + 256 * 4096, scr, r, 8, lane); continue; } r -= I_W1;
        if (r < I_W2) { transpose_item<0>(a.cmp_w2_k, 256, 128, (bf16_t*)(a.ws + WS_W2T), scr, r, 4, lane); continue; } r -= I_W2;
        transpose_item<0>(a.cmp_w2_v, 256, 128, (bf16_t*)(a.ws + WS_W2T) + 128 * 256, scr, r, 4, lane);
    }
    if (vcu == 255 && wave == 7) { const float gk = fmaxf(fabsf(a.cmp_k_norm[lane]), fabsf(a.cmp_k_norm[64 + lane])), gq = fmaxf(fabsf(a.nsa_q_norm[lane]), fabsf(a.nsa_q_norm[64 + lane]));
        const float mb = wave_max(gk) * wave_max(gq) * (128.f * 1.02f); if (lane == 0) *(float*)(a.ws + WS_MBOUND) = mb; }
    float* rope = (float*)(a.ws + WS_ROPE);
    for (int e = (vcu * NTHR + tid); e < T * 64; e += G * NTHR) { const int t = e >> 6, i = e & 63;
        const float inv_freq = (float)pow(10000.0, -(double)i / 64.0); const float ang = (float)t * inv_freq;
        rope[2 * e] = (float)cos((double)ang); rope[2 * e + 1] = (float)sin((double)ang); }
    float* pebp = (float*)(a.ws + WS_PEBP);
    for (int it = gw; it < 2 * 4 * 64; it += NGW) { const int kv = it >> 8, cg_ = (it >> 6) & 3, ch = it & 63, col = cg_ * 64 + lane;
        const float* pe = kv ? a.cmp_pe_v : a.cmp_pe_k; const float* w1 = kv ? a.cmp_w1_v : a.cmp_w1_k; float s = 0.f;
#pragma unroll
        for (int i = 0; i < 64; ++i) s += pe[ch * 64 + i] * w1[(size_t)(ch * 64 + i) * 256 + col];
        pebp[((size_t)kv * 64 + ch) * 256 + col] = s; }
}

template <bool FIRST>
__device__ __forceinline__ void norm_phase(const Args& a, LAS unsigned char* lds, const float* xsrc, const float* gain, int shift_off, int scale_off, int bid, int G) {
    int tid = threadIdx.x; asm volatile("" : "+v"(tid)); const int lane = tid & 63, wave = __builtin_amdgcn_readfirstlane(tid >> 6);
    LAS float* AS = (LAS float*)lds; LAS float* SH = AS + DM;
    const float* modp = (const float*)(a.ws + WS_MODP); float* mod = (float*)(a.ws + WS_MOD);
    const int rows_per = M / G, b = (bid * rows_per) / T;
    f32x4 v[4][8];
#pragma unroll
    for (int rr = 0; rr < 4; ++rr) { const f32x4* xr = (const f32x4*)(xsrc + (size_t)(bid * rows_per + wave + 8 * rr) * DM) + lane;
#pragma unroll
        for (int j = 0; j < 8; ++j) v[rr][j] = xr[64 * j]; }
    if (FIRST) handoff_wait((unsigned*)(a.ws + CTL_CNT_ADALN), 16u * 48u);
    for (int d = tid; d < DM; d += NTHR) { float sc, sh;
        if (FIRST) { sc = a.b_ada[scale_off + d]; sh = a.b_ada[shift_off + d];
#pragma unroll
            for (int kc = 0; kc < 16; ++kc) { sc += modp[((size_t)kc * 2 + b) * (6 * DM) + scale_off + d]; sh += modp[((size_t)kc * 2 + b) * (6 * DM) + shift_off + d]; } }
        else { sc = mod[b * 6 * DM + scale_off + d]; sh = mod[b * 6 * DM + shift_off + d]; }
        AS[d] = gain[d] * (1.f + sc); SH[d] = sh; }
    if (FIRST) {
        for (int e = bid * NTHR + tid; e < 2 * 6 * DM; e += G * NTHR) { const int bb = e / (6 * DM), j = e % (6 * DM); float s = a.b_ada[j];
#pragma unroll
            for (int kc = 0; kc < 16; ++kc) s += modp[((size_t)kc * 2 + bb) * (6 * DM) + j];
            mod[e] = s; }
    }
    __syncthreads();
    bf16_t* XN = (bf16_t*)(a.ws + WS_XN);
    for (int r0 = 0; r0 < rows_per; r0 += 32) {
        if (r0 > 0) {
#pragma unroll
            for (int rr = 0; rr < 4; ++rr) { const f32x4* xr = (const f32x4*)(xsrc + (size_t)(bid * rows_per + r0 + wave + 8 * rr) * DM) + lane;
#pragma unroll
                for (int j = 0; j < 8; ++j) v[rr][j] = xr[64 * j]; } }
#pragma unroll
        for (int rr = 0; rr < 4; ++rr) { const int row = bid * rows_per + r0 + wave + 8 * rr; float ss = 0.f;
#pragma unroll
            for (int j = 0; j < 8; ++j) ss += (v[rr][j][0] * v[rr][j][0] + v[rr][j][1] * v[rr][j][1]) + (v[rr][j][2] * v[rr][j][2] + v[rr][j][3] * v[rr][j][3]);
            const float rstd = 1.0f / sqrtf(wave_sum(ss) * (1.f / DM) + EPS);
            u32x2* o8 = (u32x2*)(XN + (size_t)row * DM) + lane;
#pragma unroll
            for (int j = 0; j < 8; ++j) { const f32x4 as = *(const LAS f32x4*)(AS + 4 * lane + 256 * j), sh = *(const LAS f32x4*)(SH + 4 * lane + 256 * j);
                const f32x4 h = v[rr][j] * rstd * as + sh; u32x2 w; w.x = cvt_pk_bf16(h[0], h[1]); w.y = cvt_pk_bf16(h[2], h[3]); o8[64 * j] = w; } }
    }
    __syncthreads();
}


__device__ __forceinline__ void cmp2_phase(const Args& a, LAS unsigned char* lds, int L0, int Lstride) {
    int tid = threadIdx.x; asm volatile("" : "+v"(tid)); const int lane = tid & 63, wave = __builtin_amdgcn_readfirstlane(tid >> 6);
    unsigned char* ws = a.ws;
    for (int L = L0; L < 64; L += Lstride) {
        {
            const int kv = L >> 5, bg = (L >> 3) & 3, rt = L & 7;
            LAS bf16_t* hidL = (LAS bf16_t*)lds;
            LAS float* red = (LAS float*)(lds + 32768);
            LAS float* pebL = (LAS float*)(lds + 36864);
            if (tid < 256) { const float* pebp = (const float*)(ws + WS_PEBP) + (size_t)kv * 64 * 256 + tid; float sp = 0.f;
#pragma unroll
                for (int ch = 0; ch < 64; ++ch) sp += pebp[ch * 256];
                pebL[tid] = sp; }
            __syncthreads();
            { const int row = tid >> 4, c0 = (tid & 15) * 16;
              const float* pp = (const float*)(ws + WS_PART) + ((size_t)(kv * 4 + bg) * 4) * 65536 + (size_t)(rt * 32 + row) * 256 + c0;
              const LAS float* peb = pebL + c0;
              f32x4 s0 = *(const LAS f32x4*)peb, s1 = *(const LAS f32x4*)(peb + 4), s2 = *(const LAS f32x4*)(peb + 8), s3 = *(const LAS f32x4*)(peb + 12);
#pragma unroll 4
              for (int ks = 0; ks < 4; ++ks) { const float* q = pp + (size_t)ks * 65536; s0 += *(const f32x4*)q; s1 += *(const f32x4*)(q + 4); s2 += *(const f32x4*)(q + 8); s3 += *(const f32x4*)(q + 12); }
              f32x4 sv[4] = {s0, s1, s2, s3}; unsigned w[8];
#pragma unroll
              for (int i = 0; i < 4; ++i) { f32x4 v = sv[i];
#pragma unroll
                  for (int e = 0; e < 4; ++e) v[e] = v[e] / (1.f + __expf(-v[e]));
                  w[2 * i] = cvt_pk_bf16(v[0], v[1]); w[2 * i + 1] = cvt_pk_bf16(v[2], v[3]); }
              *(LAS u32x4*)(hidL + row * 264 + c0) = (u32x4){w[0], w[1], w[2], w[3]}; *(LAS u32x4*)(hidL + row * 264 + c0 + 8) = (u32x4){w[4], w[5], w[6], w[7]}; }
            __syncthreads();
            const int fr = lane & 15, fq = lane >> 4;
            f32x4 acc[2] = {(f32x4){0.f, 0.f, 0.f, 0.f}, (f32x4){0.f, 0.f, 0.f, 0.f}};
            const bf16_t* w2 = (const bf16_t*)(ws + WS_W2T) + (size_t)kv * 128 * 256 + (size_t)(16 * wave + fr) * 256 + 8 * fq;
#pragma unroll
            for (int ks = 0; ks < 8; ++ks) { const bf16x8 bf = *(const bf16x8*)(w2 + ks * 32);
#pragma unroll
                for (int rg = 0; rg < 2; ++rg) { const bf16x8 af = *(const LAS bf16x8*)(hidL + (rg * 16 + fr) * 264 + ks * 32 + 8 * fq);
                    acc[rg] = __builtin_amdgcn_mfma_f32_16x16x32_bf16(af, bf, acc[rg], 0, 0, 0); } }
            float rstd[2][4];
            if (kv == 0) {
#pragma unroll
                for (int rg = 0; rg < 2; ++rg)
#pragma unroll
                    for (int e = 0; e < 4; ++e) { float q = acc[rg][e] * acc[rg][e]; q += __shfl_xor(q, 1); q += __shfl_xor(q, 2); q += __shfl_xor(q, 4); q += __shfl_xor(q, 8);
                        if (fr == 0) red[(rg * 16 + 4 * fq + e) * 8 + wave] = q; }
                __syncthreads();
#pragma unroll
                for (int rg = 0; rg < 2; ++rg)
#pragma unroll
                    for (int e = 0; e < 4; ++e) { const LAS float* rp = red + (rg * 16 + 4 * fq + e) * 8; const float tot = ((rp[0] + rp[1]) + (rp[2] + rp[3])) + ((rp[4] + rp[5]) + (rp[6] + rp[7]));
                        rstd[rg][e] = 1.0f / sqrtf(tot * (1.f / 128.f) + EPS) * a.cmp_k_norm[16 * wave + fr]; }
            } else {
#pragma unroll
                for (int rg = 0; rg < 2; ++rg)
#pragma unroll
                    for (int e = 0; e < 4; ++e) rstd[rg][e] = 1.f;
            }
            bf16_t* dst = (bf16_t*)(ws + (kv ? WS_VCMP : WS_KCMP)) + (size_t)bg * 256 * 128;
#pragma unroll
            for (int rg = 0; rg < 2; ++rg)
#pragma unroll
                for (int e = 0; e < 4; ++e) { const int n = rt * 32 + rg * 16 + 4 * fq + e; const float v = (n == 255) ? 0.f : acc[rg][e] * rstd[rg][e];
                    dst[(size_t)n * 128 + 16 * wave + fr] = (bf16_t)(cvt_pk_bf16(v, 0.f) & 0xffffu); }
            __syncthreads();
        }
    }
}


#define XB_TMO      128
#define XB_XCNT(j)  (256  + 64 * (j))
#define XB_XSUB(j)  (1280 + 64 * (j))
#define XB_XGEN(j)  (2304 + 64 * (j))
#define XB_TOP      3328
#define XB_TOPGEN   3392
#define XCD_BAR_WORDS 3456
#define XB_SPIN_CAP (1u << 22)
__device__ __forceinline__ unsigned xb_ld(unsigned* p)              { return __hip_atomic_load(p, __ATOMIC_RELAXED, __HIP_MEMORY_SCOPE_AGENT); }
__device__ __forceinline__ unsigned xb_add(unsigned* p, unsigned v) { return __hip_atomic_fetch_add(p, v, __ATOMIC_RELAXED, __HIP_MEMORY_SCOPE_AGENT); }
__device__ __forceinline__ unsigned xb_xcc_id() { return (unsigned)__builtin_amdgcn_s_getreg((3 << 11) | 20) & 0xFu; }
#define XB_SPIN(cond, bar) do { unsigned _sp = 0; while (cond) { __builtin_amdgcn_s_sleep(1); \
    if ((++_sp & 255u) == 0u) { if (xb_ld(&(bar)[XB_TMO])) break; if (_sp > XB_SPIN_CAP) { atomicAdd(&(bar)[XB_TMO], 1u); break; } } } } while (0)
struct XcdBarrier { unsigned* bar; unsigned x; volatile LAS unsigned* st; };
__device__ __forceinline__ XcdBarrier xcd_barrier_post(unsigned* bar, volatile LAS unsigned* st) {
    XcdBarrier b; b.bar = bar; b.x = xb_xcc_id(); b.st = st;
    if (threadIdx.x == 0) (void)xb_add(&bar[XB_XCNT(b.x)], 1u);
    return b;
}
__device__ __forceinline__ void xcd_barrier_complete(unsigned* bar, unsigned x, unsigned& nloc, unsigned& nx) {
    const unsigned G = gridDim.x * gridDim.y * gridDim.z;
    unsigned sum, cnt, mine, sp = 0u;
    for (;;) {
        sum = 0u; cnt = 0u; mine = 0u;
#pragma unroll
        for (unsigned j = 0; j < 16; ++j) { const unsigned c = xb_ld(&bar[XB_XCNT(j)]); sum += c; cnt += (c > 0u) ? 1u : 0u; mine = (j == x) ? c : mine; }
        if (sum == G) break;
        __builtin_amdgcn_s_sleep(1);
        if ((++sp & 255u) == 0u) { if (xb_ld(&bar[XB_TMO])) break; if (sp > XB_SPIN_CAP) { atomicAdd(&bar[XB_TMO], 1u); break; } }
    }
    nloc = mine > 0u ? mine : 1u; nx = cnt > 0u ? cnt : 1u;
}
__device__ __forceinline__ void xcd_barrier(const XcdBarrier& b) {
    asm volatile("s_waitcnt vmcnt(0)" ::: "memory");
    __syncthreads();
    if (threadIdx.x == 0) {
        unsigned* bar = b.bar;
        __builtin_amdgcn_s_waitcnt(0);
        unsigned nloc = b.st[0], nx = b.st[1];
        if (nloc == 0u) { xcd_barrier_complete(bar, b.x, nloc, nx); b.st[0] = nloc; b.st[1] = nx; }
        const unsigned old = xb_add(&bar[XB_XSUB(b.x)], 1u);
        const unsigned gen = old / nloc;
        if (old + 1u == (gen + 1u) * nloc) {
            __builtin_amdgcn_fence(__ATOMIC_RELEASE, "agent");
            asm volatile("s_waitcnt vmcnt(0)" ::: "memory");
            const unsigned og = xb_add(&bar[XB_TOP], 1u);
            const unsigned tg = og / nx;
            if (og + 1u == (tg + 1u) * nx) xb_add(&bar[XB_TOPGEN], 1u);
            else XB_SPIN(xb_ld(&bar[XB_TOPGEN]) == tg, bar);
            __builtin_amdgcn_fence(__ATOMIC_ACQUIRE, "agent");
            xb_add(&bar[XB_XGEN(b.x)], 1u);
            asm volatile("s_waitcnt vmcnt(0)" ::: "memory");
        } else {
            XB_SPIN(xb_ld(&bar[XB_XGEN(b.x)]) == gen, bar);
            __builtin_amdgcn_fence(__ATOMIC_ACQUIRE, "agent");
            asm volatile("s_waitcnt vmcnt(0)" ::: "memory");
        }
    }
    __syncthreads();
}

enum { PH_PRO = 0, PH_INPROJ = 1, PH_ATTN = 2, PH_OUTPROJ = 3, PH_UP = 4, PH_DOWN = 5, PH_END = 6 };

__global__ void __launch_bounds__(NTHR, 2) mega_kernel(Args a) {
    extern __shared__ __attribute__((aligned(16))) unsigned char lds_raw[];
    LAS unsigned char* lds = (LAS unsigned char*)lds_raw;
    const int G = gridDim.x, bid = blockIdx.x;
    const int vcu = (G % 8 == 0) ? (bid % 8) * (G / 8) + bid / 8 : bid;
    unsigned char* ws = a.ws;
    volatile LAS unsigned* bst = (volatile LAS unsigned*)(lds + LDS_BYTES - 64);
    if (threadIdx.x < 2) bst[threadIdx.x] = 0u;
    __syncthreads();
    const XcdBarrier gbar = xcd_barrier_post((unsigned*)(ws + WS_CTL) + 1024, bst);
#ifndef PHMASK
#define PHMASK 0xffff
#endif
#define IN(k) (((PHMASK >> (k)) & 1) && a.ph_lo <= (k) && (k) < a.ph_hi)
#ifdef PROBE_PHASE
#define STAMP(k) do { if (bid == 0 && threadIdx.x == 0) ((unsigned long long*)(ws + WS_CTL + 24576))[(k)] = __builtin_amdgcn_s_memrealtime(); } while (0)
#else
#define STAMP(k) do { } while (0)
#endif
#define SEAM(k) do { if (IN(k) && IN((k) + 1)) xcd_barrier(gbar); STAMP((k) + 1); } while (0)
    STAMP(0);
    if (IN(PH_PRO)) { p0_prologue(a, lds, vcu, G); __syncthreads(); norm_phase<true>(a, lds, a.x, a.norm1_g, 0, DM, bid, G); } SEAM(PH_PRO);
    if (IN(PH_INPROJ)) {
        pg8::StaticOrder S; S.init(M, NPAD, G, bid, ws + WS_XN, ws + WS_WIN, DM, DM); S.rm = 1;
        pg8::EpiIn E{ws, a.fox_q_norm, a.fox_k_norm, a.nsa_q_norm, a.slc_k_norm, a.win_k_norm, a.b_forget, (LAS float*)(lds + LDS_STATS), (unsigned*)(ws + CTL_CNT_KCVC), (unsigned*)(ws + CTL_CNT_GATE)};
        pg8::gemm_phase(lds, DM, DM, DM, S, E);
        if (bid >= 224) {
            handoff_wait((unsigned*)(ws + CTL_CNT_KCVC), 64u * 8u);
            pg8::CmpOrder S2{32, bid - 224, (const char*)(ws + WS_KC), (const char*)(ws + WS_VC), (const char*)(ws + WS_W1T)};
            pg8::EpiPart E2{(float*)(ws + WS_PART), (unsigned*)(ws + CTL_CNT_PART)};
            pg8::gemm_phase(lds, 2048, 4096, 1024, S2, E2);
        }
        else if ((bid & 1) == 0 && (bid >> 3) < 16) {
            handoff_wait((unsigned*)(ws + CTL_CNT_PART), 32u * 8u);
            cmp2_phase(a, lds, (bid >> 3) * 4 + ((bid & 7) >> 1), 64);
        }
        else if ((bid & 1) == 0 && (bid >> 3) < 20) {
            handoff_wait((unsigned*)(ws + CTL_CNT_GATE), 32u * 8u);
            att::compute_kb(ws, ((bid >> 3) - 16) * 4 + ((bid & 7) >> 1), (LAS char*)lds);
        }
    } SEAM(PH_INPROJ);
#ifdef PROBE_PHASE
    unsigned long long tA0 = __builtin_amdgcn_s_memrealtime();
#endif
    if (IN(PH_ATTN)) { att::attn_phase(a, (LAS char*)lds, vcu, G); }
#ifdef PROBE_PHASE
    if (threadIdx.x == 0) { const unsigned d = (unsigned)(__builtin_amdgcn_s_memrealtime() - tA0); atomicMax((unsigned*)(ws + WS_CTL + 24576 + 256), d); atomicMax((unsigned*)(ws + WS_CTL + 24576 + 260), 0xffffffffu - d); }
#endif
    SEAM(PH_ATTN);
    if (IN(PH_OUTPROJ)) {
        pg8::StaticOrder S; S.init(M, DM, G, bid, ws + WS_AO, ws + WS_WOUT, DM, DM);
        pg8::EpiResNorm E{a.x, a.out, (const float*)(ws + WS_MOD), a.norm2_g, (bf16_t*)(ws + WS_XN), (float*)(ws + WS_SLOTS), (unsigned*)(ws + CTL_CNT_PANEL), (LAS float*)(lds + LDS_STATS)};
        pg8::gemm_phase(lds, DM, DM, DM, S, E);
    } SEAM(PH_OUTPROJ);
    if (IN(PH_UP)) {
        pg8::StaticOrder S; S.init(M, DFF, G, bid, ws + WS_XN, ws + WS_WUP, DM, DM);
        pg8::EpiUp E{(bf16_t*)(ws + WS_U), DFF};
        pg8::gemm_phase(lds, DM, DM, DM, S, E);
    } SEAM(PH_UP);
    if (IN(PH_DOWN)) {
        pg8::StaticOrder S; S.init(M, DM, G, bid, ws + WS_U, ws + WS_WDN, DFF, DFF);
        pg8::EpiRes E{a.out, a.out, (const float*)(ws + WS_MOD) + 5 * DM};
        pg8::gemm_phase(lds, DFF, DFF, DFF, S, E);
    }
    STAMP(PH_END);
#undef IN
#undef SEAM
}

#ifdef PROBE_PHASE
__global__ void probe_kernel(const unsigned long long* tsp, float* out) {
#if PROBE_PHASE == 98
    out[0] = (float)(((const unsigned*)tsp)[64]) * 1e-3f;
#elif PROBE_PHASE == 97
    out[0] = (float)(0xffffffffu - ((const unsigned*)tsp)[65]) * 1e-3f;
#elif PROBE_PHASE == 99
    out[0] = (float)(tsp[PH_END] - tsp[0]) * 5e-4f;
#else
    const unsigned long long t1 = tsp[PROBE_PHASE + 1], t0 = tsp[PROBE_PHASE]; out[0] = (float)(t1 - t0) * 1e-2f;
#endif
}
#endif
static void launch_phases(const Args& a0, int lo, int hi, int grid, hipStream_t stream) {
    Args a = a0; a.ph_lo = lo; a.ph_hi = hi; void* args[] = {&a};
    (void)args; hipLaunchKernelGGL(mega_kernel, dim3(grid), dim3(NTHR), LDS_BYTES, stream, a);
    hipError_t e = hipPeekAtLastError();
    if (e != hipSuccess) fprintf(stderr, "launch failed: %s (grid %d)\n", hipGetErrorString(e), grid);
}

extern "C" void kernel_launch(void* const* d_in, const int* in_sizes, int n_in, void* d_out, int out_size, void* d_ws, size_t ws_size, hipStream_t stream) {
    static int grid = 0;
    if (grid == 0) {
        int dev = 0, cus = 0, per_cu = 0; hipGetDevice(&dev); hipDeviceGetAttribute(&cus, hipDeviceAttributeMultiprocessorCount, dev);
        hipFuncSetAttribute((const void*)mega_kernel, hipFuncAttributeMaxDynamicSharedMemorySize, LDS_BYTES);
        hipOccupancyMaxActiveBlocksPerMultiprocessor(&per_cu, (const void*)mega_kernel, NTHR, LDS_BYTES);
        if (per_cu < 1) { fprintf(stderr, "occupancy query says %d blocks/CU\n", per_cu); per_cu = 1; }
        grid = 256;
        if (cus < 256) fprintf(stderr, "this kernel needs >= 256 CUs for a resident grid (device has %d)\n", cus);
        if (ws_size < WS_END + 24 * MiB) fprintf(stderr, "workspace too small: %zu\n", ws_size);
    }
    hipMemsetAsync((char*)d_ws + WS_CTL, 0, 49152, stream);
    Args a{};
    const float** ap = (const float**)&a;
    for (int i = 0; i < 23; ++i) ap[i] = (const float*)d_in[i];
    a.out = (float*)d_out; a.ws = (unsigned char*)d_ws;
    unsigned char* ws = a.ws;
    launch_phases(a, PH_PRO, PH_END, grid, stream);
#ifdef PROBE_PHASE
    probe_kernel<<<1, 1, 0, stream>>>((const unsigned long long*)(ws + WS_CTL + 24576), a.out);
#endif
}
```

```cpp
#include <hip/hip_runtime.h>
#include <hip/hip_cooperative_groups.h>
#include <stdint.h>
#include <math.h>
#include <cstdio>
namespace cg = cooperative_groups;
#define NF_IN 3

constexpr int DM = 2048, NB = 2, T = 4096, M = NB * T, HD = 128;
constexpr int DIN = 5664, DFF = 8192, NPAD = 5888;
constexpr int C_FQ = 0, C_FK = 1024, C_FV = 2048, C_FZ = 3072, C_NQ = 3080, C_KC = 4104, C_VC = 4360, C_KSL = 4616, C_VSL = 4872,
              C_KW = 5128, C_VW = 5384, C_GZ = 5640;
constexpr int NCMP = 255;
constexpr float SCALE = 0.08838834764831845f;
constexpr float EPS = 1e-6f;
constexpr int NWAVES = 8, NTHR = 512;

constexpr size_t MiB = 1u << 20;
constexpr size_t WS_CTL = 0;
constexpr size_t CTL_CNT_GATE = 21504;
constexpr size_t CTL_CNT_KCVC = 20480, CTL_CNT_PART = 20736, CTL_CNT_ADALN = 20992, CTL_CNT_PANEL = 32768, CTL_CNT_ATTN = 40960;
constexpr size_t WS_SLOTS = 64 * 1024;
constexpr size_t WS_MODP = 384 * 1024;
constexpr size_t WS_MOD = 2 * MiB;
constexpr size_t WS_ROPE = 3 * MiB;
constexpr size_t WS_PEBP = 5 * MiB;
constexpr size_t WS_PEB = 5 * MiB + 256 * 1024;
constexpr size_t WS_MBOUND = 5 * MiB + 300 * 1024;
constexpr size_t WS_LOGF = 5 * MiB + 320 * 1024;
constexpr size_t WS_KBIAS = 5 * MiB + 640 * 1024;
constexpr size_t WS_GATES = 6 * MiB;
constexpr size_t WS_W2T = 7 * MiB;
constexpr size_t WS_W1T = 8 * MiB;
constexpr size_t WS_WIN = 12 * MiB;
constexpr size_t WS_WOUT = 36 * MiB;
constexpr size_t WS_WUP = 44 * MiB;
constexpr size_t WS_WDN = 76 * MiB;
constexpr size_t WS_XN = 108 * MiB;
constexpr size_t WS_FQ = 140 * MiB, WS_FK = 156 * MiB, WS_FV = 172 * MiB, WS_NQ = 188 * MiB, WS_NQR = 204 * MiB;
constexpr size_t WS_KC = 220 * MiB, WS_VC = 224 * MiB, WS_KSL = 228 * MiB, WS_VSL = 232 * MiB, WS_KW = 236 * MiB, WS_VW = 240 * MiB;
constexpr size_t WS_KCMP = 244 * MiB, WS_VCMP = 244 * MiB + 512 * 1024;
constexpr size_t WS_PART = 245 * MiB;
constexpr size_t WS_NSAO = 277 * MiB;
constexpr size_t WS_X1B = WS_NSAO;
constexpr size_t WS_AO = 309 * MiB;
constexpr size_t WS_U = 140 * MiB;
constexpr size_t WS_END = 341 * MiB;
constexpr size_t WS_DEV_CUM = 341 * MiB;
constexpr size_t WS_DEV_XB = 342 * MiB;
constexpr size_t WS_DEV_HID = 358 * MiB;
constexpr size_t WS_DEV_KC = 360 * MiB;

constexpr int LDS_STATS = 131072;
constexpr int LDS_BYTES = 155648;

#define LAS __attribute__((address_space(3)))
#define GAS __attribute__((address_space(1)))
typedef unsigned short bf16_t;
typedef short bf16x8 __attribute__((ext_vector_type(8)));
typedef float f32x4 __attribute__((ext_vector_type(4)));
typedef float f32x2 __attribute__((ext_vector_type(2)));
typedef unsigned u32x4 __attribute__((ext_vector_type(4)));
typedef unsigned u32x2 __attribute__((ext_vector_type(2)));

typedef __bf16 bf16x2_t __attribute__((ext_vector_type(2)));
__device__ __forceinline__ unsigned cvt_pk_bf16(float lo, float hi) { f32x2 v = {lo, hi}; bf16x2_t b = __builtin_convertvector(v, bf16x2_t); return __builtin_bit_cast(unsigned, b); }
__device__ __forceinline__ float bf2f(bf16_t v) { return __uint_as_float(((unsigned)v) << 16); }
__device__ __forceinline__ float wave_sum(float v) {
#pragma unroll
    for (int o = 1; o < 64; o <<= 1) v += __shfl_xor(v, o);
    return v;
}
__device__ __forceinline__ float wave_max(float v) {
#pragma unroll
    for (int o = 1; o < 64; o <<= 1) v = fmaxf(v, __shfl_xor(v, o));
    return v;
}


__device__ __forceinline__ void handoff_signal(unsigned* cnt, int lane) {
    asm volatile("s_waitcnt vmcnt(0)" ::: "memory");
    if (lane == 0) __hip_atomic_fetch_add(cnt, 1u, __ATOMIC_RELAXED, __HIP_MEMORY_SCOPE_AGENT);
}
__device__ __forceinline__ void handoff_wait(unsigned* cnt, unsigned target) {
    if (threadIdx.x < 64) { unsigned sp = 0;
        while ((unsigned)__builtin_amdgcn_readfirstlane(__hip_atomic_load(cnt, __ATOMIC_RELAXED, __HIP_MEMORY_SCOPE_AGENT)) < target) { __builtin_amdgcn_s_sleep(4); if (++sp > (1u << 24)) break; }
        __builtin_amdgcn_fence(__ATOMIC_ACQUIRE, "agent"); asm volatile("s_waitcnt vmcnt(0)" ::: "memory"); }
    __syncthreads();
}

namespace pg8 {
constexpr int BM = 256, BK = 64, HALF = 128, HTB = HALF * BK * 2, STAGE_BYTES = 8 * HTB, NXCD = 8, WGM = 8;
__host__ __device__ __forceinline__ int lds_byte(int r, int c) { const int st = (r >> 4) * 2 + (c >> 5), rr = r & 15, cc = c & 31, ob = rr * 64 + cc * 2; return st * 1024 + (ob ^ (((ob >> 9) & 1) << 5)); }
__host__ __device__ __forceinline__ void stage_rc(int b, int& R, int& C) { const int st = b / 1024, sb = b % 1024, swz = sb ^ (((sb >> 9) & 1) << 5); R = (st >> 1) * 16 + swz / 64; C = (st & 1) * 32 + (swz % 64) / 2; }
__host__ __device__ __forceinline__ int perm32(int rho) { const int n = rho >> 4, i = rho & 15; return 8 * (i >> 2) + 4 * n + (i & 3); }

struct Unit { int pm, pn, aux; };
#define NF_ERN 3
#ifndef NF_IN
#define NF_IN 2
#endif

struct StaticOrder {
    int nM, nN, nwg, G, c; const char* A; const char* Bt; size_t tsA, tsB; int rm = 0;
    __device__ __forceinline__ void init(int M_, int N_, int G_, int c_, const void* A_, const void* Bt_, int lda, int ldb) { nM = M_ / BM; nN = N_ / BM; nwg = nM * nN; G = G_; c = c_; A = (const char*)A_; Bt = (const char*)Bt_; tsA = (size_t)BM * lda * 2; tsB = (size_t)BM * ldb * 2; }
    __device__ __forceinline__ bool next(int i, Unit& u) const {
        const long L = (long)i * G + c; if (L >= nwg) return false;
        int wgid = (int)L; { const int q = nwg / NXCD, r = nwg % NXCD, xcd = wgid % NXCD, off = wgid / NXCD; wgid = (xcd < r ? xcd * (q + 1) : r * (q + 1) + (xcd - r) * q) + off; }
        const int nig = WGM * nN, gid = wgid / nig, fm = gid * WGM, gsz = (nM - fm) < WGM ? (nM - fm) : WGM;
        u.pm = fm + ((wgid % nig) % gsz); u.pn = (wgid % nig) / gsz; u.aux = 0;
        if (rm) { const int p = u.pn; u.pn = (int)(((p < 12 ? 0x4a0e6734a418820ull : 0x5ab49ad507b251ull) >> (5 * (p < 12 ? p : p - 12))) & 31ull); }
        return true;
    }
    __device__ __forceinline__ void ptrs(const Unit& u, const char*& a, const char*& b) const { a = A + (size_t)u.pm * tsA; b = Bt + (size_t)u.pn * tsB; }
};

template <class Epi, class Sched>
__device__ __forceinline__ void gemm_phase(LAS unsigned char* lds, const int lda, const int ldb, const int K, const Sched& S, const Epi& E) {
    int tid = threadIdx.x; asm volatile("" : "+v"(tid));
    const int wid = __builtin_amdgcn_readfirstlane(tid >> 6), lane = tid & 63, wr = wid >> 2, wc = wid & 3, fr = lane & 15, fq = lane >> 4;
    const int nt = K / BK;
    unsigned voffA[2], voffB[2];
#pragma unroll
    for (int i = 0; i < 2; ++i) { int R, C; stage_rc(tid * 16 + i * 8192, R, C); const int Rb = Epi::PERM ? ((R & ~31) + perm32(R & 31)) : R;
        voffA[i] = (unsigned)(R * lda + C) * 2u; voffB[i] = (unsigned)(Rb * ldb + C) * 2u; }
    const size_t kstep = (size_t)(BK * 2);
    const size_t hsA = (size_t)HALF * lda * 2, hsB = (size_t)HALF * ldb * 2;
    const unsigned ldsw = (unsigned)wid * 1024u;
    const int aoff = lds_byte(wr * 64 + fr, fq * 8), boff = lds_byte(wc * 32 + fr, fq * 8);
#define PG8_SA(b, h) (((b) * 2 + (h)) * HTB)
#define PG8_SB(b, h) ((4 + (b) * 2 + (h)) * HTB)
#define PG8_STAGE(bufoff, gbase, voff) do { _Pragma("unroll") for (int _i = 0; _i < 2; ++_i) \
        __builtin_amdgcn_global_load_lds((const unsigned*)((const char*)(gbase) + (voff)[_i]), (LAS unsigned*)(lds + (bufoff) + ldsw + _i * 8192), 16, 0, 0); } while (0)
#define PG8_LDA(dst, b, h) do { _Pragma("unroll") for (int m = 0; m < 4; ++m) _Pragma("unroll") for (int k = 0; k < 2; ++k) dst[m][k] = *(const LAS bf16x8*)(lds + PG8_SA(b, h) + aoff + m * 2048 + k * 1024); } while (0)
#define PG8_LDB(dst, b, h) do { _Pragma("unroll") for (int n = 0; n < 2; ++n) _Pragma("unroll") for (int k = 0; k < 2; ++k) dst[n][k] = *(const LAS bf16x8*)(lds + PG8_SB(b, h) + boff + n * 2048 + k * 1024); } while (0)
#define PG8_MMA(ai, bj, At, Bt) do { __builtin_amdgcn_s_setprio(1); _Pragma("unroll") for (int m = 0; m < 4; ++m) _Pragma("unroll") for (int n = 0; n < 2; ++n) _Pragma("unroll") for (int k = 0; k < 2; ++k) \
        acc[ai][bj][m][n] = __builtin_amdgcn_mfma_f32_16x16x32_bf16(Bt[n][k], At[m][k], acc[ai][bj][m][n], 0, 0, 0); __builtin_amdgcn_s_setprio(0); } while (0)
#define PG8_WAIT_V(n) asm volatile("s_waitcnt vmcnt(" #n ")" ::: "memory")
#define PG8_WAIT_L(n) asm volatile("s_waitcnt lgkmcnt(" #n ")" ::: "memory")
#define PG8_BAR __builtin_amdgcn_s_barrier()
#define PG8_SCHED __builtin_amdgcn_sched_barrier(0)
    Unit cur, nxt; int ui = 0;
    if (!S.next(0, cur)) return;
    f32x4 acc[2][2][4][2];
#pragma unroll
    for (int a = 0; a < 2; ++a)
#pragma unroll
        for (int b = 0; b < 2; ++b)
#pragma unroll
            for (int m = 0; m < 4; ++m)
#pragma unroll
                for (int n = 0; n < 2; ++n) acc[a][b][m][n] = (f32x4){0.f, 0.f, 0.f, 0.f};
    bf16x8 At[4][2], B0[2][2], B1[2][2];
    const char* cA; const char* cB; S.ptrs(cur, cA, cB);
    PG8_STAGE(PG8_SB(0, 0), cB, voffB); PG8_STAGE(PG8_SB(0, 1), cB + hsB, voffB); PG8_STAGE(PG8_SA(0, 0), cA, voffA); PG8_STAGE(PG8_SA(0, 1), cA + hsA, voffA);
    if (wr == 1) PG8_BAR;
    PG8_WAIT_V(2); PG8_BAR;
    PG8_STAGE(PG8_SB(1, 0), cB + kstep, voffB); PG8_STAGE(PG8_SA(1, 0), cA + kstep, voffA); PG8_STAGE(PG8_SB(1, 1), cB + hsB + kstep, voffB);
    PG8_WAIT_V(6); PG8_BAR;
    if constexpr (Epi::PREFETCH) E.prefetch(cur, lds + STAGE_BYTES, wid, lane);
    for (;;) {
        const bool has_next = S.next(ui + 1, nxt);
        const char* nA = cA; const char* nB = cB; if (has_next) S.ptrs(nxt, nA, nB);
#pragma nounroll
        for (int t = 0; t < nt; t += 2) {
            const bool last = (t == nt - 2);
            const char* a1 = cA + (size_t)(t + 1) * kstep;
            const char* a2 = last ? nA : cA + (size_t)(t + 2) * kstep; const char* b2 = last ? nB : cB + (size_t)(t + 2) * kstep;
            const char* a3 = a2 + kstep; const char* b3 = b2 + kstep;
            PG8_LDB(B0, 0, 0); PG8_LDB(B1, 0, 1); PG8_SCHED; PG8_LDA(At, 0, 0); PG8_STAGE(PG8_SA(1, 1), a1 + hsA, voffA);
            PG8_WAIT_V(8); PG8_WAIT_L(0); PG8_BAR; PG8_MMA(0, 0, At, B0); PG8_MMA(0, 1, At, B1); PG8_BAR; PG8_SCHED;
            PG8_LDA(At, 0, 1); PG8_STAGE(PG8_SB(0, 0), b2, voffB); PG8_STAGE(PG8_SB(0, 1), b2 + hsB, voffB); PG8_STAGE(PG8_SA(0, 0), a2, voffA);
            PG8_WAIT_V(8); PG8_WAIT_L(0); PG8_BAR; PG8_MMA(1, 0, At, B0); PG8_MMA(1, 1, At, B1); PG8_BAR; PG8_SCHED;
            PG8_LDB(B0, 1, 0); PG8_LDB(B1, 1, 1); PG8_SCHED; PG8_LDA(At, 1, 0); PG8_STAGE(PG8_SA(0, 1), a2 + hsA, voffA);
            PG8_WAIT_V(8); PG8_WAIT_L(0); PG8_BAR; PG8_MMA(0, 0, At, B0); PG8_MMA(0, 1, At, B1); PG8_BAR; PG8_SCHED;
            PG8_LDA(At, 1, 1); PG8_STAGE(PG8_SB(1, 0), b3, voffB); PG8_STAGE(PG8_SB(1, 1), b3 + hsB, voffB); PG8_STAGE(PG8_SA(1, 0), a3, voffA);
            PG8_WAIT_V(8); PG8_WAIT_L(0); PG8_BAR; PG8_MMA(1, 0, At, B0); PG8_MMA(1, 1, At, B1); PG8_BAR; PG8_SCHED;
        }
        if (wr == 0) PG8_BAR;
        E(acc, cur, wr, wc, fr, fq);
        if (!has_next) break;
#pragma unroll
        for (int a = 0; a < 2; ++a)
#pragma unroll
            for (int b = 0; b < 2; ++b)
#pragma unroll
                for (int m = 0; m < 4; ++m)
#pragma unroll
                    for (int n = 0; n < 2; ++n) acc[a][b][m][n] = (f32x4){0.f, 0.f, 0.f, 0.f};
        cur = nxt; cA = nA; cB = nB; ++ui;
        if (wr == 1) PG8_BAR;
    }
    PG8_WAIT_V(0);
    PG8_BAR;
#undef PG8_SA
#undef PG8_SB
#undef PG8_STAGE
#undef PG8_LDA
#undef PG8_LDB
#undef PG8_MMA
#undef PG8_WAIT_V
#undef PG8_WAIT_L
#undef PG8_BAR
#undef PG8_SCHED
}


struct EpiRes {
    static constexpr bool PERM = true, PREFETCH = false;
    const bf16_t* base; float* out; const float* gate;
    __device__ __forceinline__ void prefetch(const Unit&, LAS unsigned char*, int, int) const {}
    __device__ __forceinline__ void operator()(const f32x4 (&acc)[2][2][4][2], const Unit& u, int wr, int wc, int fr, int fq) const {
        const int row0 = u.pm * BM + wr * 64 + fr, col0 = u.pn * BM + wc * 32 + 8 * fq;
        const int b = (u.pm * BM) / T;
        f32x4 gv[2][2];
#pragma unroll
        for (int bj = 0; bj < 2; ++bj)
#pragma unroll
            for (int n = 0; n < 2; ++n) gv[bj][n] = *(const f32x4*)(gate + (size_t)b * 6 * DM + col0 + bj * HALF + 4 * n);
#pragma unroll
        for (int ai = 0; ai < 2; ++ai)
#pragma unroll
            for (int m = 0; m < 4; ++m) { const size_t off = (size_t)(row0 + ai * HALF + m * 16) * DM + col0;
#pragma unroll
                for (int bj = 0; bj < 2; ++bj) { const u32x4 w = *(const u32x4*)(base + off + bj * HALF);
                    const f32x4 b0 = (f32x4){__uint_as_float(w.x << 16), __uint_as_float(w.x & 0xffff0000u), __uint_as_float(w.y << 16), __uint_as_float(w.y & 0xffff0000u)};
                    const f32x4 b1 = (f32x4){__uint_as_float(w.z << 16), __uint_as_float(w.z & 0xffff0000u), __uint_as_float(w.w << 16), __uint_as_float(w.w & 0xffff0000u)};
                    *(f32x4*)(out + off + bj * HALF) = b0 + gv[bj][0] * acc[ai][bj][m][0];
                    *(f32x4*)(out + off + bj * HALF + 4) = b1 + gv[bj][1] * acc[ai][bj][m][1]; } }
    }
};

struct EpiResNorm {
    static constexpr bool PERM = true, PREFETCH = false;
    const float* base; bf16_t* out; const float* mod; const float* g2; bf16_t* XN; float* slots; unsigned* cnt; LAS float* tab;
    __device__ __forceinline__ void prefetch(const Unit& u, LAS unsigned char* dummy, int wid, int lane) const {
        const float* p = base + (size_t)(u.pm * BM + wid * 32) * DM + u.pn * BM + lane * 4;
#pragma unroll 8
        for (int r = 0; r < 32; ++r) __builtin_amdgcn_global_load_lds((const unsigned*)(p + (size_t)r * DM), (LAS unsigned*)(dummy + wid * 1024), 16, 0, 0);
    }
    __device__ __forceinline__ void operator()(f32x4 (&acc)[2][2][4][2], const Unit& u, int wr, int wc, int fr, int fq) const {
        const int row0 = u.pm * BM + wr * 64 + fr, col0 = u.pn * BM + wc * 32 + 8 * fq;
        const int b = (u.pm * BM) / T; const int wid = wr * 4 + wc, lane = fr + 16 * fq;
        const float* mb = mod + (size_t)b * 6 * DM;
        {   f32x4 gv[2][2];
#pragma unroll
            for (int bj = 0; bj < 2; ++bj)
#pragma unroll
                for (int n = 0; n < 2; ++n) gv[bj][n] = *(const f32x4*)(mb + 2 * DM + col0 + bj * HALF + 4 * n);
            f32x4 bs[NF_ERN][2][2];
#define ER_LD(g) do { const size_t off_ = (size_t)(row0 + ((g) >> 2) * HALF + ((g) & 3) * 16) * DM + col0; _Pragma("unroll") for (int bj = 0; bj < 2; ++bj) _Pragma("unroll") for (int n = 0; n < 2; ++n) \
            bs[(g) % NF_ERN][bj][n] = *(const f32x4*)(base + off_ + bj * HALF + 4 * n); } while (0)
            _Pragma("unroll") for (int g = 0; g < NF_ERN; ++g) ER_LD(g);
            asm volatile("" ::: "memory");
#pragma unroll
            for (int g = 0; g < 8; ++g) { const int ai = g >> 2, m = g & 3; float ss = 0.f;
#pragma unroll
                for (int bj = 0; bj < 2; ++bj)
#pragma unroll
                    for (int n = 0; n < 2; ++n) { const f32x4 v = bs[g % NF_ERN][bj][n] + gv[bj][n] * acc[ai][bj][m][n];
                        acc[ai][bj][m][n] = v; ss += (v[0] * v[0] + v[1] * v[1]) + (v[2] * v[2] + v[3] * v[3]); }
                if (g + NF_ERN < 8) ER_LD(g + NF_ERN);
                ss += __shfl_xor(ss, 16); ss += __shfl_xor(ss, 32);
                if (fq == 0) tab[(ai * HALF + wr * 64 + m * 16 + fr) * 4 + wc] = ss;
                asm volatile("" ::: "memory"); }
#undef ER_LD
        }
        asm volatile("s_waitcnt lgkmcnt(0)" ::: "memory"); __builtin_amdgcn_s_barrier(); asm volatile("" ::: "memory");
        const int prow = wid * 32 + (lane & 31);
        if (lane < 32) { const f32x4 q = *(const LAS f32x4*)(tab + prow * 4);
            __hip_atomic_store((unsigned*)slots + ((size_t)(u.pm * BM + prow) * 8 + u.pn), __float_as_uint((q[0] + q[1]) + (q[2] + q[3])), __ATOMIC_RELAXED, __HIP_MEMORY_SCOPE_AGENT); }
        asm volatile("s_waitcnt vmcnt(0)" ::: "memory");
        if (lane == 0) __hip_atomic_fetch_add(cnt + 64 * u.pm, 1u, __ATOMIC_RELAXED, __HIP_MEMORY_SCOPE_AGENT);
        f32x4 av[2][2], sv[2][2];
#pragma unroll
        for (int bj = 0; bj < 2; ++bj)
#pragma unroll
            for (int n = 0; n < 2; ++n) { const int c = col0 + bj * HALF + 4 * n; const f32x4 gg = *(const f32x4*)(g2 + c), sc = *(const f32x4*)(mb + 4 * DM + c);
                av[bj][n] = gg * (sc + 1.f); sv[bj][n] = *(const f32x4*)(mb + 3 * DM + c); }
        if (wid == 0) { unsigned sp = 0;
            while ((unsigned)__builtin_amdgcn_readfirstlane(__hip_atomic_load(cnt + 64 * u.pm, __ATOMIC_RELAXED, __HIP_MEMORY_SCOPE_AGENT)) < 64u) { __builtin_amdgcn_s_sleep(2); if (++sp > (1u << 22)) break; }
            __builtin_amdgcn_fence(__ATOMIC_ACQUIRE, "agent"); }
        asm volatile("s_waitcnt vmcnt(0) lgkmcnt(0)" ::: "memory"); __builtin_amdgcn_s_barrier(); asm volatile("" ::: "memory");
        if (lane < 32) { const unsigned* sl = (const unsigned*)slots + (size_t)(u.pm * BM + prow) * 8; float tot = 0.f;
#pragma unroll
            for (int t = 0; t < 8; ++t) tot += __uint_as_float(__hip_atomic_load(sl + t, __ATOMIC_RELAXED, __HIP_MEMORY_SCOPE_AGENT));
            tab[1024 + prow] = __builtin_amdgcn_rsqf(tot * (1.f / DM) + EPS); }
        asm volatile("s_waitcnt vmcnt(0) lgkmcnt(0)" ::: "memory"); __builtin_amdgcn_s_barrier(); asm volatile("" ::: "memory");
#pragma unroll
        for (int ai = 0; ai < 2; ++ai)
#pragma unroll
            for (int m = 0; m < 4; ++m) { const int rl = ai * HALF + wr * 64 + m * 16 + fr; const float rstd = tab[1024 + rl]; const size_t off = (size_t)(u.pm * BM + rl) * DM + col0;
#pragma unroll
                for (int bj = 0; bj < 2; ++bj) {
                    { const f32x4 x0 = acc[ai][bj][m][0], x1 = acc[ai][bj][m][1]; u32x4 xw; xw.x = cvt_pk_bf16(x0[0], x0[1]); xw.y = cvt_pk_bf16(x0[2], x0[3]); xw.z = cvt_pk_bf16(x1[0], x1[1]); xw.w = cvt_pk_bf16(x1[2], x1[3]);
                      *(u32x4*)(out + off + bj * HALF) = xw; }
                    const f32x4 h0 = acc[ai][bj][m][0] * rstd * av[bj][0] + sv[bj][0], h1 = acc[ai][bj][m][1] * rstd * av[bj][1] + sv[bj][1];
                    u32x4 w; w.x = cvt_pk_bf16(h0[0], h0[1]); w.y = cvt_pk_bf16(h0[2], h0[3]); w.z = cvt_pk_bf16(h1[0], h1[1]); w.w = cvt_pk_bf16(h1[2], h1[3]);
                    *(u32x4*)(XN + off + bj * HALF) = w; }
                asm volatile("" ::: "memory"); }
    }
};
struct EpiUp {
    static constexpr bool PERM = true, PREFETCH = false;
    bf16_t* O; int ldc;
    __device__ __forceinline__ void operator()(const f32x4 (&acc)[2][2][4][2], const Unit& u, int wr, int wc, int fr, int fq) const {
        const int row0 = u.pm * BM + wr * 64 + fr, col0 = u.pn * BM + wc * 32 + 8 * fq;
#pragma unroll
        for (int ai = 0; ai < 2; ++ai)
#pragma unroll
            for (int m = 0; m < 4; ++m) { bf16_t* rowp = O + (size_t)(row0 + ai * HALF + m * 16) * ldc + col0;
#pragma unroll
                for (int bj = 0; bj < 2; ++bj) { f32x4 v0 = acc[ai][bj][m][0], v1 = acc[ai][bj][m][1];
                    v0 = __builtin_elementwise_max(v0, (f32x4){0.f, 0.f, 0.f, 0.f}); v1 = __builtin_elementwise_max(v1, (f32x4){0.f, 0.f, 0.f, 0.f}); v0 = v0 * v0; v1 = v1 * v1;
                    u32x4 w; w.x = cvt_pk_bf16(v0[0], v0[1]); w.y = cvt_pk_bf16(v0[2], v0[3]); w.z = cvt_pk_bf16(v1[0], v1[1]); w.w = cvt_pk_bf16(v1[2], v1[3]);
                    *(u32x4*)(rowp + bj * HALF) = w; } }
    }
};
struct EpiIn {
    static constexpr bool PERM = true, PREFETCH = false;
    unsigned char* wsb;
    const float *g_fq, *g_fk, *g_nq, *g_slc, *g_win, *b_forget; LAS float* stats; unsigned* kcvc_cnt; unsigned* gate_cnt;
    __device__ __forceinline__ void operator()(const f32x4 (&acc)[2][2][4][2], const Unit& u, int wr, int wc, int fr, int fq) const {
        const int pn = u.pn;
        unsigned char* w_ = wsb; asm volatile("" : "+s"(w_));
        GAS bf16_t* const FQ = (GAS bf16_t*)(w_ + WS_FQ); GAS bf16_t* const FK = (GAS bf16_t*)(w_ + WS_FK); GAS bf16_t* const FV = (GAS bf16_t*)(w_ + WS_FV); GAS bf16_t* const NQ = (GAS bf16_t*)(w_ + WS_NQ); GAS bf16_t* const NQR = (GAS bf16_t*)(w_ + WS_NQR);
        GAS bf16_t* const KC = (GAS bf16_t*)(w_ + WS_KC); GAS bf16_t* const VC = (GAS bf16_t*)(w_ + WS_VC); GAS bf16_t* const KSL = (GAS bf16_t*)(w_ + WS_KSL); GAS bf16_t* const VSL = (GAS bf16_t*)(w_ + WS_VSL); GAS bf16_t* const KW = (GAS bf16_t*)(w_ + WS_KW); GAS bf16_t* const VW = (GAS bf16_t*)(w_ + WS_VW);
        GAS float* const LOGF = (GAS float*)(w_ + WS_LOGF); GAS float* const GATES = (GAS float*)(w_ + WS_GATES); const GAS float* const rope = (const GAS float*)(w_ + WS_ROPE);
        const int b = u.pm >> 4, t0 = (u.pm & 15) * BM + wr * 64 + fr;
        if (pn == 12) {
            if (wc == 0) {
#pragma unroll
                for (int ai = 0; ai < 2; ++ai)
#pragma unroll
                    for (int m = 0; m < 4; ++m) { const int t = t0 + ai * HALF + m * 16;
#pragma unroll
                        for (int n = 0; n < 2; ++n)
#pragma unroll
                            for (int e = 0; e < 4; ++e) { const int p = 8 * fq + 4 * n + e; const float v = acc[ai][0][m][n][e];
                                if (p < 8) { const float z = v + b_forget[p]; __hip_atomic_store((GAS unsigned*)(LOGF + ((size_t)b * 8 + p) * T + t), __float_as_uint(fminf(z, 0.f) - __logf(1.f + __expf(-fabsf(z)))), __ATOMIC_RELAXED, __HIP_MEMORY_SCOPE_AGENT); }
                                else { GATES[((size_t)b * T + t) * 24 + (p - 8)] = 1.f / (1.f + __expf(-v)); } } }
            }
            handoff_signal(gate_cnt, fr + 16 * fq);
            return;
        }
        if (pn < 4) body<true, true, false, false>(acc, u, wr, wc, fr, fq, FQ, nullptr, g_fq, rope, 8, 2 * pn);
        else if (pn < 8) body<true, true, false, false>(acc, u, wr, wc, fr, fq, FK, nullptr, g_fk, rope, 8, 2 * (pn - 4));
        else if (pn < 12) body<false, true, false, false>(acc, u, wr, wc, fr, fq, FV, nullptr, nullptr, rope, 8, 2 * (pn - 8));
        else if (pn < 17) body<true, true, true, false>(acc, u, wr, wc, fr, fq, NQ, NQR, g_nq, rope, 8, 2 * (pn - 13));
        else if (pn < 19) body<false, true, false, true>(acc, u, wr, wc, fr, fq, pn == 17 ? KC : VC, nullptr, nullptr, rope, 2, 0);
        else if (pn < 21) body<true, false, true, false>(acc, u, wr, wc, fr, fq, nullptr, pn == 19 ? KSL : KW, pn == 19 ? g_slc : g_win, rope, 2, 0);
        else body<false, true, false, false>(acc, u, wr, wc, fr, fq, pn == 21 ? VSL : VW, nullptr, nullptr, rope, 2, 0);
    }
    template <bool NORM, bool D1, bool D2, bool WT>
    __device__ __forceinline__ void body(const f32x4 (&acc)[2][2][4][2], const Unit& u, int wr, int wc, int fr, int fq, GAS bf16_t* d1, GAS bf16_t* d2, const float* gain, const GAS float* rope, int nh, int h0) const {
        const int b = u.pm >> 4, t0 = (u.pm & 15) * BM + wr * 64 + fr;
        const int dlo = 16 * wc + 4 * fq;
        f32x4 g0 = (f32x4){1.f, 1.f, 1.f, 1.f}, g1 = g0;
        if (NORM) { g0 = *(const f32x4*)(gain + dlo); g1 = *(const f32x4*)(gain + 64 + dlo); }
        f32x4 cs[NF_IN][2];
#define EI_LD(g) do { const int tn_ = t0 + ((g) >> 2) * HALF + ((g) & 3) * 16; const GAS float* rp_ = rope + ((size_t)tn_ * 64 + dlo) * 2; cs[(g) % NF_IN][0] = *(const GAS f32x4*)rp_; cs[(g) % NF_IN][1] = *(const GAS f32x4*)(rp_ + 4); } while (0)
        if (D2) { _Pragma("unroll") for (int g = 0; g < NF_IN; ++g) EI_LD(g); }
        if (NORM) {
#pragma unroll
            for (int ai = 0; ai < 2; ++ai)
#pragma unroll
                for (int m = 0; m < 4; ++m)
#pragma unroll
                    for (int bj = 0; bj < 2; ++bj) { const f32x4 a = acc[ai][bj][m][0], c = acc[ai][bj][m][1];
                        float s = (a[0] * a[0] + a[1] * a[1]) + (a[2] * a[2] + a[3] * a[3]) + (c[0] * c[0] + c[1] * c[1]) + (c[2] * c[2] + c[3] * c[3]);
                        { const unsigned x = __float_as_uint(s); const auto r = __builtin_amdgcn_permlane32_swap(x, x, false, false); s = __uint_as_float(r[0]) + __uint_as_float(r[1]); }
                        { const unsigned x = __float_as_uint(s); const auto r = __builtin_amdgcn_permlane16_swap(x, x, false, false); s = __uint_as_float(r[0]) + __uint_as_float(r[1]); }
                        if (fq == 0) stats[(ai * HALF + wr * 64 + m * 16 + fr) * 8 + bj * 4 + wc] = s; }
            asm volatile("s_waitcnt lgkmcnt(0)" ::: "memory"); __builtin_amdgcn_s_barrier(); asm volatile("" ::: "memory");
        }
#pragma unroll
        for (int g = 0; g < 8; ++g) { const int ai = g >> 2, m = g & 3; const int t = t0 + ai * HALF + m * 16;
            float rsv[2] = {1.f, 1.f};
            if (NORM) {
#pragma unroll
                for (int bj = 0; bj < 2; ++bj) { const f32x4 q = *(const LAS f32x4*)(stats + (ai * HALF + wr * 64 + m * 16 + fr) * 8 + bj * 4);
                    rsv[bj] = __builtin_amdgcn_rsqf(((q[0] + q[1]) + (q[2] + q[3])) * (1.f / 128.f) + EPS); } }
            f32x4 c = g0, sn = g0;
            if (D2) { c = (f32x4){cs[g % NF_IN][0][0], cs[g % NF_IN][0][2], cs[g % NF_IN][1][0], cs[g % NF_IN][1][2]}; sn = (f32x4){cs[g % NF_IN][0][1], cs[g % NF_IN][0][3], cs[g % NF_IN][1][1], cs[g % NF_IN][1][3]}; }
            if (D2 && g + NF_IN < 8) EI_LD(g + NF_IN);
#pragma unroll
            for (int bj = 0; bj < 2; ++bj) { f32x4 v0 = acc[ai][bj][m][0], v1 = acc[ai][bj][m][1];
                if (NORM) { const float r = rsv[bj]; v0 = v0 * r * g0; v1 = v1 * r * g1; }
                const size_t off = (((size_t)b * nh + h0 + bj) * T + t) * 128 + dlo;
                if (D1) { u32x2 w0, w1; w0.x = cvt_pk_bf16(v0[0], v0[1]); w0.y = cvt_pk_bf16(v0[2], v0[3]); w1.x = cvt_pk_bf16(v1[0], v1[1]); w1.y = cvt_pk_bf16(v1[2], v1[3]);
                    if (WT) { __hip_atomic_store((GAS unsigned long long*)(d1 + off), ((unsigned long long)w0.y << 32) | w0.x, __ATOMIC_RELAXED, __HIP_MEMORY_SCOPE_AGENT);
                        __hip_atomic_store((GAS unsigned long long*)(d1 + off + 64), ((unsigned long long)w1.y << 32) | w1.x, __ATOMIC_RELAXED, __HIP_MEMORY_SCOPE_AGENT); }
                    else { *(GAS u32x2*)(d1 + off) = w0; *(GAS u32x2*)(d1 + off + 64) = w1; } }
                if (D2) { const f32x4 r0 = v0 * c - v1 * sn, r1 = v1 * c + v0 * sn;
                    u32x2 w0, w1; w0.x = cvt_pk_bf16(r0[0], r0[1]); w0.y = cvt_pk_bf16(r0[2], r0[3]); w1.x = cvt_pk_bf16(r1[0], r1[1]); w1.y = cvt_pk_bf16(r1[2], r1[3]);
                    *(GAS u32x2*)(d2 + off) = w0; *(GAS u32x2*)(d2 + off + 64) = w1; } }
            asm volatile("" ::: "memory"); }
#undef EI_LD
        if (WT) handoff_signal(kcvc_cnt, fr + 16 * fq);
    }
};

struct EpiPart {
    static constexpr bool PERM = true, PREFETCH = false;
    float* P; unsigned* done_cnt;
    __device__ __forceinline__ void operator()(const f32x4 (&acc)[2][2][4][2], const Unit& u, int wr, int wc, int fr, int fq) const {
        const __amdgpu_buffer_rsrc_t rsrc = __builtin_amdgcn_make_buffer_rsrc(P, 0, 128 * 65536 * 4, 0x00020000);
        const unsigned base = ((unsigned)u.aux * 65536u + (unsigned)(wr * 64 + fr) * 256u + (unsigned)(wc * 32 + 8 * fq)) * 4u;
#pragma unroll
        for (int ai = 0; ai < 2; ++ai)
#pragma unroll
            for (int m = 0; m < 4; ++m) { const unsigned rp = base + (unsigned)(ai * HALF + m * 16) * 1024u;
#pragma unroll
                for (int bj = 0; bj < 2; ++bj)
#pragma unroll
                    for (int n = 0; n < 2; ++n) __builtin_amdgcn_raw_buffer_store_b128(__builtin_bit_cast(u32x4, acc[ai][bj][m][n]), rsrc, rp + (unsigned)(bj * HALF + 4 * n) * 4u, 0, 16);
                asm volatile("" ::: "memory"); }
        handoff_signal(done_cnt, fr + 16 * fq);
    }
};
struct CmpOrder {
    int G, c; const char* KC; const char* VC; const char* W1T;
    __device__ __forceinline__ bool next(int i, Unit& u) const { const int L = i * G + c; if (L >= 32) return false; u.pm = 0; u.pn = 0; u.aux = L; return true; }
    __device__ __forceinline__ void ptrs(const Unit& u, const char*& a, const char*& b) const { const int L = u.aux, kv = L >> 4, bg = (L >> 2) & 3, ks = L & 3;
        a = (kv ? VC : KC) + ((size_t)bg * T * 128 + ks * 1024) * 2; b = W1T + ((size_t)kv * 256 * 4096 + ks * 1024) * 2; }
};
}


struct Args {
    const float *x, *c, *w_ada, *b_ada, *norm1_g, *w_in, *b_forget, *fox_q_norm, *fox_k_norm, *nsa_q_norm, *cmp_k_norm, *slc_k_norm, *win_k_norm,
        *cmp_pe_k, *cmp_w1_k, *cmp_w2_k, *cmp_pe_v, *cmp_w1_v, *cmp_w2_v, *w_out, *norm2_g, *w_up, *w_down;
    float* out; unsigned char* ws; int ph_lo, ph_hi;
};

#ifndef DEV_ATT
#define DEV_ATT 3
#endif
namespace att {
typedef float f32x16 __attribute__((ext_vector_type(16)));
typedef short s16x4 __attribute__((ext_vector_type(4)));
constexpr int NW = 8, QBLK = 32, KVBLK = 64, D = 128;
constexpr int SHM_V = KVBLK * D * 2, SHM_K = KVBLK * D * 2;
constexpr int L_V = 0, L_K = 2 * SHM_V, L_WS = 2 * SHM_V + 2 * SHM_K, L_Q = L_WS + 2048;
constexpr int LC_V = 0, LC_K = 65536, LC_WS = 131072, LC_IMP = 133120;
constexpr int L_KB = 133120;
constexpr int L_SEL = 149504;
constexpr float THR = 8.f;
constexpr float C2 = 1.4426950408889634f * SCALE;
enum { M_FOX = 0, M_WIN = 1, M_SLC = 2 };
#define KSWZ(row, colB) ((row) * 256 + ((colB) ^ (((row) & 7) << 4)))
#define SBAR() __builtin_amdgcn_sched_barrier(0)
__device__ __forceinline__ int v_st(int k, int c) { const int kk = (k & ~0xC) | ((k & 4) << 1) | ((k & 8) >> 1); return ((kk >> 3) * 4 + (c >> 5)) * 512 + ((kk & 7) * 32 + (c & 31)) * 2; }
__device__ __forceinline__ int v_rd_base(int lane) { return ((lane & 3) << 3) | (((lane >> 2) & 3) << 6) | (((lane >> 4) & 1) << 5) | (((lane >> 5) & 1) << 8); }
constexpr int v_rd_off(int d0, int ks, int half) { return d0 * 512 + ks * 4096 + half * 2048; }
__device__ __forceinline__ int crow(int r, int hi) { return (r & 3) + 8 * (r >> 2) + 4 * hi; }
__device__ __forceinline__ bf16x8 load8(const bf16_t* p) { return *(const GAS bf16x8*)p; }
__device__ __forceinline__ void mask_tile(f32x16& p0, f32x16& p1, int dq, unsigned W) {
    const float NEG = -__builtin_inff();
#pragma unroll
    for (int r = 0; r < 16; ++r) { const int c = (r & 3) + 8 * (r >> 2);
        if ((unsigned)(dq - c) >= W) p0[r] = NEG;
        if ((unsigned)(dq - c - 32) >= W) p1[r] = NEG; }
}
__device__ __forceinline__ void partialSM(f32x16& p0, f32x16& p1, float& m_reg, float& mn, float& alpha) {
    float pmax = p0[0];
#pragma unroll
    for (int r = 1; r < 16; ++r) pmax = fmaxf(pmax, p0[r]);
#pragma unroll
    for (int r = 0; r < 16; ++r) pmax = fmaxf(pmax, p1[r]);
    { auto rr = __builtin_amdgcn_permlane32_swap(__float_as_uint(pmax), __float_as_uint(pmax), false, false);
      pmax = fmaxf(__uint_as_float(rr[0]), __uint_as_float(rr[1])); }
    if (__builtin_expect(__all((pmax - m_reg) * SCALE <= THR), 1)) { mn = m_reg; alpha = 1.f; }
    else { mn = fmaxf(m_reg, pmax); alpha = __builtin_amdgcn_exp2f((m_reg - mn) * C2); m_reg = mn; }
    const float mnL = -mn * C2;
#pragma unroll
    for (int r = 0; r < 16; ++r) p0[r] = fmaf(p0[r], C2, mnL);
#pragma unroll
    for (int r = 0; r < 16; ++r) p1[r] = fmaf(p1[r], C2, mnL);
#pragma unroll
    for (int r = 0; r < 16; ++r) p0[r] = __builtin_amdgcn_exp2f(p0[r]);
}
#define PK4(P, B_, OUT) do { unsigned a0 = cvt_pk_bf16(P[B_+0], P[B_+1]), a1 = cvt_pk_bf16(P[B_+2], P[B_+3]);                          \
        unsigned b0 = cvt_pk_bf16(P[B_+4], P[B_+5]), b1 = cvt_pk_bf16(P[B_+6], P[B_+7]);                                             \
        auto r0 = __builtin_amdgcn_permlane32_swap(a0, b0, false, false); auto r1 = __builtin_amdgcn_permlane32_swap(a1, b1, false, false); \
        u32x4 w = {r0[0], r1[0], r0[1], r1[1]}; OUT = *reinterpret_cast<bf16x8*>(&w); } while (0)
__device__ __forceinline__ void finishSM(f32x16& p0, f32x16& p1, float alpha, float& l_reg, bf16x8& pa0, bf16x8& pa1, bf16x8& pa2, bf16x8& pa3, bool on = true) {
#pragma unroll
    for (int r = 0; r < 16; ++r) p1[r] = __builtin_amdgcn_exp2f(p1[r]);
    float ps = 0;
#pragma unroll
    for (int r = 0; r < 16; ++r) ps += p0[r];
#pragma unroll
    for (int r = 0; r < 16; ++r) ps += p1[r];
    { auto rr = __builtin_amdgcn_permlane32_swap(__float_as_uint(ps), __float_as_uint(ps), false, false);
      ps = __uint_as_float(rr[0]) + __uint_as_float(rr[1]); }
    l_reg = l_reg * alpha + (on ? ps : 0.f);
    PK4(p0, 0, pa0); PK4(p0, 8, pa1); PK4(p1, 0, pa2); PK4(p1, 8, pa3);
    if (!on) { const bf16x8 z = {0, 0, 0, 0, 0, 0, 0, 0}; pa0 = z; pa1 = z; pa2 = z; pa3 = z; }
}
template <int KB>
__device__ __forceinline__ void qkt(f32x16& p0, f32x16& p1, const LAS char* K_lds, int r32, int hi, const LAS char* qs) {
    const LAS char* kb[4];
#pragma unroll
    for (int dd = 0; dd < 4; ++dd) kb[dd] = K_lds + KB * SHM_K + KSWZ(r32, (dd * 16 + hi * 8) * 2);
#pragma unroll
    for (int d0 = 0; d0 < 8; ++d0) { const LAS char* a = kb[d0 & 3] + (d0 >> 2) * 128;
        const bf16x8 q = *reinterpret_cast<const LAS bf16x8*>(qs + d0 * 1024);
        bf16x8 b0 = *reinterpret_cast<const LAS bf16x8*>(a);
        bf16x8 b1 = *reinterpret_cast<const LAS bf16x8*>(a + 32 * 256);
        p0 = __builtin_amdgcn_mfma_f32_32x32x16_bf16(b0, q, p0, 0, 0, 0);
        p1 = __builtin_amdgcn_mfma_f32_32x32x16_bf16(b1, q, p1, 0, 0, 0); }
}
template <int KB>
__device__ __forceinline__ void qkt_r(f32x16& p0, f32x16& p1, const LAS char* K_lds, int r32, int hi, const bf16x8* qr) {
    const LAS char* kb[4];
#pragma unroll
    for (int dd = 0; dd < 4; ++dd) kb[dd] = K_lds + KB * SHM_K + KSWZ(r32, (dd * 16 + hi * 8) * 2);
#pragma unroll
    for (int d0 = 0; d0 < 8; ++d0) { const LAS char* a = kb[d0 & 3] + (d0 >> 2) * 128;
        bf16x8 b0 = *reinterpret_cast<const LAS bf16x8*>(a);
        bf16x8 b1 = *reinterpret_cast<const LAS bf16x8*>(a + 32 * 256);
        p0 = __builtin_amdgcn_mfma_f32_32x32x16_bf16(b0, qr[d0], p0, 0, 0, 0);
        p1 = __builtin_amdgcn_mfma_f32_32x32x16_bf16(b1, qr[d0], p1, 0, 0, 0); }
}
template <int VB>
__device__ __forceinline__ void pv_tile(f32x16* o, int vb0, bf16x8 pa0, bf16x8 pa1, bf16x8 pa2, bf16x8 pa3) {
#define TRRD(dst, off) asm volatile("ds_read_b64_tr_b16 %0, %1 offset:%2" : "=&v"(dst) : "v"(vb0), "i"(off) : "memory")
#define PV_D0(d0) do { s16x4 l0, l1, l2, l3, h0, h1, h2, h3; constexpr int b_ = VB * SHM_V + v_rd_off(d0, 0, 0); \
        TRRD(l0, b_); TRRD(h0, b_ + 2048); TRRD(l1, b_ + 4096); TRRD(h1, b_ + 6144); TRRD(l2, b_ + 8192); TRRD(h2, b_ + 10240); TRRD(l3, b_ + 12288); TRRD(h3, b_ + 14336); \
        asm volatile("s_waitcnt lgkmcnt(0)" ::: "memory"); SBAR(); \
        o[d0] = __builtin_amdgcn_mfma_f32_32x32x16_bf16(pa0, (bf16x8){l0[0], l0[1], l0[2], l0[3], h0[0], h0[1], h0[2], h0[3]}, o[d0], 0, 0, 0);   \
        o[d0] = __builtin_amdgcn_mfma_f32_32x32x16_bf16(pa1, (bf16x8){l1[0], l1[1], l1[2], l1[3], h1[0], h1[1], h1[2], h1[3]}, o[d0], 0, 0, 0);   \
        o[d0] = __builtin_amdgcn_mfma_f32_32x32x16_bf16(pa2, (bf16x8){l2[0], l2[1], l2[2], l2[3], h2[0], h2[1], h2[2], h2[3]}, o[d0], 0, 0, 0);   \
        o[d0] = __builtin_amdgcn_mfma_f32_32x32x16_bf16(pa3, (bf16x8){l3[0], l3[1], l3[2], l3[3], h3[0], h3[1], h3[2], h3[3]}, o[d0], 0, 0, 0); } while (0)
    PV_D0(0); PV_D0(1); PV_D0(2); PV_D0(3);
#undef PV_D0
#undef TRRD
}

struct Blk {
    const bf16_t* Q;
    const bf16_t* K; const bf16_t* V;
    const float* KB;
    int mode, P0, j_lo, j_hi, b, hb;
};
struct Seam { bf16x8 st_v0, st_v1, st_k0, st_k1; };
__device__ __forceinline__ int q_lane_off(int mode, int wid, int r32) { return mode == M_FOX ? (wid * 32 + r32) * 128 : ((r32 >> 3) * T + wid * 8 + (r32 & 7)) * 128; }
#define ROW(p, k0, rr) ((p) + (size_t)((k0) + (rr)) * D + sc)
#define VMW() asm volatile("s_waitcnt vmcnt(0)" ::: "memory")
#define VMWN(n) asm volatile("s_waitcnt vmcnt(%0)" :: "i"(n) : "memory")
#define SLOAD_H(Kp, Vp, k0) do { S.st_v0 = load8(ROW(Vp, k0, sr)); S.st_v1 = load8(ROW(Vp, k0, 32 + sr)); S.st_k0 = load8(ROW(Kp, k0, sr)); S.st_k1 = load8(ROW(Kp, k0, 32 + sr)); } while (0)
#define SWRITE_HK(bf) do { *(LAS bf16x8*)(K_lds + (bf) * SHM_K + kws) = S.st_k0; *(LAS bf16x8*)(K_lds + (bf) * SHM_K + kws + 32 * 256) = S.st_k1; } while (0)
#define SWRITE_HV(bf) do { *(LAS bf16x8*)(V_lds + (bf) * SHM_V + vst0) = S.st_v0; *(LAS bf16x8*)(V_lds + (bf) * SHM_V + vst1) = S.st_v1; } while (0)
#define SWRITE_H(bf) do { SWRITE_HV(bf); SWRITE_HK(bf); } while (0)
__device__ __forceinline__ void attn_prime(const Blk& cur, LAS char* lds, Seam& S) {
    const int tid = threadIdx.x;
    const int sr = tid >> 4, sc = (tid & 15) * 8, kws = KSWZ(sr, sc * 2); LAS char* K_lds = lds + L_K;
    const int kb0 = cur.j_lo * KVBLK;
    SLOAD_H(cur.K, cur.V, kb0); VMW(); SWRITE_HK(0);
    __syncthreads();
}
struct EpiCtx { bf16_t* AO; float* NSAO; const float* GATES; unsigned* panel_cnt; };
__device__ __forceinline__ void attn_block(const Blk& cur, const Blk& nxt, LAS char* lds, Seam& S, const EpiCtx& ec) {
    int tid = threadIdx.x; asm volatile("" : "+v"(tid));
    const int wid = __builtin_amdgcn_readfirstlane(tid >> 6), lane = tid & 63, r32 = lane & 31, hi = lane >> 5;
    const int mode = cur.mode;
    const int j_lo = cur.j_lo, NT = cur.j_hi - cur.j_lo;
    const int kbn = nxt.j_lo * KVBLK;
    const bool fox = mode == M_FOX;
    const int wlo = cur.P0 + (fox ? wid * 32 : wid * 8), whi = wlo + (fox ? 31 : 7);
    const int pos = cur.P0 + (fox ? wid * 32 + r32 : wid * 8 + (r32 & 7)), qm = pos - 4 * hi;
    const unsigned Wu = (mode == M_WIN) ? 512u : (1u << 30);
    LAS char* V_lds = lds + L_V; LAS char* K_lds = lds + L_K;
    LAS float* ws = (LAS float*)(lds + L_WS) + wid * 64; LAS float* li_l = ws; LAS float* al_l = ws + 32;
    float m_reg = -1e30f, l_reg = 0; f32x16 o[4] = {};
    const int sr = tid >> 4, sc = (tid & 15) * 8, vst0 = v_st(sr, sc), vst1 = v_st(32 + sr, sc), kws = KSWZ(sr, sc * 2);
    const int vb0 = (int)(unsigned)(uintptr_t)V_lds + v_rd_base(lane);
    const bf16_t* Kh = cur.K; const bf16_t* Vh = cur.V;
    unsigned long long sel = ~0ull;
    if (mode == M_SLC) sel = *(const LAS unsigned long long*)(lds + L_SEL + (wid * 8 + (r32 & 7)) * 8);
#define RESC(a_) do { if (__any((a_) < 1.f)) { if (hi == 0) al_l[r32] = (a_); asm volatile("s_waitcnt lgkmcnt(0)" ::: "memory");              \
                     _Pragma("unroll") for (int d_ = 0; d_ < 4; ++d_) _Pragma("unroll") for (int r = 0; r < 16; ++r) o[d_][r] *= al_l[crow(r, hi)]; } } while (0)
#define KBASE(t) ((j_lo + (t)) * KVBLK)
#define PRELOAD(P0_, P1_, t) do { if (fox) { const LAS float* kbp_ = (const LAS float*)(lds + L_KB) + KBASE(t) + 4 * hi; \
            _Pragma("unroll") for (int q_ = 0; q_ < 4; ++q_) { const f32x4 a_ = *(const LAS f32x4*)(kbp_ + 8 * q_), b_ = *(const LAS f32x4*)(kbp_ + 32 + 8 * q_); \
                P0_[4*q_] = a_[0]; P0_[4*q_+1] = a_[1]; P0_[4*q_+2] = a_[2]; P0_[4*q_+3] = a_[3]; P1_[4*q_] = b_[0]; P1_[4*q_+1] = b_[1]; P1_[4*q_+2] = b_[2]; P1_[4*q_+3] = b_[3]; } } \
        else { P0_ = f32x16{}; P1_ = f32x16{}; } } while (0)
#define MASKT(P0_, P1_, t) do { const int kb_ = KBASE(t); \
        if (kb_ + KVBLK - 1 > wlo || kb_ + (int)Wu <= whi) mask_tile(P0_, P1_, qm - kb_, Wu); } while (0)
#define ONT(t) (mode != M_SLC || ((sel >> (j_lo + (t))) & 1ull) != 0ull)
    if (wid >= 4) __builtin_amdgcn_s_setprio(1);
    f32x16 pA0, pA1, pB0, pB1; float mnA, mnB, alA, alB; bf16x8 pa0, pa1, pa2, pa3;
    LAS char* qs = lds + L_Q + wid * 8192 + lane * 16;
    { const bf16_t* qp = cur.Q + q_lane_off(mode, wid, r32) + hi * 8; bf16x8 tq[8];
#pragma unroll
      for (int d0 = 0; d0 < 8; ++d0) tq[d0] = load8(qp + d0 * 16);
#pragma unroll
      for (int d0 = 0; d0 < 8; ++d0) *(LAS bf16x8*)(qs + d0 * 1024) = tq[d0]; }
    PRELOAD(pA0, pA1, 0);
    SWRITE_HV(0); SBAR();
    if (NT > 1) SLOAD_H(Kh, Vh, KBASE(1));
    SBAR(); qkt<0>(pA0, pA1, K_lds, r32, hi, qs);
    if (NT > 1) PRELOAD(pB0, pB1, 1); else { pB0 = f32x16{}; pB1 = f32x16{}; }
    MASKT(pA0, pA1, 0); partialSM(pA0, pA1, m_reg, mnA, alA);
    if (NT > 1) { VMW(); SWRITE_H(1); }
    __syncthreads();
#define HALF_STEP(PX0, PX1, mnX, alX, PY0, PY1, alY, t, KB_, VB_, SB_) do {                                                      \
        SBAR(); if ((t) + 1 < NT) { SLOAD_H(Kh, Vh, KBASE((t) + 1)); SBAR(); }         \
        qkt<KB_>(PX0, PX1, K_lds, r32, hi, qs);                                             \
        finishSM(PY0, PY1, alY, l_reg, pa0, pa1, pa2, pa3, ONT((t) - 1)); SBAR();                                                           \
        if ((t) + 1 < NT) { PRELOAD(PY0, PY1, (t) + 1); SBAR(); }                                               \
        pv_tile<VB_>(o, vb0, pa0, pa1, pa2, pa3); MASKT(PX0, PX1, (t)); partialSM(PX0, PX1, m_reg, mnX, alX);                                        \
        __syncthreads();                                                                                                      \
        if ((t) + 1 < NT) { VMW(); SWRITE_H(SB_); }                                                                          \
        RESC(alX); __syncthreads(); } while (0)
    for (int t = 1; t + 1 < NT; t += 2) {
        HALF_STEP(pB0, pB1, mnB, alB, pA0, pA1, alA, t, 1, 0, 0);
        HALF_STEP(pA0, pA1, mnA, alA, pB0, pB1, alB, t + 1, 0, 1, 1);
    }
    const bool even = (NT & 1) == 0;
    if (even) { SBAR(); qkt<1>(pB0, pB1, K_lds, r32, hi, qs); SBAR(); }
    SLOAD_H(nxt.K, nxt.V, kbn); SBAR();
    SBAR();
    finishSM(pA0, pA1, alA, l_reg, pa0, pa1, pa2, pa3, ONT(even ? NT - 2 : NT - 1)); SBAR();
    pv_tile<0>(o, vb0, pa0, pa1, pa2, pa3);
    if (even) { MASKT(pB0, pB1, NT - 1); partialSM(pB0, pB1, m_reg, mnB, alB); __syncthreads(); RESC(alB);
        finishSM(pB0, pB1, alB, l_reg, pa0, pa1, pa2, pa3, ONT(NT - 1)); SBAR(); pv_tile<1>(o, vb0, pa0, pa1, pa2, pa3); }
    SBAR(); VMW(); SWRITE_HK(0); SBAR();
    if (hi == 0) li_l[r32] = l_reg; asm volatile("s_waitcnt lgkmcnt(0)" ::: "memory");
    if (fox) {
        bf16_t* Ow = ec.AO + ((size_t)cur.b * T + cur.P0 + wid * QBLK) * DM + cur.hb * 128;
#pragma unroll
        for (int r = 0; r < 16; ++r) { const int orow = crow(r, hi); const float li = li_l[orow]; const float rl = li > 0.f ? __builtin_amdgcn_rcpf(li) : 0.f;
#pragma unroll
            for (int d0 = 0; d0 < 4; ++d0) { const float v = o[d0][r] * rl; const float vn = __shfl_xor(v, 1);
                if ((r32 & 1) == 0) *(GAS unsigned*)(Ow + (size_t)orow * DM + d0 * 32 + r32) = cvt_pk_bf16(v, vn); } }
    } else {
        const int br = (mode == M_WIN) ? 2 : 1;
#pragma unroll
        for (int h8 = 0; h8 < 2; ++h8) {
            float gv[8]; float av[8][4], bv[8][4];
#pragma unroll
            for (int q = 0; q < 8; ++q) { const int rho = crow(h8 * 8 + q, hi);
                const int tok = cur.P0 + wid * 8 + (rho & 7), head = cur.hb + (rho >> 3); const size_t trow = (size_t)cur.b * T + tok;
                gv[q] = ((const GAS float*)ec.GATES)[trow * 24 + head * 3 + br];
                if (mode == M_SLC) { const GAS float* np = (const GAS float*)(ec.NSAO + trow * 1024 + head * 128 + r32); const GAS float* np2 = np + (ptrdiff_t)((WS_PART - WS_NSAO) / 4);
#pragma unroll
                    for (int d0 = 0; d0 < 4; ++d0) { av[q][d0] = np[d0 * 32]; bv[q][d0] = np2[d0 * 32]; } }
                else {
#pragma unroll
                    for (int d0 = 0; d0 < 4; ++d0) { av[q][d0] = 0.f; bv[q][d0] = 0.f; } } }
#pragma unroll
            for (int q = 0; q < 8; ++q) { const int r = h8 * 8 + q; const int rho = crow(r, hi); const float li = li_l[rho]; const float rl = li > 0.f ? __builtin_amdgcn_rcpf(li) : 0.f;
                const int tok = cur.P0 + wid * 8 + (rho & 7), head = cur.hb + (rho >> 3); const size_t trow = (size_t)cur.b * T + tok;
                const float gt = gv[q] * rl;
                GAS float* np2 = (GAS float*)(ec.NSAO + trow * 1024 + head * 128 + r32 + (ptrdiff_t)((WS_PART - WS_NSAO) / 4));
#pragma unroll
                for (int d0 = 0; d0 < 4; ++d0) {
                    if (mode == M_WIN) np2[d0 * 32] = gt * o[d0][r];
                    else { const float v = av[q][d0] + bv[q][d0] + gt * o[d0][r]; const float vn = __shfl_xor(v, 1); if ((r32 & 1) == 0) *(GAS unsigned*)(ec.AO + trow * DM + 1024 + head * 128 + d0 * 32 + r32) = cvt_pk_bf16(v, vn); } } }
            asm volatile("" ::: "memory"); }
    }
    __builtin_amdgcn_s_setprio(0);
    __syncthreads();
#undef RESC
#undef KBASE
#undef PRELOAD
#undef MASKT
#undef ONT
#undef HALF_STEP
}
#undef ROW
#undef SLOAD_H
#undef SWRITE_HK
#undef SWRITE_HV
#undef SWRITE_H

__device__ __forceinline__ bf16x8 ovfrag(int n0, int J) {
    asm volatile("" : "+v"(n0));
    unsigned w[4];
#pragma unroll
    for (int q = 0; q < 4; ++q) { unsigned lohi[2];
#pragma unroll
        for (int e = 0; e < 2; ++e) { const int dl = n0 + 2 * q + e - 4 * J; lohi[e] = (dl >= 0 && dl <= 2) ? 0x3F80u : ((dl == 3 || dl == -1) ? 0x3F00u : 0u); }
        w[q] = lohi[0] | (lohi[1] << 16); }
    u32x4 v = {w[0], w[1], w[2], w[3]}; return *reinterpret_cast<bf16x8*>(&v);
}
__device__ __forceinline__ void nsa_cmp_item(int b, int g, int qb, const bf16_t* NQ, const bf16_t* KCMP, const bf16_t* VCMP, const float* GATES, const float* mbound, float* NSAO, LAS char* lds) {
    int tid = threadIdx.x; asm volatile("" : "+v"(tid));
    const int wid = __builtin_amdgcn_readfirstlane(tid >> 6), lane = tid & 63, r32 = lane & 31, hi = lane >> 5;
    LAS char* V_lds = lds + LC_V; LAS char* K_lds = lds + LC_K;
    LAS float* ws = (LAS float*)(lds + LC_WS) + wid * 64; LAS float* li_l = ws;
    LAS float* impL = (LAS float*)(lds + LC_IMP);
    const int sr = tid >> 4, sc = (tid & 15) * 8, vst0 = v_st(sr, sc), vst1 = v_st(32 + sr, sc), kws = KSWZ(sr, sc * 2);
    const bf16_t* Kc = KCMP + (size_t)(b * 2 + g) * 256 * 128; const bf16_t* Vc = VCMP + (size_t)(b * 2 + g) * 256 * 128;
    const int ntile = ((4 * qb + 2) >> 6) + 1;
    bf16x8 qr[8];
    { const bf16_t* qp = NQ + (((size_t)b * 8 + g * 4) * T + qb * 64) * 128 + q_lane_off(M_WIN, wid, r32) + hi * 8;
#pragma unroll
      for (int d0 = 0; d0 < 8; ++d0) qr[d0] = load8(qp + d0 * 16); }
    {
        bf16x8 kk[4][2], vv[4][2];
#pragma unroll
        for (int tl = 0; tl < 4; ++tl) { kk[tl][0] = load8(Kc + (size_t)(tl * 64 + sr) * 128 + sc); kk[tl][1] = load8(Kc + (size_t)(tl * 64 + 32 + sr) * 128 + sc); }
#pragma unroll
        for (int tl = 0; tl < 4; ++tl) { vv[tl][0] = load8(Vc + (size_t)(tl * 64 + sr) * 128 + sc); vv[tl][1] = load8(Vc + (size_t)(tl * 64 + 32 + sr) * 128 + sc); }
#pragma unroll
        for (int tl = 0; tl < 4; ++tl) { *(LAS bf16x8*)(K_lds + tl * SHM_K + kws) = kk[tl][0]; *(LAS bf16x8*)(K_lds + tl * SHM_K + kws + 32 * 256) = kk[tl][1]; }
#pragma unroll
        for (int tl = 0; tl < 4; ++tl) { *(LAS bf16x8*)(V_lds + tl * SHM_V + vst0) = vv[tl][0]; *(LAS bf16x8*)(V_lds + tl * SHM_V + vst1) = vv[tl][1]; }
        asm volatile("" ::: "memory");
    }
    __syncthreads();
    const int pos = qb * 64 + wid * 8 + (r32 & 7);
    const int nmax = (pos - 31) >> 4;
    const float NEG = -__builtin_inff();
#define CMASK(P0_, P1_, tl) do { _Pragma("unroll") for (int r = 0; r < 16; ++r) { const int n_ = (tl) * 64 + crow(r, hi); if (n_ > nmax) P0_[r] = NEG; if (n_ + 32 > nmax) P1_[r] = NEG; } } while (0)
    const float mL = -(*(const GAS float*)mbound) * C2;
    float l_reg = 0.f;
    const int vb0 = (int)(unsigned)(uintptr_t)V_lds + v_rd_base(lane);
    f32x16 o[4] = {}; f32x16 io[2] = {};
#pragma nounroll
    for (int tl = 0; tl < ntile; ++tl) { f32x16 p0 = f32x16{}, p1 = f32x16{}; qkt_r<0>(p0, p1, K_lds + tl * SHM_K, r32, hi, qr); CMASK(p0, p1, tl);
        float ps = 0.f;
#pragma unroll
        for (int r = 0; r < 16; ++r) { p0[r] = __builtin_amdgcn_exp2f(fmaf(p0[r], C2, mL)); p1[r] = __builtin_amdgcn_exp2f(fmaf(p1[r], C2, mL)); ps += p0[r] + p1[r]; }
        l_reg += ps; bf16x8 pa0, pa1, pa2, pa3; PK4(p0, 0, pa0); PK4(p0, 8, pa1); PK4(p1, 0, pa2); PK4(p1, 8, pa3);
        pv_tile<0>(o, vb0 + tl * SHM_V, pa0, pa1, pa2, pa3); SBAR();
#pragma unroll
        for (int d0 = 0; d0 < 2; ++d0) { const int J = d0 * 32 + r32;
            io[d0] = __builtin_amdgcn_mfma_f32_32x32x16_bf16(pa0, ovfrag(tl * 64 + 0 + 8 * hi, J), io[d0], 0, 0, 0);
            io[d0] = __builtin_amdgcn_mfma_f32_32x32x16_bf16(pa1, ovfrag(tl * 64 + 16 + 8 * hi, J), io[d0], 0, 0, 0);
            io[d0] = __builtin_amdgcn_mfma_f32_32x32x16_bf16(pa2, ovfrag(tl * 64 + 32 + 8 * hi, J), io[d0], 0, 0, 0);
            io[d0] = __builtin_amdgcn_mfma_f32_32x32x16_bf16(pa3, ovfrag(tl * 64 + 48 + 8 * hi, J), io[d0], 0, 0, 0); } SBAR(); }
    { auto rr = __builtin_amdgcn_permlane32_swap(__float_as_uint(l_reg), __float_as_uint(l_reg), false, false); l_reg = __uint_as_float(rr[0]) + __uint_as_float(rr[1]); }
    if (hi == 0) li_l[r32] = l_reg; asm volatile("s_waitcnt lgkmcnt(0)" ::: "memory");
    {
        float gv[16];
#pragma unroll
        for (int r = 0; r < 16; ++r) { const int rho = crow(r, hi); gv[r] = ((const GAS float*)GATES)[((size_t)b * T + qb * 64 + wid * 8 + (rho & 7)) * 24 + (g * 4 + (rho >> 3)) * 3 + 0]; }
        float imps[2][4] = {};
#pragma unroll
        for (int r = 0; r < 16; ++r) { const int rho = crow(r, hi); const float li = li_l[rho]; const float rl = li > 0.f ? __builtin_amdgcn_rcpf(li) : 0.f;
            const int tok = qb * 64 + wid * 8 + (rho & 7), head = g * 4 + (rho >> 3);
            const size_t trow = (size_t)b * T + tok;
            const float gt = gv[r] * rl;
            GAS float* np = (GAS float*)(NSAO + trow * 1024 + head * 128 + r32);
#pragma unroll
            for (int d0 = 0; d0 < 4; ++d0) np[d0 * 32] = gt * o[d0][r];
            imps[0][r & 3] += io[0][r] * rl; imps[1][r & 3] += io[1][r] * rl; }
#pragma unroll
        for (int d0 = 0; d0 < 2; ++d0)
#pragma unroll
            for (int e = 0; e < 4; ++e) impL[(wid * 8 + e + 4 * hi) * 64 + d0 * 32 + r32] = imps[d0][e];
    }
#undef CMASK
    __syncthreads();
#pragma nounroll
    for (int tk = 0; tk < 8; ++tk) { const int tl = wid * 8 + tk; const int J = lane;
        const float im = impL[tl * 64 + J];
        const bool forced = (J == 0) || (J == qb) || (J == qb - 1);
        const float v = forced ? __builtin_inff() : (J <= qb ? im : NEG);
        impL[tl * 64 + J] = v; asm volatile("s_waitcnt lgkmcnt(0)" ::: "memory");
        f32x4 uv[16];
#pragma unroll
        for (int q = 0; q < 16; ++q) uv[q] = *(const LAS f32x4*)(impL + tl * 64 + 4 * q);
        int rank = 0;
#pragma unroll
        for (int q = 0; q < 16; ++q)
#pragma unroll
            for (int e = 0; e < 4; ++e) { const float u = uv[q][e]; const int jj = 4 * q + e; rank += (u > v || (u == v && jj < J)) ? 1 : 0; }
        const unsigned long long mk = __ballot(rank < 16 && J <= qb);
        if (lane == 0) *(LAS unsigned long long*)(lds + L_SEL + tl * 8) = mk; }
    __syncthreads();
}
#undef PK4
#undef VMW
#undef VMWN

template <class P> __device__ __forceinline__ P* uptr(P* p) { const unsigned long long v = (unsigned long long)p;
    const unsigned lo = __builtin_amdgcn_readfirstlane((unsigned)v), hi = __builtin_amdgcn_readfirstlane((unsigned)(v >> 32)); return (P*)(((unsigned long long)hi << 32) | lo); }
__device__ __forceinline__ Blk make_blk(unsigned char* ws, int i, int st) {
    const int bg = i >> 6, qb = i & 63, b = bg >> 1, g = bg & 1; Blk k;
    if (st < 2) {
        k.Q = uptr((const bf16_t*)(ws + WS_NQR) + (((size_t)b * 8 + g * 4) * T + qb * 64) * 128);
        k.K = uptr((const bf16_t*)(ws + (st == 0 ? WS_KW : WS_KSL)) + (size_t)bg * T * 128); k.V = uptr((const bf16_t*)(ws + (st == 0 ? WS_VW : WS_VSL)) + (size_t)bg * T * 128);
        k.KB = nullptr; k.mode = st == 0 ? M_WIN : M_SLC; k.P0 = qb * 64; k.j_lo = (st == 0 && qb >= 8) ? qb - 8 : 0; k.j_hi = qb + 1; k.b = b; k.hb = g * 4;
    } else {
        const int bh = bg * 4 + (qb & 3), qf = 15 - (qb >> 2);
        k.Q = uptr((const bf16_t*)(ws + WS_FQ) + ((size_t)bh * T + qf * 256) * 128); k.K = uptr((const bf16_t*)(ws + WS_FK) + (size_t)bh * T * 128); k.V = uptr((const bf16_t*)(ws + WS_FV) + (size_t)bh * T * 128);
        k.KB = uptr((const float*)(ws + WS_KBIAS) + (size_t)bh * T); k.mode = M_FOX; k.P0 = qf * 256; k.j_lo = 0; k.j_hi = 4 * qf + 4; k.b = bh >> 3; k.hb = bh & 7;
    }
    k.mode = __builtin_amdgcn_readfirstlane(k.mode); k.P0 = __builtin_amdgcn_readfirstlane(k.P0); k.j_lo = __builtin_amdgcn_readfirstlane(k.j_lo); k.j_hi = __builtin_amdgcn_readfirstlane(k.j_hi);
    k.b = __builtin_amdgcn_readfirstlane(k.b); k.hb = __builtin_amdgcn_readfirstlane(k.hb);
    return k;
}
__device__ __forceinline__ void compute_kb(unsigned char* ws, int bh, LAS char* lds) {
    int tid = threadIdx.x; asm volatile("" : "+v"(tid));
    LAS double* part = (LAS double*)(lds + LC_IMP);
    const float* lf = (const float*)(ws + WS_LOGF) + (size_t)bh * T + tid * 8; float* kb = (float*)(ws + WS_KBIAS) + (size_t)bh * T + tid * 8;
    const f32x4 v0 = *(const f32x4*)lf, v1 = *(const f32x4*)(lf + 4);
    double loc[8]; double run = 0.0;
    { const float vv[8] = {v0[0], v0[1], v0[2], v0[3], v1[0], v1[1], v1[2], v1[3]};
#pragma unroll
      for (int i = 0; i < 8; ++i) { run += (double)vv[i]; loc[i] = run; } }
    const int lane = tid & 63, wv = tid >> 6; double inc = run;
#pragma unroll
    for (int o = 1; o < 64; o <<= 1) { const double up = __shfl_up(inc, o); if (lane >= o) inc += up; }
    if (lane == 63) part[wv] = inc;
    __syncthreads();
    double off = inc - run;
    for (int w = 0; w < wv; ++w) off += part[w];
    f32x4 o0, o1;
#pragma unroll
    for (int i = 0; i < 4; ++i) { o0[i] = (float)(-(off + loc[i]) * (double)(1.0f / SCALE)); o1[i] = (float)(-(off + loc[4 + i]) * (double)(1.0f / SCALE)); }
    *(f32x4*)kb = o0; *(f32x4*)(kb + 4) = o1;
    asm volatile("s_waitcnt vmcnt(0)" ::: "memory");
    __syncthreads();
}
__device__ __forceinline__ void stage_kb(const float* kbg, LAS char* lds) {
    int tid = threadIdx.x; asm volatile("" : "+v"(tid));
    const f32x4 v0 = *(const GAS f32x4*)(kbg + tid * 8), v1 = *(const GAS f32x4*)(kbg + tid * 8 + 4);
    LAS float* kl = (LAS float*)(lds + L_KB) + tid * 8;
    *(LAS f32x4*)kl = v0; *(LAS f32x4*)(kl + 4) = v1;
    __syncthreads();
}
__device__ __forceinline__ void attn_phase(const Args& a, LAS char* lds, int vcu, int G) {
    unsigned char* ws = a.ws;
    EpiCtx ec{(bf16_t*)(ws + WS_AO), (float*)(ws + WS_NSAO), (const float*)(ws + WS_GATES), (unsigned*)(ws + CTL_CNT_ATTN)};
    Seam S;
    constexpr int ST0 = (DEV_ATT == 1) ? 2 : 0, ST1 = (DEV_ATT == 2) ? 2 : 3;
    for (int i = vcu; i < 256; i += G) {
#ifndef NO_CMP
        if (DEV_ATT & 2) { const int bg = i >> 6, qb = i & 63; nsa_cmp_item(bg >> 1, bg & 1, qb, (const bf16_t*)(ws + WS_NQ), (const bf16_t*)(ws + WS_KCMP), (const bf16_t*)(ws + WS_VCMP), ec.GATES, (const float*)(ws + WS_MBOUND), ec.NSAO, lds); }
#endif
#ifndef NO_BLK
        Blk cur = make_blk(ws, i, ST0);
        attn_prime(cur, lds, S);
        for (int st = ST0; st < ST1; ++st) { const Blk nxt = make_blk(ws, i, st + 1 < ST1 ? st + 1 : st);
            if (st == 2) stage_kb(cur.KB, lds);
            attn_block(cur, nxt, lds, S, ec); cur = nxt; }
#endif
    }
}
#undef KSWZ
#undef SBAR
}


__device__ __forceinline__ int win_src_col(int pg) {
    const int pn = pg >> 8, p = pg & 255;
    if (pn == 12) { if (p < 8) return C_FZ + p; if (p < 32) return C_GZ + p - 8; return -1; }
    const int bj = p >> 7, q = p & 127;
    const int d = 16 * (q >> 5) + 4 * ((q >> 3) & 3) + (q & 3) + 64 * ((q >> 2) & 1);
    int base;
    if (pn < 4) base = C_FQ + pn * 256; else if (pn < 8) base = C_FK + (pn - 4) * 256; else if (pn < 12) base = C_FV + (pn - 8) * 256;
    else if (pn < 17) base = C_NQ + (pn - 13) * 256; else if (pn == 17) base = C_KC; else if (pn == 18) base = C_VC; else if (pn == 19) base = C_KSL;
    else if (pn == 20) base = C_KW; else if (pn == 21) base = C_VSL; else base = C_VW;
    return base + bj * 128 + d;
}
template <int SRC>
__device__ __forceinline__ void transpose_item(const float* W, int K, int N, bf16_t* WT, LAS float* scr, int item, int nblk, int lane) {
    const int kb = item / nblk, nb = item % nblk, k0 = 64 * kb, n0 = 32 * nb;
    int sc = n0 + (lane & 31); if (SRC == 1) sc = win_src_col(sc);
    float tv[32];
    const float* wp = W + (size_t)(k0 + (lane >> 5)) * N + (sc >= 0 ? sc : 0);
#pragma unroll
    for (int i = 0; i < 32; ++i) tv[i] = wp[(size_t)(2 * i) * N];
#pragma unroll
    for (int i = 0; i < 32; ++i) { const int kk = 2 * i + (lane >> 5); scr[kk * 33 + (lane & 31)] = sc >= 0 ? tv[i] : 0.f; }
    asm volatile("s_waitcnt lgkmcnt(0)" ::: "memory");
    const int cch = lane & 7;
#pragma unroll
    for (int j = 0; j < 4; ++j) { const int n = (lane >> 3) + 8 * j; const LAS float* s = scr + (8 * cch) * 33 + n;
        u32x4 o; o.x = cvt_pk_bf16(s[0 * 33], s[1 * 33]); o.y = cvt_pk_bf16(s[2 * 33], s[3 * 33]); o.z = cvt_pk_bf16(s[4 * 33], s[5 * 33]); o.w = cvt_pk_bf16(s[6 * 33], s[7 * 33]);
        *(u32x4*)(WT + (size_t)(n0 + n) * K + k0 + 8 * cch) = o; }
    asm volatile("s_waitcnt lgkmcnt(0)" ::: "memory");
}

__device__ __forceinline__ void p0_prologue(const Args& a, LAS unsigned char* lds, int vcu, int G) {
    int tid = threadIdx.x; asm volatile("" : "+v"(tid)); const int lane = tid & 63, wave = __builtin_amdgcn_readfirstlane(tid >> 6);
    LAS float* ca = (LAS float*)lds;
    for (int i = tid; i < 2 * DM; i += NTHR) { const float v = a.c[i]; ca[i] = v / (1.f + __expf(-v)); }
    __syncthreads();
    const int gw = vcu * NWAVES + wave, NGW = G * NWAVES;
    float* modp = (float*)(a.ws + WS_MODP);
    if (wave < 3) { const int it = vcu * 3 + wave;
        if (it < 16 * 48) { const int kc = it / 48, cq = (it % 48) * 64 + lane;
            f32x4 a0 = (f32x4){0.f, 0.f, 0.f, 0.f}, a1 = a0;
            const float* wp = a.w_ada + (size_t)(kc * 128) * (6 * DM) + 4 * cq;
#pragma unroll 16
            for (int k = 0; k < 128; ++k) { const f32x4 w = *(const f32x4*)(wp + (size_t)k * (6 * DM)); a0 += w * ca[kc * 128 + k]; a1 += w * ca[DM + kc * 128 + k]; }
            const __amdgpu_buffer_rsrc_t rsrc = __builtin_amdgcn_make_buffer_rsrc(modp, 0, 16 * 2 * 6 * DM * 4, 0x00020000);
            __builtin_amdgcn_raw_buffer_store_b128(__builtin_bit_cast(u32x4, a0), rsrc, (unsigned)((((size_t)kc * 2 + 0) * (6 * DM) + 4 * cq) * 4), 0, 16);
            __builtin_amdgcn_raw_buffer_store_b128(__builtin_bit_cast(u32x4, a1), rsrc, (unsigned)((((size_t)kc * 2 + 1) * (6 * DM) + 4 * cq) * 4), 0, 16);
            handoff_signal((unsigned*)(a.ws + CTL_CNT_ADALN), lane); } }
    LAS float* scr = (LAS float*)(lds + 16384 + wave * 16384);
    constexpr int I_IN = 32 * (NPAD / 32), I_OUT = 32 * 64, I_UP = 32 * 256, I_DN = 128 * 64, I_W1 = 64 * 8, I_W2 = 4 * 4;
    constexpr int NIT = I_IN + I_OUT + I_UP + I_DN + 2 * I_W1 + 2 * I_W2;
    const int nslot = (NIT + G - 1) / G;
    for (int m = 0;; ++m) { int j; if (wave < 3) { if (m >= 6) break; j = wave * 6 + m; } else { j = 18 + (wave - 3) + 5 * m; }
        if (j >= nslot) break; const int it = vcu + G * j; if (it >= NIT) break; int r = it;
        if (r < I_IN) { transpose_item<1>(a.w_in, DM, DIN, (bf16_t*)(a.ws + WS_WIN), scr, r, NPAD / 32, lane); continue; } r -= I_IN;
        if (r < I_OUT) { transpose_item<0>(a.w_out, DM, DM, (bf16_t*)(a.ws + WS_WOUT), scr, r, 64, lane); continue; } r -= I_OUT;
        if (r < I_UP) { transpose_item<0>(a.w_up, DM, DFF, (bf16_t*)(a.ws + WS_WUP), scr, r, 256, lane); continue; } r -= I_UP;
        if (r < I_DN) { transpose_item<0>(a.w_down, DFF, DM, (bf16_t*)(a.ws + WS_WDN), scr, r, 64, lane); continue; } r -= I_DN;
        if (r < I_W1) { transpose_item<0>(a.cmp_w1_k, 4096, 256, (bf16_t*)(a.ws + WS_W1T), scr, r, 8, lane); continue; } r -= I_W1;
        if (r < I_W1) { transpose_item<0>(a.cmp_w1_v, 4096, 256, (bf16_t*)(a.ws + WS_W1T) + 256 * 4096, scr, r, 8, lane); continue; } r -= I_W1;
        if (r < I_W2) { transpose_item<0>(a.cmp_w2_k, 256, 128, (bf16_t*)(a.ws + WS_W2T), scr, r, 4, lane); continue; } r -= I_W2;
        transpose_item<0>(a.cmp_w2_v, 256, 128, (bf16_t*)(a.ws + WS_W2T) + 128 * 256, scr, r, 4, lane);
    }
    if (vcu == 255 && wave == 7) { const float gk = fmaxf(fabsf(a.cmp_k_norm[lane]), fabsf(a.cmp_k_norm[64 + lane])), gq = fmaxf(fabsf(a.nsa_q_norm[lane]), fabsf(a.nsa_q_norm[64 + lane]));
        const float mb = wave_max(gk) * wave_max(gq) * (128.f * 1.02f); if (lane == 0) *(float*)(a.ws + WS_MBOUND) = mb; }
    float* rope = (float*)(a.ws + WS_ROPE);
    for (int e = (vcu * NTHR + tid); e < T * 64; e += G * NTHR) { const int t = e >> 6, i = e & 63;
        const float inv_freq = (float)pow(10000.0, -(double)i / 64.0); const float ang = (float)t * inv_freq;
        rope[2 * e] = (float)cos((double)ang); rope[2 * e + 1] = (float)sin((double)ang); }
    float* pebp = (float*)(a.ws + WS_PEBP);
    for (int it = gw; it < 2 * 4 * 64; it += NGW) { const int kv = it >> 8, cg_ = (it >> 6) & 3, ch = it & 63, col = cg_ * 64 + lane;
        const float* pe = kv ? a.cmp_pe_v : a.cmp_pe_k; const float* w1 = kv ? a.cmp_w1_v : a.cmp_w1_k; float s = 0.f;
#pragma unroll
        for (int i = 0; i < 64; ++i) s += pe[ch * 64 + i] * w1[(size_t)(ch * 64 + i) * 256 + col];
        pebp[((size_t)kv * 64 + ch) * 256 + col] = s; }
}

template <bool FIRST>
__device__ __forceinline__ void norm_phase(const Args& a, LAS unsigned char* lds, const float* xsrc, const float* gain, int shift_off, int scale_off, int bid, int G) {
    int tid = threadIdx.x; asm volatile("" : "+v"(tid)); const int lane = tid & 63, wave = __builtin_amdgcn_readfirstlane(tid >> 6);
    LAS float* AS = (LAS float*)lds; LAS float* SH = AS + DM;
    const float* modp = (const float*)(a.ws + WS_MODP); float* mod = (float*)(a.ws + WS_MOD);
    const int rows_per = M / G, b = (bid * rows_per) / T;
    f32x4 v[4][8];
#pragma unroll
    for (int rr = 0; rr < 4; ++rr) { const f32x4* xr = (const f32x4*)(xsrc + (size_t)(bid * rows_per + wave + 8 * rr) * DM) + lane;
#pragma unroll
        for (int j = 0; j < 8; ++j) v[rr][j] = xr[64 * j]; }
    if (FIRST) handoff_wait((unsigned*)(a.ws + CTL_CNT_ADALN), 16u * 48u);
    for (int d = tid; d < DM; d += NTHR) { float sc, sh;
        if (FIRST) { sc = a.b_ada[scale_off + d]; sh = a.b_ada[shift_off + d];
#pragma unroll
            for (int kc = 0; kc < 16; ++kc) { sc += modp[((size_t)kc * 2 + b) * (6 * DM) + scale_off + d]; sh += modp[((size_t)kc * 2 + b) * (6 * DM) + shift_off + d]; } }
        else { sc = mod[b * 6 * DM + scale_off + d]; sh = mod[b * 6 * DM + shift_off + d]; }
        AS[d] = gain[d] * (1.f + sc); SH[d] = sh; }
    if (FIRST) {
        for (int e = bid * NTHR + tid; e < 2 * 6 * DM; e += G * NTHR) { const int bb = e / (6 * DM), j = e % (6 * DM); float s = a.b_ada[j];
#pragma unroll
            for (int kc = 0; kc < 16; ++kc) s += modp[((size_t)kc * 2 + bb) * (6 * DM) + j];
            mod[e] = s; }
    }
    __syncthreads();
    bf16_t* XN = (bf16_t*)(a.ws + WS_XN);
    for (int r0 = 0; r0 < rows_per; r0 += 32) {
        if (r0 > 0) {
#pragma unroll
            for (int rr = 0; rr < 4; ++rr) { const f32x4* xr = (const f32x4*)(xsrc + (size_t)(bid * rows_per + r0 + wave + 8 * rr) * DM) + lane;
#pragma unroll
                for (int j = 0; j < 8; ++j) v[rr][j] = xr[64 * j]; } }
#pragma unroll
        for (int rr = 0; rr < 4; ++rr) { const int row = bid * rows_per + r0 + wave + 8 * rr; float ss = 0.f;
#pragma unroll
            for (int j = 0; j < 8; ++j) ss += (v[rr][j][0] * v[rr][j][0] + v[rr][j][1] * v[rr][j][1]) + (v[rr][j][2] * v[rr][j][2] + v[rr][j][3] * v[rr][j][3]);
            const float rstd = 1.0f / sqrtf(wave_sum(ss) * (1.f / DM) + EPS);
            u32x2* o8 = (u32x2*)(XN + (size_t)row * DM) + lane;
#pragma unroll
            for (int j = 0; j < 8; ++j) { const f32x4 as = *(const LAS f32x4*)(AS + 4 * lane + 256 * j), sh = *(const LAS f32x4*)(SH + 4 * lane + 256 * j);
                const f32x4 h = v[rr][j] * rstd * as + sh; u32x2 w; w.x = cvt_pk_bf16(h[0], h[1]); w.y = cvt_pk_bf16(h[2], h[3]); o8[64 * j] = w; } }
    }
    __syncthreads();
}


__device__ __forceinline__ void cmp2_phase(const Args& a, LAS unsigned char* lds, int L0, int Lstride) {
    int tid = threadIdx.x; asm volatile("" : "+v"(tid)); const int lane = tid & 63, wave = __builtin_amdgcn_readfirstlane(tid >> 6);
    unsigned char* ws = a.ws;
    for (int L = L0; L < 64; L += Lstride) {
        {
            const int kv = L >> 5, bg = (L >> 3) & 3, rt = L & 7;
            LAS bf16_t* hidL = (LAS bf16_t*)lds;
            LAS float* red = (LAS float*)(lds + 32768);
            LAS float* pebL = (LAS float*)(lds + 36864);
            if (tid < 256) { const float* pebp = (const float*)(ws + WS_PEBP) + (size_t)kv * 64 * 256 + tid; float sp = 0.f;
#pragma unroll
                for (int ch = 0; ch < 64; ++ch) sp += pebp[ch * 256];
                pebL[tid] = sp; }
            __syncthreads();
            { const int row = tid >> 4, c0 = (tid & 15) * 16;
              const float* pp = (const float*)(ws + WS_PART) + ((size_t)(kv * 4 + bg) * 4) * 65536 + (size_t)(rt * 32 + row) * 256 + c0;
              const LAS float* peb = pebL + c0;
              f32x4 s0 = *(const LAS f32x4*)peb, s1 = *(const LAS f32x4*)(peb + 4), s2 = *(const LAS f32x4*)(peb + 8), s3 = *(const LAS f32x4*)(peb + 12);
#pragma unroll 4
              for (int ks = 0; ks < 4; ++ks) { const float* q = pp + (size_t)ks * 65536; s0 += *(const f32x4*)q; s1 += *(const f32x4*)(q + 4); s2 += *(const f32x4*)(q + 8); s3 += *(const f32x4*)(q + 12); }
              f32x4 sv[4] = {s0, s1, s2, s3}; unsigned w[8];
#pragma unroll
              for (int i = 0; i < 4; ++i) { f32x4 v = sv[i];
#pragma unroll
                  for (int e = 0; e < 4; ++e) v[e] = v[e] / (1.f + __expf(-v[e]));
                  w[2 * i] = cvt_pk_bf16(v[0], v[1]); w[2 * i + 1] = cvt_pk_bf16(v[2], v[3]); }
              *(LAS u32x4*)(hidL + row * 264 + c0) = (u32x4){w[0], w[1], w[2], w[3]}; *(LAS u32x4*)(hidL + row * 264 + c0 + 8) = (u32x4){w[4], w[5], w[6], w[7]}; }
            __syncthreads();
            const int fr = lane & 15, fq = lane >> 4;
            f32x4 acc[2] = {(f32x4){0.f, 0.f, 0.f, 0.f}, (f32x4){0.f, 0.f, 0.f, 0.f}};
            const bf16_t* w2 = (const bf16_t*)(ws + WS_W2T) + (size_t)kv * 128 * 256 + (size_t)(16 * wave + fr) * 256 + 8 * fq;
#pragma unroll
            for (int ks = 0; ks < 8; ++ks) { const bf16x8 bf = *(const bf16x8*)(w2 + ks * 32);
#pragma unroll
                for (int rg = 0; rg < 2; ++rg) { const bf16x8 af = *(const LAS bf16x8*)(hidL + (rg * 16 + fr) * 264 + ks * 32 + 8 * fq);
                    acc[rg] = __builtin_amdgcn_mfma_f32_16x16x32_bf16(af, bf, acc[rg], 0, 0, 0); } }
            float rstd[2][4];
            if (kv == 0) {
#pragma unroll
                for (int rg = 0; rg < 2; ++rg)
#pragma unroll
                    for (int e = 0; e < 4; ++e) { float q = acc[rg][e] * acc[rg][e]; q += __shfl_xor(q, 1); q += __shfl_xor(q, 2); q += __shfl_xor(q, 4); q += __shfl_xor(q, 8);
                        if (fr == 0) red[(rg * 16 + 4 * fq + e) * 8 + wave] = q; }
                __syncthreads();
#pragma unroll
                for (int rg = 0; rg < 2; ++rg)
#pragma unroll
                    for (int e = 0; e < 4; ++e) { const LAS float* rp = red + (rg * 16 + 4 * fq + e) * 8; const float tot = ((rp[0] + rp[1]) + (rp[2] + rp[3])) + ((rp[4] + rp[5]) + (rp[6] + rp[7]));
                        rstd[rg][e] = 1.0f / sqrtf(tot * (1.f / 128.f) + EPS) * a.cmp_k_norm[16 * wave + fr]; }
            } else {
#pragma unroll
                for (int rg = 0; rg < 2; ++rg)
#pragma unroll
                    for (int e = 0; e < 4; ++e) rstd[rg][e] = 1.f;
            }
            bf16_t* dst = (bf16_t*)(ws + (kv ? WS_VCMP : WS_KCMP)) + (size_t)bg * 256 * 128;
#pragma unroll
            for (int rg = 0; rg < 2; ++rg)
#pragma unroll
                for (int e = 0; e < 4; ++e) { const int n = rt * 32 + rg * 16 + 4 * fq + e; const float v = (n == 255) ? 0.f : acc[rg][e] * rstd[rg][e];
                    dst[(size_t)n * 128 + 16 * wave + fr] = (bf16_t)(cvt_pk_bf16(v, 0.f) & 0xffffu); }
            __syncthreads();
        }
    }
}


#define XB_TMO      128
#define XB_XCNT(j)  (256  + 64 * (j))
#define XB_XSUB(j)  (1280 + 64 * (j))
#define XB_XGEN(j)  (2304 + 64 * (j))
#define XB_TOP      3328
#define XB_TOPGEN   3392
#define XCD_BAR_WORDS 3456
#define XB_SPIN_CAP (1u << 22)
__device__ __forceinline__ unsigned xb_ld(unsigned* p)              { return __hip_atomic_load(p, __ATOMIC_RELAXED, __HIP_MEMORY_SCOPE_AGENT); }
__device__ __forceinline__ unsigned xb_add(unsigned* p, unsigned v) { return __hip_atomic_fetch_add(p, v, __ATOMIC_RELAXED, __HIP_MEMORY_SCOPE_AGENT); }
__device__ __forceinline__ unsigned xb_xcc_id() { return (unsigned)__builtin_amdgcn_s_getreg((3 << 11) | 20) & 0xFu; }
#define XB_SPIN(cond, bar) do { unsigned _sp = 0; while (cond) { __builtin_amdgcn_s_sleep(1); \
    if ((++_sp & 255u) == 0u) { if (xb_ld(&(bar)[XB_TMO])) break; if (_sp > XB_SPIN_CAP) { atomicAdd(&(bar)[XB_TMO], 1u); break; } } } } while (0)
struct XcdBarrier { unsigned* bar; unsigned x; volatile LAS unsigned* st; };
__device__ __forceinline__ XcdBarrier xcd_barrier_post(unsigned* bar, volatile LAS unsigned* st) {
    XcdBarrier b; b.bar = bar; b.x = xb_xcc_id(); b.st = st;
    if (threadIdx.x == 0) (void)xb_add(&bar[XB_XCNT(b.x)], 1u);
    return b;
}
__device__ __forceinline__ void xcd_barrier_complete(unsigned* bar, unsigned x, unsigned& nloc, unsigned& nx) {
    const unsigned G = gridDim.x * gridDim.y * gridDim.z;
    unsigned sum, cnt, mine, sp = 0u;
    for (;;) {
        sum = 0u; cnt = 0u; mine = 0u;
#pragma unroll
        for (unsigned j = 0; j < 16; ++j) { const unsigned c = xb_ld(&bar[XB_XCNT(j)]); sum += c; cnt += (c > 0u) ? 1u : 0u; mine = (j == x) ? c : mine; }
        if (sum == G) break;
        __builtin_amdgcn_s_sleep(1);
        if ((++sp & 255u) == 0u) { if (xb_ld(&bar[XB_TMO])) break; if (sp > XB_SPIN_CAP) { atomicAdd(&bar[XB_TMO], 1u); break; } }
    }
    nloc = mine > 0u ? mine : 1u; nx = cnt > 0u ? cnt : 1u;
}
__device__ __forceinline__ void xcd_barrier(const XcdBarrier& b) {
    asm volatile("s_waitcnt vmcnt(0)" ::: "memory");
    __syncthreads();
    if (threadIdx.x == 0) {
        unsigned* bar = b.bar;
        __builtin_amdgcn_s_waitcnt(0);
        unsigned nloc = b.st[0], nx = b.st[1];
        if (nloc == 0u) { xcd_barrier_complete(bar, b.x, nloc, nx); b.st[0] = nloc; b.st[1] = nx; }
        const unsigned old = xb_add(&bar[XB_XSUB(b.x)], 1u);
        const unsigned gen = old / nloc;
        if (old + 1u == (gen + 1u) * nloc) {
            __builtin_amdgcn_fence(__ATOMIC_RELEASE, "agent");
            asm volatile("s_waitcnt vmcnt(0)" ::: "memory");
            const unsigned og = xb_add(&bar[XB_TOP], 1u);
            const unsigned tg = og / nx;
            if (og + 1u == (tg + 1u) * nx) xb_add(&bar[XB_TOPGEN], 1u);
            else XB_SPIN(xb_ld(&bar[XB_TOPGEN]) == tg, bar);
            __builtin_amdgcn_fence(__ATOMIC_ACQUIRE, "agent");
            xb_add(&bar[XB_XGEN(b.x)], 1u);
            asm volatile("s_waitcnt vmcnt(0)" ::: "memory");
        } else {
            XB_SPIN(xb_ld(&bar[XB_XGEN(b.x)]) == gen, bar);
            __builtin_amdgcn_fence(__ATOMIC_ACQUIRE, "agent");
            asm volatile("s_waitcnt vmcnt(0)" ::: "memory");
        }
    }
    __syncthreads();
}

enum { PH_PRO = 0, PH_INPROJ = 1, PH_ATTN = 2, PH_OUTPROJ = 3, PH_UP = 4, PH_DOWN = 5, PH_END = 6 };

__global__ void __launch_bounds__(NTHR, 2) mega_kernel(Args a) {
    extern __shared__ __attribute__((aligned(16))) unsigned char lds_raw[];
    LAS unsigned char* lds = (LAS unsigned char*)lds_raw;
    const int G = gridDim.x, bid = blockIdx.x;
    const int vcu = (G % 8 == 0) ? (bid % 8) * (G / 8) + bid / 8 : bid;
    unsigned char* ws = a.ws;
    volatile LAS unsigned* bst = (volatile LAS unsigned*)(lds + LDS_BYTES - 64);
    if (threadIdx.x < 2) bst[threadIdx.x] = 0u;
    __syncthreads();
    const XcdBarrier gbar = xcd_barrier_post((unsigned*)(ws + WS_CTL) + 1024, bst);
#ifndef PHMASK
#define PHMASK 0xffff
#endif
#define IN(k) (((PHMASK >> (k)) & 1) && a.ph_lo <= (k) && (k) < a.ph_hi)
#ifdef PROBE_PHASE
#define STAMP(k) do { if (bid == 0 && threadIdx.x == 0) ((unsigned long long*)(ws + WS_CTL + 24576))[(k)] = __builtin_amdgcn_s_memrealtime(); } while (0)
#else
#define STAMP(k) do { } while (0)
#endif
#define SEAM(k) do { if (IN(k) && IN((k) + 1)) xcd_barrier(gbar); STAMP((k) + 1); } while (0)
    STAMP(0);
    if (IN(PH_PRO)) { p0_prologue(a, lds, vcu, G); __syncthreads(); norm_phase<true>(a, lds, a.x, a.norm1_g, 0, DM, bid, G); } SEAM(PH_PRO);
    if (IN(PH_INPROJ)) {
        pg8::StaticOrder S; S.init(M, NPAD, G, bid, ws + WS_XN, ws + WS_WIN, DM, DM); S.rm = 1;
        pg8::EpiIn E{ws, a.fox_q_norm, a.fox_k_norm, a.nsa_q_norm, a.slc_k_norm, a.win_k_norm, a.b_forget, (LAS float*)(lds + LDS_STATS), (unsigned*)(ws + CTL_CNT_KCVC), (unsigned*)(ws + CTL_CNT_GATE)};
        pg8::gemm_phase(lds, DM, DM, DM, S, E);
        if (bid >= 224) {
            handoff_wait((unsigned*)(ws + CTL_CNT_KCVC), 64u * 8u);
            pg8::CmpOrder S2{32, bid - 224, (const char*)(ws + WS_KC), (const char*)(ws + WS_VC), (const char*)(ws + WS_W1T)};
            pg8::EpiPart E2{(float*)(ws + WS_PART), (unsigned*)(ws + CTL_CNT_PART)};
            pg8::gemm_phase(lds, 2048, 4096, 1024, S2, E2);
        }
        else if ((bid & 1) == 0 && (bid >> 3) < 16) {
            handoff_wait((unsigned*)(ws + CTL_CNT_PART), 32u * 8u);
            cmp2_phase(a, lds, (bid >> 3) * 4 + ((bid & 7) >> 1), 64);
        }
        else if ((bid & 1) == 0 && (bid >> 3) < 20) {
            handoff_wait((unsigned*)(ws + CTL_CNT_GATE), 32u * 8u);
            att::compute_kb(ws, ((bid >> 3) - 16) * 4 + ((bid & 7) >> 1), (LAS char*)lds);
        }
    } SEAM(PH_INPROJ);
#ifdef PROBE_PHASE
    unsigned long long tA0 = __builtin_amdgcn_s_memrealtime();
#endif
    if (IN(PH_ATTN)) { att::attn_phase(a, (LAS char*)lds, vcu, G); }
#ifdef PROBE_PHASE
    if (threadIdx.x == 0) { const unsigned d = (unsigned)(__builtin_amdgcn_s_memrealtime() - tA0); atomicMax((unsigned*)(ws + WS_CTL + 24576 + 256), d); atomicMax((unsigned*)(ws + WS_CTL + 24576 + 260), 0xffffffffu - d); }
#endif
    SEAM(PH_ATTN);
    if (IN(PH_OUTPROJ)) {
        pg8::StaticOrder S; S.init(M, DM, G, bid, ws + WS_AO, ws + WS_WOUT, DM, DM);
        pg8::EpiResNorm E{a.x, (bf16_t*)(ws + WS_X1B), (const float*)(ws + WS_MOD), a.norm2_g, (bf16_t*)(ws + WS_XN), (float*)(ws + WS_SLOTS), (unsigned*)(ws + CTL_CNT_PANEL), (LAS float*)(lds + LDS_STATS)};
        pg8::gemm_phase(lds, DM, DM, DM, S, E);
    } SEAM(PH_OUTPROJ);
    if (IN(PH_UP)) {
        pg8::StaticOrder S; S.init(M, DFF, G, bid, ws + WS_XN, ws + WS_WUP, DM, DM);
        pg8::EpiUp E{(bf16_t*)(ws + WS_U), DFF};
        pg8::gemm_phase(lds, DM, DM, DM, S, E);
    } SEAM(PH_UP);
    if (IN(PH_DOWN)) {
        pg8::StaticOrder S; S.init(M, DM, G, bid, ws + WS_U, ws + WS_WDN, DFF, DFF);
        pg8::EpiRes E{(const bf16_t*)(ws + WS_X1B), a.out, (const float*)(ws + WS_MOD) + 5 * DM};
        pg8::gemm_phase(lds, DFF, DFF, DFF, S, E);
    }
    STAMP(PH_END);
#undef IN
#undef SEAM
}

#ifdef PROBE_PHASE
__global__ void probe_kernel(const unsigned long long* tsp, float* out) {
#if PROBE_PHASE == 98
    out[0] = (float)(((const unsigned*)tsp)[64]) * 1e-3f;
#elif PROBE_PHASE == 97
    out[0] = (float)(0xffffffffu - ((const unsigned*)tsp)[65]) * 1e-3f;
#elif PROBE_PHASE == 99
    out[0] = (float)(tsp[PH_END] - tsp[0]) * 5e-4f;
#else
    const unsigned long long t1 = tsp[PROBE_PHASE + 1], t0 = tsp[PROBE_PHASE]; out[0] = (float)(t1 - t0) * 1e-2f;
#endif
}
#endif
static void launch_phases(const Args& a0, int lo, int hi, int grid, hipStream_t stream) {
    Args a = a0; a.ph_lo = lo; a.ph_hi = hi; void* args[] = {&a};
    (void)args; hipLaunchKernelGGL(mega_kernel, dim3(grid), dim3(NTHR), LDS_BYTES, stream, a);
    hipError_t e = hipPeekAtLastError();
    if (e != hipSuccess) fprintf(stderr, "launch failed: %s (grid %d)\n", hipGetErrorString(e), grid);
}

extern "C" void kernel_launch(void* const* d_in, const int* in_sizes, int n_in, void* d_out, int out_size, void* d_ws, size_t ws_size, hipStream_t stream) {
    static int grid = 0;
    if (grid == 0) {
        int dev = 0, cus = 0, per_cu = 0; hipGetDevice(&dev); hipDeviceGetAttribute(&cus, hipDeviceAttributeMultiprocessorCount, dev);
        hipFuncSetAttribute((const void*)mega_kernel, hipFuncAttributeMaxDynamicSharedMemorySize, LDS_BYTES);
        hipOccupancyMaxActiveBlocksPerMultiprocessor(&per_cu, (const void*)mega_kernel, NTHR, LDS_BYTES);
        if (per_cu < 1) { fprintf(stderr, "occupancy query says %d blocks/CU\n", per_cu); per_cu = 1; }
        grid = 256;
        if (cus < 256) fprintf(stderr, "this kernel needs >= 256 CUs for a resident grid (device has %d)\n", cus);
        if (ws_size < WS_END + 24 * MiB) fprintf(stderr, "workspace too small: %zu\n", ws_size);
    }
    hipMemsetAsync((char*)d_ws + WS_CTL, 0, 49152, stream);
    Args a{};
    const float** ap = (const float**)&a;
    for (int i = 0; i < 23; ++i) ap[i] = (const float*)d_in[i];
    a.out = (float*)d_out; a.ws = (unsigned char*)d_ws;
    unsigned char* ws = a.ws;
    launch_phases(a, PH_PRO, PH_END, grid, stream);
#ifdef PROBE_PHASE
    probe_kernel<<<1, 1, 0, stream>>>((const unsigned long long*)(ws + WS_CTL + 24576), a.out);
#endif
}
```

```cpp
#include <hip/hip_runtime.h>
#include <hip/hip_cooperative_groups.h>
#include <stdint.h>
#include <math.h>
#include <cstdio>
namespace cg = cooperative_groups;
#define NF_IN 3

constexpr int DM = 2048, NB = 2, T = 4096, M = NB * T, HD = 128;
constexpr int DIN = 5664, DFF = 8192, NPAD = 5888;
constexpr int C_FQ = 0, C_FK = 1024, C_FV = 2048, C_FZ = 3072, C_NQ = 3080, C_KC = 4104, C_VC = 4360, C_KSL = 4616, C_VSL = 4872,
              C_KW = 5128, C_VW = 5384, C_GZ = 5640;
constexpr int NCMP = 255;
constexpr float SCALE = 0.08838834764831845f;
constexpr float EPS = 1e-6f;
constexpr int NWAVES = 8, NTHR = 512;

constexpr size_t MiB = 1u << 20;
constexpr size_t WS_CTL = 0;
constexpr size_t CTL_CNT_GATE = 21504;
constexpr size_t CTL_CNT_KCVC = 20480, CTL_CNT_PART = 20736, CTL_CNT_ADALN = 20992, CTL_CNT_PANEL = 32768, CTL_CNT_ATTN = 40960;
constexpr size_t WS_SLOTS = 64 * 1024;
constexpr size_t WS_MODP = 384 * 1024;
constexpr size_t WS_MOD = 2 * MiB;
constexpr size_t WS_ROPE = 3 * MiB;
constexpr size_t WS_PEBP = 5 * MiB;
constexpr size_t WS_PEB = 5 * MiB + 256 * 1024;
constexpr size_t WS_MBOUND = 5 * MiB + 300 * 1024;
constexpr size_t WS_LOGF = 5 * MiB + 320 * 1024;
constexpr size_t WS_KBIAS = 5 * MiB + 640 * 1024;
constexpr size_t WS_GATES = 6 * MiB;
constexpr size_t WS_W2T = 7 * MiB;
constexpr size_t WS_W1T = 8 * MiB;
constexpr size_t WS_WIN = 12 * MiB;
constexpr size_t WS_WOUT = 36 * MiB;
constexpr size_t WS_WUP = 44 * MiB;
constexpr size_t WS_WDN = 76 * MiB;
constexpr size_t WS_XN = 108 * MiB;
constexpr size_t WS_FQ = 140 * MiB, WS_FK = 156 * MiB, WS_FV = 172 * MiB, WS_NQ = 188 * MiB, WS_NQR = 204 * MiB;
constexpr size_t WS_KC = 220 * MiB, WS_VC = 224 * MiB, WS_KSL = 228 * MiB, WS_VSL = 232 * MiB, WS_KW = 236 * MiB, WS_VW = 240 * MiB;
constexpr size_t WS_KCMP = 244 * MiB, WS_VCMP = 244 * MiB + 512 * 1024;
constexpr size_t WS_PART = 245 * MiB;
constexpr size_t WS_NSAO = 277 * MiB;
constexpr size_t WS_X1B = WS_NSAO;
constexpr size_t WS_AO = 309 * MiB;
constexpr size_t WS_U = 140 * MiB;
constexpr size_t WS_END = 341 * MiB;
constexpr size_t WS_DEV_CUM = 341 * MiB;
constexpr size_t WS_DEV_XB = 342 * MiB;
constexpr size_t WS_DEV_HID = 358 * MiB;
constexpr size_t WS_DEV_KC = 360 * MiB;

constexpr int LDS_STATS = 131072;
constexpr int LDS_BYTES = 155648;

#define LAS __attribute__((address_space(3)))
#define GAS __attribute__((address_space(1)))
typedef unsigned short bf16_t;
typedef short bf16x8 __attribute__((ext_vector_type(8)));
typedef float f32x4 __attribute__((ext_vector_type(4)));
typedef float f32x2 __attribute__((ext_vector_type(2)));
typedef unsigned u32x4 __attribute__((ext_vector_type(4)));
typedef unsigned u32x2 __attribute__((ext_vector_type(2)));

typedef __bf16 bf16x2_t __attribute__((ext_vector_type(2)));
__device__ __forceinline__ unsigned cvt_pk_bf16(float lo, float hi) { f32x2 v = {lo, hi}; bf16x2_t b = __builtin_convertvector(v, bf16x2_t); return __builtin_bit_cast(unsigned, b); }
__device__ __forceinline__ float bf2f(bf16_t v) { return __uint_as_float(((unsigned)v) << 16); }
__device__ __forceinline__ float wave_sum(float v) {
#pragma unroll
    for (int o = 1; o < 64; o <<= 1) v += __shfl_xor(v, o);
    return v;
}
__device__ __forceinline__ float wave_max(float v) {
#pragma unroll
    for (int o = 1; o < 64; o <<= 1) v = fmaxf(v, __shfl_xor(v, o));
    return v;
}


__device__ __forceinline__ void handoff_signal(unsigned* cnt, int lane) {
    asm volatile("s_waitcnt vmcnt(0)" ::: "memory");
    if (lane == 0) __hip_atomic_fetch_add(cnt, 1u, __ATOMIC_RELAXED, __HIP_MEMORY_SCOPE_AGENT);
}
__device__ __forceinline__ void handoff_wait(unsigned* cnt, unsigned target) {
    if (threadIdx.x < 64) { unsigned sp = 0;
        while ((unsigned)__builtin_amdgcn_readfirstlane(__hip_atomic_load(cnt, __ATOMIC_RELAXED, __HIP_MEMORY_SCOPE_AGENT)) < target) { __builtin_amdgcn_s_sleep(4); if (++sp > (1u << 24)) break; }
        __builtin_amdgcn_fence(__ATOMIC_ACQUIRE, "agent"); asm volatile("s_waitcnt vmcnt(0)" ::: "memory"); }
    __syncthreads();
}

namespace pg8 {
constexpr int BM = 256, BK = 64, HALF = 128, HTB = HALF * BK * 2, STAGE_BYTES = 8 * HTB, NXCD = 8, WGM = 8;
__host__ __device__ __forceinline__ int lds_byte(int r, int c) { const int st = (r >> 4) * 2 + (c >> 5), rr = r & 15, cc = c & 31, ob = rr * 64 + cc * 2; return st * 1024 + (ob ^ (((ob >> 9) & 1) << 5)); }
__host__ __device__ __forceinline__ void stage_rc(int b, int& R, int& C) { const int st = b / 1024, sb = b % 1024, swz = sb ^ (((sb >> 9) & 1) << 5); R = (st >> 1) * 16 + swz / 64; C = (st & 1) * 32 + (swz % 64) / 2; }
__host__ __device__ __forceinline__ int perm32(int rho) { const int n = rho >> 4, i = rho & 15; return 8 * (i >> 2) + 4 * n + (i & 3); }

struct Unit { int pm, pn, aux; };
#define NF_ERN 3
#ifndef NF_IN
#define NF_IN 2
#endif

struct StaticOrder {
    int nM, nN, nwg, G, c; const char* A; const char* Bt; size_t tsA, tsB; int rm = 0;
    __device__ __forceinline__ void init(int M_, int N_, int G_, int c_, const void* A_, const void* Bt_, int lda, int ldb) { nM = M_ / BM; nN = N_ / BM; nwg = nM * nN; G = G_; c = c_; A = (const char*)A_; Bt = (const char*)Bt_; tsA = (size_t)BM * lda * 2; tsB = (size_t)BM * ldb * 2; }
    __device__ __forceinline__ bool next(int i, Unit& u) const {
        const long L = (long)i * G + c; if (L >= nwg) return false;
        int wgid = (int)L; { const int q = nwg / NXCD, r = nwg % NXCD, xcd = wgid % NXCD, off = wgid / NXCD; wgid = (xcd < r ? xcd * (q + 1) : r * (q + 1) + (xcd - r) * q) + off; }
        const int nig = WGM * nN, gid = wgid / nig, fm = gid * WGM, gsz = (nM - fm) < WGM ? (nM - fm) : WGM;
        u.pm = fm + ((wgid % nig) % gsz); u.pn = (wgid % nig) / gsz; u.aux = 0;
        if (rm) { const int p = u.pn; u.pn = (int)(((p < 12 ? 0x4a0e6734a418820ull : 0x5ab49ad507b251ull) >> (5 * (p < 12 ? p : p - 12))) & 31ull); }
        return true;
    }
    __device__ __forceinline__ void ptrs(const Unit& u, const char*& a, const char*& b) const { a = A + (size_t)u.pm * tsA; b = Bt + (size_t)u.pn * tsB; }
};

template <class Epi, class Sched>
__device__ __forceinline__ void gemm_phase(LAS unsigned char* lds, const int lda, const int ldb, const int K, const Sched& S, const Epi& E) {
    int tid = threadIdx.x; asm volatile("" : "+v"(tid));
    const int wid = __builtin_amdgcn_readfirstlane(tid >> 6), lane = tid & 63, wr = wid >> 2, wc = wid & 3, fr = lane & 15, fq = lane >> 4;
    const int nt = K / BK;
    unsigned voffA[2], voffB[2];
#pragma unroll
    for (int i = 0; i < 2; ++i) { int R, C; stage_rc(tid * 16 + i * 8192, R, C); const int Rb = Epi::PERM ? ((R & ~31) + perm32(R & 31)) : R;
        voffA[i] = (unsigned)(R * lda + C) * 2u; voffB[i] = (unsigned)(Rb * ldb + C) * 2u; }
    const size_t kstep = (size_t)(BK * 2);
    const size_t hsA = (size_t)HALF * lda * 2, hsB = (size_t)HALF * ldb * 2;
    const unsigned ldsw = (unsigned)wid * 1024u;
    const int aoff = lds_byte(wr * 64 + fr, fq * 8), boff = lds_byte(wc * 32 + fr, fq * 8);
#define PG8_SA(b, h) (((b) * 2 + (h)) * HTB)
#define PG8_SB(b, h) ((4 + (b) * 2 + (h)) * HTB)
#define PG8_STAGE(bufoff, gbase, voff) do { _Pragma("unroll") for (int _i = 0; _i < 2; ++_i) \
        __builtin_amdgcn_global_load_lds((const unsigned*)((const char*)(gbase) + (voff)[_i]), (LAS unsigned*)(lds + (bufoff) + ldsw + _i * 8192), 16, 0, 0); } while (0)
#define PG8_LDA(dst, b, h) do { _Pragma("unroll") for (int m = 0; m < 4; ++m) _Pragma("unroll") for (int k = 0; k < 2; ++k) dst[m][k] = *(const LAS bf16x8*)(lds + PG8_SA(b, h) + aoff + m * 2048 + k * 1024); } while (0)
#define PG8_LDB(dst, b, h) do { _Pragma("unroll") for (int n = 0; n < 2; ++n) _Pragma("unroll") for (int k = 0; k < 2; ++k) dst[n][k] = *(const LAS bf16x8*)(lds + PG8_SB(b, h) + boff + n * 2048 + k * 1024); } while (0)
#define PG8_MMA(ai, bj, At, Bt) do { __builtin_amdgcn_s_setprio(1); _Pragma("unroll") for (int m = 0; m < 4; ++m) _Pragma("unroll") for (int n = 0; n < 2; ++n) _Pragma("unroll") for (int k = 0; k < 2; ++k) \
        acc[ai][bj][m][n] = __builtin_amdgcn_mfma_f32_16x16x32_bf16(Bt[n][k], At[m][k], acc[ai][bj][m][n], 0, 0, 0); __builtin_amdgcn_s_setprio(0); } while (0)
#define PG8_WAIT_V(n) asm volatile("s_waitcnt vmcnt(" #n ")" ::: "memory")
#define PG8_WAIT_VX do { static_assert(Epi::NS == 0 || Epi::NS == 16, "unit-boundary wait count"); asm volatile("s_waitcnt vmcnt(24)" ::: "memory"); } while (0)
#define PG8_WAIT_L(n) asm volatile("s_waitcnt lgkmcnt(" #n ")" ::: "memory")
#define PG8_BAR __builtin_amdgcn_s_barrier()
#define PG8_SCHED __builtin_amdgcn_sched_barrier(0)
    Unit cur, nxt; int ui = 0; bool fresh = false;
    if (!S.next(0, cur)) return;
    f32x4 acc[2][2][4][2];
#pragma unroll
    for (int a = 0; a < 2; ++a)
#pragma unroll
        for (int b = 0; b < 2; ++b)
#pragma unroll
            for (int m = 0; m < 4; ++m)
#pragma unroll
                for (int n = 0; n < 2; ++n) acc[a][b][m][n] = (f32x4){0.f, 0.f, 0.f, 0.f};
    bf16x8 At[4][2], B0[2][2], B1[2][2];
    const char* cA; const char* cB; S.ptrs(cur, cA, cB);
    PG8_STAGE(PG8_SB(0, 0), cB, voffB); PG8_STAGE(PG8_SB(0, 1), cB + hsB, voffB); PG8_STAGE(PG8_SA(0, 0), cA, voffA); PG8_STAGE(PG8_SA(0, 1), cA + hsA, voffA);
    if (wr == 1) PG8_BAR;
    PG8_WAIT_V(2); PG8_BAR;
    PG8_STAGE(PG8_SB(1, 0), cB + kstep, voffB); PG8_STAGE(PG8_SA(1, 0), cA + kstep, voffA); PG8_STAGE(PG8_SB(1, 1), cB + hsB + kstep, voffB);
    PG8_WAIT_V(6); PG8_BAR;
    if constexpr (Epi::PREFETCH) E.prefetch(cur, lds + STAGE_BYTES, wid, lane);
    for (;;) {
        const bool has_next = S.next(ui + 1, nxt);
        const char* nA = cA; const char* nB = cB; if (has_next) S.ptrs(nxt, nA, nB);
#pragma nounroll
        for (int t = 0; t < nt; t += 2) {
            const bool last = (t == nt - 2);
            const char* a1 = cA + (size_t)(t + 1) * kstep;
            const char* a2 = last ? nA : cA + (size_t)(t + 2) * kstep; const char* b2 = last ? nB : cB + (size_t)(t + 2) * kstep;
            const char* a3 = a2 + kstep; const char* b3 = b2 + kstep;
            const bool fz = (Epi::NS > 0) && fresh && t == 0;
            PG8_LDB(B0, 0, 0); PG8_LDB(B1, 0, 1); PG8_SCHED; PG8_LDA(At, 0, 0); PG8_STAGE(PG8_SA(1, 1), a1 + hsA, voffA);
            if (fz) PG8_WAIT_VX; else PG8_WAIT_V(8);
            PG8_WAIT_L(0); PG8_BAR; PG8_MMA(0, 0, At, B0); PG8_MMA(0, 1, At, B1); PG8_BAR; PG8_SCHED;
            PG8_LDA(At, 0, 1); PG8_STAGE(PG8_SB(0, 0), b2, voffB); PG8_STAGE(PG8_SB(0, 1), b2 + hsB, voffB); PG8_STAGE(PG8_SA(0, 0), a2, voffA);
            if (fz) PG8_WAIT_VX; else PG8_WAIT_V(8);
            PG8_WAIT_L(0); PG8_BAR; PG8_MMA(1, 0, At, B0); PG8_MMA(1, 1, At, B1); PG8_BAR; PG8_SCHED;
            PG8_LDB(B0, 1, 0); PG8_LDB(B1, 1, 1); PG8_SCHED; PG8_LDA(At, 1, 0); PG8_STAGE(PG8_SA(0, 1), a2 + hsA, voffA);
            PG8_WAIT_V(8); PG8_WAIT_L(0); PG8_BAR; PG8_MMA(0, 0, At, B0); PG8_MMA(0, 1, At, B1); PG8_BAR; PG8_SCHED;
            PG8_LDA(At, 1, 1); PG8_STAGE(PG8_SB(1, 0), b3, voffB); PG8_STAGE(PG8_SB(1, 1), b3 + hsB, voffB); PG8_STAGE(PG8_SA(1, 0), a3, voffA);
            PG8_WAIT_V(8); PG8_WAIT_L(0); PG8_BAR; PG8_MMA(1, 0, At, B0); PG8_MMA(1, 1, At, B1); PG8_BAR; PG8_SCHED;
        }
        if (wr == 0) PG8_BAR;
        E(acc, cur, wr, wc, fr, fq);
        if (!has_next) break;
#pragma unroll
        for (int a = 0; a < 2; ++a)
#pragma unroll
            for (int b = 0; b < 2; ++b)
#pragma unroll
                for (int m = 0; m < 4; ++m)
#pragma unroll
                    for (int n = 0; n < 2; ++n) acc[a][b][m][n] = (f32x4){0.f, 0.f, 0.f, 0.f};
        cur = nxt; cA = nA; cB = nB; ++ui; fresh = true;
        if (wr == 1) PG8_BAR;
    }
    PG8_WAIT_V(0);
    PG8_BAR;
#undef PG8_SA
#undef PG8_SB
#undef PG8_STAGE
#undef PG8_LDA
#undef PG8_LDB
#undef PG8_MMA
#undef PG8_WAIT_V
#undef PG8_WAIT_VX
#undef PG8_WAIT_L
#undef PG8_BAR
#undef PG8_SCHED
}


struct EpiRes {
    static constexpr int NS = 0; static constexpr bool PERM = true, PREFETCH = false;
    const bf16_t* base; float* out; const float* gate;
    __device__ __forceinline__ void prefetch(const Unit&, LAS unsigned char*, int, int) const {}
    __device__ __forceinline__ void operator()(const f32x4 (&acc)[2][2][4][2], const Unit& u, int wr, int wc, int fr, int fq) const {
        const int row0 = u.pm * BM + wr * 64 + fr, col0 = u.pn * BM + wc * 32 + 8 * fq;
        const int b = (u.pm * BM) / T;
        f32x4 gv[2][2];
#pragma unroll
        for (int bj = 0; bj < 2; ++bj)
#pragma unroll
            for (int n = 0; n < 2; ++n) gv[bj][n] = *(const f32x4*)(gate + (size_t)b * 6 * DM + col0 + bj * HALF + 4 * n);
#pragma unroll
        for (int ai = 0; ai < 2; ++ai)
#pragma unroll
            for (int m = 0; m < 4; ++m) { const size_t off = (size_t)(row0 + ai * HALF + m * 16) * DM + col0;
#pragma unroll
                for (int bj = 0; bj < 2; ++bj) { const u32x4 w = *(const u32x4*)(base + off + bj * HALF);
                    const f32x4 b0 = (f32x4){__uint_as_float(w.x << 16), __uint_as_float(w.x & 0xffff0000u), __uint_as_float(w.y << 16), __uint_as_float(w.y & 0xffff0000u)};
                    const f32x4 b1 = (f32x4){__uint_as_float(w.z << 16), __uint_as_float(w.z & 0xffff0000u), __uint_as_float(w.w << 16), __uint_as_float(w.w & 0xffff0000u)};
                    *(f32x4*)(out + off + bj * HALF) = b0 + gv[bj][0] * acc[ai][bj][m][0];
                    *(f32x4*)(out + off + bj * HALF + 4) = b1 + gv[bj][1] * acc[ai][bj][m][1]; } }
    }
};

struct EpiResNorm {
    static constexpr int NS = 0; static constexpr bool PERM = true, PREFETCH = false;
    const float* base; bf16_t* out; const float* mod; const float* g2; bf16_t* XN; float* slots; unsigned* cnt; LAS float* tab;
    __device__ __forceinline__ void prefetch(const Unit& u, LAS unsigned char* dummy, int wid, int lane) const {
        const float* p = base + (size_t)(u.pm * BM + wid * 32) * DM + u.pn * BM + lane * 4;
#pragma unroll 8
        for (int r = 0; r < 32; ++r) __builtin_amdgcn_global_load_lds((const unsigned*)(p + (size_t)r * DM), (LAS unsigned*)(dummy + wid * 1024), 16, 0, 0);
    }
    __device__ __forceinline__ void operator()(f32x4 (&acc)[2][2][4][2], const Unit& u, int wr, int wc, int fr, int fq) const {
        const int row0 = u.pm * BM + wr * 64 + fr, col0 = u.pn * BM + wc * 32 + 8 * fq;
        const int b = (u.pm * BM) / T; const int wid = wr * 4 + wc, lane = fr + 16 * fq;
        const float* mb = mod + (size_t)b * 6 * DM;
        {   f32x4 gv[2][2];
#pragma unroll
            for (int bj = 0; bj < 2; ++bj)
#pragma unroll
                for (int n = 0; n < 2; ++n) gv[bj][n] = *(const f32x4*)(mb + 2 * DM + col0 + bj * HALF + 4 * n);
            f32x4 bs[NF_ERN][2][2];
#define ER_LD(g) do { const size_t off_ = (size_t)(row0 + ((g) >> 2) * HALF + ((g) & 3) * 16) * DM + col0; _Pragma("unroll") for (int bj = 0; bj < 2; ++bj) _Pragma("unroll") for (int n = 0; n < 2; ++n) \
            bs[(g) % NF_ERN][bj][n] = *(const f32x4*)(base + off_ + bj * HALF + 4 * n); } while (0)
            _Pragma("unroll") for (int g = 0; g < NF_ERN; ++g) ER_LD(g);
            asm volatile("" ::: "memory");
#pragma unroll
            for (int g = 0; g < 8; ++g) { const int ai = g >> 2, m = g & 3; float ss = 0.f;
#pragma unroll
                for (int bj = 0; bj < 2; ++bj)
#pragma unroll
                    for (int n = 0; n < 2; ++n) { const f32x4 v = bs[g % NF_ERN][bj][n] + gv[bj][n] * acc[ai][bj][m][n];
                        acc[ai][bj][m][n] = v; ss += (v[0] * v[0] + v[1] * v[1]) + (v[2] * v[2] + v[3] * v[3]); }
                if (g + NF_ERN < 8) ER_LD(g + NF_ERN);
                ss += __shfl_xor(ss, 16); ss += __shfl_xor(ss, 32);
                if (fq == 0) tab[(ai * HALF + wr * 64 + m * 16 + fr) * 4 + wc] = ss;
                asm volatile("" ::: "memory"); }
#undef ER_LD
        }
        asm volatile("s_waitcnt lgkmcnt(0)" ::: "memory"); __builtin_amdgcn_s_barrier(); asm volatile("" ::: "memory");
        const int prow = wid * 32 + (lane & 31);
        if (lane < 32) { const f32x4 q = *(const LAS f32x4*)(tab + prow * 4);
            __hip_atomic_store((unsigned*)slots + ((size_t)(u.pm * BM + prow) * 8 + u.pn), __float_as_uint((q[0] + q[1]) + (q[2] + q[3])), __ATOMIC_RELAXED, __HIP_MEMORY_SCOPE_AGENT); }
        asm volatile("s_waitcnt vmcnt(0)" ::: "memory");
        if (lane == 0) __hip_atomic_fetch_add(cnt + 64 * u.pm, 1u, __ATOMIC_RELAXED, __HIP_MEMORY_SCOPE_AGENT);
        f32x4 av[2][2], sv[2][2];
#pragma unroll
        for (int bj = 0; bj < 2; ++bj)
#pragma unroll
            for (int n = 0; n < 2; ++n) { const int c = col0 + bj * HALF + 4 * n; const f32x4 gg = *(const f32x4*)(g2 + c), sc = *(const f32x4*)(mb + 4 * DM + c);
                av[bj][n] = gg * (sc + 1.f); sv[bj][n] = *(const f32x4*)(mb + 3 * DM + c); }
        if (wid == 0) { unsigned sp = 0;
            while ((unsigned)__builtin_amdgcn_readfirstlane(__hip_atomic_load(cnt + 64 * u.pm, __ATOMIC_RELAXED, __HIP_MEMORY_SCOPE_AGENT)) < 64u) { __builtin_amdgcn_s_sleep(2); if (++sp > (1u << 22)) break; }
            __builtin_amdgcn_fence(__ATOMIC_ACQUIRE, "agent"); }
        asm volatile("s_waitcnt vmcnt(0) lgkmcnt(0)" ::: "memory"); __builtin_amdgcn_s_barrier(); asm volatile("" ::: "memory");
        if (lane < 32) { const unsigned* sl = (const unsigned*)slots + (size_t)(u.pm * BM + prow) * 8; float tot = 0.f;
#pragma unroll
            for (int t = 0; t < 8; ++t) tot += __uint_as_float(__hip_atomic_load(sl + t, __ATOMIC_RELAXED, __HIP_MEMORY_SCOPE_AGENT));
            tab[1024 + prow] = __builtin_amdgcn_rsqf(tot * (1.f / DM) + EPS); }
        asm volatile("s_waitcnt vmcnt(0) lgkmcnt(0)" ::: "memory"); __builtin_amdgcn_s_barrier(); asm volatile("" ::: "memory");
#pragma unroll
        for (int ai = 0; ai < 2; ++ai)
#pragma unroll
            for (int m = 0; m < 4; ++m) { const int rl = ai * HALF + wr * 64 + m * 16 + fr; const float rstd = tab[1024 + rl]; const size_t off = (size_t)(u.pm * BM + rl) * DM + col0;
#pragma unroll
                for (int bj = 0; bj < 2; ++bj) {
                    { const f32x4 x0 = acc[ai][bj][m][0], x1 = acc[ai][bj][m][1]; u32x4 xw; xw.x = cvt_pk_bf16(x0[0], x0[1]); xw.y = cvt_pk_bf16(x0[2], x0[3]); xw.z = cvt_pk_bf16(x1[0], x1[1]); xw.w = cvt_pk_bf16(x1[2], x1[3]);
                      *(u32x4*)(out + off + bj * HALF) = xw; }
                    const f32x4 h0 = acc[ai][bj][m][0] * rstd * av[bj][0] + sv[bj][0], h1 = acc[ai][bj][m][1] * rstd * av[bj][1] + sv[bj][1];
                    u32x4 w; w.x = cvt_pk_bf16(h0[0], h0[1]); w.y = cvt_pk_bf16(h0[2], h0[3]); w.z = cvt_pk_bf16(h1[0], h1[1]); w.w = cvt_pk_bf16(h1[2], h1[3]);
                    *(u32x4*)(XN + off + bj * HALF) = w; }
                asm volatile("" ::: "memory"); }
    }
};
struct EpiUp {
    static constexpr int NS = 16;   static constexpr bool PERM = true, PREFETCH = false;
    bf16_t* O; int ldc;
    __device__ __forceinline__ void operator()(const f32x4 (&acc)[2][2][4][2], const Unit& u, int wr, int wc, int fr, int fq) const {
        const int row0 = u.pm * BM + wr * 64 + fr, col0 = u.pn * BM + wc * 32 + 8 * fq;
#pragma unroll
        for (int ai = 0; ai < 2; ++ai)
#pragma unroll
            for (int m = 0; m < 4; ++m) { bf16_t* rowp = O + (size_t)(row0 + ai * HALF + m * 16) * ldc + col0;
#pragma unroll
                for (int bj = 0; bj < 2; ++bj) { f32x4 v0 = acc[ai][bj][m][0], v1 = acc[ai][bj][m][1];
                    v0 = __builtin_elementwise_max(v0, (f32x4){0.f, 0.f, 0.f, 0.f}); v1 = __builtin_elementwise_max(v1, (f32x4){0.f, 0.f, 0.f, 0.f}); v0 = v0 * v0; v1 = v1 * v1;
                    u32x4 w; w.x = cvt_pk_bf16(v0[0], v0[1]); w.y = cvt_pk_bf16(v0[2], v0[3]); w.z = cvt_pk_bf16(v1[0], v1[1]); w.w = cvt_pk_bf16(v1[2], v1[3]);
                    *(u32x4*)(rowp + bj * HALF) = w; } }
    }
};
struct EpiIn {
    static constexpr int NS = 0; static constexpr bool PERM = true, PREFETCH = false;
    unsigned char* wsb;
    const float *g_fq, *g_fk, *g_nq, *g_slc, *g_win, *b_forget; LAS float* stats; unsigned* kcvc_cnt; unsigned* gate_cnt;
    __device__ __forceinline__ void operator()(const f32x4 (&acc)[2][2][4][2], const Unit& u, int wr, int wc, int fr, int fq) const {
        const int pn = u.pn;
        unsigned char* w_ = wsb; asm volatile("" : "+s"(w_));
        GAS bf16_t* const FQ = (GAS bf16_t*)(w_ + WS_FQ); GAS bf16_t* const FK = (GAS bf16_t*)(w_ + WS_FK); GAS bf16_t* const FV = (GAS bf16_t*)(w_ + WS_FV); GAS bf16_t* const NQ = (GAS bf16_t*)(w_ + WS_NQ); GAS bf16_t* const NQR = (GAS bf16_t*)(w_ + WS_NQR);
        GAS bf16_t* const KC = (GAS bf16_t*)(w_ + WS_KC); GAS bf16_t* const VC = (GAS bf16_t*)(w_ + WS_VC); GAS bf16_t* const KSL = (GAS bf16_t*)(w_ + WS_KSL); GAS bf16_t* const VSL = (GAS bf16_t*)(w_ + WS_VSL); GAS bf16_t* const KW = (GAS bf16_t*)(w_ + WS_KW); GAS bf16_t* const VW = (GAS bf16_t*)(w_ + WS_VW);
        GAS float* const LOGF = (GAS float*)(w_ + WS_LOGF); GAS float* const GATES = (GAS float*)(w_ + WS_GATES); const GAS float* const rope = (const GAS float*)(w_ + WS_ROPE);
        const int b = u.pm >> 4, t0 = (u.pm & 15) * BM + wr * 64 + fr;
        if (pn == 12) {
            if (wc == 0) {
#pragma unroll
                for (int ai = 0; ai < 2; ++ai)
#pragma unroll
                    for (int m = 0; m < 4; ++m) { const int t = t0 + ai * HALF + m * 16;
#pragma unroll
                        for (int n = 0; n < 2; ++n)
#pragma unroll
                            for (int e = 0; e < 4; ++e) { const int p = 8 * fq + 4 * n + e; const float v = acc[ai][0][m][n][e];
                                if (p < 8) { const float z = v + b_forget[p]; __hip_atomic_store((GAS unsigned*)(LOGF + ((size_t)b * 8 + p) * T + t), __float_as_uint(fminf(z, 0.f) - __logf(1.f + __expf(-fabsf(z)))), __ATOMIC_RELAXED, __HIP_MEMORY_SCOPE_AGENT); }
                                else { GATES[((size_t)b * T + t) * 24 + (p - 8)] = 1.f / (1.f + __expf(-v)); } } }
            }
            handoff_signal(gate_cnt, fr + 16 * fq);
            return;
        }
        if (pn < 4) body<true, true, false, false>(acc, u, wr, wc, fr, fq, FQ, nullptr, g_fq, rope, 8, 2 * pn);
        else if (pn < 8) body<true, true, false, false>(acc, u, wr, wc, fr, fq, FK, nullptr, g_fk, rope, 8, 2 * (pn - 4));
        else if (pn < 12) body<false, true, false, false>(acc, u, wr, wc, fr, fq, FV, nullptr, nullptr, rope, 8, 2 * (pn - 8));
        else if (pn < 17) body<true, true, true, false>(acc, u, wr, wc, fr, fq, NQ, NQR, g_nq, rope, 8, 2 * (pn - 13));
        else if (pn < 19) body<false, true, false, true>(acc, u, wr, wc, fr, fq, pn == 17 ? KC : VC, nullptr, nullptr, rope, 2, 0);
        else if (pn < 21) body<true, false, true, false>(acc, u, wr, wc, fr, fq, nullptr, pn == 19 ? KSL : KW, pn == 19 ? g_slc : g_win, rope, 2, 0);
        else body<false, true, false, false>(acc, u, wr, wc, fr, fq, pn == 21 ? VSL : VW, nullptr, nullptr, rope, 2, 0);
    }
    template <bool NORM, bool D1, bool D2, bool WT>
    __device__ __forceinline__ void body(const f32x4 (&acc)[2][2][4][2], const Unit& u, int wr, int wc, int fr, int fq, GAS bf16_t* d1, GAS bf16_t* d2, const float* gain, const GAS float* rope, int nh, int h0) const {
        const int b = u.pm >> 4, t0 = (u.pm & 15) * BM + wr * 64 + fr;
        const int dlo = 16 * wc + 4 * fq;
        f32x4 g0 = (f32x4){1.f, 1.f, 1.f, 1.f}, g1 = g0;
        if (NORM) { g0 = *(const f32x4*)(gain + dlo); g1 = *(const f32x4*)(gain + 64 + dlo); }
        f32x4 cs[NF_IN][2];
#define EI_LD(g) do { const int tn_ = t0 + ((g) >> 2) * HALF + ((g) & 3) * 16; const GAS float* rp_ = rope + ((size_t)tn_ * 64 + dlo) * 2; cs[(g) % NF_IN][0] = *(const GAS f32x4*)rp_; cs[(g) % NF_IN][1] = *(const GAS f32x4*)(rp_ + 4); } while (0)
        if (D2) { _Pragma("unroll") for (int g = 0; g < NF_IN; ++g) EI_LD(g); }
        if (NORM) {
#pragma unroll
            for (int ai = 0; ai < 2; ++ai)
#pragma unroll
                for (int m = 0; m < 4; ++m)
#pragma unroll
                    for (int bj = 0; bj < 2; ++bj) { const f32x4 a = acc[ai][bj][m][0], c = acc[ai][bj][m][1];
                        float s = (a[0] * a[0] + a[1] * a[1]) + (a[2] * a[2] + a[3] * a[3]) + (c[0] * c[0] + c[1] * c[1]) + (c[2] * c[2] + c[3] * c[3]);
                        { const unsigned x = __float_as_uint(s); const auto r = __builtin_amdgcn_permlane32_swap(x, x, false, false); s = __uint_as_float(r[0]) + __uint_as_float(r[1]); }
                        { const unsigned x = __float_as_uint(s); const auto r = __builtin_amdgcn_permlane16_swap(x, x, false, false); s = __uint_as_float(r[0]) + __uint_as_float(r[1]); }
                        if (fq == 0) stats[(ai * HALF + wr * 64 + m * 16 + fr) * 8 + bj * 4 + wc] = s; }
            asm volatile("s_waitcnt lgkmcnt(0)" ::: "memory"); __builtin_amdgcn_s_barrier(); asm volatile("" ::: "memory");
        }
#pragma unroll
        for (int g = 0; g < 8; ++g) { const int ai = g >> 2, m = g & 3; const int t = t0 + ai * HALF + m * 16;
            float rsv[2] = {1.f, 1.f};
            if (NORM) {
#pragma unroll
                for (int bj = 0; bj < 2; ++bj) { const f32x4 q = *(const LAS f32x4*)(stats + (ai * HALF + wr * 64 + m * 16 + fr) * 8 + bj * 4);
                    rsv[bj] = __builtin_amdgcn_rsqf(((q[0] + q[1]) + (q[2] + q[3])) * (1.f / 128.f) + EPS); } }
            f32x4 c = g0, sn = g0;
            if (D2) { c = (f32x4){cs[g % NF_IN][0][0], cs[g % NF_IN][0][2], cs[g % NF_IN][1][0], cs[g % NF_IN][1][2]}; sn = (f32x4){cs[g % NF_IN][0][1], cs[g % NF_IN][0][3], cs[g % NF_IN][1][1], cs[g % NF_IN][1][3]}; }
            if (D2 && g + NF_IN < 8) EI_LD(g + NF_IN);
#pragma unroll
            for (int bj = 0; bj < 2; ++bj) { f32x4 v0 = acc[ai][bj][m][0], v1 = acc[ai][bj][m][1];
                if (NORM) { const float r = rsv[bj]; v0 = v0 * r * g0; v1 = v1 * r * g1; }
                const size_t off = (((size_t)b * nh + h0 + bj) * T + t) * 128 + dlo;
                if (D1) { u32x2 w0, w1; w0.x = cvt_pk_bf16(v0[0], v0[1]); w0.y = cvt_pk_bf16(v0[2], v0[3]); w1.x = cvt_pk_bf16(v1[0], v1[1]); w1.y = cvt_pk_bf16(v1[2], v1[3]);
                    if (WT) { __hip_atomic_store((GAS unsigned long long*)(d1 + off), ((unsigned long long)w0.y << 32) | w0.x, __ATOMIC_RELAXED, __HIP_MEMORY_SCOPE_AGENT);
                        __hip_atomic_store((GAS unsigned long long*)(d1 + off + 64), ((unsigned long long)w1.y << 32) | w1.x, __ATOMIC_RELAXED, __HIP_MEMORY_SCOPE_AGENT); }
                    else { *(GAS u32x2*)(d1 + off) = w0; *(GAS u32x2*)(d1 + off + 64) = w1; } }
                if (D2) { const f32x4 r0 = v0 * c - v1 * sn, r1 = v1 * c + v0 * sn;
                    u32x2 w0, w1; w0.x = cvt_pk_bf16(r0[0], r0[1]); w0.y = cvt_pk_bf16(r0[2], r0[3]); w1.x = cvt_pk_bf16(r1[0], r1[1]); w1.y = cvt_pk_bf16(r1[2], r1[3]);
                    *(GAS u32x2*)(d2 + off) = w0; *(GAS u32x2*)(d2 + off + 64) = w1; } }
            asm volatile("" ::: "memory"); }
#undef EI_LD
        if (WT) handoff_signal(kcvc_cnt, fr + 16 * fq);
    }
};

struct EpiPart {
    static constexpr int NS = 0; static constexpr bool PERM = true, PREFETCH = false;
    float* P; unsigned* done_cnt;
    __device__ __forceinline__ void operator()(const f32x4 (&acc)[2][2][4][2], const Unit& u, int wr, int wc, int fr, int fq) const {
        const __amdgpu_buffer_rsrc_t rsrc = __builtin_amdgcn_make_buffer_rsrc(P, 0, 128 * 65536 * 4, 0x00020000);
        const unsigned base = ((unsigned)u.aux * 65536u + (unsigned)(wr * 64 + fr) * 256u + (unsigned)(wc * 32 + 8 * fq)) * 4u;
#pragma unroll
        for (int ai = 0; ai < 2; ++ai)
#pragma unroll
            for (int m = 0; m < 4; ++m) { const unsigned rp = base + (unsigned)(ai * HALF + m * 16) * 1024u;
#pragma unroll
                for (int bj = 0; bj < 2; ++bj)
#pragma unroll
                    for (int n = 0; n < 2; ++n) __builtin_amdgcn_raw_buffer_store_b128(__builtin_bit_cast(u32x4, acc[ai][bj][m][n]), rsrc, rp + (unsigned)(bj * HALF + 4 * n) * 4u, 0, 16);
                asm volatile("" ::: "memory"); }
        handoff_signal(done_cnt, fr + 16 * fq);
    }
};
struct CmpOrder {
    int G, c; const char* KC; const char* VC; const char* W1T;
    __device__ __forceinline__ bool next(int i, Unit& u) const { const int L = i * G + c; if (L >= 32) return false; u.pm = 0; u.pn = 0; u.aux = L; return true; }
    __device__ __forceinline__ void ptrs(const Unit& u, const char*& a, const char*& b) const { const int L = u.aux, kv = L >> 4, bg = (L >> 2) & 3, ks = L & 3;
        a = (kv ? VC : KC) + ((size_t)bg * T * 128 + ks * 1024) * 2; b = W1T + ((size_t)kv * 256 * 4096 + ks * 1024) * 2; }
};
}


struct Args {
    const float *x, *c, *w_ada, *b_ada, *norm1_g, *w_in, *b_forget, *fox_q_norm, *fox_k_norm, *nsa_q_norm, *cmp_k_norm, *slc_k_norm, *win_k_norm,
        *cmp_pe_k, *cmp_w1_k, *cmp_w2_k, *cmp_pe_v, *cmp_w1_v, *cmp_w2_v, *w_out, *norm2_g, *w_up, *w_down;
    float* out; unsigned char* ws; int ph_lo, ph_hi;
};

#ifndef DEV_ATT
#define DEV_ATT 3
#endif
namespace att {
typedef float f32x16 __attribute__((ext_vector_type(16)));
typedef short s16x4 __attribute__((ext_vector_type(4)));
constexpr int NW = 8, QBLK = 32, KVBLK = 64, D = 128;
constexpr int SHM_V = KVBLK * D * 2, SHM_K = KVBLK * D * 2;
constexpr int L_V = 0, L_K = 2 * SHM_V, L_WS = 2 * SHM_V + 2 * SHM_K, L_Q = L_WS + 2048;
constexpr int LC_V = 0, LC_K = 65536, LC_WS = 131072, LC_IMP = 133120;
constexpr int L_KB = 133120;
constexpr int L_SEL = 149504;
constexpr float THR = 8.f;
constexpr float C2 = 1.4426950408889634f * SCALE;
enum { M_FOX = 0, M_WIN = 1, M_SLC = 2 };
#define KSWZ(row, colB) ((row) * 256 + ((colB) ^ (((row) & 7) << 4)))
#define SBAR() __builtin_amdgcn_sched_barrier(0)
__device__ __forceinline__ int v_st(int k, int c) { const int kk = (k & ~0xC) | ((k & 4) << 1) | ((k & 8) >> 1); return ((kk >> 3) * 4 + (c >> 5)) * 512 + ((kk & 7) * 32 + (c & 31)) * 2; }
__device__ __forceinline__ int v_rd_base(int lane) { return ((lane & 3) << 3) | (((lane >> 2) & 3) << 6) | (((lane >> 4) & 1) << 5) | (((lane >> 5) & 1) << 8); }
constexpr int v_rd_off(int d0, int ks, int half) { return d0 * 512 + ks * 4096 + half * 2048; }
__device__ __forceinline__ int crow(int r, int hi) { return (r & 3) + 8 * (r >> 2) + 4 * hi; }
__device__ __forceinline__ bf16x8 load8(const bf16_t* p) { return *(const GAS bf16x8*)p; }
__device__ __forceinline__ void mask_tile(f32x16& p0, f32x16& p1, int dq, unsigned W) {
    const float NEG = -__builtin_inff();
#pragma unroll
    for (int r = 0; r < 16; ++r) { const int c = (r & 3) + 8 * (r >> 2);
        if ((unsigned)(dq - c) >= W) p0[r] = NEG;
        if ((unsigned)(dq - c - 32) >= W) p1[r] = NEG; }
}
__device__ __forceinline__ void partialSM(f32x16& p0, f32x16& p1, float& m_reg, float& mn, float& alpha) {
    float pmax = p0[0];
#pragma unroll
    for (int r = 1; r < 16; ++r) pmax = fmaxf(pmax, p0[r]);
#pragma unroll
    for (int r = 0; r < 16; ++r) pmax = fmaxf(pmax, p1[r]);
    { auto rr = __builtin_amdgcn_permlane32_swap(__float_as_uint(pmax), __float_as_uint(pmax), false, false);
      pmax = fmaxf(__uint_as_float(rr[0]), __uint_as_float(rr[1])); }
    if (__builtin_expect(__all((pmax - m_reg) * SCALE <= THR), 1)) { mn = m_reg; alpha = 1.f; }
    else { mn = fmaxf(m_reg, pmax); alpha = __builtin_amdgcn_exp2f((m_reg - mn) * C2); m_reg = mn; }
    const float mnL = -mn * C2;
#pragma unroll
    for (int r = 0; r < 16; ++r) p0[r] = fmaf(p0[r], C2, mnL);
#pragma unroll
    for (int r = 0; r < 16; ++r) p1[r] = fmaf(p1[r], C2, mnL);
#pragma unroll
    for (int r = 0; r < 16; ++r) p0[r] = __builtin_amdgcn_exp2f(p0[r]);
}
#define PK4(P, B_, OUT) do { unsigned a0 = cvt_pk_bf16(P[B_+0], P[B_+1]), a1 = cvt_pk_bf16(P[B_+2], P[B_+3]);                          \
        unsigned b0 = cvt_pk_bf16(P[B_+4], P[B_+5]), b1 = cvt_pk_bf16(P[B_+6], P[B_+7]);                                             \
        auto r0 = __builtin_amdgcn_permlane32_swap(a0, b0, false, false); auto r1 = __builtin_amdgcn_permlane32_swap(a1, b1, false, false); \
        u32x4 w = {r0[0], r1[0], r0[1], r1[1]}; OUT = *reinterpret_cast<bf16x8*>(&w); } while (0)
__device__ __forceinline__ void finishSM(f32x16& p0, f32x16& p1, float alpha, float& l_reg, bf16x8& pa0, bf16x8& pa1, bf16x8& pa2, bf16x8& pa3, bool on = true) {
#pragma unroll
    for (int r = 0; r < 16; ++r) p1[r] = __builtin_amdgcn_exp2f(p1[r]);
    float ps = 0;
#pragma unroll
    for (int r = 0; r < 16; ++r) ps += p0[r];
#pragma unroll
    for (int r = 0; r < 16; ++r) ps += p1[r];
    { auto rr = __builtin_amdgcn_permlane32_swap(__float_as_uint(ps), __float_as_uint(ps), false, false);
      ps = __uint_as_float(rr[0]) + __uint_as_float(rr[1]); }
    l_reg = l_reg * alpha + (on ? ps : 0.f);
    PK4(p0, 0, pa0); PK4(p0, 8, pa1); PK4(p1, 0, pa2); PK4(p1, 8, pa3);
    if (!on) { const bf16x8 z = {0, 0, 0, 0, 0, 0, 0, 0}; pa0 = z; pa1 = z; pa2 = z; pa3 = z; }
}
template <int KB>
__device__ __forceinline__ void qkt(f32x16& p0, f32x16& p1, const LAS char* K_lds, int r32, int hi, const LAS char* qs) {
    const LAS char* kb[4];
#pragma unroll
    for (int dd = 0; dd < 4; ++dd) kb[dd] = K_lds + KB * SHM_K + KSWZ(r32, (dd * 16 + hi * 8) * 2);
#pragma unroll
    for (int d0 = 0; d0 < 8; ++d0) { const LAS char* a = kb[d0 & 3] + (d0 >> 2) * 128;
        const bf16x8 q = *reinterpret_cast<const LAS bf16x8*>(qs + d0 * 1024);
        bf16x8 b0 = *reinterpret_cast<const LAS bf16x8*>(a);
        bf16x8 b1 = *reinterpret_cast<const LAS bf16x8*>(a + 32 * 256);
        p0 = __builtin_amdgcn_mfma_f32_32x32x16_bf16(b0, q, p0, 0, 0, 0);
        p1 = __builtin_amdgcn_mfma_f32_32x32x16_bf16(b1, q, p1, 0, 0, 0); }
}
template <int KB>
__device__ __forceinline__ void qkt_r(f32x16& p0, f32x16& p1, const LAS char* K_lds, int r32, int hi, const bf16x8* qr) {
    const LAS char* kb[4];
#pragma unroll
    for (int dd = 0; dd < 4; ++dd) kb[dd] = K_lds + KB * SHM_K + KSWZ(r32, (dd * 16 + hi * 8) * 2);
#pragma unroll
    for (int d0 = 0; d0 < 8; ++d0) { const LAS char* a = kb[d0 & 3] + (d0 >> 2) * 128;
        bf16x8 b0 = *reinterpret_cast<const LAS bf16x8*>(a);
        bf16x8 b1 = *reinterpret_cast<const LAS bf16x8*>(a + 32 * 256);
        p0 = __builtin_amdgcn_mfma_f32_32x32x16_bf16(b0, qr[d0], p0, 0, 0, 0);
        p1 = __builtin_amdgcn_mfma_f32_32x32x16_bf16(b1, qr[d0], p1, 0, 0, 0); }
}
template <int VB>
__device__ __forceinline__ void pv_tile(f32x16* o, int vb0, bf16x8 pa0, bf16x8 pa1, bf16x8 pa2, bf16x8 pa3) {
#define TRRD(dst, off) asm volatile("ds_read_b64_tr_b16 %0, %1 offset:%2" : "=&v"(dst) : "v"(vb0), "i"(off) : "memory")
#define PV_D0(d0) do { s16x4 l0, l1, l2, l3, h0, h1, h2, h3; constexpr int b_ = VB * SHM_V + v_rd_off(d0, 0, 0); \
        TRRD(l0, b_); TRRD(h0, b_ + 2048); TRRD(l1, b_ + 4096); TRRD(h1, b_ + 6144); TRRD(l2, b_ + 8192); TRRD(h2, b_ + 10240); TRRD(l3, b_ + 12288); TRRD(h3, b_ + 14336); \
        asm volatile("s_waitcnt lgkmcnt(0)" ::: "memory"); SBAR(); \
        o[d0] = __builtin_amdgcn_mfma_f32_32x32x16_bf16(pa0, (bf16x8){l0[0], l0[1], l0[2], l0[3], h0[0], h0[1], h0[2], h0[3]}, o[d0], 0, 0, 0);   \
        o[d0] = __builtin_amdgcn_mfma_f32_32x32x16_bf16(pa1, (bf16x8){l1[0], l1[1], l1[2], l1[3], h1[0], h1[1], h1[2], h1[3]}, o[d0], 0, 0, 0);   \
        o[d0] = __builtin_amdgcn_mfma_f32_32x32x16_bf16(pa2, (bf16x8){l2[0], l2[1], l2[2], l2[3], h2[0], h2[1], h2[2], h2[3]}, o[d0], 0, 0, 0);   \
        o[d0] = __builtin_amdgcn_mfma_f32_32x32x16_bf16(pa3, (bf16x8){l3[0], l3[1], l3[2], l3[3], h3[0], h3[1], h3[2], h3[3]}, o[d0], 0, 0, 0); } while (0)
    PV_D0(0); PV_D0(1); PV_D0(2); PV_D0(3);
#undef PV_D0
#undef TRRD
}

struct Blk {
    const bf16_t* Q;
    const bf16_t* K; const bf16_t* V;
    const float* KB;
    int mode, P0, j_lo, j_hi, b, hb;
};
struct Seam { bf16x8 st_v0, st_v1, st_k0, st_k1; };
__device__ __forceinline__ int q_lane_off(int mode, int wid, int r32) { return mode == M_FOX ? (wid * 32 + r32) * 128 : ((r32 >> 3) * T + wid * 8 + (r32 & 7)) * 128; }
#define ROW(p, k0, rr) ((p) + (size_t)((k0) + (rr)) * D + sc)
#define VMW() asm volatile("s_waitcnt vmcnt(0)" ::: "memory")
#define VMWN(n) asm volatile("s_waitcnt vmcnt(%0)" :: "i"(n) : "memory")
#define SLOAD_H(Kp, Vp, k0) do { S.st_v0 = load8(ROW(Vp, k0, sr)); S.st_v1 = load8(ROW(Vp, k0, 32 + sr)); S.st_k0 = load8(ROW(Kp, k0, sr)); S.st_k1 = load8(ROW(Kp, k0, 32 + sr)); } while (0)
#define SWRITE_HK(bf) do { *(LAS bf16x8*)(K_lds + (bf) * SHM_K + kws) = S.st_k0; *(LAS bf16x8*)(K_lds + (bf) * SHM_K + kws + 32 * 256) = S.st_k1; } while (0)
#define SWRITE_HV(bf) do { *(LAS bf16x8*)(V_lds + (bf) * SHM_V + vst0) = S.st_v0; *(LAS bf16x8*)(V_lds + (bf) * SHM_V + vst1) = S.st_v1; } while (0)
#define SWRITE_H(bf) do { SWRITE_HV(bf); SWRITE_HK(bf); } while (0)
__device__ __forceinline__ void attn_prime(const Blk& cur, LAS char* lds, Seam& S) {
    const int tid = threadIdx.x;
    const int sr = tid >> 4, sc = (tid & 15) * 8, kws = KSWZ(sr, sc * 2); LAS char* K_lds = lds + L_K;
    const int kb0 = cur.j_lo * KVBLK;
    SLOAD_H(cur.K, cur.V, kb0); VMW(); SWRITE_HK(0);
    __syncthreads();
}
struct EpiCtx { bf16_t* AO; float* NSAO; const float* GATES; unsigned* panel_cnt; };
__device__ __forceinline__ void attn_block(const Blk& cur, const Blk& nxt, LAS char* lds, Seam& S, const EpiCtx& ec) {
    int tid = threadIdx.x; asm volatile("" : "+v"(tid));
    const int wid = __builtin_amdgcn_readfirstlane(tid >> 6), lane = tid & 63, r32 = lane & 31, hi = lane >> 5;
    const int mode = cur.mode;
    const int j_lo = cur.j_lo, NT = cur.j_hi - cur.j_lo;
    const int kbn = nxt.j_lo * KVBLK;
    const bool fox = mode == M_FOX;
    const int wlo = cur.P0 + (fox ? wid * 32 : wid * 8), whi = wlo + (fox ? 31 : 7);
    const int pos = cur.P0 + (fox ? wid * 32 + r32 : wid * 8 + (r32 & 7)), qm = pos - 4 * hi;
    const unsigned Wu = (mode == M_WIN) ? 512u : (1u << 30);
    LAS char* V_lds = lds + L_V; LAS char* K_lds = lds + L_K;
    LAS float* ws = (LAS float*)(lds + L_WS) + wid * 64; LAS float* li_l = ws; LAS float* al_l = ws + 32;
    float m_reg = -1e30f, l_reg = 0; f32x16 o[4] = {};
    const int sr = tid >> 4, sc = (tid & 15) * 8, vst0 = v_st(sr, sc), vst1 = v_st(32 + sr, sc), kws = KSWZ(sr, sc * 2);
    const int vb0 = (int)(unsigned)(uintptr_t)V_lds + v_rd_base(lane);
    const bf16_t* Kh = cur.K; const bf16_t* Vh = cur.V;
    unsigned long long sel = ~0ull;
    if (mode == M_SLC) sel = *(const LAS unsigned long long*)(lds + L_SEL + (wid * 8 + (r32 & 7)) * 8);
#define RESC(a_) do { if (__any((a_) < 1.f)) { if (hi == 0) al_l[r32] = (a_); asm volatile("s_waitcnt lgkmcnt(0)" ::: "memory");              \
                     _Pragma("unroll") for (int d_ = 0; d_ < 4; ++d_) _Pragma("unroll") for (int r = 0; r < 16; ++r) o[d_][r] *= al_l[crow(r, hi)]; } } while (0)
#define KBASE(t) ((j_lo + (t)) * KVBLK)
#define PRELOAD(P0_, P1_, t) do { if (fox) { const LAS float* kbp_ = (const LAS float*)(lds + L_KB) + KBASE(t) + 4 * hi; \
            _Pragma("unroll") for (int q_ = 0; q_ < 4; ++q_) { const f32x4 a_ = *(const LAS f32x4*)(kbp_ + 8 * q_), b_ = *(const LAS f32x4*)(kbp_ + 32 + 8 * q_); \
                P0_[4*q_] = a_[0]; P0_[4*q_+1] = a_[1]; P0_[4*q_+2] = a_[2]; P0_[4*q_+3] = a_[3]; P1_[4*q_] = b_[0]; P1_[4*q_+1] = b_[1]; P1_[4*q_+2] = b_[2]; P1_[4*q_+3] = b_[3]; } } \
        else { P0_ = f32x16{}; P1_ = f32x16{}; } } while (0)
#define MASKT(P0_, P1_, t) do { const int kb_ = KBASE(t); \
        if (kb_ + KVBLK - 1 > wlo || kb_ + (int)Wu <= whi) mask_tile(P0_, P1_, qm - kb_, Wu); } while (0)
#define ONT(t) (mode != M_SLC || ((sel >> (j_lo + (t))) & 1ull) != 0ull)
    if (wid >= 4) __builtin_amdgcn_s_setprio(1);
    f32x16 pA0, pA1, pB0, pB1; float mnA, mnB, alA, alB; bf16x8 pa0, pa1, pa2, pa3;
    LAS char* qs = lds + L_Q + wid * 8192 + lane * 16;
    if (mode != M_SLC)
    { const bf16_t* qp = cur.Q + q_lane_off(mode, wid, r32) + hi * 8; bf16x8 tq[8];
#pragma unroll
      for (int d0 = 0; d0 < 8; ++d0) tq[d0] = load8(qp + d0 * 16);
#pragma unroll
      for (int d0 = 0; d0 < 8; ++d0) *(LAS bf16x8*)(qs + d0 * 1024) = tq[d0]; }
    PRELOAD(pA0, pA1, 0);
    SWRITE_HV(0); SBAR();
    if (NT > 1) SLOAD_H(Kh, Vh, KBASE(1));
    SBAR(); qkt<0>(pA0, pA1, K_lds, r32, hi, qs);
    if (NT > 1) PRELOAD(pB0, pB1, 1); else { pB0 = f32x16{}; pB1 = f32x16{}; }
    MASKT(pA0, pA1, 0); partialSM(pA0, pA1, m_reg, mnA, alA);
    if (NT > 1) { VMW(); SWRITE_H(1); }
    __syncthreads();
#define HALF_STEP(PX0, PX1, mnX, alX, PY0, PY1, alY, t, KB_, VB_, SB_) do {                                                      \
        SBAR(); if ((t) + 1 < NT) { SLOAD_H(Kh, Vh, KBASE((t) + 1)); SBAR(); }         \
        qkt<KB_>(PX0, PX1, K_lds, r32, hi, qs);                                             \
        finishSM(PY0, PY1, alY, l_reg, pa0, pa1, pa2, pa3, ONT((t) - 1)); SBAR();                                                           \
        if ((t) + 1 < NT) { PRELOAD(PY0, PY1, (t) + 1); SBAR(); }                                               \
        pv_tile<VB_>(o, vb0, pa0, pa1, pa2, pa3); MASKT(PX0, PX1, (t)); partialSM(PX0, PX1, m_reg, mnX, alX);                                        \
        __syncthreads();                                                                                                      \
        if ((t) + 1 < NT) { VMW(); SWRITE_H(SB_); }                                                                          \
        RESC(alX); __syncthreads(); } while (0)
    for (int t = 1; t + 1 < NT; t += 2) {
        HALF_STEP(pB0, pB1, mnB, alB, pA0, pA1, alA, t, 1, 0, 0);
        HALF_STEP(pA0, pA1, mnA, alA, pB0, pB1, alB, t + 1, 0, 1, 1);
    }
    const bool even = (NT & 1) == 0;
    if (even) { SBAR(); qkt<1>(pB0, pB1, K_lds, r32, hi, qs); SBAR(); }
    SLOAD_H(nxt.K, nxt.V, kbn); SBAR();
    SBAR();
    finishSM(pA0, pA1, alA, l_reg, pa0, pa1, pa2, pa3, ONT(even ? NT - 2 : NT - 1)); SBAR();
    pv_tile<0>(o, vb0, pa0, pa1, pa2, pa3);
    if (even) { MASKT(pB0, pB1, NT - 1); partialSM(pB0, pB1, m_reg, mnB, alB); __syncthreads(); RESC(alB);
        finishSM(pB0, pB1, alB, l_reg, pa0, pa1, pa2, pa3, ONT(NT - 1)); SBAR(); pv_tile<1>(o, vb0, pa0, pa1, pa2, pa3); }
    SBAR(); VMW(); SWRITE_HK(0); SBAR();
    if (hi == 0) li_l[r32] = l_reg; asm volatile("s_waitcnt lgkmcnt(0)" ::: "memory");
    if (fox) {
        bf16_t* Ow = ec.AO + ((size_t)cur.b * T + cur.P0 + wid * QBLK) * DM + cur.hb * 128;
#pragma unroll
        for (int r = 0; r < 16; ++r) { const int orow = crow(r, hi); const float li = li_l[orow]; const float rl = li > 0.f ? __builtin_amdgcn_rcpf(li) : 0.f;
#pragma unroll
            for (int d0 = 0; d0 < 4; ++d0) { const float v = o[d0][r] * rl; const float vn = __shfl_xor(v, 1);
                if ((r32 & 1) == 0) *(GAS unsigned*)(Ow + (size_t)orow * DM + d0 * 32 + r32) = cvt_pk_bf16(v, vn); } }
    } else {
        const int br = (mode == M_WIN) ? 2 : 1;
#pragma unroll
        for (int h8 = 0; h8 < 2; ++h8) {
            float gv[8]; float av[8][4], bv[8][4];
#pragma unroll
            for (int q = 0; q < 8; ++q) { const int rho = crow(h8 * 8 + q, hi);
                const int tok = cur.P0 + wid * 8 + (rho & 7), head = cur.hb + (rho >> 3); const size_t trow = (size_t)cur.b * T + tok;
                gv[q] = ((const GAS float*)ec.GATES)[trow * 24 + head * 3 + br];
                if (mode == M_SLC) { const GAS float* np = (const GAS float*)(ec.NSAO + trow * 1024 + head * 128 + r32); const GAS float* np2 = np + (ptrdiff_t)((WS_PART - WS_NSAO) / 4);
#pragma unroll
                    for (int d0 = 0; d0 < 4; ++d0) { av[q][d0] = np[d0 * 32]; bv[q][d0] = np2[d0 * 32]; } }
                else {
#pragma unroll
                    for (int d0 = 0; d0 < 4; ++d0) { av[q][d0] = 0.f; bv[q][d0] = 0.f; } } }
#pragma unroll
            for (int q = 0; q < 8; ++q) { const int r = h8 * 8 + q; const int rho = crow(r, hi); const float li = li_l[rho]; const float rl = li > 0.f ? __builtin_amdgcn_rcpf(li) : 0.f;
                const int tok = cur.P0 + wid * 8 + (rho & 7), head = cur.hb + (rho >> 3); const size_t trow = (size_t)cur.b * T + tok;
                const float gt = gv[q] * rl;
                GAS float* np2 = (GAS float*)(ec.NSAO + trow * 1024 + head * 128 + r32 + (ptrdiff_t)((WS_PART - WS_NSAO) / 4));
#pragma unroll
                for (int d0 = 0; d0 < 4; ++d0) {
                    if (mode == M_WIN) np2[d0 * 32] = gt * o[d0][r];
                    else { const float v = av[q][d0] + bv[q][d0] + gt * o[d0][r]; const float vn = __shfl_xor(v, 1); if ((r32 & 1) == 0) *(GAS unsigned*)(ec.AO + trow * DM + 1024 + head * 128 + d0 * 32 + r32) = cvt_pk_bf16(v, vn); } } }
            asm volatile("" ::: "memory"); }
    }
    __builtin_amdgcn_s_setprio(0);
    __syncthreads();
#undef RESC
#undef KBASE
#undef PRELOAD
#undef MASKT
#undef ONT
#undef HALF_STEP
}
#undef ROW
#undef SLOAD_H
#undef SWRITE_HK
#undef SWRITE_HV
#undef SWRITE_H

__device__ __forceinline__ bf16x8 ovfrag(int n0, int J) {
    asm volatile("" : "+v"(n0));
    unsigned w[4];
#pragma unroll
    for (int q = 0; q < 4; ++q) { unsigned lohi[2];
#pragma unroll
        for (int e = 0; e < 2; ++e) { const int dl = n0 + 2 * q + e - 4 * J; lohi[e] = (dl >= 0 && dl <= 2) ? 0x3F80u : ((dl == 3 || dl == -1) ? 0x3F00u : 0u); }
        w[q] = lohi[0] | (lohi[1] << 16); }
    u32x4 v = {w[0], w[1], w[2], w[3]}; return *reinterpret_cast<bf16x8*>(&v);
}
__device__ __forceinline__ void nsa_cmp_item(int b, int g, int qb, const bf16_t* NQ, const bf16_t* KCMP, const bf16_t* VCMP, const float* GATES, const float* mbound, float* NSAO, LAS char* lds) {
    int tid = threadIdx.x; asm volatile("" : "+v"(tid));
    const int wid = __builtin_amdgcn_readfirstlane(tid >> 6), lane = tid & 63, r32 = lane & 31, hi = lane >> 5;
    LAS char* V_lds = lds + LC_V; LAS char* K_lds = lds + LC_K;
    LAS float* ws = (LAS float*)(lds + LC_WS) + wid * 64; LAS float* li_l = ws;
    LAS float* impL = (LAS float*)(lds + LC_IMP);
    const int sr = tid >> 4, sc = (tid & 15) * 8, vst0 = v_st(sr, sc), vst1 = v_st(32 + sr, sc), kws = KSWZ(sr, sc * 2);
    const bf16_t* Kc = KCMP + (size_t)(b * 2 + g) * 256 * 128; const bf16_t* Vc = VCMP + (size_t)(b * 2 + g) * 256 * 128;
    const int ntile = ((4 * qb + 2) >> 6) + 1;
    bf16x8 qr[8];
    { const bf16_t* qp = NQ + (((size_t)b * 8 + g * 4) * T + qb * 64) * 128 + q_lane_off(M_WIN, wid, r32) + hi * 8;
#pragma unroll
      for (int d0 = 0; d0 < 8; ++d0) qr[d0] = load8(qp + d0 * 16); }
    {
        bf16x8 kk[4][2], vv[4][2];
#pragma unroll
        for (int tl = 0; tl < 4; ++tl) { kk[tl][0] = load8(Kc + (size_t)(tl * 64 + sr) * 128 + sc); kk[tl][1] = load8(Kc + (size_t)(tl * 64 + 32 + sr) * 128 + sc); }
#pragma unroll
        for (int tl = 0; tl < 4; ++tl) { vv[tl][0] = load8(Vc + (size_t)(tl * 64 + sr) * 128 + sc); vv[tl][1] = load8(Vc + (size_t)(tl * 64 + 32 + sr) * 128 + sc); }
#pragma unroll
        for (int tl = 0; tl < 4; ++tl) { *(LAS bf16x8*)(K_lds + tl * SHM_K + kws) = kk[tl][0]; *(LAS bf16x8*)(K_lds + tl * SHM_K + kws + 32 * 256) = kk[tl][1]; }
#pragma unroll
        for (int tl = 0; tl < 4; ++tl) { *(LAS bf16x8*)(V_lds + tl * SHM_V + vst0) = vv[tl][0]; *(LAS bf16x8*)(V_lds + tl * SHM_V + vst1) = vv[tl][1]; }
        asm volatile("" ::: "memory");
    }
    __syncthreads();
    const int pos = qb * 64 + wid * 8 + (r32 & 7);
    const int nmax = (pos - 31) >> 4;
    const float NEG = -__builtin_inff();
#define CMASK(P0_, P1_, tl) do { _Pragma("unroll") for (int r = 0; r < 16; ++r) { const int n_ = (tl) * 64 + crow(r, hi); if (n_ > nmax) P0_[r] = NEG; if (n_ + 32 > nmax) P1_[r] = NEG; } } while (0)
    const float mL = -(*(const GAS float*)mbound) * C2;
    float l_reg = 0.f;
    const int vb0 = (int)(unsigned)(uintptr_t)V_lds + v_rd_base(lane);
    f32x16 o[4] = {}; f32x16 io[2] = {};
#pragma nounroll
    for (int tl = 0; tl < ntile; ++tl) { f32x16 p0 = f32x16{}, p1 = f32x16{}; qkt_r<0>(p0, p1, K_lds + tl * SHM_K, r32, hi, qr); CMASK(p0, p1, tl);
        float ps = 0.f;
#pragma unroll
        for (int r = 0; r < 16; ++r) { p0[r] = __builtin_amdgcn_exp2f(fmaf(p0[r], C2, mL)); p1[r] = __builtin_amdgcn_exp2f(fmaf(p1[r], C2, mL)); ps += p0[r] + p1[r]; }
        l_reg += ps; bf16x8 pa0, pa1, pa2, pa3; PK4(p0, 0, pa0); PK4(p0, 8, pa1); PK4(p1, 0, pa2); PK4(p1, 8, pa3);
        pv_tile<0>(o, vb0 + tl * SHM_V, pa0, pa1, pa2, pa3); SBAR();
#pragma unroll
        for (int d0 = 0; d0 < 2; ++d0) { const int J = d0 * 32 + r32;
            io[d0] = __builtin_amdgcn_mfma_f32_32x32x16_bf16(pa0, ovfrag(tl * 64 + 0 + 8 * hi, J), io[d0], 0, 0, 0);
            io[d0] = __builtin_amdgcn_mfma_f32_32x32x16_bf16(pa1, ovfrag(tl * 64 + 16 + 8 * hi, J), io[d0], 0, 0, 0);
            io[d0] = __builtin_amdgcn_mfma_f32_32x32x16_bf16(pa2, ovfrag(tl * 64 + 32 + 8 * hi, J), io[d0], 0, 0, 0);
            io[d0] = __builtin_amdgcn_mfma_f32_32x32x16_bf16(pa3, ovfrag(tl * 64 + 48 + 8 * hi, J), io[d0], 0, 0, 0); } SBAR(); }
    { auto rr = __builtin_amdgcn_permlane32_swap(__float_as_uint(l_reg), __float_as_uint(l_reg), false, false); l_reg = __uint_as_float(rr[0]) + __uint_as_float(rr[1]); }
    if (hi == 0) li_l[r32] = l_reg; asm volatile("s_waitcnt lgkmcnt(0)" ::: "memory");
    {
        float gv[16];
#pragma unroll
        for (int r = 0; r < 16; ++r) { const int rho = crow(r, hi); gv[r] = ((const GAS float*)GATES)[((size_t)b * T + qb * 64 + wid * 8 + (rho & 7)) * 24 + (g * 4 + (rho >> 3)) * 3 + 0]; }
        float imps[2][4] = {};
#pragma unroll
        for (int r = 0; r < 16; ++r) { const int rho = crow(r, hi); const float li = li_l[rho]; const float rl = li > 0.f ? __builtin_amdgcn_rcpf(li) : 0.f;
            const int tok = qb * 64 + wid * 8 + (rho & 7), head = g * 4 + (rho >> 3);
            const size_t trow = (size_t)b * T + tok;
            const float gt = gv[r] * rl;
            GAS float* np = (GAS float*)(NSAO + trow * 1024 + head * 128 + r32);
#pragma unroll
            for (int d0 = 0; d0 < 4; ++d0) np[d0 * 32] = gt * o[d0][r];
            imps[0][r & 3] += io[0][r] * rl; imps[1][r & 3] += io[1][r] * rl; }
#pragma unroll
        for (int d0 = 0; d0 < 2; ++d0)
#pragma unroll
            for (int e = 0; e < 4; ++e) impL[(wid * 8 + e + 4 * hi) * 64 + d0 * 32 + r32] = imps[d0][e];
    }
#undef CMASK
    __syncthreads();
#pragma nounroll
    for (int tk = 0; tk < 8; ++tk) { const int tl = wid * 8 + tk; const int J = lane;
        const float im = impL[tl * 64 + J];
        const bool forced = (J == 0) || (J == qb) || (J == qb - 1);
        const float v = forced ? __builtin_inff() : (J <= qb ? im : NEG);
        impL[tl * 64 + J] = v; asm volatile("s_waitcnt lgkmcnt(0)" ::: "memory");
        f32x4 uv[16];
#pragma unroll
        for (int q = 0; q < 16; ++q) uv[q] = *(const LAS f32x4*)(impL + tl * 64 + 4 * q);
        int rank = 0;
#pragma unroll
        for (int q = 0; q < 16; ++q)
#pragma unroll
            for (int e = 0; e < 4; ++e) { const float u = uv[q][e]; const int jj = 4 * q + e; rank += (u > v || (u == v && jj < J)) ? 1 : 0; }
        const unsigned long long mk = __ballot(rank < 16 && J <= qb);
        if (lane == 0) *(LAS unsigned long long*)(lds + L_SEL + tl * 8) = mk; }
    __syncthreads();
}
#undef PK4
#undef VMW
#undef VMWN

template <class P> __device__ __forceinline__ P* uptr(P* p) { const unsigned long long v = (unsigned long long)p;
    const unsigned lo = __builtin_amdgcn_readfirstlane((unsigned)v), hi = __builtin_amdgcn_readfirstlane((unsigned)(v >> 32)); return (P*)(((unsigned long long)hi << 32) | lo); }
__device__ __forceinline__ Blk make_blk(unsigned char* ws, int i, int st) {
    const int bg = i >> 6, qb = i & 63, b = bg >> 1, g = bg & 1; Blk k;
    if (st < 2) {
        k.Q = uptr((const bf16_t*)(ws + WS_NQR) + (((size_t)b * 8 + g * 4) * T + qb * 64) * 128);
        k.K = uptr((const bf16_t*)(ws + (st == 0 ? WS_KW : WS_KSL)) + (size_t)bg * T * 128); k.V = uptr((const bf16_t*)(ws + (st == 0 ? WS_VW : WS_VSL)) + (size_t)bg * T * 128);
        k.KB = nullptr; k.mode = st == 0 ? M_WIN : M_SLC; k.P0 = qb * 64; k.j_lo = (st == 0 && qb >= 8) ? qb - 8 : 0; k.j_hi = qb + 1; k.b = b; k.hb = g * 4;
    } else {
        const int bh = bg * 4 + (qb & 3), qf = 15 - (qb >> 2);
        k.Q = uptr((const bf16_t*)(ws + WS_FQ) + ((size_t)bh * T + qf * 256) * 128); k.K = uptr((const bf16_t*)(ws + WS_FK) + (size_t)bh * T * 128); k.V = uptr((const bf16_t*)(ws + WS_FV) + (size_t)bh * T * 128);
        k.KB = uptr((const float*)(ws + WS_KBIAS) + (size_t)bh * T); k.mode = M_FOX; k.P0 = qf * 256; k.j_lo = 0; k.j_hi = 4 * qf + 4; k.b = bh >> 3; k.hb = bh & 7;
    }
    k.mode = __builtin_amdgcn_readfirstlane(k.mode); k.P0 = __builtin_amdgcn_readfirstlane(k.P0); k.j_lo = __builtin_amdgcn_readfirstlane(k.j_lo); k.j_hi = __builtin_amdgcn_readfirstlane(k.j_hi);
    k.b = __builtin_amdgcn_readfirstlane(k.b); k.hb = __builtin_amdgcn_readfirstlane(k.hb);
    return k;
}
__device__ __forceinline__ void compute_kb(unsigned char* ws, int bh, LAS char* lds) {
    int tid = threadIdx.x; asm volatile("" : "+v"(tid));
    LAS double* part = (LAS double*)(lds + LC_IMP);
    const float* lf = (const float*)(ws + WS_LOGF) + (size_t)bh * T + tid * 8; float* kb = (float*)(ws + WS_KBIAS) + (size_t)bh * T + tid * 8;
    const f32x4 v0 = *(const f32x4*)lf, v1 = *(const f32x4*)(lf + 4);
    double loc[8]; double run = 0.0;
    { const float vv[8] = {v0[0], v0[1], v0[2], v0[3], v1[0], v1[1], v1[2], v1[3]};
#pragma unroll
      for (int i = 0; i < 8; ++i) { run += (double)vv[i]; loc[i] = run; } }
    const int lane = tid & 63, wv = tid >> 6; double inc = run;
#pragma unroll
    for (int o = 1; o < 64; o <<= 1) { const double up = __shfl_up(inc, o); if (lane >= o) inc += up; }
    if (lane == 63) part[wv] = inc;
    __syncthreads();
    double off = inc - run;
    for (int w = 0; w < wv; ++w) off += part[w];
    f32x4 o0, o1;
#pragma unroll
    for (int i = 0; i < 4; ++i) { o0[i] = (float)(-(off + loc[i]) * (double)(1.0f / SCALE)); o1[i] = (float)(-(off + loc[4 + i]) * (double)(1.0f / SCALE)); }
    *(f32x4*)kb = o0; *(f32x4*)(kb + 4) = o1;
    asm volatile("s_waitcnt vmcnt(0)" ::: "memory");
    __syncthreads();
}
__device__ __forceinline__ void stage_kb(const float* kbg, LAS char* lds) {
    int tid = threadIdx.x; asm volatile("" : "+v"(tid));
    const f32x4 v0 = *(const GAS f32x4*)(kbg + tid * 8), v1 = *(const GAS f32x4*)(kbg + tid * 8 + 4);
    LAS float* kl = (LAS float*)(lds + L_KB) + tid * 8;
    *(LAS f32x4*)kl = v0; *(LAS f32x4*)(kl + 4) = v1;
    __syncthreads();
}
__device__ __forceinline__ void attn_phase(const Args& a, LAS char* lds, int vcu, int G) {
    unsigned char* ws = a.ws;
    EpiCtx ec{(bf16_t*)(ws + WS_AO), (float*)(ws + WS_NSAO), (const float*)(ws + WS_GATES), (unsigned*)(ws + CTL_CNT_ATTN)};
    Seam S;
    constexpr int ST0 = (DEV_ATT == 1) ? 2 : 0, ST1 = (DEV_ATT == 2) ? 2 : 3;
    for (int i = vcu; i < 256; i += G) {
#ifndef NO_CMP
        if (DEV_ATT & 2) { const int bg = i >> 6, qb = i & 63; nsa_cmp_item(bg >> 1, bg & 1, qb, (const bf16_t*)(ws + WS_NQ), (const bf16_t*)(ws + WS_KCMP), (const bf16_t*)(ws + WS_VCMP), ec.GATES, (const float*)(ws + WS_MBOUND), ec.NSAO, lds); }
#endif
#ifndef NO_BLK
        Blk cur = make_blk(ws, i, ST0);
        attn_prime(cur, lds, S);
        for (int st = ST0; st < ST1; ++st) { const Blk nxt = make_blk(ws, i, st + 1 < ST1 ? st + 1 : st);
            if (st == 1) { const int tid_ = threadIdx.x, w_ = __builtin_amdgcn_readfirstlane(tid_ >> 6), l_ = tid_ & 63; const float* kbg = (const float*)(ws + WS_KBIAS) + (size_t)((i >> 6) * 4 + (i & 3)) * T;
#pragma unroll
                for (int h_ = 0; h_ < 2; ++h_) __builtin_amdgcn_global_load_lds((const unsigned*)(kbg + (w_ * 2 + h_) * 256 + l_ * 4), (LAS unsigned*)(lds + L_KB + (w_ * 2 + h_) * 1024), 16, 0, 0); }
            if (st == 2) { asm volatile("s_waitcnt vmcnt(0)" ::: "memory"); __syncthreads(); }
            attn_block(cur, nxt, lds, S, ec); cur = nxt; }
#endif
    }
}
#undef KSWZ
#undef SBAR
}


__device__ __forceinline__ int win_src_col(int pg) {
    const int pn = pg >> 8, p = pg & 255;
    if (pn == 12) { if (p < 8) return C_FZ + p; if (p < 32) return C_GZ + p - 8; return -1; }
    const int bj = p >> 7, q = p & 127;
    const int d = 16 * (q >> 5) + 4 * ((q >> 3) & 3) + (q & 3) + 64 * ((q >> 2) & 1);
    int base;
    if (pn < 4) base = C_FQ + pn * 256; else if (pn < 8) base = C_FK + (pn - 4) * 256; else if (pn < 12) base = C_FV + (pn - 8) * 256;
    else if (pn < 17) base = C_NQ + (pn - 13) * 256; else if (pn == 17) base = C_KC; else if (pn == 18) base = C_VC; else if (pn == 19) base = C_KSL;
    else if (pn == 20) base = C_KW; else if (pn == 21) base = C_VSL; else base = C_VW;
    return base + bj * 128 + d;
}
template <int SRC>
__device__ __forceinline__ void transpose_item(const float* W, int K, int N, bf16_t* WT, LAS float* scr, int item, int nblk, int lane) {
    const int kb = item / nblk, nb = item % nblk, k0 = 64 * kb, n0 = 32 * nb;
    int sc = n0 + (lane & 31); if (SRC == 1) sc = win_src_col(sc);
    float tv[32];
    const float* wp = W + (size_t)(k0 + (lane >> 5)) * N + (sc >= 0 ? sc : 0);
#pragma unroll
    for (int i = 0; i < 32; ++i) tv[i] = wp[(size_t)(2 * i) * N];
#pragma unroll
    for (int i = 0; i < 32; ++i) { const int kk = 2 * i + (lane >> 5); scr[kk * 33 + (lane & 31)] = sc >= 0 ? tv[i] : 0.f; }
    asm volatile("s_waitcnt lgkmcnt(0)" ::: "memory");
    const int cch = lane & 7;
#pragma unroll
    for (int j = 0; j < 4; ++j) { const int n = (lane >> 3) + 8 * j; const LAS float* s = scr + (8 * cch) * 33 + n;
        u32x4 o; o.x = cvt_pk_bf16(s[0 * 33], s[1 * 33]); o.y = cvt_pk_bf16(s[2 * 33], s[3 * 33]); o.z = cvt_pk_bf16(s[4 * 33], s[5 * 33]); o.w = cvt_pk_bf16(s[6 * 33], s[7 * 33]);
        *(u32x4*)(WT + (size_t)(n0 + n) * K + k0 + 8 * cch) = o; }
    asm volatile("s_waitcnt lgkmcnt(0)" ::: "memory");
}

__device__ __forceinline__ void p0_prologue(const Args& a, LAS unsigned char* lds, int vcu, int G) {
    int tid = threadIdx.x; asm volatile("" : "+v"(tid)); const int lane = tid & 63, wave = __builtin_amdgcn_readfirstlane(tid >> 6);
    LAS float* ca = (LAS float*)lds;
    for (int i = tid; i < 2 * DM; i += NTHR) { const float v = a.c[i]; ca[i] = v / (1.f + __expf(-v)); }
    __syncthreads();
    const int gw = vcu * NWAVES + wave, NGW = G * NWAVES;
    float* modp = (float*)(a.ws + WS_MODP);
    if (wave < 3) { const int it = vcu * 3 + wave;
        if (it < 16 * 48) { const int kc = it / 48, cq = (it % 48) * 64 + lane;
            f32x4 a0 = (f32x4){0.f, 0.f, 0.f, 0.f}, a1 = a0;
            const float* wp = a.w_ada + (size_t)(kc * 128) * (6 * DM) + 4 * cq;
#pragma unroll 16
            for (int k = 0; k < 128; ++k) { const f32x4 w = *(const f32x4*)(wp + (size_t)k * (6 * DM)); a0 += w * ca[kc * 128 + k]; a1 += w * ca[DM + kc * 128 + k]; }
            const __amdgpu_buffer_rsrc_t rsrc = __builtin_amdgcn_make_buffer_rsrc(modp, 0, 16 * 2 * 6 * DM * 4, 0x00020000);
            __builtin_amdgcn_raw_buffer_store_b128(__builtin_bit_cast(u32x4, a0), rsrc, (unsigned)((((size_t)kc * 2 + 0) * (6 * DM) + 4 * cq) * 4), 0, 16);
            __builtin_amdgcn_raw_buffer_store_b128(__builtin_bit_cast(u32x4, a1), rsrc, (unsigned)((((size_t)kc * 2 + 1) * (6 * DM) + 4 * cq) * 4), 0, 16);
            handoff_signal((unsigned*)(a.ws + CTL_CNT_ADALN), lane); } }
    LAS float* scr = (LAS float*)(lds + 16384 + wave * 16384);
    constexpr int I_IN = 32 * (NPAD / 32), I_OUT = 32 * 64, I_UP = 32 * 256, I_DN = 128 * 64, I_W1 = 64 * 8, I_W2 = 4 * 4;
    constexpr int NIT = I_IN + I_OUT + I_UP + I_DN + 2 * I_W1 + 2 * I_W2;
    const int nslot = (NIT + G - 1) / G;
    for (int m = 0;; ++m) { int j; if (wave < 3) { if (m >= 6) break; j = wave * 6 + m; } else { j = 18 + (wave - 3) + 5 * m; }
        if (j >= nslot) break; const int it = vcu + G * j; if (it >= NIT) break; int r = it;
        if (r < I_IN) { transpose_item<1>(a.w_in, DM, DIN, (bf16_t*)(a.ws + WS_WIN), scr, r, NPAD / 32, lane); continue; } r -= I_IN;
        if (r < I_OUT) { transpose_item<0>(a.w_out, DM, DM, (bf16_t*)(a.ws + WS_WOUT), scr, r, 64, lane); continue; } r -= I_OUT;
        if (r < I_UP) { transpose_item<0>(a.w_up, DM, DFF, (bf16_t*)(a.ws + WS_WUP), scr, r, 256, lane); continue; } r -= I_UP;
        if (r < I_DN) { transpose_item<0>(a.w_down, DFF, DM, (bf16_t*)(a.ws + WS_WDN), scr, r, 64, lane); continue; } r -= I_DN;
        if (r < I_W1) { transpose_item<0>(a.cmp_w1_k, 4096, 256, (bf16_t*)(a.ws + WS_W1T), scr, r, 8, lane); continue; } r -= I_W1;
        if (r < I_W1) { transpose_item<0>(a.cmp_w1_v, 4096, 256, (bf16_t*)(a.ws + WS_W1T) + 256 * 4096, scr, r, 8, lane); continue; } r -= I_W1;
        if (r < I_W2) { transpose_item<0>(a.cmp_w2_k, 256, 128, (bf16_t*)(a.ws + WS_W2T), scr, r, 4, lane); continue; } r -= I_W2;
        transpose_item<0>(a.cmp_w2_v, 256, 128, (bf16_t*)(a.ws + WS_W2T) + 128 * 256, scr, r, 4, lane);
    }
    if (vcu == 255 && wave == 7) { const float gk = fmaxf(fabsf(a.cmp_k_norm[lane]), fabsf(a.cmp_k_norm[64 + lane])), gq = fmaxf(fabsf(a.nsa_q_norm[lane]), fabsf(a.nsa_q_norm[64 + lane]));
        const float mb = wave_max(gk) * wave_max(gq) * (128.f * 1.02f); if (lane == 0) *(float*)(a.ws + WS_MBOUND) = mb; }
    float* rope = (float*)(a.ws + WS_ROPE);
    for (int e = (vcu * NTHR + tid); e < T * 64; e += G * NTHR) { const int t = e >> 6, i = e & 63;
        const float inv_freq = (float)pow(10000.0, -(double)i / 64.0); const float ang = (float)t * inv_freq;
        rope[2 * e] = (float)cos((double)ang); rope[2 * e + 1] = (float)sin((double)ang); }
    float* pebp = (float*)(a.ws + WS_PEBP);
    for (int it = gw; it < 2 * 4 * 64; it += NGW) { const int kv = it >> 8, cg_ = (it >> 6) & 3, ch = it & 63, col = cg_ * 64 + lane;
        const float* pe = kv ? a.cmp_pe_v : a.cmp_pe_k; const float* w1 = kv ? a.cmp_w1_v : a.cmp_w1_k; float s = 0.f;
#pragma unroll
        for (int i = 0; i < 64; ++i) s += pe[ch * 64 + i] * w1[(size_t)(ch * 64 + i) * 256 + col];
        pebp[((size_t)kv * 64 + ch) * 256 + col] = s; }
}

template <bool FIRST>
__device__ __forceinline__ void norm_phase(const Args& a, LAS unsigned char* lds, const float* xsrc, const float* gain, int shift_off, int scale_off, int bid, int G) {
    int tid = threadIdx.x; asm volatile("" : "+v"(tid)); const int lane = tid & 63, wave = __builtin_amdgcn_readfirstlane(tid >> 6);
    LAS float* AS = (LAS float*)lds; LAS float* SH = AS + DM;
    const float* modp = (const float*)(a.ws + WS_MODP); float* mod = (float*)(a.ws + WS_MOD);
    const int rows_per = M / G, b = (bid * rows_per) / T;
    f32x4 v[4][8];
#pragma unroll
    for (int rr = 0; rr < 4; ++rr) { const f32x4* xr = (const f32x4*)(xsrc + (size_t)(bid * rows_per + wave + 8 * rr) * DM) + lane;
#pragma unroll
        for (int j = 0; j < 8; ++j) v[rr][j] = xr[64 * j]; }
    if (FIRST) handoff_wait((unsigned*)(a.ws + CTL_CNT_ADALN), 16u * 48u);
    for (int d = tid; d < DM; d += NTHR) { float sc, sh;
        if (FIRST) { sc = a.b_ada[scale_off + d]; sh = a.b_ada[shift_off + d];
#pragma unroll
            for (int kc = 0; kc < 16; ++kc) { sc += modp[((size_t)kc * 2 + b) * (6 * DM) + scale_off + d]; sh += modp[((size_t)kc * 2 + b) * (6 * DM) + shift_off + d]; } }
        else { sc = mod[b * 6 * DM + scale_off + d]; sh = mod[b * 6 * DM + shift_off + d]; }
        AS[d] = gain[d] * (1.f + sc); SH[d] = sh; }
    if (FIRST) {
        for (int e = bid * NTHR + tid; e < 2 * 6 * DM; e += G * NTHR) { const int bb = e / (6 * DM), j = e % (6 * DM); float s = a.b_ada[j];
#pragma unroll
            for (int kc = 0; kc < 16; ++kc) s += modp[((size_t)kc * 2 + bb) * (6 * DM) + j];
            mod[e] = s; }
    }
    __syncthreads();
    bf16_t* XN = (bf16_t*)(a.ws + WS_XN);
    for (int r0 = 0; r0 < rows_per; r0 += 32) {
        if (r0 > 0) {
#pragma unroll
            for (int rr = 0; rr < 4; ++rr) { const f32x4* xr = (const f32x4*)(xsrc + (size_t)(bid * rows_per + r0 + wave + 8 * rr) * DM) + lane;
#pragma unroll
                for (int j = 0; j < 8; ++j) v[rr][j] = xr[64 * j]; } }
#pragma unroll
        for (int rr = 0; rr < 4; ++rr) { const int row = bid * rows_per + r0 + wave + 8 * rr; float ss = 0.f;
#pragma unroll
            for (int j = 0; j < 8; ++j) ss += (v[rr][j][0] * v[rr][j][0] + v[rr][j][1] * v[rr][j][1]) + (v[rr][j][2] * v[rr][j][2] + v[rr][j][3] * v[rr][j][3]);
            const float rstd = 1.0f / sqrtf(wave_sum(ss) * (1.f / DM) + EPS);
            u32x2* o8 = (u32x2*)(XN + (size_t)row * DM) + lane;
#pragma unroll
            for (int j = 0; j < 8; ++j) { const f32x4 as = *(const LAS f32x4*)(AS + 4 * lane + 256 * j), sh = *(const LAS f32x4*)(SH + 4 * lane + 256 * j);
                const f32x4 h = v[rr][j] * rstd * as + sh; u32x2 w; w.x = cvt_pk_bf16(h[0], h[1]); w.y = cvt_pk_bf16(h[2], h[3]); o8[64 * j] = w; } }
    }
    __syncthreads();
}


__device__ __forceinline__ void cmp2_phase(const Args& a, LAS unsigned char* lds, int L0, int Lstride) {
    int tid = threadIdx.x; asm volatile("" : "+v"(tid)); const int lane = tid & 63, wave = __builtin_amdgcn_readfirstlane(tid >> 6);
    unsigned char* ws = a.ws;
    for (int L = L0; L < 64; L += Lstride) {
        {
            const int kv = L >> 5, bg = (L >> 3) & 3, rt = L & 7;
            LAS bf16_t* hidL = (LAS bf16_t*)lds;
            LAS float* red = (LAS float*)(lds + 32768);
            LAS float* pebL = (LAS float*)(lds + 36864);
            if (tid < 256) { const float* pebp = (const float*)(ws + WS_PEBP) + (size_t)kv * 64 * 256 + tid; float sp = 0.f;
#pragma unroll
                for (int ch = 0; ch < 64; ++ch) sp += pebp[ch * 256];
                pebL[tid] = sp; }
            __syncthreads();
            { const int row = tid >> 4, c0 = (tid & 15) * 16;
              const float* pp = (const float*)(ws + WS_PART) + ((size_t)(kv * 4 + bg) * 4) * 65536 + (size_t)(rt * 32 + row) * 256 + c0;
              const LAS float* peb = pebL + c0;
              f32x4 s0 = *(const LAS f32x4*)peb, s1 = *(const LAS f32x4*)(peb + 4), s2 = *(const LAS f32x4*)(peb + 8), s3 = *(const LAS f32x4*)(peb + 12);
#pragma unroll 4
              for (int ks = 0; ks < 4; ++ks) { const float* q = pp + (size_t)ks * 65536; s0 += *(const f32x4*)q; s1 += *(const f32x4*)(q + 4); s2 += *(const f32x4*)(q + 8); s3 += *(const f32x4*)(q + 12); }
              f32x4 sv[4] = {s0, s1, s2, s3}; unsigned w[8];
#pragma unroll
              for (int i = 0; i < 4; ++i) { f32x4 v = sv[i];
#pragma unroll
                  for (int e = 0; e < 4; ++e) v[e] = v[e] / (1.f + __expf(-v[e]));
                  w[2 * i] = cvt_pk_bf16(v[0], v[1]); w[2 * i + 1] = cvt_pk_bf16(v[2], v[3]); }
              *(LAS u32x4*)(hidL + row * 264 + c0) = (u32x4){w[0], w[1], w[2], w[3]}; *(LAS u32x4*)(hidL + row * 264 + c0 + 8) = (u32x4){w[4], w[5], w[6], w[7]}; }
            __syncthreads();
            const int fr = lane & 15, fq = lane >> 4;
            f32x4 acc[2] = {(f32x4){0.f, 0.f, 0.f, 0.f}, (f32x4){0.f, 0.f, 0.f, 0.f}};
            const bf16_t* w2 = (const bf16_t*)(ws + WS_W2T) + (size_t)kv * 128 * 256 + (size_t)(16 * wave + fr) * 256 + 8 * fq;
#pragma unroll
            for (int ks = 0; ks < 8; ++ks) { const bf16x8 bf = *(const bf16x8*)(w2 + ks * 32);
#pragma unroll
                for (int rg = 0; rg < 2; ++rg) { const bf16x8 af = *(const LAS bf16x8*)(hidL + (rg * 16 + fr) * 264 + ks * 32 + 8 * fq);
                    acc[rg] = __builtin_amdgcn_mfma_f32_16x16x32_bf16(af, bf, acc[rg], 0, 0, 0); } }
            float rstd[2][4];
            if (kv == 0) {
#pragma unroll
                for (int rg = 0; rg < 2; ++rg)
#pragma unroll
                    for (int e = 0; e < 4; ++e) { float q = acc[rg][e] * acc[rg][e]; q += __shfl_xor(q, 1); q += __shfl_xor(q, 2); q += __shfl_xor(q, 4); q += __shfl_xor(q, 8);
                        if (fr == 0) red[(rg * 16 + 4 * fq + e) * 8 + wave] = q; }
                __syncthreads();
#pragma unroll
                for (int rg = 0; rg < 2; ++rg)
#pragma unroll
                    for (int e = 0; e < 4; ++e) { const LAS float* rp = red + (rg * 16 + 4 * fq + e) * 8; const float tot = ((rp[0] + rp[1]) + (rp[2] + rp[3])) + ((rp[4] + rp[5]) + (rp[6] + rp[7]));
                        rstd[rg][e] = 1.0f / sqrtf(tot * (1.f / 128.f) + EPS) * a.cmp_k_norm[16 * wave + fr]; }
            } else {
#pragma unroll
                for (int rg = 0; rg < 2; ++rg)
#pragma unroll
                    for (int e = 0; e < 4; ++e) rstd[rg][e] = 1.f;
            }
            bf16_t* dst = (bf16_t*)(ws + (kv ? WS_VCMP : WS_KCMP)) + (size_t)bg * 256 * 128;
#pragma unroll
            for (int rg = 0; rg < 2; ++rg)
#pragma unroll
                for (int e = 0; e < 4; ++e) { const int n = rt * 32 + rg * 16 + 4 * fq + e; const float v = (n == 255) ? 0.f : acc[rg][e] * rstd[rg][e];
                    dst[(size_t)n * 128 + 16 * wave + fr] = (bf16_t)(cvt_pk_bf16(v, 0.f) & 0xffffu); }
            __syncthreads();
        }
    }
}


#define XB_TMO      128
#define XB_XCNT(j)  (256  + 64 * (j))
#define XB_XSUB(j)  (1280 + 64 * (j))
#define XB_XGEN(j)  (2304 + 64 * (j))
#define XB_TOP      3328
#define XB_TOPGEN   3392
#define XCD_BAR_WORDS 3456
#define XB_SPIN_CAP (1u << 22)
__device__ __forceinline__ unsigned xb_ld(unsigned* p)              { return __hip_atomic_load(p, __ATOMIC_RELAXED, __HIP_MEMORY_SCOPE_AGENT); }
__device__ __forceinline__ unsigned xb_add(unsigned* p, unsigned v) { return __hip_atomic_fetch_add(p, v, __ATOMIC_RELAXED, __HIP_MEMORY_SCOPE_AGENT); }
__device__ __forceinline__ unsigned xb_xcc_id() { return (unsigned)__builtin_amdgcn_s_getreg((3 << 11) | 20) & 0xFu; }
#define XB_SPIN(cond, bar) do { unsigned _sp = 0; while (cond) { __builtin_amdgcn_s_sleep(1); \
    if ((++_sp & 255u) == 0u) { if (xb_ld(&(bar)[XB_TMO])) break; if (_sp > XB_SPIN_CAP) { atomicAdd(&(bar)[XB_TMO], 1u); break; } } } } while (0)
struct XcdBarrier { unsigned* bar; unsigned x; volatile LAS unsigned* st; };
__device__ __forceinline__ XcdBarrier xcd_barrier_post(unsigned* bar, volatile LAS unsigned* st) {
    XcdBarrier b; b.bar = bar; b.x = xb_xcc_id(); b.st = st;
    if (threadIdx.x == 0) (void)xb_add(&bar[XB_XCNT(b.x)], 1u);
    return b;
}
__device__ __forceinline__ void xcd_barrier_complete(unsigned* bar, unsigned x, unsigned& nloc, unsigned& nx) {
    const unsigned G = gridDim.x * gridDim.y * gridDim.z;
    unsigned sum, cnt, mine, sp = 0u;
    for (;;) {
        sum = 0u; cnt = 0u; mine = 0u;
#pragma unroll
        for (unsigned j = 0; j < 16; ++j) { const unsigned c = xb_ld(&bar[XB_XCNT(j)]); sum += c; cnt += (c > 0u) ? 1u : 0u; mine = (j == x) ? c : mine; }
        if (sum == G) break;
        __builtin_amdgcn_s_sleep(1);
        if ((++sp & 255u) == 0u) { if (xb_ld(&bar[XB_TMO])) break; if (sp > XB_SPIN_CAP) { atomicAdd(&bar[XB_TMO], 1u); break; } }
    }
    nloc = mine > 0u ? mine : 1u; nx = cnt > 0u ? cnt : 1u;
}
__device__ __forceinline__ void xcd_barrier(const XcdBarrier& b) {
    asm volatile("s_waitcnt vmcnt(0)" ::: "memory");
    __syncthreads();
    if (threadIdx.x == 0) {
        unsigned* bar = b.bar;
        __builtin_amdgcn_s_waitcnt(0);
        unsigned nloc = b.st[0], nx = b.st[1];
        if (nloc == 0u) { xcd_barrier_complete(bar, b.x, nloc, nx); b.st[0] = nloc; b.st[1] = nx; }
        const unsigned old = xb_add(&bar[XB_XSUB(b.x)], 1u);
        const unsigned gen = old / nloc;
        if (old + 1u == (gen + 1u) * nloc) {
            __builtin_amdgcn_fence(__ATOMIC_RELEASE, "agent");
            asm volatile("s_waitcnt vmcnt(0)" ::: "memory");
            const unsigned og = xb_add(&bar[XB_TOP], 1u);
            const unsigned tg = og / nx;
            if (og + 1u == (tg + 1u) * nx) xb_add(&bar[XB_TOPGEN], 1u);
            else XB_SPIN(xb_ld(&bar[XB_TOPGEN]) == tg, bar);
            __builtin_amdgcn_fence(__ATOMIC_ACQUIRE, "agent");
            xb_add(&bar[XB_XGEN(b.x)], 1u);
            asm volatile("s_waitcnt vmcnt(0)" ::: "memory");
        } else {
            XB_SPIN(xb_ld(&bar[XB_XGEN(b.x)]) == gen, bar);
            __builtin_amdgcn_fence(__ATOMIC_ACQUIRE, "agent");
            asm volatile("s_waitcnt vmcnt(0)" ::: "memory");
        }
    }
    __syncthreads();
}

enum { PH_PRO = 0, PH_INPROJ = 1, PH_ATTN = 2, PH_OUTPROJ = 3, PH_UP = 4, PH_DOWN = 5, PH_END = 6 };

__global__ void __launch_bounds__(NTHR, 2) mega_kernel(Args a) {
    extern __shared__ __attribute__((aligned(16))) unsigned char lds_raw[];
    LAS unsigned char* lds = (LAS unsigned char*)lds_raw;
    const int G = gridDim.x, bid = blockIdx.x;
    const int vcu = (G % 8 == 0) ? (bid % 8) * (G / 8) + bid / 8 : bid;
    unsigned char* ws = a.ws;
    volatile LAS unsigned* bst = (volatile LAS unsigned*)(lds + LDS_BYTES - 64);
    if (threadIdx.x < 2) bst[threadIdx.x] = 0u;
    __syncthreads();
    const XcdBarrier gbar = xcd_barrier_post((unsigned*)(ws + WS_CTL) + 1024, bst);
#ifndef PHMASK
#define PHMASK 0xffff
#endif
#define IN(k) (((PHMASK >> (k)) & 1) && a.ph_lo <= (k) && (k) < a.ph_hi)
#ifdef PROBE_PHASE
#define STAMP(k) do { if (bid == 0 && threadIdx.x == 0) ((unsigned long long*)(ws + WS_CTL + 24576))[(k)] = __builtin_amdgcn_s_memrealtime(); } while (0)
#else
#define STAMP(k) do { } while (0)
#endif
#define SEAM(k) do { if (IN(k) && IN((k) + 1)) xcd_barrier(gbar); STAMP((k) + 1); } while (0)
    STAMP(0);
    if (IN(PH_PRO)) { p0_prologue(a, lds, vcu, G); __syncthreads(); norm_phase<true>(a, lds, a.x, a.norm1_g, 0, DM, bid, G); } SEAM(PH_PRO);
    if (IN(PH_INPROJ)) {
        pg8::StaticOrder S; S.init(M, NPAD, G, bid, ws + WS_XN, ws + WS_WIN, DM, DM); S.rm = 1;
        pg8::EpiIn E{ws, a.fox_q_norm, a.fox_k_norm, a.nsa_q_norm, a.slc_k_norm, a.win_k_norm, a.b_forget, (LAS float*)(lds + LDS_STATS), (unsigned*)(ws + CTL_CNT_KCVC), (unsigned*)(ws + CTL_CNT_GATE)};
        pg8::gemm_phase(lds, DM, DM, DM, S, E);
        if (bid >= 224) {
            handoff_wait((unsigned*)(ws + CTL_CNT_KCVC), 64u * 8u);
            pg8::CmpOrder S2{32, bid - 224, (const char*)(ws + WS_KC), (const char*)(ws + WS_VC), (const char*)(ws + WS_W1T)};
            pg8::EpiPart E2{(float*)(ws + WS_PART), (unsigned*)(ws + CTL_CNT_PART)};
            pg8::gemm_phase(lds, 2048, 4096, 1024, S2, E2);
        }
        else if ((bid & 1) == 0 && (bid >> 3) < 16) {
            handoff_wait((unsigned*)(ws + CTL_CNT_PART), 32u * 8u);
            cmp2_phase(a, lds, (bid >> 3) * 4 + ((bid & 7) >> 1), 64);
        }
        else if ((bid & 1) == 0 && (bid >> 3) < 20) {
            handoff_wait((unsigned*)(ws + CTL_CNT_GATE), 32u * 8u);
            att::compute_kb(ws, ((bid >> 3) - 16) * 4 + ((bid & 7) >> 1), (LAS char*)lds);
        }
    } SEAM(PH_INPROJ);
#ifdef PROBE_PHASE
    unsigned long long tA0 = __builtin_amdgcn_s_memrealtime();
#endif
    if (IN(PH_ATTN)) { att::attn_phase(a, (LAS char*)lds, vcu, G); }
#ifdef PROBE_PHASE
    if (threadIdx.x == 0) { const unsigned d = (unsigned)(__builtin_amdgcn_s_memrealtime() - tA0); atomicMax((unsigned*)(ws + WS_CTL + 24576 + 256), d); atomicMax((unsigned*)(ws + WS_CTL + 24576 + 260), 0xffffffffu - d); }
#endif
    SEAM(PH_ATTN);
    if (IN(PH_OUTPROJ)) {
        pg8::StaticOrder S; S.init(M, DM, G, bid, ws + WS_AO, ws + WS_WOUT, DM, DM);
        pg8::EpiResNorm E{a.x, (bf16_t*)(ws + WS_X1B), (const float*)(ws + WS_MOD), a.norm2_g, (bf16_t*)(ws + WS_XN), (float*)(ws + WS_SLOTS), (unsigned*)(ws + CTL_CNT_PANEL), (LAS float*)(lds + LDS_STATS)};
        pg8::gemm_phase(lds, DM, DM, DM, S, E);
    } SEAM(PH_OUTPROJ);
    if (IN(PH_UP)) {
        pg8::StaticOrder S; S.init(M, DFF, G, bid, ws + WS_XN, ws + WS_WUP, DM, DM);
        pg8::EpiUp E{(bf16_t*)(ws + WS_U), DFF};
        pg8::gemm_phase(lds, DM, DM, DM, S, E);
    } SEAM(PH_UP);
    if (IN(PH_DOWN)) {
        pg8::StaticOrder S; S.init(M, DM, G, bid, ws + WS_U, ws + WS_WDN, DFF, DFF);
        pg8::EpiRes E{(const bf16_t*)(ws + WS_X1B), a.out, (const float*)(ws + WS_MOD) + 5 * DM};
        pg8::gemm_phase(lds, DFF, DFF, DFF, S, E);
    }
    STAMP(PH_END);
#undef IN
#undef SEAM
}

#ifdef PROBE_PHASE
__global__ void probe_kernel(const unsigned long long* tsp, float* out) {
#if PROBE_PHASE == 98
    out[0] = (float)(((const unsigned*)tsp)[64]) * 1e-3f;
#elif PROBE_PHASE == 97
    out[0] = (float)(0xffffffffu - ((const unsigned*)tsp)[65]) * 1e-3f;
#elif PROBE_PHASE == 99
    out[0] = (float)(tsp[PH_END] - tsp[0]) * 5e-4f;
#else
    const unsigned long long t1 = tsp[PROBE_PHASE + 1], t0 = tsp[PROBE_PHASE]; out[0] = (float)(t1 - t0) * 1e-2f;
#endif
}
#endif
static void launch_phases(const Args& a0, int lo, int hi, int grid, hipStream_t stream) {
    Args a = a0; a.ph_lo = lo; a.ph_hi = hi; void* args[] = {&a};
    (void)args; hipLaunchKernelGGL(mega_kernel, dim3(grid), dim3(NTHR), LDS_BYTES, stream, a);
    hipError_t e = hipPeekAtLastError();
    if (e != hipSuccess) fprintf(stderr, "launch failed: %s (grid %d)\n", hipGetErrorString(e), grid);
}

extern "C" void kernel_launch(void* const* d_in, const int* in_sizes, int n_in, void* d_out, int out_size, void* d_ws, size_t ws_size, hipStream_t stream) {
    static int grid = 0;
    if (grid == 0) {
        int dev = 0, cus = 0, per_cu = 0; hipGetDevice(&dev); hipDeviceGetAttribute(&cus, hipDeviceAttributeMultiprocessorCount, dev);
        hipFuncSetAttribute((const void*)mega_kernel, hipFuncAttributeMaxDynamicSharedMemorySize, LDS_BYTES);
        hipOccupancyMaxActiveBlocksPerMultiprocessor(&per_cu, (const void*)mega_kernel, NTHR, LDS_BYTES);
        if (per_cu < 1) { fprintf(stderr, "occupancy query says %d blocks/CU\n", per_cu); per_cu = 1; }
        grid = 256;
        if (cus < 256) fprintf(stderr, "this kernel needs >= 256 CUs for a resident grid (device has %d)\n", cus);
        if (ws_size < WS_END + 24 * MiB) fprintf(stderr, "workspace too small: %zu\n", ws_size);
    }
    hipMemsetAsync((char*)d_ws + WS_CTL, 0, 49152, stream);
    Args a{};
    const float** ap = (const float**)&a;
    for (int i = 0; i < 23; ++i) ap[i] = (const float*)d_in[i];
    a.out = (float*)d_out; a.ws = (unsigned char*)d_ws;
    unsigned char* ws = a.ws;
    launch_phases(a, PH_PRO, PH_END, grid, stream);
#ifdef PROBE_PHASE
    probe_kernel<<<1, 1, 0, stream>>>((const unsigned long long*)(ws + WS_CTL + 24576), a.out);
#endif
}
```

```cpp
#include <hip/hip_runtime.h>
#include <hip/hip_cooperative_groups.h>
#include <stdint.h>
#include <math.h>
#include <cstdio>
namespace cg = cooperative_groups;
#define NF_IN 3

constexpr int DM = 2048, NB = 2, T = 4096, M = NB * T, HD = 128;
constexpr int DIN = 5664, DFF = 8192, NPAD = 5888;
constexpr int C_FQ = 0, C_FK = 1024, C_FV = 2048, C_FZ = 3072, C_NQ = 3080, C_KC = 4104, C_VC = 4360, C_KSL = 4616, C_VSL = 4872,
              C_KW = 5128, C_VW = 5384, C_GZ = 5640;
constexpr int NCMP = 255;
constexpr float SCALE = 0.08838834764831845f;
constexpr float EPS = 1e-6f;
constexpr int NWAVES = 8, NTHR = 512;

constexpr size_t MiB = 1u << 20;
constexpr size_t WS_CTL = 0;
constexpr size_t CTL_CNT_GATE = 21504;
constexpr size_t CTL_CNT_KCVC = 20480, CTL_CNT_PART = 20736, CTL_CNT_ADALN = 20992, CTL_CNT_PANEL = 32768, CTL_CNT_ATTN = 40960;
constexpr size_t WS_SLOTS = 64 * 1024;
constexpr size_t WS_MODP = 384 * 1024;
constexpr size_t WS_MOD = 2 * MiB;
constexpr size_t WS_ROPE = 3 * MiB;
constexpr size_t WS_PEBP = 5 * MiB;
constexpr size_t WS_PEB = 5 * MiB + 256 * 1024;
constexpr size_t WS_MBOUND = 5 * MiB + 300 * 1024;
constexpr size_t WS_LOGF = 5 * MiB + 320 * 1024;
constexpr size_t WS_KBIAS = 5 * MiB + 640 * 1024;
constexpr size_t WS_GATES = 6 * MiB;
constexpr size_t WS_W2T = 7 * MiB;
constexpr size_t WS_W1T = 8 * MiB;
constexpr size_t WS_WIN = 12 * MiB;
constexpr size_t WS_WOUT = 36 * MiB;
constexpr size_t WS_WUP = 44 * MiB;
constexpr size_t WS_WDN = 76 * MiB;
constexpr size_t WS_XN = 108 * MiB;
constexpr size_t WS_FQ = 140 * MiB, WS_FK = 156 * MiB, WS_FV = 172 * MiB, WS_NQ = 188 * MiB, WS_NQR = 204 * MiB;
constexpr size_t WS_KC = 220 * MiB, WS_VC = 224 * MiB, WS_KSL = 228 * MiB, WS_VSL = 232 * MiB, WS_KW = 236 * MiB, WS_VW = 240 * MiB;
constexpr size_t WS_KCMP = 244 * MiB, WS_VCMP = 244 * MiB + 512 * 1024;
constexpr size_t WS_PART = 245 * MiB;
constexpr size_t WS_NSAO = 277 * MiB;
constexpr size_t WS_X1B = WS_NSAO;
constexpr size_t WS_AO = 309 * MiB;
constexpr size_t WS_U = 140 * MiB;
constexpr size_t WS_END = 341 * MiB;
constexpr size_t WS_DEV_CUM = 341 * MiB;
constexpr size_t WS_DEV_XB = 342 * MiB;
constexpr size_t WS_DEV_HID = 358 * MiB;
constexpr size_t WS_DEV_KC = 360 * MiB;

constexpr int LDS_STATS = 131072;
constexpr int LDS_BYTES = 155648;

#define LAS __attribute__((address_space(3)))
#define GAS __attribute__((address_space(1)))
typedef unsigned short bf16_t;
typedef short bf16x8 __attribute__((ext_vector_type(8)));
typedef float f32x4 __attribute__((ext_vector_type(4)));
typedef float f32x2 __attribute__((ext_vector_type(2)));
typedef unsigned u32x4 __attribute__((ext_vector_type(4)));
typedef unsigned u32x2 __attribute__((ext_vector_type(2)));

typedef __bf16 bf16x2_t __attribute__((ext_vector_type(2)));
__device__ __forceinline__ unsigned cvt_pk_bf16(float lo, float hi) { f32x2 v = {lo, hi}; bf16x2_t b = __builtin_convertvector(v, bf16x2_t); return __builtin_bit_cast(unsigned, b); }
__device__ __forceinline__ float bf2f(bf16_t v) { return __uint_as_float(((unsigned)v) << 16); }
__device__ __forceinline__ float wave_sum(float v) {
#pragma unroll
    for (int o = 1; o < 64; o <<= 1) v += __shfl_xor(v, o);
    return v;
}
__device__ __forceinline__ float wave_max(float v) {
#pragma unroll
    for (int o = 1; o < 64; o <<= 1) v = fmaxf(v, __shfl_xor(v, o));
    return v;
}


__device__ __forceinline__ void handoff_signal(unsigned* cnt, int lane) {
    asm volatile("s_waitcnt vmcnt(0)" ::: "memory");
    if (lane == 0) __hip_atomic_fetch_add(cnt, 1u, __ATOMIC_RELAXED, __HIP_MEMORY_SCOPE_AGENT);
}
__device__ __forceinline__ void handoff_wait(unsigned* cnt, unsigned target) {
    if (threadIdx.x < 64) { unsigned sp = 0;
        while ((unsigned)__builtin_amdgcn_readfirstlane(__hip_atomic_load(cnt, __ATOMIC_RELAXED, __HIP_MEMORY_SCOPE_AGENT)) < target) { __builtin_amdgcn_s_sleep(4); if (++sp > (1u << 24)) break; }
        __builtin_amdgcn_fence(__ATOMIC_ACQUIRE, "agent"); asm volatile("s_waitcnt vmcnt(0)" ::: "memory"); }
    __syncthreads();
}

namespace pg8 {
constexpr int BM = 256, BK = 64, HALF = 128, HTB = HALF * BK * 2, STAGE_BYTES = 8 * HTB, NXCD = 8, WGM = 8;
__host__ __device__ __forceinline__ int lds_byte(int r, int c) { const int st = (r >> 4) * 2 + (c >> 5), rr = r & 15, cc = c & 31, ob = rr * 64 + cc * 2; return st * 1024 + (ob ^ (((ob >> 9) & 1) << 5)); }
__host__ __device__ __forceinline__ void stage_rc(int b, int& R, int& C) { const int st = b / 1024, sb = b % 1024, swz = sb ^ (((sb >> 9) & 1) << 5); R = (st >> 1) * 16 + swz / 64; C = (st & 1) * 32 + (swz % 64) / 2; }
__host__ __device__ __forceinline__ int perm32(int rho) { const int n = rho >> 4, i = rho & 15; return 8 * (i >> 2) + 4 * n + (i & 3); }

struct Unit { int pm, pn, aux; };
#define NF_ERN 3
#ifndef NF_IN
#define NF_IN 2
#endif

struct StaticOrder {
    int nM, nN, nwg, G, c; const char* A; const char* Bt; size_t tsA, tsB; int rm = 0;
    __device__ __forceinline__ void init(int M_, int N_, int G_, int c_, const void* A_, const void* Bt_, int lda, int ldb) { nM = M_ / BM; nN = N_ / BM; nwg = nM * nN; G = G_; c = c_; A = (const char*)A_; Bt = (const char*)Bt_; tsA = (size_t)BM * lda * 2; tsB = (size_t)BM * ldb * 2; }
    __device__ __forceinline__ bool next(int i, Unit& u) const {
        const long L = (long)i * G + c; if (L >= nwg) return false;
        int wgid = (int)L; { const int q = nwg / NXCD, r = nwg % NXCD, xcd = wgid % NXCD, off = wgid / NXCD; wgid = (xcd < r ? xcd * (q + 1) : r * (q + 1) + (xcd - r) * q) + off; }
        const int nig = WGM * nN, gid = wgid / nig, fm = gid * WGM, gsz = (nM - fm) < WGM ? (nM - fm) : WGM;
        u.pm = fm + ((wgid % nig) % gsz); u.pn = (wgid % nig) / gsz; u.aux = 0;
        if (rm) { const int p = u.pn; u.pn = (int)(((p < 12 ? 0x4a0e6734a418820ull : 0x5ab49ad507b251ull) >> (5 * (p < 12 ? p : p - 12))) & 31ull); }
        return true;
    }
    __device__ __forceinline__ void ptrs(const Unit& u, const char*& a, const char*& b) const { a = A + (size_t)u.pm * tsA; b = Bt + (size_t)u.pn * tsB; }
};

template <class Epi, class Sched>
__device__ __forceinline__ void gemm_phase(LAS unsigned char* lds, const int lda, const int ldb, const int K, const Sched& S, const Epi& E) {
    int tid = threadIdx.x; asm volatile("" : "+v"(tid));
    const int wid = __builtin_amdgcn_readfirstlane(tid >> 6), lane = tid & 63, wr = wid >> 2, wc = wid & 3, fr = lane & 15, fq = lane >> 4;
    const int nt = K / BK;
    unsigned voffA[2], voffB[2];
#pragma unroll
    for (int i = 0; i < 2; ++i) { int R, C; stage_rc(tid * 16 + i * 8192, R, C); const int Rb = Epi::PERM ? ((R & ~31) + perm32(R & 31)) : R;
        voffA[i] = (unsigned)(R * lda + C) * 2u; voffB[i] = (unsigned)(Rb * ldb + C) * 2u; }
    const size_t kstep = (size_t)(BK * 2);
    const size_t hsA = (size_t)HALF * lda * 2, hsB = (size_t)HALF * ldb * 2;
    const unsigned ldsw = (unsigned)wid * 1024u;
    const int aoff = lds_byte(wr * 64 + fr, fq * 8), boff = lds_byte(wc * 32 + fr, fq * 8);
#define PG8_SA(b, h) (((b) * 2 + (h)) * HTB)
#define PG8_SB(b, h) ((4 + (b) * 2 + (h)) * HTB)
#define PG8_STAGE(bufoff, gbase, voff) do { _Pragma("unroll") for (int _i = 0; _i < 2; ++_i) \
        __builtin_amdgcn_global_load_lds((const unsigned*)((const char*)(gbase) + (voff)[_i]), (LAS unsigned*)(lds + (bufoff) + ldsw + _i * 8192), 16, 0, 0); } while (0)
#define PG8_LDA(dst, b, h) do { _Pragma("unroll") for (int m = 0; m < 4; ++m) _Pragma("unroll") for (int k = 0; k < 2; ++k) dst[m][k] = *(const LAS bf16x8*)(lds + PG8_SA(b, h) + aoff + m * 2048 + k * 1024); } while (0)
#define PG8_LDB(dst, b, h) do { _Pragma("unroll") for (int n = 0; n < 2; ++n) _Pragma("unroll") for (int k = 0; k < 2; ++k) dst[n][k] = *(const LAS bf16x8*)(lds + PG8_SB(b, h) + boff + n * 2048 + k * 1024); } while (0)
#define PG8_MMA(ai, bj, At, Bt) do { __builtin_amdgcn_s_setprio(1); _Pragma("unroll") for (int m = 0; m < 4; ++m) _Pragma("unroll") for (int n = 0; n < 2; ++n) _Pragma("unroll") for (int k = 0; k < 2; ++k) \
        acc[ai][bj][m][n] = __builtin_amdgcn_mfma_f32_16x16x32_bf16(Bt[n][k], At[m][k], acc[ai][bj][m][n], 0, 0, 0); __builtin_amdgcn_s_setprio(0); } while (0)
#define PG8_WAIT_V(n) asm volatile("s_waitcnt vmcnt(" #n ")" ::: "memory")
#define PG8_WAIT_VX do { static_assert(Epi::NS == 0 || Epi::NS == 16, "unit-boundary wait count"); asm volatile("s_waitcnt vmcnt(24)" ::: "memory"); } while (0)
#define PG8_WAIT_L(n) asm volatile("s_waitcnt lgkmcnt(" #n ")" ::: "memory")
#define PG8_BAR __builtin_amdgcn_s_barrier()
#define PG8_SCHED __builtin_amdgcn_sched_barrier(0)
    Unit cur, nxt; int ui = 0; bool fresh = false;
    if (!S.next(0, cur)) return;
    f32x4 acc[2][2][4][2];
#pragma unroll
    for (int a = 0; a < 2; ++a)
#pragma unroll
        for (int b = 0; b < 2; ++b)
#pragma unroll
            for (int m = 0; m < 4; ++m)
#pragma unroll
                for (int n = 0; n < 2; ++n) acc[a][b][m][n] = (f32x4){0.f, 0.f, 0.f, 0.f};
    bf16x8 At[4][2], B0[2][2], B1[2][2];
    const char* cA; const char* cB; S.ptrs(cur, cA, cB);
    PG8_STAGE(PG8_SB(0, 0), cB, voffB); PG8_STAGE(PG8_SB(0, 1), cB + hsB, voffB); PG8_STAGE(PG8_SA(0, 0), cA, voffA); PG8_STAGE(PG8_SA(0, 1), cA + hsA, voffA);
    if (wr == 1) PG8_BAR;
    PG8_WAIT_V(2); PG8_BAR;
    PG8_STAGE(PG8_SB(1, 0), cB + kstep, voffB); PG8_STAGE(PG8_SA(1, 0), cA + kstep, voffA); PG8_STAGE(PG8_SB(1, 1), cB + hsB + kstep, voffB);
    PG8_WAIT_V(6); PG8_BAR;
    if constexpr (Epi::PREFETCH) E.prefetch(cur, lds + STAGE_BYTES, wid, lane);
    for (;;) {
        const bool has_next = S.next(ui + 1, nxt);
        const char* nA = cA; const char* nB = cB; if (has_next) S.ptrs(nxt, nA, nB);
#pragma nounroll
        for (int t = 0; t < nt; t += 2) {
            const bool last = (t == nt - 2);
            const char* a1 = cA + (size_t)(t + 1) * kstep;
            const char* a2 = last ? nA : cA + (size_t)(t + 2) * kstep; const char* b2 = last ? nB : cB + (size_t)(t + 2) * kstep;
            const char* a3 = a2 + kstep; const char* b3 = b2 + kstep;
            const bool fz = (Epi::NS > 0) && fresh && t == 0;
            PG8_LDB(B0, 0, 0); PG8_LDB(B1, 0, 1); PG8_SCHED; PG8_LDA(At, 0, 0); PG8_STAGE(PG8_SA(1, 1), a1 + hsA, voffA);
            if (fz) PG8_WAIT_VX; else PG8_WAIT_V(8);
            PG8_WAIT_L(0); PG8_BAR; PG8_MMA(0, 0, At, B0); PG8_MMA(0, 1, At, B1); PG8_BAR; PG8_SCHED;
            PG8_LDA(At, 0, 1); PG8_STAGE(PG8_SB(0, 0), b2, voffB); PG8_STAGE(PG8_SB(0, 1), b2 + hsB, voffB); PG8_STAGE(PG8_SA(0, 0), a2, voffA);
            if (fz) PG8_WAIT_VX; else PG8_WAIT_V(8);
            PG8_WAIT_L(0); PG8_BAR; PG8_MMA(1, 0, At, B0); PG8_MMA(1, 1, At, B1); PG8_BAR; PG8_SCHED;
            PG8_LDB(B0, 1, 0); PG8_LDB(B1, 1, 1); PG8_SCHED; PG8_LDA(At, 1, 0); PG8_STAGE(PG8_SA(0, 1), a2 + hsA, voffA);
            PG8_WAIT_V(8); PG8_WAIT_L(0); PG8_BAR; PG8_MMA(0, 0, At, B0); PG8_MMA(0, 1, At, B1); PG8_BAR; PG8_SCHED;
            PG8_LDA(At, 1, 1); PG8_STAGE(PG8_SB(1, 0), b3, voffB); PG8_STAGE(PG8_SB(1, 1), b3 + hsB, voffB); PG8_STAGE(PG8_SA(1, 0), a3, voffA);
            PG8_WAIT_V(8); PG8_WAIT_L(0); PG8_BAR; PG8_MMA(1, 0, At, B0); PG8_MMA(1, 1, At, B1); PG8_BAR; PG8_SCHED;
        }
        if (wr == 0) PG8_BAR;
        E(acc, cur, wr, wc, fr, fq);
        if (!has_next) break;
#pragma unroll
        for (int a = 0; a < 2; ++a)
#pragma unroll
            for (int b = 0; b < 2; ++b)
#pragma unroll
                for (int m = 0; m < 4; ++m)
#pragma unroll
                    for (int n = 0; n < 2; ++n) acc[a][b][m][n] = (f32x4){0.f, 0.f, 0.f, 0.f};
        cur = nxt; cA = nA; cB = nB; ++ui; fresh = true;
        if (wr == 1) PG8_BAR;
    }
    PG8_WAIT_V(0);
    PG8_BAR;
#undef PG8_SA
#undef PG8_SB
#undef PG8_STAGE
#undef PG8_LDA
#undef PG8_LDB
#undef PG8_MMA
#undef PG8_WAIT_V
#undef PG8_WAIT_VX
#undef PG8_WAIT_L
#undef PG8_BAR
#undef PG8_SCHED
}


struct EpiRes {
    static constexpr int NS = 0; static constexpr bool PERM = true, PREFETCH = false;
    const bf16_t* base; float* out; const float* gate;
    __device__ __forceinline__ void prefetch(const Unit&, LAS unsigned char*, int, int) const {}
    __device__ __forceinline__ void operator()(const f32x4 (&acc)[2][2][4][2], const Unit& u, int wr, int wc, int fr, int fq) const {
        const int row0 = u.pm * BM + wr * 64 + fr, col0 = u.pn * BM + wc * 32 + 8 * fq;
        const int b = (u.pm * BM) / T;
        f32x4 gv[2][2];
#pragma unroll
        for (int bj = 0; bj < 2; ++bj)
#pragma unroll
            for (int n = 0; n < 2; ++n) gv[bj][n] = *(const f32x4*)(gate + (size_t)b * 6 * DM + col0 + bj * HALF + 4 * n);
#pragma unroll
        for (int ai = 0; ai < 2; ++ai)
#pragma unroll
            for (int m = 0; m < 4; ++m) { const size_t off = (size_t)(row0 + ai * HALF + m * 16) * DM + col0;
#pragma unroll
                for (int bj = 0; bj < 2; ++bj) { const u32x4 w = *(const u32x4*)(base + off + bj * HALF);
                    const f32x4 b0 = (f32x4){__uint_as_float(w.x << 16), __uint_as_float(w.x & 0xffff0000u), __uint_as_float(w.y << 16), __uint_as_float(w.y & 0xffff0000u)};
                    const f32x4 b1 = (f32x4){__uint_as_float(w.z << 16), __uint_as_float(w.z & 0xffff0000u), __uint_as_float(w.w << 16), __uint_as_float(w.w & 0xffff0000u)};
                    *(f32x4*)(out + off + bj * HALF) = b0 + gv[bj][0] * acc[ai][bj][m][0];
                    *(f32x4*)(out + off + bj * HALF + 4) = b1 + gv[bj][1] * acc[ai][bj][m][1]; } }
    }
};

struct EpiResNorm {
    static constexpr int NS = 0; static constexpr bool PERM = true, PREFETCH = false;
    const float* base; bf16_t* out; const float* mod; const float* g2; bf16_t* XN; float* slots; unsigned* cnt; LAS float* tab;
    __device__ __forceinline__ void prefetch(const Unit& u, LAS unsigned char* dummy, int wid, int lane) const {
        const float* p = base + (size_t)(u.pm * BM + wid * 32) * DM + u.pn * BM + lane * 4;
#pragma unroll 8
        for (int r = 0; r < 32; ++r) __builtin_amdgcn_global_load_lds((const unsigned*)(p + (size_t)r * DM), (LAS unsigned*)(dummy + wid * 1024), 16, 0, 0);
    }
    __device__ __forceinline__ void operator()(f32x4 (&acc)[2][2][4][2], const Unit& u, int wr, int wc, int fr, int fq) const {
        const int row0 = u.pm * BM + wr * 64 + fr, col0 = u.pn * BM + wc * 32 + 8 * fq;
        const int b = (u.pm * BM) / T; const int wid = wr * 4 + wc, lane = fr + 16 * fq;
        const float* mb = mod + (size_t)b * 6 * DM;
        {   f32x4 gv[2][2];
#pragma unroll
            for (int bj = 0; bj < 2; ++bj)
#pragma unroll
                for (int n = 0; n < 2; ++n) gv[bj][n] = *(const f32x4*)(mb + 2 * DM + col0 + bj * HALF + 4 * n);
            f32x4 bs[NF_ERN][2][2];
#define ER_LD(g) do { const size_t off_ = (size_t)(row0 + ((g) >> 2) * HALF + ((g) & 3) * 16) * DM + col0; _Pragma("unroll") for (int bj = 0; bj < 2; ++bj) _Pragma("unroll") for (int n = 0; n < 2; ++n) \
            bs[(g) % NF_ERN][bj][n] = *(const f32x4*)(base + off_ + bj * HALF + 4 * n); } while (0)
            _Pragma("unroll") for (int g = 0; g < NF_ERN; ++g) ER_LD(g);
            asm volatile("" ::: "memory");
#pragma unroll
            for (int g = 0; g < 8; ++g) { const int ai = g >> 2, m = g & 3; float ss = 0.f;
#pragma unroll
                for (int bj = 0; bj < 2; ++bj)
#pragma unroll
                    for (int n = 0; n < 2; ++n) { const f32x4 v = bs[g % NF_ERN][bj][n] + gv[bj][n] * acc[ai][bj][m][n];
                        acc[ai][bj][m][n] = v; ss += (v[0] * v[0] + v[1] * v[1]) + (v[2] * v[2] + v[3] * v[3]); }
                if (g + NF_ERN < 8) ER_LD(g + NF_ERN);
                ss += __shfl_xor(ss, 16); ss += __shfl_xor(ss, 32);
                if (fq == 0) tab[(ai * HALF + wr * 64 + m * 16 + fr) * 4 + wc] = ss;
                asm volatile("" ::: "memory"); }
#undef ER_LD
        }
        asm volatile("s_waitcnt lgkmcnt(0)" ::: "memory"); __builtin_amdgcn_s_barrier(); asm volatile("" ::: "memory");
        const int prow = wid * 32 + (lane & 31);
        if (lane < 32) { const f32x4 q = *(const LAS f32x4*)(tab + prow * 4);
            __hip_atomic_store((unsigned*)slots + ((size_t)(u.pm * BM + prow) * 8 + u.pn), __float_as_uint((q[0] + q[1]) + (q[2] + q[3])), __ATOMIC_RELAXED, __HIP_MEMORY_SCOPE_AGENT); }
        asm volatile("s_waitcnt vmcnt(0)" ::: "memory");
        if (lane == 0) __hip_atomic_fetch_add(cnt + 64 * u.pm, 1u, __ATOMIC_RELAXED, __HIP_MEMORY_SCOPE_AGENT);
        f32x4 av[2][2], sv[2][2];
#pragma unroll
        for (int bj = 0; bj < 2; ++bj)
#pragma unroll
            for (int n = 0; n < 2; ++n) { const int c = col0 + bj * HALF + 4 * n; const f32x4 gg = *(const f32x4*)(g2 + c), sc = *(const f32x4*)(mb + 4 * DM + c);
                av[bj][n] = gg * (sc + 1.f); sv[bj][n] = *(const f32x4*)(mb + 3 * DM + c); }
        if (wid == 0) { unsigned sp = 0;
            while ((unsigned)__builtin_amdgcn_readfirstlane(__hip_atomic_load(cnt + 64 * u.pm, __ATOMIC_RELAXED, __HIP_MEMORY_SCOPE_AGENT)) < 64u) { __builtin_amdgcn_s_sleep(2); if (++sp > (1u << 22)) break; }
            __builtin_amdgcn_fence(__ATOMIC_ACQUIRE, "agent"); }
        asm volatile("s_waitcnt vmcnt(0) lgkmcnt(0)" ::: "memory"); __builtin_amdgcn_s_barrier(); asm volatile("" ::: "memory");
        if (lane < 32) { const unsigned* sl = (const unsigned*)slots + (size_t)(u.pm * BM + prow) * 8; float tot = 0.f;
#pragma unroll
            for (int t = 0; t < 8; ++t) tot += __uint_as_float(__hip_atomic_load(sl + t, __ATOMIC_RELAXED, __HIP_MEMORY_SCOPE_AGENT));
            tab[1024 + prow] = __builtin_amdgcn_rsqf(tot * (1.f / DM) + EPS); }
        asm volatile("s_waitcnt vmcnt(0) lgkmcnt(0)" ::: "memory"); __builtin_amdgcn_s_barrier(); asm volatile("" ::: "memory");
#pragma unroll
        for (int ai = 0; ai < 2; ++ai)
#pragma unroll
            for (int m = 0; m < 4; ++m) { const int rl = ai * HALF + wr * 64 + m * 16 + fr; const float rstd = tab[1024 + rl]; const size_t off = (size_t)(u.pm * BM + rl) * DM + col0;
#pragma unroll
                for (int bj = 0; bj < 2; ++bj) {
                    { const f32x4 x0 = acc[ai][bj][m][0], x1 = acc[ai][bj][m][1]; u32x4 xw; xw.x = cvt_pk_bf16(x0[0], x0[1]); xw.y = cvt_pk_bf16(x0[2], x0[3]); xw.z = cvt_pk_bf16(x1[0], x1[1]); xw.w = cvt_pk_bf16(x1[2], x1[3]);
                      *(u32x4*)(out + off + bj * HALF) = xw; }
                    const f32x4 h0 = acc[ai][bj][m][0] * rstd * av[bj][0] + sv[bj][0], h1 = acc[ai][bj][m][1] * rstd * av[bj][1] + sv[bj][1];
                    u32x4 w; w.x = cvt_pk_bf16(h0[0], h0[1]); w.y = cvt_pk_bf16(h0[2], h0[3]); w.z = cvt_pk_bf16(h1[0], h1[1]); w.w = cvt_pk_bf16(h1[2], h1[3]);
                    *(u32x4*)(XN + off + bj * HALF) = w; }
                asm volatile("" ::: "memory"); }
    }
};
struct EpiUp {
    static constexpr int NS = 16;   static constexpr bool PERM = true, PREFETCH = false;
    bf16_t* O; int ldc;
    __device__ __forceinline__ void operator()(const f32x4 (&acc)[2][2][4][2], const Unit& u, int wr, int wc, int fr, int fq) const {
        const int row0 = u.pm * BM + wr * 64 + fr, col0 = u.pn * BM + wc * 32 + 8 * fq;
#pragma unroll
        for (int ai = 0; ai < 2; ++ai)
#pragma unroll
            for (int m = 0; m < 4; ++m) { bf16_t* rowp = O + (size_t)(row0 + ai * HALF + m * 16) * ldc + col0;
#pragma unroll
                for (int bj = 0; bj < 2; ++bj) { f32x4 v0 = acc[ai][bj][m][0], v1 = acc[ai][bj][m][1];
                    v0 = __builtin_elementwise_max(v0, (f32x4){0.f, 0.f, 0.f, 0.f}); v1 = __builtin_elementwise_max(v1, (f32x4){0.f, 0.f, 0.f, 0.f}); v0 = v0 * v0; v1 = v1 * v1;
                    u32x4 w; w.x = cvt_pk_bf16(v0[0], v0[1]); w.y = cvt_pk_bf16(v0[2], v0[3]); w.z = cvt_pk_bf16(v1[0], v1[1]); w.w = cvt_pk_bf16(v1[2], v1[3]);
                    *(u32x4*)(rowp + bj * HALF) = w; } }
    }
};
struct EpiIn {
    static constexpr int NS = 0; static constexpr bool PERM = true, PREFETCH = false;
    unsigned char* wsb;
    const float *g_fq, *g_fk, *g_nq, *g_slc, *g_win, *b_forget; LAS float* stats; unsigned* kcvc_cnt; unsigned* gate_cnt;
    __device__ __forceinline__ void operator()(const f32x4 (&acc)[2][2][4][2], const Unit& u, int wr, int wc, int fr, int fq) const {
        const int pn = u.pn;
        unsigned char* w_ = wsb; asm volatile("" : "+s"(w_));
        GAS bf16_t* const FQ = (GAS bf16_t*)(w_ + WS_FQ); GAS bf16_t* const FK = (GAS bf16_t*)(w_ + WS_FK); GAS bf16_t* const FV = (GAS bf16_t*)(w_ + WS_FV); GAS bf16_t* const NQ = (GAS bf16_t*)(w_ + WS_NQ); GAS bf16_t* const NQR = (GAS bf16_t*)(w_ + WS_NQR);
        GAS bf16_t* const KC = (GAS bf16_t*)(w_ + WS_KC); GAS bf16_t* const VC = (GAS bf16_t*)(w_ + WS_VC); GAS bf16_t* const KSL = (GAS bf16_t*)(w_ + WS_KSL); GAS bf16_t* const VSL = (GAS bf16_t*)(w_ + WS_VSL); GAS bf16_t* const KW = (GAS bf16_t*)(w_ + WS_KW); GAS bf16_t* const VW = (GAS bf16_t*)(w_ + WS_VW);
        GAS float* const LOGF = (GAS float*)(w_ + WS_LOGF); GAS float* const GATES = (GAS float*)(w_ + WS_GATES); const GAS float* const rope = (const GAS float*)(w_ + WS_ROPE);
        const int b = u.pm >> 4, t0 = (u.pm & 15) * BM + wr * 64 + fr;
        if (pn == 12) {
            if (wc == 0) {
#pragma unroll
                for (int ai = 0; ai < 2; ++ai)
#pragma unroll
                    for (int m = 0; m < 4; ++m) { const int t = t0 + ai * HALF + m * 16;
#pragma unroll
                        for (int n = 0; n < 2; ++n)
#pragma unroll
                            for (int e = 0; e < 4; ++e) { const int p = 8 * fq + 4 * n + e; const float v = acc[ai][0][m][n][e];
                                if (p < 8) { const float z = v + b_forget[p]; __hip_atomic_store((GAS unsigned*)(LOGF + ((size_t)b * 8 + p) * T + t), __float_as_uint(fminf(z, 0.f) - __logf(1.f + __expf(-fabsf(z)))), __ATOMIC_RELAXED, __HIP_MEMORY_SCOPE_AGENT); }
                                else { GATES[((size_t)b * T + t) * 24 + (p - 8)] = 1.f / (1.f + __expf(-v)); } } }
            }
            handoff_signal(gate_cnt, fr + 16 * fq);
            return;
        }
        if (pn < 4) body<true, true, false, false>(acc, u, wr, wc, fr, fq, FQ, nullptr, g_fq, rope, 8, 2 * pn);
        else if (pn < 8) body<true, true, false, false>(acc, u, wr, wc, fr, fq, FK, nullptr, g_fk, rope, 8, 2 * (pn - 4));
        else if (pn < 12) body<false, true, false, false>(acc, u, wr, wc, fr, fq, FV, nullptr, nullptr, rope, 8, 2 * (pn - 8));
        else if (pn < 17) body<true, true, true, false>(acc, u, wr, wc, fr, fq, NQ, NQR, g_nq, rope, 8, 2 * (pn - 13));
        else if (pn < 19) body<false, true, false, true>(acc, u, wr, wc, fr, fq, pn == 17 ? KC : VC, nullptr, nullptr, rope, 2, 0);
        else if (pn < 21) body<true, false, true, false>(acc, u, wr, wc, fr, fq, nullptr, pn == 19 ? KSL : KW, pn == 19 ? g_slc : g_win, rope, 2, 0);
        else body<false, true, false, false>(acc, u, wr, wc, fr, fq, pn == 21 ? VSL : VW, nullptr, nullptr, rope, 2, 0);
    }
    template <bool NORM, bool D1, bool D2, bool WT>
    __device__ __forceinline__ void body(const f32x4 (&acc)[2][2][4][2], const Unit& u, int wr, int wc, int fr, int fq, GAS bf16_t* d1, GAS bf16_t* d2, const float* gain, const GAS float* rope, int nh, int h0) const {
        const int b = u.pm >> 4, t0 = (u.pm & 15) * BM + wr * 64 + fr;
        const int dlo = 16 * wc + 4 * fq;
        f32x4 g0 = (f32x4){1.f, 1.f, 1.f, 1.f}, g1 = g0;
        if (NORM) { g0 = *(const f32x4*)(gain + dlo); g1 = *(const f32x4*)(gain + 64 + dlo); }
        f32x4 cs[NF_IN][2];
#define EI_LD(g) do { const int tn_ = t0 + ((g) >> 2) * HALF + ((g) & 3) * 16; const GAS float* rp_ = rope + ((size_t)tn_ * 64 + dlo) * 2; cs[(g) % NF_IN][0] = *(const GAS f32x4*)rp_; cs[(g) % NF_IN][1] = *(const GAS f32x4*)(rp_ + 4); } while (0)
        if (D2) { _Pragma("unroll") for (int g = 0; g < NF_IN; ++g) EI_LD(g); }
        if (NORM) {
#pragma unroll
            for (int ai = 0; ai < 2; ++ai)
#pragma unroll
                for (int m = 0; m < 4; ++m)
#pragma unroll
                    for (int bj = 0; bj < 2; ++bj) { const f32x4 a = acc[ai][bj][m][0], c = acc[ai][bj][m][1];
                        float s = (a[0] * a[0] + a[1] * a[1]) + (a[2] * a[2] + a[3] * a[3]) + (c[0] * c[0] + c[1] * c[1]) + (c[2] * c[2] + c[3] * c[3]);
                        { const unsigned x = __float_as_uint(s); const auto r = __builtin_amdgcn_permlane32_swap(x, x, false, false); s = __uint_as_float(r[0]) + __uint_as_float(r[1]); }
                        { const unsigned x = __float_as_uint(s); const auto r = __builtin_amdgcn_permlane16_swap(x, x, false, false); s = __uint_as_float(r[0]) + __uint_as_float(r[1]); }
                        if (fq == 0) stats[(ai * HALF + wr * 64 + m * 16 + fr) * 8 + bj * 4 + wc] = s; }
            asm volatile("s_waitcnt lgkmcnt(0)" ::: "memory"); __builtin_amdgcn_s_barrier(); asm volatile("" ::: "memory");
        }
#pragma unroll
        for (int g = 0; g < 8; ++g) { const int ai = g >> 2, m = g & 3; const int t = t0 + ai * HALF + m * 16;
            float rsv[2] = {1.f, 1.f};
            if (NORM) {
#pragma unroll
                for (int bj = 0; bj < 2; ++bj) { const f32x4 q = *(const LAS f32x4*)(stats + (ai * HALF + wr * 64 + m * 16 + fr) * 8 + bj * 4);
                    rsv[bj] = __builtin_amdgcn_rsqf(((q[0] + q[1]) + (q[2] + q[3])) * (1.f / 128.f) + EPS); } }
            f32x4 c = g0, sn = g0;
            if (D2) { c = (f32x4){cs[g % NF_IN][0][0], cs[g % NF_IN][0][2], cs[g % NF_IN][1][0], cs[g % NF_IN][1][2]}; sn = (f32x4){cs[g % NF_IN][0][1], cs[g % NF_IN][0][3], cs[g % NF_IN][1][1], cs[g % NF_IN][1][3]}; }
            if (D2 && g + NF_IN < 8) EI_LD(g + NF_IN);
#pragma unroll
            for (int bj = 0; bj < 2; ++bj) { f32x4 v0 = acc[ai][bj][m][0], v1 = acc[ai][bj][m][1];
                if (NORM) { const float r = rsv[bj]; v0 = v0 * r * g0; v1 = v1 * r * g1; }
                const size_t off = (((size_t)b * nh + h0 + bj) * T + t) * 128 + dlo;
                if (D1) { u32x2 w0, w1; w0.x = cvt_pk_bf16(v0[0], v0[1]); w0.y = cvt_pk_bf16(v0[2], v0[3]); w1.x = cvt_pk_bf16(v1[0], v1[1]); w1.y = cvt_pk_bf16(v1[2], v1[3]);
                    if (WT) { __hip_atomic_store((GAS unsigned long long*)(d1 + off), ((unsigned long long)w0.y << 32) | w0.x, __ATOMIC_RELAXED, __HIP_MEMORY_SCOPE_AGENT);
                        __hip_atomic_store((GAS unsigned long long*)(d1 + off + 64), ((unsigned long long)w1.y << 32) | w1.x, __ATOMIC_RELAXED, __HIP_MEMORY_SCOPE_AGENT); }
                    else { *(GAS u32x2*)(d1 + off) = w0; *(GAS u32x2*)(d1 + off + 64) = w1; } }
                if (D2) { const f32x4 r0 = v0 * c - v1 * sn, r1 = v1 * c + v0 * sn;
                    u32x2 w0, w1; w0.x = cvt_pk_bf16(r0[0], r0[1]); w0.y = cvt_pk_bf16(r0[2], r0[3]); w1.x = cvt_pk_bf16(r1[0], r1[1]); w1.y = cvt_pk_bf16(r1[2], r1[3]);
                    *(GAS u32x2*)(d2 + off) = w0; *(GAS u32x2*)(d2 + off + 64) = w1; } }
            asm volatile("" ::: "memory"); }
#undef EI_LD
        if (WT) handoff_signal(kcvc_cnt, fr + 16 * fq);
    }
};

struct EpiPart {
    static constexpr int NS = 0; static constexpr bool PERM = true, PREFETCH = false;
    float* P; unsigned* done_cnt;
    __device__ __forceinline__ void operator()(const f32x4 (&acc)[2][2][4][2], const Unit& u, int wr, int wc, int fr, int fq) const {
        const __amdgpu_buffer_rsrc_t rsrc = __builtin_amdgcn_make_buffer_rsrc(P, 0, 128 * 65536 * 4, 0x00020000);
        const unsigned base = ((unsigned)u.aux * 65536u + (unsigned)(wr * 64 + fr) * 256u + (unsigned)(wc * 32 + 8 * fq)) * 4u;
#pragma unroll
        for (int ai = 0; ai < 2; ++ai)
#pragma unroll
            for (int m = 0; m < 4; ++m) { const unsigned rp = base + (unsigned)(ai * HALF + m * 16) * 1024u;
#pragma unroll
                for (int bj = 0; bj < 2; ++bj)
#pragma unroll
                    for (int n = 0; n < 2; ++n) __builtin_amdgcn_raw_buffer_store_b128(__builtin_bit_cast(u32x4, acc[ai][bj][m][n]), rsrc, rp + (unsigned)(bj * HALF + 4 * n) * 4u, 0, 16);
                asm volatile("" ::: "memory"); }
        handoff_signal(done_cnt, fr + 16 * fq);
    }
};
struct CmpOrder {
    int G, c; const char* KC; const char* VC; const char* W1T;
    __device__ __forceinline__ bool next(int i, Unit& u) const { const int L = i * G + c; if (L >= 32) return false; u.pm = 0; u.pn = 0; u.aux = L; return true; }
    __device__ __forceinline__ void ptrs(const Unit& u, const char*& a, const char*& b) const { const int L = u.aux, kv = L >> 4, bg = (L >> 2) & 3, ks = L & 3;
        a = (kv ? VC : KC) + ((size_t)bg * T * 128 + ks * 1024) * 2; b = W1T + ((size_t)kv * 256 * 4096 + ks * 1024) * 2; }
};
}


struct Args {
    const float *x, *c, *w_ada, *b_ada, *norm1_g, *w_in, *b_forget, *fox_q_norm, *fox_k_norm, *nsa_q_norm, *cmp_k_norm, *slc_k_norm, *win_k_norm,
        *cmp_pe_k, *cmp_w1_k, *cmp_w2_k, *cmp_pe_v, *cmp_w1_v, *cmp_w2_v, *w_out, *norm2_g, *w_up, *w_down;
    float* out; unsigned char* ws; int ph_lo, ph_hi;
};

#ifndef DEV_ATT
#define DEV_ATT 3
#endif
namespace att {
typedef float f32x16 __attribute__((ext_vector_type(16)));
typedef short s16x4 __attribute__((ext_vector_type(4)));
constexpr int NW = 8, QBLK = 32, KVBLK = 64, D = 128;
constexpr int SHM_V = KVBLK * D * 2, SHM_K = KVBLK * D * 2;
constexpr int L_V = 0, L_K = 2 * SHM_V, L_WS = 2 * SHM_V + 2 * SHM_K, L_Q = L_WS + 2048;
constexpr int LC_V = 0, LC_K = 65536, LC_WS = 131072, LC_IMP = 133120;
constexpr int L_KB = 133120;
constexpr int L_SEL = 149504;
constexpr float THR = 8.f;
constexpr float C2 = 1.4426950408889634f * SCALE;
enum { M_FOX = 0, M_WIN = 1, M_SLC = 2 };
#define KSWZ(row, colB) ((row) * 256 + ((colB) ^ (((row) & 7) << 4)))
#define SBAR() __builtin_amdgcn_sched_barrier(0)
__device__ __forceinline__ int v_st(int k, int c) { const int kk = (k & ~0xC) | ((k & 4) << 1) | ((k & 8) >> 1); return ((kk >> 3) * 4 + (c >> 5)) * 512 + ((kk & 7) * 32 + (c & 31)) * 2; }
__device__ __forceinline__ int v_rd_base(int lane) { return ((lane & 3) << 3) | (((lane >> 2) & 3) << 6) | (((lane >> 4) & 1) << 5) | (((lane >> 5) & 1) << 8); }
constexpr int v_rd_off(int d0, int ks, int half) { return d0 * 512 + ks * 4096 + half * 2048; }
__device__ __forceinline__ int crow(int r, int hi) { return (r & 3) + 8 * (r >> 2) + 4 * hi; }
__device__ __forceinline__ bf16x8 load8(const bf16_t* p) { return *(const GAS bf16x8*)p; }
__device__ __forceinline__ void mask_tile(f32x16& p0, f32x16& p1, int dq, unsigned W) {
    const float NEG = -__builtin_inff();
#pragma unroll
    for (int r = 0; r < 16; ++r) { const int c = (r & 3) + 8 * (r >> 2);
        if ((unsigned)(dq - c) >= W) p0[r] = NEG;
        if ((unsigned)(dq - c - 32) >= W) p1[r] = NEG; }
}
__device__ __forceinline__ void partialSM(f32x16& p0, f32x16& p1, float& m_reg, float& mn, float& alpha) {
    float pmax = p0[0];
#pragma unroll
    for (int r = 1; r < 16; ++r) pmax = fmaxf(pmax, p0[r]);
#pragma unroll
    for (int r = 0; r < 16; ++r) pmax = fmaxf(pmax, p1[r]);
    { auto rr = __builtin_amdgcn_permlane32_swap(__float_as_uint(pmax), __float_as_uint(pmax), false, false);
      pmax = fmaxf(__uint_as_float(rr[0]), __uint_as_float(rr[1])); }
    if (__builtin_expect(__all((pmax - m_reg) * SCALE <= THR), 1)) { mn = m_reg; alpha = 1.f; }
    else { mn = fmaxf(m_reg, pmax); alpha = __builtin_amdgcn_exp2f((m_reg - mn) * C2); m_reg = mn; }
    const float mnL = -mn * C2;
#pragma unroll
    for (int r = 0; r < 16; ++r) p0[r] = fmaf(p0[r], C2, mnL);
#pragma unroll
    for (int r = 0; r < 16; ++r) p1[r] = fmaf(p1[r], C2, mnL);
#pragma unroll
    for (int r = 0; r < 16; ++r) p0[r] = __builtin_amdgcn_exp2f(p0[r]);
}
#define PK4(P, B_, OUT) do { unsigned a0 = cvt_pk_bf16(P[B_+0], P[B_+1]), a1 = cvt_pk_bf16(P[B_+2], P[B_+3]);                          \
        unsigned b0 = cvt_pk_bf16(P[B_+4], P[B_+5]), b1 = cvt_pk_bf16(P[B_+6], P[B_+7]);                                             \
        auto r0 = __builtin_amdgcn_permlane32_swap(a0, b0, false, false); auto r1 = __builtin_amdgcn_permlane32_swap(a1, b1, false, false); \
        u32x4 w = {r0[0], r1[0], r0[1], r1[1]}; OUT = *reinterpret_cast<bf16x8*>(&w); } while (0)
__device__ __forceinline__ void finishSM(f32x16& p0, f32x16& p1, float alpha, float& l_reg, bf16x8& pa0, bf16x8& pa1, bf16x8& pa2, bf16x8& pa3, bool on = true) {
#pragma unroll
    for (int r = 0; r < 16; ++r) p1[r] = __builtin_amdgcn_exp2f(p1[r]);
    float ps = 0;
#pragma unroll
    for (int r = 0; r < 16; ++r) ps += p0[r];
#pragma unroll
    for (int r = 0; r < 16; ++r) ps += p1[r];
    { auto rr = __builtin_amdgcn_permlane32_swap(__float_as_uint(ps), __float_as_uint(ps), false, false);
      ps = __uint_as_float(rr[0]) + __uint_as_float(rr[1]); }
    l_reg = l_reg * alpha + (on ? ps : 0.f);
    PK4(p0, 0, pa0); PK4(p0, 8, pa1); PK4(p1, 0, pa2); PK4(p1, 8, pa3);
    if (!on) { const bf16x8 z = {0, 0, 0, 0, 0, 0, 0, 0}; pa0 = z; pa1 = z; pa2 = z; pa3 = z; }
}
template <int KB>
__device__ __forceinline__ void qkt(f32x16& p0, f32x16& p1, const LAS char* K_lds, int r32, int hi, const LAS char* qs) {
    const LAS char* kb[4];
#pragma unroll
    for (int dd = 0; dd < 4; ++dd) kb[dd] = K_lds + KB * SHM_K + KSWZ(r32, (dd * 16 + hi * 8) * 2);
#pragma unroll
    for (int d0 = 0; d0 < 8; ++d0) { const LAS char* a = kb[d0 & 3] + (d0 >> 2) * 128;
        const bf16x8 q = *reinterpret_cast<const LAS bf16x8*>(qs + d0 * 1024);
        bf16x8 b0 = *reinterpret_cast<const LAS bf16x8*>(a);
        bf16x8 b1 = *reinterpret_cast<const LAS bf16x8*>(a + 32 * 256);
        p0 = __builtin_amdgcn_mfma_f32_32x32x16_bf16(b0, q, p0, 0, 0, 0);
        p1 = __builtin_amdgcn_mfma_f32_32x32x16_bf16(b1, q, p1, 0, 0, 0); }
}
template <int KB>
__device__ __forceinline__ void qkt_r(f32x16& p0, f32x16& p1, const LAS char* K_lds, int r32, int hi, const bf16x8* qr) {
    const LAS char* kb[4];
#pragma unroll
    for (int dd = 0; dd < 4; ++dd) kb[dd] = K_lds + KB * SHM_K + KSWZ(r32, (dd * 16 + hi * 8) * 2);
#pragma unroll
    for (int d0 = 0; d0 < 8; ++d0) { const LAS char* a = kb[d0 & 3] + (d0 >> 2) * 128;
        bf16x8 b0 = *reinterpret_cast<const LAS bf16x8*>(a);
        bf16x8 b1 = *reinterpret_cast<const LAS bf16x8*>(a + 32 * 256);
        p0 = __builtin_amdgcn_mfma_f32_32x32x16_bf16(b0, qr[d0], p0, 0, 0, 0);
        p1 = __builtin_amdgcn_mfma_f32_32x32x16_bf16(b1, qr[d0], p1, 0, 0, 0); }
}
template <int VB>
__device__ __forceinline__ void pv_tile(f32x16* o, int vb0, bf16x8 pa0, bf16x8 pa1, bf16x8 pa2, bf16x8 pa3) {
#define TRRD(dst, off) asm volatile("ds_read_b64_tr_b16 %0, %1 offset:%2" : "=&v"(dst) : "v"(vb0), "i"(off) : "memory")
#define PV_D0(d0) do { s16x4 l0, l1, l2, l3, h0, h1, h2, h3; constexpr int b_ = VB * SHM_V + v_rd_off(d0, 0, 0); \
        TRRD(l0, b_); TRRD(h0, b_ + 2048); TRRD(l1, b_ + 4096); TRRD(h1, b_ + 6144); TRRD(l2, b_ + 8192); TRRD(h2, b_ + 10240); TRRD(l3, b_ + 12288); TRRD(h3, b_ + 14336); \
        asm volatile("s_waitcnt lgkmcnt(0)" ::: "memory"); SBAR(); \
        o[d0] = __builtin_amdgcn_mfma_f32_32x32x16_bf16(pa0, (bf16x8){l0[0], l0[1], l0[2], l0[3], h0[0], h0[1], h0[2], h0[3]}, o[d0], 0, 0, 0);   \
        o[d0] = __builtin_amdgcn_mfma_f32_32x32x16_bf16(pa1, (bf16x8){l1[0], l1[1], l1[2], l1[3], h1[0], h1[1], h1[2], h1[3]}, o[d0], 0, 0, 0);   \
        o[d0] = __builtin_amdgcn_mfma_f32_32x32x16_bf16(pa2, (bf16x8){l2[0], l2[1], l2[2], l2[3], h2[0], h2[1], h2[2], h2[3]}, o[d0], 0, 0, 0);   \
        o[d0] = __builtin_amdgcn_mfma_f32_32x32x16_bf16(pa3, (bf16x8){l3[0], l3[1], l3[2], l3[3], h3[0], h3[1], h3[2], h3[3]}, o[d0], 0, 0, 0); } while (0)
    PV_D0(0); PV_D0(1); PV_D0(2); PV_D0(3);
#undef PV_D0
#undef TRRD
}

struct Blk {
    const bf16_t* Q;
    const bf16_t* K; const bf16_t* V;
    const float* KB;
    int mode, P0, j_lo, j_hi, b, hb;
};
struct Seam { bf16x8 st_v0, st_v1, st_k0, st_k1; };
__device__ __forceinline__ int q_lane_off(int mode, int wid, int r32) { return mode == M_FOX ? (wid * 32 + r32) * 128 : ((r32 >> 3) * T + wid * 8 + (r32 & 7)) * 128; }
#define ROW(p, k0, rr) ((p) + (size_t)((k0) + (rr)) * D + sc)
#define VMW() asm volatile("s_waitcnt vmcnt(0)" ::: "memory")
#define VMWN(n) asm volatile("s_waitcnt vmcnt(%0)" :: "i"(n) : "memory")
#define SLOAD_H(Kp, Vp, k0) do { S.st_v0 = load8(ROW(Vp, k0, sr)); S.st_v1 = load8(ROW(Vp, k0, 32 + sr)); S.st_k0 = load8(ROW(Kp, k0, sr)); S.st_k1 = load8(ROW(Kp, k0, 32 + sr)); } while (0)
#define SWRITE_HK(bf) do { *(LAS bf16x8*)(K_lds + (bf) * SHM_K + kws) = S.st_k0; *(LAS bf16x8*)(K_lds + (bf) * SHM_K + kws + 32 * 256) = S.st_k1; } while (0)
#define SWRITE_HV(bf) do { *(LAS bf16x8*)(V_lds + (bf) * SHM_V + vst0) = S.st_v0; *(LAS bf16x8*)(V_lds + (bf) * SHM_V + vst1) = S.st_v1; } while (0)
#define SWRITE_H(bf) do { SWRITE_HV(bf); SWRITE_HK(bf); } while (0)
__device__ __forceinline__ void attn_prime(const Blk& cur, LAS char* lds, Seam& S) {
    const int tid = threadIdx.x;
    const int sr = tid >> 4, sc = (tid & 15) * 8, kws = KSWZ(sr, sc * 2); LAS char* K_lds = lds + L_K;
    const int kb0 = cur.j_lo * KVBLK;
    SLOAD_H(cur.K, cur.V, kb0); VMW(); SWRITE_HK(0);
    __syncthreads();
}
struct EpiCtx { bf16_t* AO; float* NSAO; const float* GATES; unsigned* panel_cnt; };
__device__ __forceinline__ void attn_block(const Blk& cur, const Blk& nxt, LAS char* lds, Seam& S, const EpiCtx& ec) {
    int tid = threadIdx.x; asm volatile("" : "+v"(tid));
    const int wid = __builtin_amdgcn_readfirstlane(tid >> 6), lane = tid & 63, r32 = lane & 31, hi = lane >> 5;
    const int mode = cur.mode;
    const int j_lo = cur.j_lo, NT = cur.j_hi - cur.j_lo;
    const int kbn = nxt.j_lo * KVBLK;
    const bool fox = mode == M_FOX;
    const int wlo = cur.P0 + (fox ? wid * 32 : wid * 8), whi = wlo + (fox ? 31 : 7);
    const int pos = cur.P0 + (fox ? wid * 32 + r32 : wid * 8 + (r32 & 7)), qm = pos - 4 * hi;
    const unsigned Wu = (mode == M_WIN) ? 512u : (1u << 30);
    LAS char* V_lds = lds + L_V; LAS char* K_lds = lds + L_K;
    LAS float* ws = (LAS float*)(lds + L_WS) + wid * 64; LAS float* li_l = ws; LAS float* al_l = ws + 32;
    float m_reg = -1e30f, l_reg = 0; f32x16 o[4] = {};
    const int sr = tid >> 4, sc = (tid & 15) * 8, vst0 = v_st(sr, sc), vst1 = v_st(32 + sr, sc), kws = KSWZ(sr, sc * 2);
    const int vb0 = (int)(unsigned)(uintptr_t)V_lds + v_rd_base(lane);
    const bf16_t* Kh = cur.K; const bf16_t* Vh = cur.V;
    unsigned long long sel = ~0ull;
    if (mode == M_SLC) sel = *(const LAS unsigned long long*)(lds + L_SEL + (wid * 8 + (r32 & 7)) * 8);
#define RESC(a_) do { if (__any((a_) < 1.f)) { if (hi == 0) al_l[r32] = (a_); asm volatile("s_waitcnt lgkmcnt(0)" ::: "memory");              \
                     _Pragma("unroll") for (int d_ = 0; d_ < 4; ++d_) _Pragma("unroll") for (int r = 0; r < 16; ++r) o[d_][r] *= al_l[crow(r, hi)]; } } while (0)
#define KBASE(t) ((j_lo + (t)) * KVBLK)
#define PRELOAD(P0_, P1_, t) do { if (fox) { const LAS float* kbp_ = (const LAS float*)(lds + L_KB) + KBASE(t) + 4 * hi; \
            _Pragma("unroll") for (int q_ = 0; q_ < 4; ++q_) { const f32x4 a_ = *(const LAS f32x4*)(kbp_ + 8 * q_), b_ = *(const LAS f32x4*)(kbp_ + 32 + 8 * q_); \
                P0_[4*q_] = a_[0]; P0_[4*q_+1] = a_[1]; P0_[4*q_+2] = a_[2]; P0_[4*q_+3] = a_[3]; P1_[4*q_] = b_[0]; P1_[4*q_+1] = b_[1]; P1_[4*q_+2] = b_[2]; P1_[4*q_+3] = b_[3]; } } \
        else { P0_ = f32x16{}; P1_ = f32x16{}; } } while (0)
#define MASKT(P0_, P1_, t) do { const int kb_ = KBASE(t); \
        if (kb_ + KVBLK - 1 > wlo || kb_ + (int)Wu <= whi) mask_tile(P0_, P1_, qm - kb_, Wu); } while (0)
#define ONT(t) (mode != M_SLC || ((sel >> (j_lo + (t))) & 1ull) != 0ull)
    if (wid >= 4) __builtin_amdgcn_s_setprio(1);
    f32x16 pA0, pA1, pB0, pB1; float mnA, mnB, alA, alB; bf16x8 pa0, pa1, pa2, pa3;
    LAS char* qs = lds + L_Q + wid * 8192 + lane * 16;
    if (mode != M_SLC)
    { const bf16_t* qp = cur.Q + q_lane_off(mode, wid, r32) + hi * 8; bf16x8 tq[8];
#pragma unroll
      for (int d0 = 0; d0 < 8; ++d0) tq[d0] = load8(qp + d0 * 16);
#pragma unroll
      for (int d0 = 0; d0 < 8; ++d0) *(LAS bf16x8*)(qs + d0 * 1024) = tq[d0]; }
    PRELOAD(pA0, pA1, 0);
    SWRITE_HV(0); SBAR();
    if (NT > 1) SLOAD_H(Kh, Vh, KBASE(1));
    SBAR(); qkt<0>(pA0, pA1, K_lds, r32, hi, qs);
    if (NT > 1) PRELOAD(pB0, pB1, 1); else { pB0 = f32x16{}; pB1 = f32x16{}; }
    MASKT(pA0, pA1, 0); partialSM(pA0, pA1, m_reg, mnA, alA);
    if (NT > 1) { VMW(); SWRITE_H(1); }
    __syncthreads();
#define HALF_STEP(PX0, PX1, mnX, alX, PY0, PY1, alY, t, KB_, VB_, SB_) do {                                                      \
        SBAR(); if ((t) + 1 < NT) { SLOAD_H(Kh, Vh, KBASE((t) + 1)); SBAR(); }         \
        qkt<KB_>(PX0, PX1, K_lds, r32, hi, qs);                                             \
        finishSM(PY0, PY1, alY, l_reg, pa0, pa1, pa2, pa3, ONT((t) - 1)); SBAR();                                                           \
        if ((t) + 1 < NT) { PRELOAD(PY0, PY1, (t) + 1); SBAR(); }                                               \
        pv_tile<VB_>(o, vb0, pa0, pa1, pa2, pa3); MASKT(PX0, PX1, (t)); partialSM(PX0, PX1, m_reg, mnX, alX);                                        \
        __syncthreads();                                                                                                      \
        if ((t) + 1 < NT) { VMW(); SWRITE_H(SB_); }                                                                          \
        RESC(alX); __syncthreads(); } while (0)
    for (int t = 1; t + 1 < NT; t += 2) {
        HALF_STEP(pB0, pB1, mnB, alB, pA0, pA1, alA, t, 1, 0, 0);
        HALF_STEP(pA0, pA1, mnA, alA, pB0, pB1, alB, t + 1, 0, 1, 1);
    }
    const bool even = (NT & 1) == 0;
    if (even) { SBAR(); qkt<1>(pB0, pB1, K_lds, r32, hi, qs); SBAR(); }
    SLOAD_H(nxt.K, nxt.V, kbn); SBAR();
    SBAR();
    finishSM(pA0, pA1, alA, l_reg, pa0, pa1, pa2, pa3, ONT(even ? NT - 2 : NT - 1)); SBAR();
    pv_tile<0>(o, vb0, pa0, pa1, pa2, pa3);
    if (even) { MASKT(pB0, pB1, NT - 1); partialSM(pB0, pB1, m_reg, mnB, alB); __syncthreads(); RESC(alB);
        finishSM(pB0, pB1, alB, l_reg, pa0, pa1, pa2, pa3, ONT(NT - 1)); SBAR(); pv_tile<1>(o, vb0, pa0, pa1, pa2, pa3); }
    SBAR(); VMW(); SWRITE_HK(0); SBAR();
    if (hi == 0) li_l[r32] = l_reg; asm volatile("s_waitcnt lgkmcnt(0)" ::: "memory");
    if (fox) {
        bf16_t* Ow = ec.AO + ((size_t)cur.b * T + cur.P0 + wid * QBLK) * DM + cur.hb * 128;
#pragma unroll
        for (int r = 0; r < 16; ++r) { const int orow = crow(r, hi); const float li = li_l[orow]; const float rl = li > 0.f ? __builtin_amdgcn_rcpf(li) : 0.f;
#pragma unroll
            for (int d0 = 0; d0 < 4; ++d0) { const float v = o[d0][r] * rl; const float vn = __shfl_xor(v, 1);
                if ((r32 & 1) == 0) *(GAS unsigned*)(Ow + (size_t)orow * DM + d0 * 32 + r32) = cvt_pk_bf16(v, vn); } }
    } else {
        const int br = (mode == M_WIN) ? 2 : 1;
#pragma unroll
        for (int h8 = 0; h8 < 2; ++h8) {
            float gv[8]; float av[8][4], bv[8][4];
#pragma unroll
            for (int q = 0; q < 8; ++q) { const int rho = crow(h8 * 8 + q, hi);
                const int tok = cur.P0 + wid * 8 + (rho & 7), head = cur.hb + (rho >> 3); const size_t trow = (size_t)cur.b * T + tok;
                gv[q] = ((const GAS float*)ec.GATES)[trow * 24 + head * 3 + br];
                if (mode == M_SLC) { const GAS float* np = (const GAS float*)(ec.NSAO + trow * 1024 + head * 128 + r32); const GAS float* np2 = np + (ptrdiff_t)((WS_PART - WS_NSAO) / 4);
#pragma unroll
                    for (int d0 = 0; d0 < 4; ++d0) { av[q][d0] = np[d0 * 32]; bv[q][d0] = np2[d0 * 32]; } }
                else {
#pragma unroll
                    for (int d0 = 0; d0 < 4; ++d0) { av[q][d0] = 0.f; bv[q][d0] = 0.f; } } }
#pragma unroll
            for (int q = 0; q < 8; ++q) { const int r = h8 * 8 + q; const int rho = crow(r, hi); const float li = li_l[rho]; const float rl = li > 0.f ? __builtin_amdgcn_rcpf(li) : 0.f;
                const int tok = cur.P0 + wid * 8 + (rho & 7), head = cur.hb + (rho >> 3); const size_t trow = (size_t)cur.b * T + tok;
                const float gt = gv[q] * rl;
                GAS float* np2 = (GAS float*)(ec.NSAO + trow * 1024 + head * 128 + r32 + (ptrdiff_t)((WS_PART - WS_NSAO) / 4));
#pragma unroll
                for (int d0 = 0; d0 < 4; ++d0) {
                    if (mode == M_WIN) np2[d0 * 32] = gt * o[d0][r];
                    else { const float v = av[q][d0] + bv[q][d0] + gt * o[d0][r]; const float vn = __shfl_xor(v, 1); if ((r32 & 1) == 0) *(GAS unsigned*)(ec.AO + trow * DM + 1024 + head * 128 + d0 * 32 + r32) = cvt_pk_bf16(v, vn); } } }
            asm volatile("" ::: "memory"); }
    }
    __builtin_amdgcn_s_setprio(0);
    __syncthreads();
#undef RESC
#undef KBASE
#undef PRELOAD
#undef MASKT
#undef ONT
#undef HALF_STEP
}
#undef ROW
#undef SLOAD_H
#undef SWRITE_HK
#undef SWRITE_HV
#undef SWRITE_H

__device__ __forceinline__ bf16x8 ovfrag(int n0, int J) {
    asm volatile("" : "+v"(n0));
    unsigned w[4];
#pragma unroll
    for (int q = 0; q < 4; ++q) { unsigned lohi[2];
#pragma unroll
        for (int e = 0; e < 2; ++e) { const int dl = n0 + 2 * q + e - 4 * J; lohi[e] = (dl >= 0 && dl <= 2) ? 0x3F80u : ((dl == 3 || dl == -1) ? 0x3F00u : 0u); }
        w[q] = lohi[0] | (lohi[1] << 16); }
    u32x4 v = {w[0], w[1], w[2], w[3]}; return *reinterpret_cast<bf16x8*>(&v);
}
__device__ __forceinline__ void nsa_cmp_item(int b, int g, int qb, const bf16_t* NQ, const bf16_t* KCMP, const bf16_t* VCMP, const float* GATES, const float* mbound, float* NSAO, LAS char* lds) {
    int tid = threadIdx.x; asm volatile("" : "+v"(tid));
    const int wid = __builtin_amdgcn_readfirstlane(tid >> 6), lane = tid & 63, r32 = lane & 31, hi = lane >> 5;
    LAS char* V_lds = lds + LC_V; LAS char* K_lds = lds + LC_K;
    LAS float* ws = (LAS float*)(lds + LC_WS) + wid * 64; LAS float* li_l = ws;
    LAS float* impL = (LAS float*)(lds + LC_IMP);
    const int sr = tid >> 4, sc = (tid & 15) * 8, vst0 = v_st(sr, sc), vst1 = v_st(32 + sr, sc), kws = KSWZ(sr, sc * 2);
    const bf16_t* Kc = KCMP + (size_t)(b * 2 + g) * 256 * 128; const bf16_t* Vc = VCMP + (size_t)(b * 2 + g) * 256 * 128;
    const int ntile = ((4 * qb + 2) >> 6) + 1;
    bf16x8 qr[8];
    { const bf16_t* qp = NQ + (((size_t)b * 8 + g * 4) * T + qb * 64) * 128 + q_lane_off(M_WIN, wid, r32) + hi * 8;
#pragma unroll
      for (int d0 = 0; d0 < 8; ++d0) qr[d0] = load8(qp + d0 * 16); }
    {
        bf16x8 kk[4][2], vv[4][2];
#pragma unroll
        for (int tl = 0; tl < 4; ++tl) { kk[tl][0] = load8(Kc + (size_t)(tl * 64 + sr) * 128 + sc); kk[tl][1] = load8(Kc + (size_t)(tl * 64 + 32 + sr) * 128 + sc); }
#pragma unroll
        for (int tl = 0; tl < 4; ++tl) { vv[tl][0] = load8(Vc + (size_t)(tl * 64 + sr) * 128 + sc); vv[tl][1] = load8(Vc + (size_t)(tl * 64 + 32 + sr) * 128 + sc); }
#pragma unroll
        for (int tl = 0; tl < 4; ++tl) { *(LAS bf16x8*)(K_lds + tl * SHM_K + kws) = kk[tl][0]; *(LAS bf16x8*)(K_lds + tl * SHM_K + kws + 32 * 256) = kk[tl][1]; }
#pragma unroll
        for (int tl = 0; tl < 4; ++tl) { *(LAS bf16x8*)(V_lds + tl * SHM_V + vst0) = vv[tl][0]; *(LAS bf16x8*)(V_lds + tl * SHM_V + vst1) = vv[tl][1]; }
        asm volatile("" ::: "memory");
    }
    __syncthreads();
    const int pos = qb * 64 + wid * 8 + (r32 & 7);
    const int nmax = (pos - 31) >> 4;
    const float NEG = -__builtin_inff();
#define CMASK(P0_, P1_, tl) do { _Pragma("unroll") for (int r = 0; r < 16; ++r) { const int n_ = (tl) * 64 + crow(r, hi); if (n_ > nmax) P0_[r] = NEG; if (n_ + 32 > nmax) P1_[r] = NEG; } } while (0)
    const float mL = -(*(const GAS float*)mbound) * C2;
    float l_reg = 0.f;
    const int vb0 = (int)(unsigned)(uintptr_t)V_lds + v_rd_base(lane);
    f32x16 o[4] = {}; f32x16 io[2] = {};
#pragma nounroll
    for (int tl = 0; tl < ntile; ++tl) { f32x16 p0 = f32x16{}, p1 = f32x16{}; qkt_r<0>(p0, p1, K_lds + tl * SHM_K, r32, hi, qr); CMASK(p0, p1, tl);
        float ps = 0.f;
#pragma unroll
        for (int r = 0; r < 16; ++r) { p0[r] = __builtin_amdgcn_exp2f(fmaf(p0[r], C2, mL)); p1[r] = __builtin_amdgcn_exp2f(fmaf(p1[r], C2, mL)); ps += p0[r] + p1[r]; }
        l_reg += ps; bf16x8 pa0, pa1, pa2, pa3; PK4(p0, 0, pa0); PK4(p0, 8, pa1); PK4(p1, 0, pa2); PK4(p1, 8, pa3);
        pv_tile<0>(o, vb0 + tl * SHM_V, pa0, pa1, pa2, pa3); SBAR();
#pragma unroll
        for (int d0 = 0; d0 < 2; ++d0) { const int J = d0 * 32 + r32;
            io[d0] = __builtin_amdgcn_mfma_f32_32x32x16_bf16(pa0, ovfrag(tl * 64 + 0 + 8 * hi, J), io[d0], 0, 0, 0);
            io[d0] = __builtin_amdgcn_mfma_f32_32x32x16_bf16(pa1, ovfrag(tl * 64 + 16 + 8 * hi, J), io[d0], 0, 0, 0);
            io[d0] = __builtin_amdgcn_mfma_f32_32x32x16_bf16(pa2, ovfrag(tl * 64 + 32 + 8 * hi, J), io[d0], 0, 0, 0);
            io[d0] = __builtin_amdgcn_mfma_f32_32x32x16_bf16(pa3, ovfrag(tl * 64 + 48 + 8 * hi, J), io[d0], 0, 0, 0); } SBAR(); }
    { auto rr = __builtin_amdgcn_permlane32_swap(__float_as_uint(l_reg), __float_as_uint(l_reg), false, false); l_reg = __uint_as_float(rr[0]) + __uint_as_float(rr[1]); }
    if (hi == 0) li_l[r32] = l_reg; asm volatile("s_waitcnt lgkmcnt(0)" ::: "memory");
    {
        float gv[16];
#pragma unroll
        for (int r = 0; r < 16; ++r) { const int rho = crow(r, hi); gv[r] = ((const GAS float*)GATES)[((size_t)b * T + qb * 64 + wid * 8 + (rho & 7)) * 24 + (g * 4 + (rho >> 3)) * 3 + 0]; }
        float imps[2][4] = {};
#pragma unroll
        for (int r = 0; r < 16; ++r) { const int rho = crow(r, hi); const float li = li_l[rho]; const float rl = li > 0.f ? __builtin_amdgcn_rcpf(li) : 0.f;
            const int tok = qb * 64 + wid * 8 + (rho & 7), head = g * 4 + (rho >> 3);
            const size_t trow = (size_t)b * T + tok;
            const float gt = gv[r] * rl;
            GAS float* np = (GAS float*)(NSAO + trow * 1024 + head * 128 + r32);
#pragma unroll
            for (int d0 = 0; d0 < 4; ++d0) np[d0 * 32] = gt * o[d0][r];
            imps[0][r & 3] += io[0][r] * rl; imps[1][r & 3] += io[1][r] * rl; }
#pragma unroll
        for (int d0 = 0; d0 < 2; ++d0)
#pragma unroll
            for (int e = 0; e < 4; ++e) impL[(wid * 8 + e + 4 * hi) * 64 + d0 * 32 + r32] = imps[d0][e];
    }
#undef CMASK
    __syncthreads();
#pragma nounroll
    for (int tk = 0; tk < 8; ++tk) { const int tl = wid * 8 + tk; const int J = lane;
        const float im = impL[tl * 64 + J];
        const bool forced = (J == 0) || (J == qb) || (J == qb - 1);
        const float v = forced ? __builtin_inff() : (J <= qb ? im : NEG);
        impL[tl * 64 + J] = v; asm volatile("s_waitcnt lgkmcnt(0)" ::: "memory");
        f32x4 uv[16];
#pragma unroll
        for (int q = 0; q < 16; ++q) uv[q] = *(const LAS f32x4*)(impL + tl * 64 + 4 * q);
        int rank = 0;
#pragma unroll
        for (int q = 0; q < 16; ++q)
#pragma unroll
            for (int e = 0; e < 4; ++e) { const float u = uv[q][e]; const int jj = 4 * q + e; rank += (u > v || (u == v && jj < J)) ? 1 : 0; }
        const unsigned long long mk = __ballot(rank < 16 && J <= qb);
        if (lane == 0) *(LAS unsigned long long*)(lds + L_SEL + tl * 8) = mk; }
    __syncthreads();
}
#undef PK4
#undef VMW
#undef VMWN

template <class P> __device__ __forceinline__ P* uptr(P* p) { const unsigned long long v = (unsigned long long)p;
    const unsigned lo = __builtin_amdgcn_readfirstlane((unsigned)v), hi = __builtin_amdgcn_readfirstlane((unsigned)(v >> 32)); return (P*)(((unsigned long long)hi << 32) | lo); }
__device__ __forceinline__ Blk make_blk(unsigned char* ws, int i, int st) {
    const int bg = i >> 6, qb = i & 63, b = bg >> 1, g = bg & 1; Blk k;
    if (st < 2) {
        k.Q = uptr((const bf16_t*)(ws + WS_NQR) + (((size_t)b * 8 + g * 4) * T + qb * 64) * 128);
        k.K = uptr((const bf16_t*)(ws + (st == 0 ? WS_KW : WS_KSL)) + (size_t)bg * T * 128); k.V = uptr((const bf16_t*)(ws + (st == 0 ? WS_VW : WS_VSL)) + (size_t)bg * T * 128);
        k.KB = nullptr; k.mode = st == 0 ? M_WIN : M_SLC; k.P0 = qb * 64; k.j_lo = (st == 0 && qb >= 8) ? qb - 8 : 0; k.j_hi = qb + 1; k.b = b; k.hb = g * 4;
    } else {
        const int bh = bg * 4 + (qb & 3), qf = 15 - (qb >> 2);
        k.Q = uptr((const bf16_t*)(ws + WS_FQ) + ((size_t)bh * T + qf * 256) * 128); k.K = uptr((const bf16_t*)(ws + WS_FK) + (size_t)bh * T * 128); k.V = uptr((const bf16_t*)(ws + WS_FV) + (size_t)bh * T * 128);
        k.KB = uptr((const float*)(ws + WS_KBIAS) + (size_t)bh * T); k.mode = M_FOX; k.P0 = qf * 256; k.j_lo = 0; k.j_hi = 4 * qf + 4; k.b = bh >> 3; k.hb = bh & 7;
    }
    k.mode = __builtin_amdgcn_readfirstlane(k.mode); k.P0 = __builtin_amdgcn_readfirstlane(k.P0); k.j_lo = __builtin_amdgcn_readfirstlane(k.j_lo); k.j_hi = __builtin_amdgcn_readfirstlane(k.j_hi);
    k.b = __builtin_amdgcn_readfirstlane(k.b); k.hb = __builtin_amdgcn_readfirstlane(k.hb);
    return k;
}
__device__ __forceinline__ void compute_kb(unsigned char* ws, int bh, LAS char* lds) {
    int tid = threadIdx.x; asm volatile("" : "+v"(tid));
    LAS double* part = (LAS double*)(lds + LC_IMP);
    const float* lf = (const float*)(ws + WS_LOGF) + (size_t)bh * T + tid * 8; float* kb = (float*)(ws + WS_KBIAS) + (size_t)bh * T + tid * 8;
    const f32x4 v0 = *(const f32x4*)lf, v1 = *(const f32x4*)(lf + 4);
    double loc[8]; double run = 0.0;
    { const float vv[8] = {v0[0], v0[1], v0[2], v0[3], v1[0], v1[1], v1[2], v1[3]};
#pragma unroll
      for (int i = 0; i < 8; ++i) { run += (double)vv[i]; loc[i] = run; } }
    const int lane = tid & 63, wv = tid >> 6; double inc = run;
#pragma unroll
    for (int o = 1; o < 64; o <<= 1) { const double up = __shfl_up(inc, o); if (lane >= o) inc += up; }
    if (lane == 63) part[wv] = inc;
    __syncthreads();
    double off = inc - run;
    for (int w = 0; w < wv; ++w) off += part[w];
    f32x4 o0, o1;
#pragma unroll
    for (int i = 0; i < 4; ++i) { o0[i] = (float)(-(off + loc[i]) * (double)(1.0f / SCALE)); o1[i] = (float)(-(off + loc[4 + i]) * (double)(1.0f / SCALE)); }
    *(f32x4*)kb = o0; *(f32x4*)(kb + 4) = o1;
    asm volatile("s_waitcnt vmcnt(0)" ::: "memory");
    __syncthreads();
}
__device__ __forceinline__ void stage_kb(const float* kbg, LAS char* lds) {
    int tid = threadIdx.x; asm volatile("" : "+v"(tid));
    const f32x4 v0 = *(const GAS f32x4*)(kbg + tid * 8), v1 = *(const GAS f32x4*)(kbg + tid * 8 + 4);
    LAS float* kl = (LAS float*)(lds + L_KB) + tid * 8;
    *(LAS f32x4*)kl = v0; *(LAS f32x4*)(kl + 4) = v1;
    __syncthreads();
}
__device__ __forceinline__ void attn_phase(const Args& a, LAS char* lds, int vcu, int G) {
    unsigned char* ws = a.ws;
    EpiCtx ec{(bf16_t*)(ws + WS_AO), (float*)(ws + WS_NSAO), (const float*)(ws + WS_GATES), (unsigned*)(ws + CTL_CNT_ATTN)};
    Seam S;
    constexpr int ST0 = (DEV_ATT == 1) ? 2 : 0, ST1 = (DEV_ATT == 2) ? 2 : 3;
    for (int i = vcu; i < 256; i += G) {
#ifndef NO_CMP
        if (DEV_ATT & 2) { const int bg = i >> 6, qb = i & 63; nsa_cmp_item(bg >> 1, bg & 1, qb, (const bf16_t*)(ws + WS_NQ), (const bf16_t*)(ws + WS_KCMP), (const bf16_t*)(ws + WS_VCMP), ec.GATES, (const float*)(ws + WS_MBOUND), ec.NSAO, lds); }
#endif
#ifndef NO_BLK
        Blk cur = make_blk(ws, i, ST0);
        attn_prime(cur, lds, S);
        for (int st = ST0; st < ST1; ++st) { const Blk nxt = make_blk(ws, i, st + 1 < ST1 ? st + 1 : st);
            if (st == 1) { const int tid_ = threadIdx.x, w_ = __builtin_amdgcn_readfirstlane(tid_ >> 6), l_ = tid_ & 63; const float* kbg = (const float*)(ws + WS_KBIAS) + (size_t)((i >> 6) * 4 + (i & 3)) * T;
#pragma unroll
                for (int h_ = 0; h_ < 2; ++h_) __builtin_amdgcn_global_load_lds((const unsigned*)(kbg + (w_ * 2 + h_) * 256 + l_ * 4), (LAS unsigned*)(lds + L_KB + (w_ * 2 + h_) * 1024), 16, 0, 0); }
            if (st == 2) { asm volatile("s_waitcnt vmcnt(0)" ::: "memory"); __syncthreads(); }
            attn_block(cur, nxt, lds, S, ec); cur = nxt; }
#endif
    }
}
#undef KSWZ
#undef SBAR
}


__device__ __forceinline__ int win_src_col(int pg) {
    const int pn = pg >> 8, p = pg & 255;
    if (pn == 12) { if (p < 8) return C_FZ + p; if (p < 32) return C_GZ + p - 8; return -1; }
    const int bj = p >> 7, q = p & 127;
    const int d = 16 * (q >> 5) + 4 * ((q >> 3) & 3) + (q & 3) + 64 * ((q >> 2) & 1);
    int base;
    if (pn < 4) base = C_FQ + pn * 256; else if (pn < 8) base = C_FK + (pn - 4) * 256; else if (pn < 12) base = C_FV + (pn - 8) * 256;
    else if (pn < 17) base = C_NQ + (pn - 13) * 256; else if (pn == 17) base = C_KC; else if (pn == 18) base = C_VC; else if (pn == 19) base = C_KSL;
    else if (pn == 20) base = C_KW; else if (pn == 21) base = C_VSL; else base = C_VW;
    return base + bj * 128 + d;
}
template <int SRC>
__device__ __forceinline__ void transpose_item(const float* W, int K, int N, bf16_t* WT, LAS float* scr, int item, int nblk, int lane) {
    const int kb = item / nblk, nb = item % nblk, k0 = 64 * kb, n0 = 32 * nb;
    int sc = n0 + (lane & 31); if (SRC == 1) sc = win_src_col(sc);
    float tv[32];
    const float* wp = W + (size_t)(k0 + (lane >> 5)) * N + (sc >= 0 ? sc : 0);
#pragma unroll
    for (int i = 0; i < 32; ++i) tv[i] = wp[(size_t)(2 * i) * N];
#pragma unroll
    for (int i = 0; i < 32; ++i) { const int kk = 2 * i + (lane >> 5); scr[kk * 33 + (lane & 31)] = sc >= 0 ? tv[i] : 0.f; }
    asm volatile("s_waitcnt lgkmcnt(0)" ::: "memory");
    const int cch = lane & 7;
#pragma unroll
    for (int j = 0; j < 4; ++j) { const int n = (lane >> 3) + 8 * j; const LAS float* s = scr + (8 * cch) * 33 + n;
        u32x4 o; o.x = cvt_pk_bf16(s[0 * 33], s[1 * 33]); o.y = cvt_pk_bf16(s[2 * 33], s[3 * 33]); o.z = cvt_pk_bf16(s[4 * 33], s[5 * 33]); o.w = cvt_pk_bf16(s[6 * 33], s[7 * 33]);
        *(u32x4*)(WT + (size_t)(n0 + n) * K + k0 + 8 * cch) = o; }
    asm volatile("s_waitcnt lgkmcnt(0)" ::: "memory");
}

__device__ __forceinline__ void p0_prologue(const Args& a, LAS unsigned char* lds, int vcu, int G) {
    int tid = threadIdx.x; asm volatile("" : "+v"(tid)); const int lane = tid & 63, wave = __builtin_amdgcn_readfirstlane(tid >> 6);
    LAS float* ca = (LAS float*)lds;
    for (int i = tid; i < 2 * DM; i += NTHR) { const float v = a.c[i]; ca[i] = v / (1.f + __expf(-v)); }
    __syncthreads();
    const int gw = vcu * NWAVES + wave, NGW = G * NWAVES;
    float* modp = (float*)(a.ws + WS_MODP);
    if (wave < 3) { const int it = vcu * 3 + wave;
        if (it < 16 * 48) { const int kc = it / 48, cq = (it % 48) * 64 + lane;
            f32x4 a0 = (f32x4){0.f, 0.f, 0.f, 0.f}, a1 = a0;
            const float* wp = a.w_ada + (size_t)(kc * 128) * (6 * DM) + 4 * cq;
#pragma unroll 16
            for (int k = 0; k < 128; ++k) { const f32x4 w = *(const f32x4*)(wp + (size_t)k * (6 * DM)); a0 += w * ca[kc * 128 + k]; a1 += w * ca[DM + kc * 128 + k]; }
            const __amdgpu_buffer_rsrc_t rsrc = __builtin_amdgcn_make_buffer_rsrc(modp, 0, 16 * 2 * 6 * DM * 4, 0x00020000);
            __builtin_amdgcn_raw_buffer_store_b128(__builtin_bit_cast(u32x4, a0), rsrc, (unsigned)((((size_t)kc * 2 + 0) * (6 * DM) + 4 * cq) * 4), 0, 16);
            __builtin_amdgcn_raw_buffer_store_b128(__builtin_bit_cast(u32x4, a1), rsrc, (unsigned)((((size_t)kc * 2 + 1) * (6 * DM) + 4 * cq) * 4), 0, 16);
            handoff_signal((unsigned*)(a.ws + CTL_CNT_ADALN), lane); } }
    LAS float* scr = (LAS float*)(lds + 16384 + wave * 16384);
    constexpr int I_IN = 32 * (NPAD / 32), I_OUT = 32 * 64, I_UP = 32 * 256, I_DN = 128 * 64, I_W1 = 64 * 8, I_W2 = 4 * 4;
    constexpr int NIT = I_IN + I_OUT + I_UP + I_DN + 2 * I_W1 + 2 * I_W2;
    const int nslot = (NIT + G - 1) / G;
    auto slot_item = [&](int m) -> int { int j; if (wave < 3) { if (m >= 6) return -1; j = wave * 6 + m; } else { j = 18 + (wave - 3) + 5 * m; }
        if (j >= nslot) return -1; const int it = vcu + G * j; return it < NIT ? it : -1; };
    struct TrIt { const float* wp; bf16_t* wt; int N, K, ok; };
    auto decode = [&](int it) -> TrIt { int r = it; const float* W; bf16_t* WT; int K, N, nblk; bool src = false;
        if (r < I_IN) { W = a.w_in; K = DM; N = DIN; WT = (bf16_t*)(a.ws + WS_WIN); nblk = NPAD / 32; src = true; }
        else if ((r -= I_IN) < I_OUT) { W = a.w_out; K = DM; N = DM; WT = (bf16_t*)(a.ws + WS_WOUT); nblk = 64; }
        else if ((r -= I_OUT) < I_UP) { W = a.w_up; K = DM; N = DFF; WT = (bf16_t*)(a.ws + WS_WUP); nblk = 256; }
        else if ((r -= I_UP) < I_DN) { W = a.w_down; K = DFF; N = DM; WT = (bf16_t*)(a.ws + WS_WDN); nblk = 64; }
        else if ((r -= I_DN) < I_W1) { W = a.cmp_w1_k; K = 4096; N = 256; WT = (bf16_t*)(a.ws + WS_W1T); nblk = 8; }
        else if ((r -= I_W1) < I_W1) { W = a.cmp_w1_v; K = 4096; N = 256; WT = (bf16_t*)(a.ws + WS_W1T) + 256 * 4096; nblk = 8; }
        else if ((r -= I_W1) < I_W2) { W = a.cmp_w2_k; K = 256; N = 128; WT = (bf16_t*)(a.ws + WS_W2T); nblk = 4; }
        else { r -= I_W2; W = a.cmp_w2_v; K = 256; N = 128; WT = (bf16_t*)(a.ws + WS_W2T) + 128 * 256; nblk = 4; }
        const int kb = r / nblk, nb = r % nblk, k0 = 64 * kb, n0 = 32 * nb; int sc = n0 + (lane & 31); if (src) sc = win_src_col(sc);
        TrIt t; t.wp = W + (size_t)(k0 + (lane >> 5)) * N + (sc >= 0 ? sc : 0); t.wt = WT + (size_t)n0 * K + k0; t.N = N; t.K = K; t.ok = sc >= 0; return t; };
    auto tr_load = [&](const TrIt& t, float (&tv)[32]) {
#pragma unroll
        for (int i = 0; i < 32; ++i) tv[i] = t.wp[(size_t)(2 * i) * t.N]; };
    auto tr_store = [&](const TrIt& t, const float (&tv)[32]) {
#pragma unroll
        for (int i = 0; i < 32; ++i) { const int kk = 2 * i + (lane >> 5); scr[kk * 33 + (lane & 31)] = t.ok ? tv[i] : 0.f; }
        asm volatile("s_waitcnt lgkmcnt(0)" ::: "memory");
        const int cch = lane & 7;
#pragma unroll
        for (int j = 0; j < 4; ++j) { const int n = (lane >> 3) + 8 * j; const LAS float* sp = scr + (8 * cch) * 33 + n;
            u32x4 o; o.x = cvt_pk_bf16(sp[0 * 33], sp[1 * 33]); o.y = cvt_pk_bf16(sp[2 * 33], sp[3 * 33]); o.z = cvt_pk_bf16(sp[4 * 33], sp[5 * 33]); o.w = cvt_pk_bf16(sp[6 * 33], sp[7 * 33]);
            *(u32x4*)(t.wt + (size_t)n * t.K + 8 * cch) = o; }
        asm volatile("s_waitcnt lgkmcnt(0)" ::: "memory"); };
    {   float tva[32], tvb[32]; TrIt ta, tb; int ia = slot_item(0), ib;
        if (ia >= 0) { ta = decode(ia); tr_load(ta, tva); }
        for (int m = 1; ia >= 0; m += 2) {
            ib = slot_item(m); if (ib >= 0) { tb = decode(ib); tr_load(tb, tvb); }
            asm volatile("" ::: "memory");
            tr_store(ta, tva);
            if (ib < 0) break;
            ia = slot_item(m + 1); if (ia >= 0) { ta = decode(ia); tr_load(ta, tva); }
            asm volatile("" ::: "memory");
            tr_store(tb, tvb);
        }
    }
    if (vcu == 255 && wave == 7) { const float gk = fmaxf(fabsf(a.cmp_k_norm[lane]), fabsf(a.cmp_k_norm[64 + lane])), gq = fmaxf(fabsf(a.nsa_q_norm[lane]), fabsf(a.nsa_q_norm[64 + lane]));
        const float mb = wave_max(gk) * wave_max(gq) * (128.f * 1.02f); if (lane == 0) *(float*)(a.ws + WS_MBOUND) = mb; }
    float* rope = (float*)(a.ws + WS_ROPE);
    for (int e = (vcu * NTHR + tid); e < T * 64; e += G * NTHR) { const int t = e >> 6, i = e & 63;
        const float inv_freq = (float)pow(10000.0, -(double)i / 64.0); const float ang = (float)t * inv_freq;
        rope[2 * e] = (float)cos((double)ang); rope[2 * e + 1] = (float)sin((double)ang); }
    float* pebp = (float*)(a.ws + WS_PEBP);
    for (int it = gw; it < 2 * 4 * 64; it += NGW) { const int kv = it >> 8, cg_ = (it >> 6) & 3, ch = it & 63, col = cg_ * 64 + lane;
        const float* pe = kv ? a.cmp_pe_v : a.cmp_pe_k; const float* w1 = kv ? a.cmp_w1_v : a.cmp_w1_k; float s = 0.f;
#pragma unroll
        for (int i = 0; i < 64; ++i) s += pe[ch * 64 + i] * w1[(size_t)(ch * 64 + i) * 256 + col];
        pebp[((size_t)kv * 64 + ch) * 256 + col] = s; }
}

template <bool FIRST>
__device__ __forceinline__ void norm_phase(const Args& a, LAS unsigned char* lds, const float* xsrc, const float* gain, int shift_off, int scale_off, int bid, int G) {
    int tid = threadIdx.x; asm volatile("" : "+v"(tid)); const int lane = tid & 63, wave = __builtin_amdgcn_readfirstlane(tid >> 6);
    LAS float* AS = (LAS float*)lds; LAS float* SH = AS + DM;
    const float* modp = (const float*)(a.ws + WS_MODP); float* mod = (float*)(a.ws + WS_MOD);
    const int rows_per = M / G, b = (bid * rows_per) / T;
    f32x4 v[4][8];
#pragma unroll
    for (int rr = 0; rr < 4; ++rr) { const f32x4* xr = (const f32x4*)(xsrc + (size_t)(bid * rows_per + wave + 8 * rr) * DM) + lane;
#pragma unroll
        for (int j = 0; j < 8; ++j) v[rr][j] = xr[64 * j]; }
    if (FIRST) handoff_wait((unsigned*)(a.ws + CTL_CNT_ADALN), 16u * 48u);
    for (int d = tid; d < DM; d += NTHR) { float sc, sh;
        if (FIRST) { sc = a.b_ada[scale_off + d]; sh = a.b_ada[shift_off + d];
#pragma unroll
            for (int kc = 0; kc < 16; ++kc) { sc += modp[((size_t)kc * 2 + b) * (6 * DM) + scale_off + d]; sh += modp[((size_t)kc * 2 + b) * (6 * DM) + shift_off + d]; } }
        else { sc = mod[b * 6 * DM + scale_off + d]; sh = mod[b * 6 * DM + shift_off + d]; }
        AS[d] = gain[d] * (1.f + sc); SH[d] = sh; }
    if (FIRST) {
        for (int e = bid * NTHR + tid; e < 2 * 6 * DM; e += G * NTHR) { const int bb = e / (6 * DM), j = e % (6 * DM); float s = a.b_ada[j];
#pragma unroll
            for (int kc = 0; kc < 16; ++kc) s += modp[((size_t)kc * 2 + bb) * (6 * DM) + j];
            mod[e] = s; }
    }
    __syncthreads();
    bf16_t* XN = (bf16_t*)(a.ws + WS_XN);
    for (int r0 = 0; r0 < rows_per; r0 += 32) {
        if (r0 > 0) {
#pragma unroll
            for (int rr = 0; rr < 4; ++rr) { const f32x4* xr = (const f32x4*)(xsrc + (size_t)(bid * rows_per + r0 + wave + 8 * rr) * DM) + lane;
#pragma unroll
                for (int j = 0; j < 8; ++j) v[rr][j] = xr[64 * j]; } }
#pragma unroll
        for (int rr = 0; rr < 4; ++rr) { const int row = bid * rows_per + r0 + wave + 8 * rr; float ss = 0.f;
#pragma unroll
            for (int j = 0; j < 8; ++j) ss += (v[rr][j][0] * v[rr][j][0] + v[rr][j][1] * v[rr][j][1]) + (v[rr][j][2] * v[rr][j][2] + v[rr][j][3] * v[rr][j][3]);
            const float rstd = 1.0f / sqrtf(wave_sum(ss) * (1.f / DM) + EPS);
            u32x2* o8 = (u32x2*)(XN + (size_t)row * DM) + lane;
#pragma unroll
            for (int j = 0; j < 8; ++j) { const f32x4 as = *(const LAS f32x4*)(AS + 4 * lane + 256 * j), sh = *(const LAS f32x4*)(SH + 4 * lane + 256 * j);
                const f32x4 h = v[rr][j] * rstd * as + sh; u32x2 w; w.x = cvt_pk_bf16(h[0], h[1]); w.y = cvt_pk_bf16(h[2], h[3]); o8[64 * j] = w; } }
    }
    __syncthreads();
}


__device__ __forceinline__ void cmp2_phase(const Args& a, LAS unsigned char* lds, int L0, int Lstride) {
    int tid = threadIdx.x; asm volatile("" : "+v"(tid)); const int lane = tid & 63, wave = __builtin_amdgcn_readfirstlane(tid >> 6);
    unsigned char* ws = a.ws;
    for (int L = L0; L < 64; L += Lstride) {
        {
            const int kv = L >> 5, bg = (L >> 3) & 3, rt = L & 7;
            LAS bf16_t* hidL = (LAS bf16_t*)lds;
            LAS float* red = (LAS float*)(lds + 32768);
            LAS float* pebL = (LAS float*)(lds + 36864);
            if (tid < 256) { const float* pebp = (const float*)(ws + WS_PEBP) + (size_t)kv * 64 * 256 + tid; float sp = 0.f;
#pragma unroll
                for (int ch = 0; ch < 64; ++ch) sp += pebp[ch * 256];
                pebL[tid] = sp; }
            __syncthreads();
            { const int row = tid >> 4, c0 = (tid & 15) * 16;
              const float* pp = (const float*)(ws + WS_PART) + ((size_t)(kv * 4 + bg) * 4) * 65536 + (size_t)(rt * 32 + row) * 256 + c0;
              const LAS float* peb = pebL + c0;
              f32x4 s0 = *(const LAS f32x4*)peb, s1 = *(const LAS f32x4*)(peb + 4), s2 = *(const LAS f32x4*)(peb + 8), s3 = *(const LAS f32x4*)(peb + 12);
#pragma unroll 4
              for (int ks = 0; ks < 4; ++ks) { const float* q = pp + (size_t)ks * 65536; s0 += *(const f32x4*)q; s1 += *(const f32x4*)(q + 4); s2 += *(const f32x4*)(q + 8); s3 += *(const f32x4*)(q + 12); }
              f32x4 sv[4] = {s0, s1, s2, s3}; unsigned w[8];
#pragma unroll
              for (int i = 0; i < 4; ++i) { f32x4 v = sv[i];
#pragma unroll
                  for (int e = 0; e < 4; ++e) v[e] = v[e] / (1.f + __expf(-v[e]));
                  w[2 * i] = cvt_pk_bf16(v[0], v[1]); w[2 * i + 1] = cvt_pk_bf16(v[2], v[3]); }
              *(LAS u32x4*)(hidL + row * 264 + c0) = (u32x4){w[0], w[1], w[2], w[3]}; *(LAS u32x4*)(hidL + row * 264 + c0 + 8) = (u32x4){w[4], w[5], w[6], w[7]}; }
            __syncthreads();
            const int fr = lane & 15, fq = lane >> 4;
            f32x4 acc[2] = {(f32x4){0.f, 0.f, 0.f, 0.f}, (f32x4){0.f, 0.f, 0.f, 0.f}};
            const bf16_t* w2 = (const bf16_t*)(ws + WS_W2T) + (size_t)kv * 128 * 256 + (size_t)(16 * wave + fr) * 256 + 8 * fq;
#pragma unroll
            for (int ks = 0; ks < 8; ++ks) { const bf16x8 bf = *(const bf16x8*)(w2 + ks * 32);
#pragma unroll
                for (int rg = 0; rg < 2; ++rg) { const bf16x8 af = *(const LAS bf16x8*)(hidL + (rg * 16 + fr) * 264 + ks * 32 + 8 * fq);
                    acc[rg] = __builtin_amdgcn_mfma_f32_16x16x32_bf16(af, bf, acc[rg], 0, 0, 0); } }
            float rstd[2][4];
            if (kv == 0) {
#pragma unroll
                for (int rg = 0; rg < 2; ++rg)
#pragma unroll
                    for (int e = 0; e < 4; ++e) { float q = acc[rg][e] * acc[rg][e]; q += __shfl_xor(q, 1); q += __shfl_xor(q, 2); q += __shfl_xor(q, 4); q += __shfl_xor(q, 8);
                        if (fr == 0) red[(rg * 16 + 4 * fq + e) * 8 + wave] = q; }
                __syncthreads();
#pragma unroll
                for (int rg = 0; rg < 2; ++rg)
#pragma unroll
                    for (int e = 0; e < 4; ++e) { const LAS float* rp = red + (rg * 16 + 4 * fq + e) * 8; const float tot = ((rp[0] + rp[1]) + (rp[2] + rp[3])) + ((rp[4] + rp[5]) + (rp[6] + rp[7]));
                        rstd[rg][e] = 1.0f / sqrtf(tot * (1.f / 128.f) + EPS) * a.cmp_k_norm[16 * wave + fr]; }
            } else {
#pragma unroll
                for (int rg = 0; rg < 2; ++rg)
#pragma unroll
                    for (int e = 0; e < 4; ++e) rstd[rg][e] = 1.f;
            }
            bf16_t* dst = (bf16_t*)(ws + (kv ? WS_VCMP : WS_KCMP)) + (size_t)bg * 256 * 128;
#pragma unroll
            for (int rg = 0; rg < 2; ++rg)
#pragma unroll
                for (int e = 0; e < 4; ++e) { const int n = rt * 32 + rg * 16 + 4 * fq + e; const float v = (n == 255) ? 0.f : acc[rg][e] * rstd[rg][e];
                    dst[(size_t)n * 128 + 16 * wave + fr] = (bf16_t)(cvt_pk_bf16(v, 0.f) & 0xffffu); }
            __syncthreads();
        }
    }
}


#define XB_TMO      128
#define XB_XCNT(j)  (256  + 64 * (j))
#define XB_XSUB(j)  (1280 + 64 * (j))
#define XB_XGEN(j)  (2304 + 64 * (j))
#define XB_TOP      3328
#define XB_TOPGEN   3392
#define XCD_BAR_WORDS 3456
#define XB_SPIN_CAP (1u << 22)
__device__ __forceinline__ unsigned xb_ld(unsigned* p)              { return __hip_atomic_load(p, __ATOMIC_RELAXED, __HIP_MEMORY_SCOPE_AGENT); }
__device__ __forceinline__ unsigned xb_add(unsigned* p, unsigned v) { return __hip_atomic_fetch_add(p, v, __ATOMIC_RELAXED, __HIP_MEMORY_SCOPE_AGENT); }
__device__ __forceinline__ unsigned xb_xcc_id() { return (unsigned)__builtin_amdgcn_s_getreg((3 << 11) | 20) & 0xFu; }
#define XB_SPIN(cond, bar) do { unsigned _sp = 0; while (cond) { __builtin_amdgcn_s_sleep(1); \
    if ((++_sp & 255u) == 0u) { if (xb_ld(&(bar)[XB_TMO])) break; if (_sp > XB_SPIN_CAP) { atomicAdd(&(bar)[XB_TMO], 1u); break; } } } } while (0)
struct XcdBarrier { unsigned* bar; unsigned x; volatile LAS unsigned* st; };
__device__ __forceinline__ XcdBarrier xcd_barrier_post(unsigned* bar, volatile LAS unsigned* st) {
    XcdBarrier b; b.bar = bar; b.x = xb_xcc_id(); b.st = st;
    if (threadIdx.x == 0) (void)xb_add(&bar[XB_XCNT(b.x)], 1u);
    return b;
}
__device__ __forceinline__ void xcd_barrier_complete(unsigned* bar, unsigned x, unsigned& nloc, unsigned& nx) {
    const unsigned G = gridDim.x * gridDim.y * gridDim.z;
    unsigned sum, cnt, mine, sp = 0u;
    for (;;) {
        sum = 0u; cnt = 0u; mine = 0u;
#pragma unroll
        for (unsigned j = 0; j < 16; ++j) { const unsigned c = xb_ld(&bar[XB_XCNT(j)]); sum += c; cnt += (c > 0u) ? 1u : 0u; mine = (j == x) ? c : mine; }
        if (sum == G) break;
        __builtin_amdgcn_s_sleep(1);
        if ((++sp & 255u) == 0u) { if (xb_ld(&bar[XB_TMO])) break; if (sp > XB_SPIN_CAP) { atomicAdd(&bar[XB_TMO], 1u); break; } }
    }
    nloc = mine > 0u ? mine : 1u; nx = cnt > 0u ? cnt : 1u;
}
__device__ __forceinline__ void xcd_barrier(const XcdBarrier& b) {
    asm volatile("s_waitcnt vmcnt(0)" ::: "memory");
    __syncthreads();
    if (threadIdx.x == 0) {
        unsigned* bar = b.bar;
        __builtin_amdgcn_s_waitcnt(0);
        unsigned nloc = b.st[0], nx = b.st[1];
        if (nloc == 0u) { xcd_barrier_complete(bar, b.x, nloc, nx); b.st[0] = nloc; b.st[1] = nx; }
        const unsigned old = xb_add(&bar[XB_XSUB(b.x)], 1u);
        const unsigned gen = old / nloc;
        if (old + 1u == (gen + 1u) * nloc) {
            __builtin_amdgcn_fence(__ATOMIC_RELEASE, "agent");
            asm volatile("s_waitcnt vmcnt(0)" ::: "memory");
            const unsigned og = xb_add(&bar[XB_TOP], 1u);
            const unsigned tg = og / nx;
            if (og + 1u == (tg + 1u) * nx) xb_add(&bar[XB_TOPGEN], 1u);
            else XB_SPIN(xb_ld(&bar[XB_TOPGEN]) == tg, bar);
            __builtin_amdgcn_fence(__ATOMIC_ACQUIRE, "agent");
            xb_add(&bar[XB_XGEN(b.x)], 1u);
            asm volatile("s_waitcnt vmcnt(0)" ::: "memory");
        } else {
            XB_SPIN(xb_ld(&bar[XB_XGEN(b.x)]) == gen, bar);
            __builtin_amdgcn_fence(__ATOMIC_ACQUIRE, "agent");
            asm volatile("s_waitcnt vmcnt(0)" ::: "memory");
        }
    }
    __syncthreads();
}

enum { PH_PRO = 0, PH_INPROJ = 1, PH_ATTN = 2, PH_OUTPROJ = 3, PH_UP = 4, PH_DOWN = 5, PH_END = 6 };

__global__ void __launch_bounds__(NTHR, 2) mega_kernel(Args a) {
    extern __shared__ __attribute__((aligned(16))) unsigned char lds_raw[];
    LAS unsigned char* lds = (LAS unsigned char*)lds_raw;
    const int G = gridDim.x, bid = blockIdx.x;
    const int vcu = (G % 8 == 0) ? (bid % 8) * (G / 8) + bid / 8 : bid;
    unsigned char* ws = a.ws;
    volatile LAS unsigned* bst = (volatile LAS unsigned*)(lds + LDS_BYTES - 64);
    if (threadIdx.x < 2) bst[threadIdx.x] = 0u;
    __syncthreads();
    const XcdBarrier gbar = xcd_barrier_post((unsigned*)(ws + WS_CTL) + 1024, bst);
#ifndef PHMASK
#define PHMASK 0xffff
#endif
#define IN(k) (((PHMASK >> (k)) & 1) && a.ph_lo <= (k) && (k) < a.ph_hi)
#ifdef PROBE_PHASE
#define STAMP(k) do { if (bid == 0 && threadIdx.x == 0) ((unsigned long long*)(ws + WS_CTL + 24576))[(k)] = __builtin_amdgcn_s_memrealtime(); } while (0)
#else
#define STAMP(k) do { } while (0)
#endif
#define SEAM(k) do { if (IN(k) && IN((k) + 1)) xcd_barrier(gbar); STAMP((k) + 1); } while (0)
    STAMP(0);
    if (IN(PH_PRO)) { p0_prologue(a, lds, vcu, G); __syncthreads(); norm_phase<true>(a, lds, a.x, a.norm1_g, 0, DM, bid, G); } SEAM(PH_PRO);
    if (IN(PH_INPROJ)) {
        pg8::StaticOrder S; S.init(M, NPAD, G, bid, ws + WS_XN, ws + WS_WIN, DM, DM); S.rm = 1;
        pg8::EpiIn E{ws, a.fox_q_norm, a.fox_k_norm, a.nsa_q_norm, a.slc_k_norm, a.win_k_norm, a.b_forget, (LAS float*)(lds + LDS_STATS), (unsigned*)(ws + CTL_CNT_KCVC), (unsigned*)(ws + CTL_CNT_GATE)};
        pg8::gemm_phase(lds, DM, DM, DM, S, E);
        if (bid >= 224) {
            handoff_wait((unsigned*)(ws + CTL_CNT_KCVC), 64u * 8u);
            pg8::CmpOrder S2{32, bid - 224, (const char*)(ws + WS_KC), (const char*)(ws + WS_VC), (const char*)(ws + WS_W1T)};
            pg8::EpiPart E2{(float*)(ws + WS_PART), (unsigned*)(ws + CTL_CNT_PART)};
            pg8::gemm_phase(lds, 2048, 4096, 1024, S2, E2);
        }
        else if ((bid & 1) == 0 && (bid >> 3) < 16) {
            handoff_wait((unsigned*)(ws + CTL_CNT_PART), 32u * 8u);
            cmp2_phase(a, lds, (bid >> 3) * 4 + ((bid & 7) >> 1), 64);
        }
        else if ((bid & 1) == 0 && (bid >> 3) < 20) {
            handoff_wait((unsigned*)(ws + CTL_CNT_GATE), 32u * 8u);
            att::compute_kb(ws, ((bid >> 3) - 16) * 4 + ((bid & 7) >> 1), (LAS char*)lds);
        }
    } SEAM(PH_INPROJ);
#ifdef PROBE_PHASE
    unsigned long long tA0 = __builtin_amdgcn_s_memrealtime();
#endif
    if (IN(PH_ATTN)) { att::attn_phase(a, (LAS char*)lds, vcu, G); }
#ifdef PROBE_PHASE
    if (threadIdx.x == 0) { const unsigned d = (unsigned)(__builtin_amdgcn_s_memrealtime() - tA0); atomicMax((unsigned*)(ws + WS_CTL + 24576 + 256), d); atomicMax((unsigned*)(ws + WS_CTL + 24576 + 260), 0xffffffffu - d); }
#endif
    SEAM(PH_ATTN);
    if (IN(PH_OUTPROJ)) {
        pg8::StaticOrder S; S.init(M, DM, G, bid, ws + WS_AO, ws + WS_WOUT, DM, DM);
        pg8::EpiResNorm E{a.x, (bf16_t*)(ws + WS_X1B), (const float*)(ws + WS_MOD), a.norm2_g, (bf16_t*)(ws + WS_XN), (float*)(ws + WS_SLOTS), (unsigned*)(ws + CTL_CNT_PANEL), (LAS float*)(lds + LDS_STATS)};
        pg8::gemm_phase(lds, DM, DM, DM, S, E);
    } SEAM(PH_OUTPROJ);
    if (IN(PH_UP)) {
        pg8::StaticOrder S; S.init(M, DFF, G, bid, ws + WS_XN, ws + WS_WUP, DM, DM);
        pg8::EpiUp E{(bf16_t*)(ws + WS_U), DFF};
        pg8::gemm_phase(lds, DM, DM, DM, S, E);
    } SEAM(PH_UP);
    if (IN(PH_DOWN)) {
        pg8::StaticOrder S; S.init(M, DM, G, bid, ws + WS_U, ws + WS_WDN, DFF, DFF);
        pg8::EpiRes E{(const bf16_t*)(ws + WS_X1B), a.out, (const float*)(ws + WS_MOD) + 5 * DM};
        pg8::gemm_phase(lds, DFF, DFF, DFF, S, E);
    }
    STAMP(PH_END);
#undef IN
#undef SEAM
}

#ifdef PROBE_PHASE
__global__ void probe_kernel(const unsigned long long* tsp, float* out) {
#if PROBE_PHASE == 98
    out[0] = (float)(((const unsigned*)tsp)[64]) * 1e-3f;
#elif PROBE_PHASE == 97
    out[0] = (float)(0xffffffffu - ((const unsigned*)tsp)[65]) * 1e-3f;
#elif PROBE_PHASE == 99
    out[0] = (float)(tsp[PH_END] - tsp[0]) * 5e-4f;
#else
    const unsigned long long t1 = tsp[PROBE_PHASE + 1], t0 = tsp[PROBE_PHASE]; out[0] = (float)(t1 - t0) * 1e-2f;
#endif
}
#endif
static void launch_phases(const Args& a0, int lo, int hi, int grid, hipStream_t stream) {
    Args a = a0; a.ph_lo = lo; a.ph_hi = hi; void* args[] = {&a};
    (void)args; hipLaunchKernelGGL(mega_kernel, dim3(grid), dim3(NTHR), LDS_BYTES, stream, a);
    hipError_t e = hipPeekAtLastError();
    if (e != hipSuccess) fprintf(stderr, "launch failed: %s (grid %d)\n", hipGetErrorString(e), grid);
}

extern "C" void kernel_launch(void* const* d_in, const int* in_sizes, int n_in, void* d_out, int out_size, void* d_ws, size_t ws_size, hipStream_t stream) {
    static int grid = 0;
    if (grid == 0) {
        int dev = 0, cus = 0, per_cu = 0; hipGetDevice(&dev); hipDeviceGetAttribute(&cus, hipDeviceAttributeMultiprocessorCount, dev);
        hipFuncSetAttribute((const void*)mega_kernel, hipFuncAttributeMaxDynamicSharedMemorySize, LDS_BYTES);
        hipOccupancyMaxActiveBlocksPerMultiprocessor(&per_cu, (const void*)mega_kernel, NTHR, LDS_BYTES);
        if (per_cu < 1) { fprintf(stderr, "occupancy query says %d blocks/CU\n", per_cu); per_cu = 1; }
        grid = 256;
        if (cus < 256) fprintf(stderr, "this kernel needs >= 256 CUs for a resident grid (device has %d)\n", cus);
        if (ws_size < WS_END + 24 * MiB) fprintf(stderr, "workspace too small: %zu\n", ws_size);
    }
    hipMemsetAsync((char*)d_ws + WS_CTL, 0, 49152, stream);
    Args a{};
    const float** ap = (const float**)&a;
    for (int i = 0; i < 23; ++i) ap[i] = (const float*)d_in[i];
    a.out = (float*)d_out; a.ws = (unsigned char*)d_ws;
    unsigned char* ws = a.ws;
    launch_phases(a, PH_PRO, PH_END, grid, stream);
#ifdef PROBE_PHASE
    probe_kernel<<<1, 1, 0, stream>>>((const unsigned long long*)(ws + WS_CTL + 24576), a.out);
#endif
}
```

```cpp
#include <hip/hip_runtime.h>
#include <hip/hip_cooperative_groups.h>
#include <stdint.h>
#include <math.h>
#include <cstdio>
namespace cg = cooperative_groups;
#define NF_IN 3

constexpr int DM = 2048, NB = 2, T = 4096, M = NB * T, HD = 128;
constexpr int DIN = 5664, DFF = 8192, NPAD = 5888;
constexpr int C_FQ = 0, C_FK = 1024, C_FV = 2048, C_FZ = 3072, C_NQ = 3080, C_KC = 4104, C_VC = 4360, C_KSL = 4616, C_VSL = 4872,
              C_KW = 5128, C_VW = 5384, C_GZ = 5640;
constexpr int NCMP = 255;
constexpr float SCALE = 0.08838834764831845f;
constexpr float EPS = 1e-6f;
constexpr int NWAVES = 8, NTHR = 512;

constexpr size_t MiB = 1u << 20;
constexpr size_t WS_CTL = 0;
constexpr size_t CTL_CNT_GATE = 21504;
constexpr size_t CTL_CNT_KCVC = 20480, CTL_CNT_PART = 20736, CTL_CNT_ADALN = 20992, CTL_CNT_PANEL = 32768, CTL_CNT_ATTN = 40960;
constexpr size_t WS_SLOTS = 64 * 1024;
constexpr size_t WS_MODP = 384 * 1024;
constexpr size_t WS_MOD = 2 * MiB;
constexpr size_t WS_ROPE = 3 * MiB;
constexpr size_t WS_PEBP = 5 * MiB;
constexpr size_t WS_PEB = 5 * MiB + 256 * 1024;
constexpr size_t WS_MBOUND = 5 * MiB + 300 * 1024;
constexpr size_t WS_LOGF = 5 * MiB + 320 * 1024;
constexpr size_t WS_KBIAS = 5 * MiB + 640 * 1024;
constexpr size_t WS_GATES = 6 * MiB;
constexpr size_t WS_W2T = 7 * MiB;
constexpr size_t WS_W1T = 8 * MiB;
constexpr size_t WS_WIN = 12 * MiB;
constexpr size_t WS_WOUT = 36 * MiB;
constexpr size_t WS_WUP = 44 * MiB;
constexpr size_t WS_WDN = 76 * MiB;
constexpr size_t WS_XN = 108 * MiB;
constexpr size_t WS_FQ = 140 * MiB, WS_FK = 156 * MiB, WS_FV = 172 * MiB, WS_NQ = 188 * MiB, WS_NQR = 204 * MiB;
constexpr size_t WS_KC = 220 * MiB, WS_VC = 224 * MiB, WS_KSL = 228 * MiB, WS_VSL = 232 * MiB, WS_KW = 236 * MiB, WS_VW = 240 * MiB;
constexpr size_t WS_KCMP = 244 * MiB, WS_VCMP = 244 * MiB + 512 * 1024;
constexpr size_t WS_PART = 245 * MiB;
constexpr size_t WS_NSAO = 277 * MiB;
constexpr size_t WS_X1B = WS_NSAO;
constexpr size_t WS_AO = 309 * MiB;
constexpr size_t WS_U = 140 * MiB;
constexpr size_t WS_END = 341 * MiB;
constexpr size_t WS_DEV_CUM = 341 * MiB;
constexpr size_t WS_DEV_XB = 342 * MiB;
constexpr size_t WS_DEV_HID = 358 * MiB;
constexpr size_t WS_DEV_KC = 360 * MiB;

constexpr int LDS_STATS = 131072;
constexpr int LDS_BYTES = 155648;

#define LAS __attribute__((address_space(3)))
#define GAS __attribute__((address_space(1)))
typedef unsigned short bf16_t;
typedef short bf16x8 __attribute__((ext_vector_type(8)));
typedef float f32x4 __attribute__((ext_vector_type(4)));
typedef float f32x2 __attribute__((ext_vector_type(2)));
typedef unsigned u32x4 __attribute__((ext_vector_type(4)));
typedef unsigned u32x2 __attribute__((ext_vector_type(2)));

typedef __bf16 bf16x2_t __attribute__((ext_vector_type(2)));
__device__ __forceinline__ unsigned cvt_pk_bf16(float lo, float hi) { f32x2 v = {lo, hi}; bf16x2_t b = __builtin_convertvector(v, bf16x2_t); return __builtin_bit_cast(unsigned, b); }
__device__ __forceinline__ float bf2f(bf16_t v) { return __uint_as_float(((unsigned)v) << 16); }
__device__ __forceinline__ float wave_sum(float v) {
#pragma unroll
    for (int o = 1; o < 64; o <<= 1) v += __shfl_xor(v, o);
    return v;
}
__device__ __forceinline__ float wave_max(float v) {
#pragma unroll
    for (int o = 1; o < 64; o <<= 1) v = fmaxf(v, __shfl_xor(v, o));
    return v;
}


__device__ __forceinline__ void handoff_signal(unsigned* cnt, int lane) {
    asm volatile("s_waitcnt vmcnt(0)" ::: "memory");
    if (lane == 0) __hip_atomic_fetch_add(cnt, 1u, __ATOMIC_RELAXED, __HIP_MEMORY_SCOPE_AGENT);
}
__device__ __forceinline__ void handoff_wait(unsigned* cnt, unsigned target) {
    if (threadIdx.x < 64) { unsigned sp = 0;
        while ((unsigned)__builtin_amdgcn_readfirstlane(__hip_atomic_load(cnt, __ATOMIC_RELAXED, __HIP_MEMORY_SCOPE_AGENT)) < target) { __builtin_amdgcn_s_sleep(4); if (++sp > (1u << 24)) break; }
        __builtin_amdgcn_fence(__ATOMIC_ACQUIRE, "agent"); asm volatile("s_waitcnt vmcnt(0)" ::: "memory"); }
    __syncthreads();
}

namespace pg8 {
constexpr int BM = 256, BK = 64, HALF = 128, HTB = HALF * BK * 2, STAGE_BYTES = 8 * HTB, NXCD = 8, WGM = 8;
__host__ __device__ __forceinline__ int lds_byte(int r, int c) { const int st = (r >> 4) * 2 + (c >> 5), rr = r & 15, cc = c & 31, ob = rr * 64 + cc * 2; return st * 1024 + (ob ^ (((ob >> 9) & 1) << 5)); }
__host__ __device__ __forceinline__ void stage_rc(int b, int& R, int& C) { const int st = b / 1024, sb = b % 1024, swz = sb ^ (((sb >> 9) & 1) << 5); R = (st >> 1) * 16 + swz / 64; C = (st & 1) * 32 + (swz % 64) / 2; }
__host__ __device__ __forceinline__ int perm32(int rho) { const int n = rho >> 4, i = rho & 15; return 8 * (i >> 2) + 4 * n + (i & 3); }

struct Unit { int pm, pn, aux; };
#define NF_ERN 3
#ifndef NF_IN
#define NF_IN 2
#endif

struct StaticOrder {
    int nM, nN, nwg, G, c; const char* A; const char* Bt; size_t tsA, tsB; int rm = 0;
    __device__ __forceinline__ void init(int M_, int N_, int G_, int c_, const void* A_, const void* Bt_, int lda, int ldb) { nM = M_ / BM; nN = N_ / BM; nwg = nM * nN; G = G_; c = c_; A = (const char*)A_; Bt = (const char*)Bt_; tsA = (size_t)BM * lda * 2; tsB = (size_t)BM * ldb * 2; }
    __device__ __forceinline__ bool next(int i, Unit& u) const {
        const long L = (long)i * G + c; if (L >= nwg) return false;
        int wgid = (int)L; { const int q = nwg / NXCD, r = nwg % NXCD, xcd = wgid % NXCD, off = wgid / NXCD; wgid = (xcd < r ? xcd * (q + 1) : r * (q + 1) + (xcd - r) * q) + off; }
        const int nig = WGM * nN, gid = wgid / nig, fm = gid * WGM, gsz = (nM - fm) < WGM ? (nM - fm) : WGM;
        u.pm = fm + ((wgid % nig) % gsz); u.pn = (wgid % nig) / gsz; u.aux = 0;
        if (rm) { const int p = u.pn; u.pn = (int)(((p < 12 ? 0x4a0e6734a418820ull : 0x5ab49ad507b251ull) >> (5 * (p < 12 ? p : p - 12))) & 31ull); }
        return true;
    }
    __device__ __forceinline__ void ptrs(const Unit& u, const char*& a, const char*& b) const { a = A + (size_t)u.pm * tsA; b = Bt + (size_t)u.pn * tsB; }
};

template <class Epi, class Sched>
__device__ __forceinline__ void gemm_phase(LAS unsigned char* lds, const int lda, const int ldb, const int K, const Sched& S, const Epi& E) {
    int tid = threadIdx.x; asm volatile("" : "+v"(tid));
    const int wid = __builtin_amdgcn_readfirstlane(tid >> 6), lane = tid & 63, wr = wid >> 2, wc = wid & 3, fr = lane & 15, fq = lane >> 4;
    const int nt = K / BK;
    unsigned voffA[2], voffB[2];
#pragma unroll
    for (int i = 0; i < 2; ++i) { int R, C; stage_rc(tid * 16 + i * 8192, R, C); const int Rb = Epi::PERM ? ((R & ~31) + perm32(R & 31)) : R;
        voffA[i] = (unsigned)(R * lda + C) * 2u; voffB[i] = (unsigned)(Rb * ldb + C) * 2u; }
    const size_t kstep = (size_t)(BK * 2);
    const size_t hsA = (size_t)HALF * lda * 2, hsB = (size_t)HALF * ldb * 2;
    const unsigned ldsw = (unsigned)wid * 1024u;
    const int aoff = lds_byte(wr * 64 + fr, fq * 8), boff = lds_byte(wc * 32 + fr, fq * 8);
#define PG8_SA(b, h) (((b) * 2 + (h)) * HTB)
#define PG8_SB(b, h) ((4 + (b) * 2 + (h)) * HTB)
#define PG8_STAGE(bufoff, gbase, voff) do { _Pragma("unroll") for (int _i = 0; _i < 2; ++_i) \
        __builtin_amdgcn_global_load_lds((const unsigned*)((const char*)(gbase) + (voff)[_i]), (LAS unsigned*)(lds + (bufoff) + ldsw + _i * 8192), 16, 0, 0); } while (0)
#define PG8_LDA(dst, b, h) do { _Pragma("unroll") for (int m = 0; m < 4; ++m) _Pragma("unroll") for (int k = 0; k < 2; ++k) dst[m][k] = *(const LAS bf16x8*)(lds + PG8_SA(b, h) + aoff + m * 2048 + k * 1024); } while (0)
#define PG8_LDB(dst, b, h) do { _Pragma("unroll") for (int n = 0; n < 2; ++n) _Pragma("unroll") for (int k = 0; k < 2; ++k) dst[n][k] = *(const LAS bf16x8*)(lds + PG8_SB(b, h) + boff + n * 2048 + k * 1024); } while (0)
#define PG8_MMA(ai, bj, At, Bt) do { __builtin_amdgcn_s_setprio(1); _Pragma("unroll") for (int m = 0; m < 4; ++m) _Pragma("unroll") for (int n = 0; n < 2; ++n) _Pragma("unroll") for (int k = 0; k < 2; ++k) \
        acc[ai][bj][m][n] = __builtin_amdgcn_mfma_f32_16x16x32_bf16(Bt[n][k], At[m][k], acc[ai][bj][m][n], 0, 0, 0); __builtin_amdgcn_s_setprio(0); } while (0)
#define PG8_WAIT_V(n) asm volatile("s_waitcnt vmcnt(" #n ")" ::: "memory")
#define PG8_WAIT_VX do { static_assert(Epi::NS == 0 || Epi::NS == 16, "unit-boundary wait count"); asm volatile("s_waitcnt vmcnt(24)" ::: "memory"); } while (0)
#define PG8_WAIT_L(n) asm volatile("s_waitcnt lgkmcnt(" #n ")" ::: "memory")
#define PG8_BAR __builtin_amdgcn_s_barrier()
#define PG8_SCHED __builtin_amdgcn_sched_barrier(0)
    Unit cur, nxt; int ui = 0; bool fresh = false;
    if (!S.next(0, cur)) return;
    f32x4 acc[2][2][4][2];
#pragma unroll
    for (int a = 0; a < 2; ++a)
#pragma unroll
        for (int b = 0; b < 2; ++b)
#pragma unroll
            for (int m = 0; m < 4; ++m)
#pragma unroll
                for (int n = 0; n < 2; ++n) acc[a][b][m][n] = (f32x4){0.f, 0.f, 0.f, 0.f};
    bf16x8 At[4][2], B0[2][2], B1[2][2];
    const char* cA; const char* cB; S.ptrs(cur, cA, cB);
    PG8_STAGE(PG8_SB(0, 0), cB, voffB); PG8_STAGE(PG8_SB(0, 1), cB + hsB, voffB); PG8_STAGE(PG8_SA(0, 0), cA, voffA); PG8_STAGE(PG8_SA(0, 1), cA + hsA, voffA);
    if (wr == 1) PG8_BAR;
    PG8_WAIT_V(2); PG8_BAR;
    PG8_STAGE(PG8_SB(1, 0), cB + kstep, voffB); PG8_STAGE(PG8_SA(1, 0), cA + kstep, voffA); PG8_STAGE(PG8_SB(1, 1), cB + hsB + kstep, voffB);
    PG8_WAIT_V(6); PG8_BAR;
    if constexpr (Epi::PREFETCH) E.prefetch(cur, lds + STAGE_BYTES, wid, lane);
    for (;;) {
        const bool has_next = S.next(ui + 1, nxt);
        const char* nA = cA; const char* nB = cB; if (has_next) S.ptrs(nxt, nA, nB);
#pragma nounroll
        for (int t = 0; t < nt; t += 2) {
            const bool last = (t == nt - 2);
            const char* a1 = cA + (size_t)(t + 1) * kstep;
            const char* a2 = last ? nA : cA + (size_t)(t + 2) * kstep; const char* b2 = last ? nB : cB + (size_t)(t + 2) * kstep;
            const char* a3 = a2 + kstep; const char* b3 = b2 + kstep;
            const bool fz = (Epi::NS > 0) && fresh && t == 0;
            PG8_LDB(B0, 0, 0); PG8_LDB(B1, 0, 1); PG8_SCHED; PG8_LDA(At, 0, 0); PG8_STAGE(PG8_SA(1, 1), a1 + hsA, voffA);
            if (fz) PG8_WAIT_VX; else PG8_WAIT_V(8);
            PG8_WAIT_L(0); PG8_BAR; PG8_MMA(0, 0, At, B0); PG8_MMA(0, 1, At, B1); PG8_BAR; PG8_SCHED;
            PG8_LDA(At, 0, 1); PG8_STAGE(PG8_SB(0, 0), b2, voffB); PG8_STAGE(PG8_SB(0, 1), b2 + hsB, voffB); PG8_STAGE(PG8_SA(0, 0), a2, voffA);
            if (fz) PG8_WAIT_VX; else PG8_WAIT_V(8);
            PG8_WAIT_L(0); PG8_BAR; PG8_MMA(1, 0, At, B0); PG8_MMA(1, 1, At, B1); PG8_BAR; PG8_SCHED;
            PG8_LDB(B0, 1, 0); PG8_LDB(B1, 1, 1); PG8_SCHED; PG8_LDA(At, 1, 0); PG8_STAGE(PG8_SA(0, 1), a2 + hsA, voffA);
            PG8_WAIT_V(8); PG8_WAIT_L(0); PG8_BAR; PG8_MMA(0, 0, At, B0); PG8_MMA(0, 1, At, B1); PG8_BAR; PG8_SCHED;
            PG8_LDA(At, 1, 1); PG8_STAGE(PG8_SB(1, 0), b3, voffB); PG8_STAGE(PG8_SB(1, 1), b3 + hsB, voffB); PG8_STAGE(PG8_SA(1, 0), a3, voffA);
            PG8_WAIT_V(8); PG8_WAIT_L(0); PG8_BAR; PG8_MMA(1, 0, At, B0); PG8_MMA(1, 1, At, B1); PG8_BAR; PG8_SCHED;
        }
        if (wr == 0) PG8_BAR;
        E(acc, cur, wr, wc, fr, fq);
        if (!has_next) break;
#pragma unroll
        for (int a = 0; a < 2; ++a)
#pragma unroll
            for (int b = 0; b < 2; ++b)
#pragma unroll
                for (int m = 0; m < 4; ++m)
#pragma unroll
                    for (int n = 0; n < 2; ++n) acc[a][b][m][n] = (f32x4){0.f, 0.f, 0.f, 0.f};
        cur = nxt; cA = nA; cB = nB; ++ui; fresh = true;
        if (wr == 1) PG8_BAR;
    }
    PG8_WAIT_V(0);
    PG8_BAR;
#undef PG8_SA
#undef PG8_SB
#undef PG8_STAGE
#undef PG8_LDA
#undef PG8_LDB
#undef PG8_MMA
#undef PG8_WAIT_V
#undef PG8_WAIT_VX
#undef PG8_WAIT_L
#undef PG8_BAR
#undef PG8_SCHED
}


struct EpiRes {
    static constexpr int NS = 0; static constexpr bool PERM = true, PREFETCH = false;
    const bf16_t* base; float* out; const float* gate;
    __device__ __forceinline__ void prefetch(const Unit&, LAS unsigned char*, int, int) const {}
    __device__ __forceinline__ void operator()(const f32x4 (&acc)[2][2][4][2], const Unit& u, int wr, int wc, int fr, int fq) const {
        const int row0 = u.pm * BM + wr * 64 + fr, col0 = u.pn * BM + wc * 32 + 8 * fq;
        const int b = (u.pm * BM) / T;
        f32x4 gv[2][2];
#pragma unroll
        for (int bj = 0; bj < 2; ++bj)
#pragma unroll
            for (int n = 0; n < 2; ++n) gv[bj][n] = *(const f32x4*)(gate + (size_t)b * 6 * DM + col0 + bj * HALF + 4 * n);
#pragma unroll
        for (int ai = 0; ai < 2; ++ai)
#pragma unroll
            for (int m = 0; m < 4; ++m) { const size_t off = (size_t)(row0 + ai * HALF + m * 16) * DM + col0;
#pragma unroll
                for (int bj = 0; bj < 2; ++bj) { const u32x4 w = *(const u32x4*)(base + off + bj * HALF);
                    const f32x4 b0 = (f32x4){__uint_as_float(w.x << 16), __uint_as_float(w.x & 0xffff0000u), __uint_as_float(w.y << 16), __uint_as_float(w.y & 0xffff0000u)};
                    const f32x4 b1 = (f32x4){__uint_as_float(w.z << 16), __uint_as_float(w.z & 0xffff0000u), __uint_as_float(w.w << 16), __uint_as_float(w.w & 0xffff0000u)};
                    *(f32x4*)(out + off + bj * HALF) = b0 + gv[bj][0] * acc[ai][bj][m][0];
                    *(f32x4*)(out + off + bj * HALF + 4) = b1 + gv[bj][1] * acc[ai][bj][m][1]; } }
    }
};

struct EpiResNorm {
    static constexpr int NS = 0; static constexpr bool PERM = true, PREFETCH = false;
    const float* base; bf16_t* out; const float* mod; const float* g2; bf16_t* XN; float* slots; unsigned* cnt; LAS float* tab;
    __device__ __forceinline__ void prefetch(const Unit& u, LAS unsigned char* dummy, int wid, int lane) const {
        const float* p = base + (size_t)(u.pm * BM + wid * 32) * DM + u.pn * BM + lane * 4;
#pragma unroll 8
        for (int r = 0; r < 32; ++r) __builtin_amdgcn_global_load_lds((const unsigned*)(p + (size_t)r * DM), (LAS unsigned*)(dummy + wid * 1024), 16, 0, 0);
    }
    __device__ __forceinline__ void operator()(f32x4 (&acc)[2][2][4][2], const Unit& u, int wr, int wc, int fr, int fq) const {
        const int row0 = u.pm * BM + wr * 64 + fr, col0 = u.pn * BM + wc * 32 + 8 * fq;
        const int b = (u.pm * BM) / T; const int wid = wr * 4 + wc, lane = fr + 16 * fq;
        const float* mb = mod + (size_t)b * 6 * DM;
        {   f32x4 gv[2][2];
#pragma unroll
            for (int bj = 0; bj < 2; ++bj)
#pragma unroll
                for (int n = 0; n < 2; ++n) gv[bj][n] = *(const f32x4*)(mb + 2 * DM + col0 + bj * HALF + 4 * n);
            f32x4 bs[NF_ERN][2][2];
#define ER_LD(g) do { const size_t off_ = (size_t)(row0 + ((g) >> 2) * HALF + ((g) & 3) * 16) * DM + col0; _Pragma("unroll") for (int bj = 0; bj < 2; ++bj) _Pragma("unroll") for (int n = 0; n < 2; ++n) \
            bs[(g) % NF_ERN][bj][n] = *(const f32x4*)(base + off_ + bj * HALF + 4 * n); } while (0)
            _Pragma("unroll") for (int g = 0; g < NF_ERN; ++g) ER_LD(g);
            asm volatile("" ::: "memory");
#pragma unroll
            for (int g = 0; g < 8; ++g) { const int ai = g >> 2, m = g & 3; float ss = 0.f;
#pragma unroll
                for (int bj = 0; bj < 2; ++bj)
#pragma unroll
                    for (int n = 0; n < 2; ++n) { const f32x4 v = bs[g % NF_ERN][bj][n] + gv[bj][n] * acc[ai][bj][m][n];
                        acc[ai][bj][m][n] = v; ss += (v[0] * v[0] + v[1] * v[1]) + (v[2] * v[2] + v[3] * v[3]); }
                if (g + NF_ERN < 8) ER_LD(g + NF_ERN);
                ss += __shfl_xor(ss, 16); ss += __shfl_xor(ss, 32);
                if (fq == 0) tab[(ai * HALF + wr * 64 + m * 16 + fr) * 4 + wc] = ss;
                asm volatile("" ::: "memory"); }
#undef ER_LD
        }
        asm volatile("s_waitcnt lgkmcnt(0)" ::: "memory"); __builtin_amdgcn_s_barrier(); asm volatile("" ::: "memory");
        const int prow = wid * 32 + (lane & 31);
        if (lane < 32) { const f32x4 q = *(const LAS f32x4*)(tab + prow * 4);
            __hip_atomic_store((unsigned*)slots + ((size_t)(u.pm * BM + prow) * 8 + u.pn), __float_as_uint((q[0] + q[1]) + (q[2] + q[3])), __ATOMIC_RELAXED, __HIP_MEMORY_SCOPE_AGENT); }
        asm volatile("s_waitcnt vmcnt(0)" ::: "memory");
        if (lane == 0) __hip_atomic_fetch_add(cnt + 64 * u.pm, 1u, __ATOMIC_RELAXED, __HIP_MEMORY_SCOPE_AGENT);
        f32x4 av[2][2], sv[2][2];
#pragma unroll
        for (int bj = 0; bj < 2; ++bj)
#pragma unroll
            for (int n = 0; n < 2; ++n) { const int c = col0 + bj * HALF + 4 * n; const f32x4 gg = *(const f32x4*)(g2 + c), sc = *(const f32x4*)(mb + 4 * DM + c);
                av[bj][n] = gg * (sc + 1.f); sv[bj][n] = *(const f32x4*)(mb + 3 * DM + c); }
        if (wid == 0) { unsigned sp = 0;
            while ((unsigned)__builtin_amdgcn_readfirstlane(__hip_atomic_load(cnt + 64 * u.pm, __ATOMIC_RELAXED, __HIP_MEMORY_SCOPE_AGENT)) < 64u) { __builtin_amdgcn_s_sleep(2); if (++sp > (1u << 22)) break; }
            __builtin_amdgcn_fence(__ATOMIC_ACQUIRE, "agent"); }
        asm volatile("s_waitcnt vmcnt(0) lgkmcnt(0)" ::: "memory"); __builtin_amdgcn_s_barrier(); asm volatile("" ::: "memory");
        if (lane < 32) { const unsigned* sl = (const unsigned*)slots + (size_t)(u.pm * BM + prow) * 8; float tot = 0.f;
#pragma unroll
            for (int t = 0; t < 8; ++t) tot += __uint_as_float(__hip_atomic_load(sl + t, __ATOMIC_RELAXED, __HIP_MEMORY_SCOPE_AGENT));
            tab[1024 + prow] = __builtin_amdgcn_rsqf(tot * (1.f / DM) + EPS); }
        asm volatile("s_waitcnt vmcnt(0) lgkmcnt(0)" ::: "memory"); __builtin_amdgcn_s_barrier(); asm volatile("" ::: "memory");
#pragma unroll
        for (int ai = 0; ai < 2; ++ai)
#pragma unroll
            for (int m = 0; m < 4; ++m) { const int rl = ai * HALF + wr * 64 + m * 16 + fr; const float rstd = tab[1024 + rl]; const size_t off = (size_t)(u.pm * BM + rl) * DM + col0;
#pragma unroll
                for (int bj = 0; bj < 2; ++bj) {
                    { const f32x4 x0 = acc[ai][bj][m][0], x1 = acc[ai][bj][m][1]; u32x4 xw; xw.x = cvt_pk_bf16(x0[0], x0[1]); xw.y = cvt_pk_bf16(x0[2], x0[3]); xw.z = cvt_pk_bf16(x1[0], x1[1]); xw.w = cvt_pk_bf16(x1[2], x1[3]);
                      *(u32x4*)(out + off + bj * HALF) = xw; }
                    const f32x4 h0 = acc[ai][bj][m][0] * rstd * av[bj][0] + sv[bj][0], h1 = acc[ai][bj][m][1] * rstd * av[bj][1] + sv[bj][1];
                    u32x4 w; w.x = cvt_pk_bf16(h0[0], h0[1]); w.y = cvt_pk_bf16(h0[2], h0[3]); w.z = cvt_pk_bf16(h1[0], h1[1]); w.w = cvt_pk_bf16(h1[2], h1[3]);
                    *(u32x4*)(XN + off + bj * HALF) = w; }
                asm volatile("" ::: "memory"); }
    }
};
struct EpiUp {
    static constexpr int NS = 16;   static constexpr bool PERM = true, PREFETCH = false;
    bf16_t* O; int ldc;
    __device__ __forceinline__ void operator()(const f32x4 (&acc)[2][2][4][2], const Unit& u, int wr, int wc, int fr, int fq) const {
        const int row0 = u.pm * BM + wr * 64 + fr, col0 = u.pn * BM + wc * 32 + 8 * fq;
#pragma unroll
        for (int ai = 0; ai < 2; ++ai)
#pragma unroll
            for (int m = 0; m < 4; ++m) { bf16_t* rowp = O + (size_t)(row0 + ai * HALF + m * 16) * ldc + col0;
#pragma unroll
                for (int bj = 0; bj < 2; ++bj) { f32x4 v0 = acc[ai][bj][m][0], v1 = acc[ai][bj][m][1];
                    v0 = __builtin_elementwise_max(v0, (f32x4){0.f, 0.f, 0.f, 0.f}); v1 = __builtin_elementwise_max(v1, (f32x4){0.f, 0.f, 0.f, 0.f}); v0 = v0 * v0; v1 = v1 * v1;
                    u32x4 w; w.x = cvt_pk_bf16(v0[0], v0[1]); w.y = cvt_pk_bf16(v0[2], v0[3]); w.z = cvt_pk_bf16(v1[0], v1[1]); w.w = cvt_pk_bf16(v1[2], v1[3]);
                    *(u32x4*)(rowp + bj * HALF) = w; } }
    }
};
struct EpiIn {
    static constexpr int NS = 0; static constexpr bool PERM = true, PREFETCH = false;
    unsigned char* wsb;
    const float *g_fq, *g_fk, *g_nq, *g_slc, *g_win, *b_forget; LAS float* stats; unsigned* kcvc_cnt; unsigned* gate_cnt;
    __device__ __forceinline__ void operator()(const f32x4 (&acc)[2][2][4][2], const Unit& u, int wr, int wc, int fr, int fq) const {
        const int pn = u.pn;
        unsigned char* w_ = wsb; asm volatile("" : "+s"(w_));
        GAS bf16_t* const FQ = (GAS bf16_t*)(w_ + WS_FQ); GAS bf16_t* const FK = (GAS bf16_t*)(w_ + WS_FK); GAS bf16_t* const FV = (GAS bf16_t*)(w_ + WS_FV); GAS bf16_t* const NQ = (GAS bf16_t*)(w_ + WS_NQ); GAS bf16_t* const NQR = (GAS bf16_t*)(w_ + WS_NQR);
        GAS bf16_t* const KC = (GAS bf16_t*)(w_ + WS_KC); GAS bf16_t* const VC = (GAS bf16_t*)(w_ + WS_VC); GAS bf16_t* const KSL = (GAS bf16_t*)(w_ + WS_KSL); GAS bf16_t* const VSL = (GAS bf16_t*)(w_ + WS_VSL); GAS bf16_t* const KW = (GAS bf16_t*)(w_ + WS_KW); GAS bf16_t* const VW = (GAS bf16_t*)(w_ + WS_VW);
        GAS float* const LOGF = (GAS float*)(w_ + WS_LOGF); GAS float* const GATES = (GAS float*)(w_ + WS_GATES); const GAS float* const rope = (const GAS float*)(w_ + WS_ROPE);
        const int b = u.pm >> 4, t0 = (u.pm & 15) * BM + wr * 64 + fr;
        if (pn == 12) {
            if (wc == 0) {
#pragma unroll
                for (int ai = 0; ai < 2; ++ai)
#pragma unroll
                    for (int m = 0; m < 4; ++m) { const int t = t0 + ai * HALF + m * 16;
#pragma unroll
                        for (int n = 0; n < 2; ++n)
#pragma unroll
                            for (int e = 0; e < 4; ++e) { const int p = 8 * fq + 4 * n + e; const float v = acc[ai][0][m][n][e];
                                if (p < 8) { const float z = v + b_forget[p]; __hip_atomic_store((GAS unsigned*)(LOGF + ((size_t)b * 8 + p) * T + t), __float_as_uint(fminf(z, 0.f) - __logf(1.f + __expf(-fabsf(z)))), __ATOMIC_RELAXED, __HIP_MEMORY_SCOPE_AGENT); }
                                else { GATES[((size_t)b * T + t) * 24 + (p - 8)] = 1.f / (1.f + __expf(-v)); } } }
            }
            handoff_signal(gate_cnt, fr + 16 * fq);
            return;
        }
        if (pn < 4) body<true, true, false, false>(acc, u, wr, wc, fr, fq, FQ, nullptr, g_fq, rope, 8, 2 * pn);
        else if (pn < 8) body<true, true, false, false>(acc, u, wr, wc, fr, fq, FK, nullptr, g_fk, rope, 8, 2 * (pn - 4));
        else if (pn < 12) body<false, true, false, false>(acc, u, wr, wc, fr, fq, FV, nullptr, nullptr, rope, 8, 2 * (pn - 8));
        else if (pn < 17) body<true, true, true, false>(acc, u, wr, wc, fr, fq, NQ, NQR, g_nq, rope, 8, 2 * (pn - 13));
        else if (pn < 19) body<false, true, false, true>(acc, u, wr, wc, fr, fq, pn == 17 ? KC : VC, nullptr, nullptr, rope, 2, 0);
        else if (pn < 21) body<true, false, true, false>(acc, u, wr, wc, fr, fq, nullptr, pn == 19 ? KSL : KW, pn == 19 ? g_slc : g_win, rope, 2, 0);
        else body<false, true, false, false>(acc, u, wr, wc, fr, fq, pn == 21 ? VSL : VW, nullptr, nullptr, rope, 2, 0);
    }
    template <bool NORM, bool D1, bool D2, bool WT>
    __device__ __forceinline__ void body(const f32x4 (&acc)[2][2][4][2], const Unit& u, int wr, int wc, int fr, int fq, GAS bf16_t* d1, GAS bf16_t* d2, const float* gain, const GAS float* rope, int nh, int h0) const {
        const int b = u.pm >> 4, t0 = (u.pm & 15) * BM + wr * 64 + fr;
        const int dlo = 16 * wc + 4 * fq;
        f32x4 g0 = (f32x4){1.f, 1.f, 1.f, 1.f}, g1 = g0;
        if (NORM) { g0 = *(const f32x4*)(gain + dlo); g1 = *(const f32x4*)(gain + 64 + dlo); }
        f32x4 cs[NF_IN][2];
#define EI_LD(g) do { const int tn_ = t0 + ((g) >> 2) * HALF + ((g) & 3) * 16; const GAS float* rp_ = rope + ((size_t)tn_ * 64 + dlo) * 2; cs[(g) % NF_IN][0] = *(const GAS f32x4*)rp_; cs[(g) % NF_IN][1] = *(const GAS f32x4*)(rp_ + 4); } while (0)
        if (D2) { _Pragma("unroll") for (int g = 0; g < NF_IN; ++g) EI_LD(g); }
        if (NORM) {
#pragma unroll
            for (int ai = 0; ai < 2; ++ai)
#pragma unroll
                for (int m = 0; m < 4; ++m)
#pragma unroll
                    for (int bj = 0; bj < 2; ++bj) { const f32x4 a = acc[ai][bj][m][0], c = acc[ai][bj][m][1];
                        float s = (a[0] * a[0] + a[1] * a[1]) + (a[2] * a[2] + a[3] * a[3]) + (c[0] * c[0] + c[1] * c[1]) + (c[2] * c[2] + c[3] * c[3]);
                        { const unsigned x = __float_as_uint(s); const auto r = __builtin_amdgcn_permlane32_swap(x, x, false, false); s = __uint_as_float(r[0]) + __uint_as_float(r[1]); }
                        { const unsigned x = __float_as_uint(s); const auto r = __builtin_amdgcn_permlane16_swap(x, x, false, false); s = __uint_as_float(r[0]) + __uint_as_float(r[1]); }
                        if (fq == 0) stats[(ai * HALF + wr * 64 + m * 16 + fr) * 8 + bj * 4 + wc] = s; }
            asm volatile("s_waitcnt lgkmcnt(0)" ::: "memory"); __builtin_amdgcn_s_barrier(); asm volatile("" ::: "memory");
        }
#pragma unroll
        for (int g = 0; g < 8; ++g) { const int ai = g >> 2, m = g & 3; const int t = t0 + ai * HALF + m * 16;
            float rsv[2] = {1.f, 1.f};
            if (NORM) {
#pragma unroll
                for (int bj = 0; bj < 2; ++bj) { const f32x4 q = *(const LAS f32x4*)(stats + (ai * HALF + wr * 64 + m * 16 + fr) * 8 + bj * 4);
                    rsv[bj] = __builtin_amdgcn_rsqf(((q[0] + q[1]) + (q[2] + q[3])) * (1.f / 128.f) + EPS); } }
            f32x4 c = g0, sn = g0;
            if (D2) { c = (f32x4){cs[g % NF_IN][0][0], cs[g % NF_IN][0][2], cs[g % NF_IN][1][0], cs[g % NF_IN][1][2]}; sn = (f32x4){cs[g % NF_IN][0][1], cs[g % NF_IN][0][3], cs[g % NF_IN][1][1], cs[g % NF_IN][1][3]}; }
            if (D2 && g + NF_IN < 8) EI_LD(g + NF_IN);
#pragma unroll
            for (int bj = 0; bj < 2; ++bj) { f32x4 v0 = acc[ai][bj][m][0], v1 = acc[ai][bj][m][1];
                if (NORM) { const float r = rsv[bj]; v0 = v0 * r * g0; v1 = v1 * r * g1; }
                const size_t off = (((size_t)b * nh + h0 + bj) * T + t) * 128 + dlo;
                if (D1) { u32x2 w0, w1; w0.x = cvt_pk_bf16(v0[0], v0[1]); w0.y = cvt_pk_bf16(v0[2], v0[3]); w1.x = cvt_pk_bf16(v1[0], v1[1]); w1.y = cvt_pk_bf16(v1[2], v1[3]);
                    if (WT) { __hip_atomic_store((GAS unsigned long long*)(d1 + off), ((unsigned long long)w0.y << 32) | w0.x, __ATOMIC_RELAXED, __HIP_MEMORY_SCOPE_AGENT);
                        __hip_atomic_store((GAS unsigned long long*)(d1 + off + 64), ((unsigned long long)w1.y << 32) | w1.x, __ATOMIC_RELAXED, __HIP_MEMORY_SCOPE_AGENT); }
                    else { *(GAS u32x2*)(d1 + off) = w0; *(GAS u32x2*)(d1 + off + 64) = w1; } }
                if (D2) { const f32x4 r0 = v0 * c - v1 * sn, r1 = v1 * c + v0 * sn;
                    u32x2 w0, w1; w0.x = cvt_pk_bf16(r0[0], r0[1]); w0.y = cvt_pk_bf16(r0[2], r0[3]); w1.x = cvt_pk_bf16(r1[0], r1[1]); w1.y = cvt_pk_bf16(r1[2], r1[3]);
                    *(GAS u32x2*)(d2 + off) = w0; *(GAS u32x2*)(d2 + off + 64) = w1; } }
            asm volatile("" ::: "memory"); }
#undef EI_LD
        if (WT) handoff_signal(kcvc_cnt, fr + 16 * fq);
    }
};

struct EpiPart {
    static constexpr int NS = 0; static constexpr bool PERM = true, PREFETCH = false;
    float* P; unsigned* done_cnt;
    __device__ __forceinline__ void operator()(const f32x4 (&acc)[2][2][4][2], const Unit& u, int wr, int wc, int fr, int fq) const {
        const __amdgpu_buffer_rsrc_t rsrc = __builtin_amdgcn_make_buffer_rsrc(P, 0, 128 * 65536 * 4, 0x00020000);
        const unsigned base = ((unsigned)u.aux * 65536u + (unsigned)(wr * 64 + fr) * 256u + (unsigned)(wc * 32 + 8 * fq)) * 4u;
#pragma unroll
        for (int ai = 0; ai < 2; ++ai)
#pragma unroll
            for (int m = 0; m < 4; ++m) { const unsigned rp = base + (unsigned)(ai * HALF + m * 16) * 1024u;
#pragma unroll
                for (int bj = 0; bj < 2; ++bj)
#pragma unroll
                    for (int n = 0; n < 2; ++n) __builtin_amdgcn_raw_buffer_store_b128(__builtin_bit_cast(u32x4, acc[ai][bj][m][n]), rsrc, rp + (unsigned)(bj * HALF + 4 * n) * 4u, 0, 16);
                asm volatile("" ::: "memory"); }
        handoff_signal(done_cnt, fr + 16 * fq);
    }
};
struct CmpOrder {
    int G, c; const char* KC; const char* VC; const char* W1T;
    __device__ __forceinline__ bool next(int i, Unit& u) const { const int L = i * G + c; if (L >= 32) return false; u.pm = 0; u.pn = 0; u.aux = L; return true; }
    __device__ __forceinline__ void ptrs(const Unit& u, const char*& a, const char*& b) const { const int L = u.aux, kv = L >> 4, bg = (L >> 2) & 3, ks = L & 3;
        a = (kv ? VC : KC) + ((size_t)bg * T * 128 + ks * 1024) * 2; b = W1T + ((size_t)kv * 256 * 4096 + ks * 1024) * 2; }
};
}


struct Args {
    const float *x, *c, *w_ada, *b_ada, *norm1_g, *w_in, *b_forget, *fox_q_norm, *fox_k_norm, *nsa_q_norm, *cmp_k_norm, *slc_k_norm, *win_k_norm,
        *cmp_pe_k, *cmp_w1_k, *cmp_w2_k, *cmp_pe_v, *cmp_w1_v, *cmp_w2_v, *w_out, *norm2_g, *w_up, *w_down;
    float* out; unsigned char* ws; int ph_lo, ph_hi;
};

#ifndef DEV_ATT
#define DEV_ATT 3
#endif
namespace att {
typedef float f32x16 __attribute__((ext_vector_type(16)));
typedef short s16x4 __attribute__((ext_vector_type(4)));
constexpr int NW = 8, QBLK = 32, KVBLK = 64, D = 128;
constexpr int SHM_V = KVBLK * D * 2, SHM_K = KVBLK * D * 2;
constexpr int L_V = 0, L_K = 2 * SHM_V, L_WS = 2 * SHM_V + 2 * SHM_K, L_Q = L_WS + 2048;
constexpr int LC_V = 0, LC_K = 65536, LC_WS = 131072, LC_IMP = 133120;
constexpr int L_KB = 133120;
constexpr int L_SEL = 149504;
constexpr float THR = 8.f;
constexpr float C2 = 1.4426950408889634f * SCALE;
enum { M_FOX = 0, M_WIN = 1, M_SLC = 2 };
#define KSWZ(row, colB) ((row) * 256 + ((colB) ^ (((row) & 7) << 4)))
#define SBAR() __builtin_amdgcn_sched_barrier(0)
__device__ __forceinline__ int v_st(int k, int c) { const int kk = (k & ~0xC) | ((k & 4) << 1) | ((k & 8) >> 1); return ((kk >> 3) * 4 + (c >> 5)) * 512 + ((kk & 7) * 32 + (c & 31)) * 2; }
__device__ __forceinline__ int v_rd_base(int lane) { return ((lane & 3) << 3) | (((lane >> 2) & 3) << 6) | (((lane >> 4) & 1) << 5) | (((lane >> 5) & 1) << 8); }
constexpr int v_rd_off(int d0, int ks, int half) { return d0 * 512 + ks * 4096 + half * 2048; }
__device__ __forceinline__ int crow(int r, int hi) { return (r & 3) + 8 * (r >> 2) + 4 * hi; }
__device__ __forceinline__ bf16x8 load8(const bf16_t* p) { return *(const GAS bf16x8*)p; }
__device__ __forceinline__ void mask_tile(f32x16& p0, f32x16& p1, int dq, unsigned W) {
    const float NEG = -__builtin_inff();
#pragma unroll
    for (int r = 0; r < 16; ++r) { const int c = (r & 3) + 8 * (r >> 2);
        if ((unsigned)(dq - c) >= W) p0[r] = NEG;
        if ((unsigned)(dq - c - 32) >= W) p1[r] = NEG; }
}
__device__ __forceinline__ void partialSM(f32x16& p0, f32x16& p1, float& m_reg, float& mn, float& alpha) {
    float pmax = p0[0];
#pragma unroll
    for (int r = 1; r < 16; ++r) pmax = fmaxf(pmax, p0[r]);
#pragma unroll
    for (int r = 0; r < 16; ++r) pmax = fmaxf(pmax, p1[r]);
    { auto rr = __builtin_amdgcn_permlane32_swap(__float_as_uint(pmax), __float_as_uint(pmax), false, false);
      pmax = fmaxf(__uint_as_float(rr[0]), __uint_as_float(rr[1])); }
    if (__builtin_expect(__all((pmax - m_reg) * SCALE <= THR), 1)) { mn = m_reg; alpha = 1.f; }
    else { mn = fmaxf(m_reg, pmax); alpha = __builtin_amdgcn_exp2f((m_reg - mn) * C2); m_reg = mn; }
    const float mnL = -mn * C2;
#pragma unroll
    for (int r = 0; r < 16; ++r) p0[r] = fmaf(p0[r], C2, mnL);
#pragma unroll
    for (int r = 0; r < 16; ++r) p1[r] = fmaf(p1[r], C2, mnL);
#pragma unroll
    for (int r = 0; r < 16; ++r) p0[r] = __builtin_amdgcn_exp2f(p0[r]);
}
#define PK4(P, B_, OUT) do { unsigned a0 = cvt_pk_bf16(P[B_+0], P[B_+1]), a1 = cvt_pk_bf16(P[B_+2], P[B_+3]);                          \
        unsigned b0 = cvt_pk_bf16(P[B_+4], P[B_+5]), b1 = cvt_pk_bf16(P[B_+6], P[B_+7]);                                             \
        auto r0 = __builtin_amdgcn_permlane32_swap(a0, b0, false, false); auto r1 = __builtin_amdgcn_permlane32_swap(a1, b1, false, false); \
        u32x4 w = {r0[0], r1[0], r0[1], r1[1]}; OUT = *reinterpret_cast<bf16x8*>(&w); } while (0)
__device__ __forceinline__ void finishSM(f32x16& p0, f32x16& p1, float alpha, float& l_reg, bf16x8& pa0, bf16x8& pa1, bf16x8& pa2, bf16x8& pa3, bool on = true) {
#pragma unroll
    for (int r = 0; r < 16; ++r) p1[r] = __builtin_amdgcn_exp2f(p1[r]);
    float ps = 0;
#pragma unroll
    for (int r = 0; r < 16; ++r) ps += p0[r];
#pragma unroll
    for (int r = 0; r < 16; ++r) ps += p1[r];
    { auto rr = __builtin_amdgcn_permlane32_swap(__float_as_uint(ps), __float_as_uint(ps), false, false);
      ps = __uint_as_float(rr[0]) + __uint_as_float(rr[1]); }
    l_reg = l_reg * alpha + (on ? ps : 0.f);
    PK4(p0, 0, pa0); PK4(p0, 8, pa1); PK4(p1, 0, pa2); PK4(p1, 8, pa3);
    if (!on) { const bf16x8 z = {0, 0, 0, 0, 0, 0, 0, 0}; pa0 = z; pa1 = z; pa2 = z; pa3 = z; }
}
template <int KB>
__device__ __forceinline__ void qkt(f32x16& p0, f32x16& p1, const LAS char* K_lds, int r32, int hi, const LAS char* qs) {
    const LAS char* kb[4];
#pragma unroll
    for (int dd = 0; dd < 4; ++dd) kb[dd] = K_lds + KB * SHM_K + KSWZ(r32, (dd * 16 + hi * 8) * 2);
#pragma unroll
    for (int d0 = 0; d0 < 8; ++d0) { const LAS char* a = kb[d0 & 3] + (d0 >> 2) * 128;
        const bf16x8 q = *reinterpret_cast<const LAS bf16x8*>(qs + d0 * 1024);
        bf16x8 b0 = *reinterpret_cast<const LAS bf16x8*>(a);
        bf16x8 b1 = *reinterpret_cast<const LAS bf16x8*>(a + 32 * 256);
        p0 = __builtin_amdgcn_mfma_f32_32x32x16_bf16(b0, q, p0, 0, 0, 0);
        p1 = __builtin_amdgcn_mfma_f32_32x32x16_bf16(b1, q, p1, 0, 0, 0); }
}
template <int KB>
__device__ __forceinline__ void qkt_r(f32x16& p0, f32x16& p1, const LAS char* K_lds, int r32, int hi, const bf16x8* qr) {
    const LAS char* kb[4];
#pragma unroll
    for (int dd = 0; dd < 4; ++dd) kb[dd] = K_lds + KB * SHM_K + KSWZ(r32, (dd * 16 + hi * 8) * 2);
#pragma unroll
    for (int d0 = 0; d0 < 8; ++d0) { const LAS char* a = kb[d0 & 3] + (d0 >> 2) * 128;
        bf16x8 b0 = *reinterpret_cast<const LAS bf16x8*>(a);
        bf16x8 b1 = *reinterpret_cast<const LAS bf16x8*>(a + 32 * 256);
        p0 = __builtin_amdgcn_mfma_f32_32x32x16_bf16(b0, qr[d0], p0, 0, 0, 0);
        p1 = __builtin_amdgcn_mfma_f32_32x32x16_bf16(b1, qr[d0], p1, 0, 0, 0); }
}
template <int VB>
__device__ __forceinline__ void pv_tile(f32x16* o, int vb0, bf16x8 pa0, bf16x8 pa1, bf16x8 pa2, bf16x8 pa3) {
#define TRRD(dst, off) asm volatile("ds_read_b64_tr_b16 %0, %1 offset:%2" : "=&v"(dst) : "v"(vb0), "i"(off) : "memory")
#define PV_D0(d0) do { s16x4 l0, l1, l2, l3, h0, h1, h2, h3; constexpr int b_ = VB * SHM_V + v_rd_off(d0, 0, 0); \
        TRRD(l0, b_); TRRD(h0, b_ + 2048); TRRD(l1, b_ + 4096); TRRD(h1, b_ + 6144); TRRD(l2, b_ + 8192); TRRD(h2, b_ + 10240); TRRD(l3, b_ + 12288); TRRD(h3, b_ + 14336); \
        asm volatile("s_waitcnt lgkmcnt(0)" ::: "memory"); SBAR(); \
        o[d0] = __builtin_amdgcn_mfma_f32_32x32x16_bf16(pa0, (bf16x8){l0[0], l0[1], l0[2], l0[3], h0[0], h0[1], h0[2], h0[3]}, o[d0], 0, 0, 0);   \
        o[d0] = __builtin_amdgcn_mfma_f32_32x32x16_bf16(pa1, (bf16x8){l1[0], l1[1], l1[2], l1[3], h1[0], h1[1], h1[2], h1[3]}, o[d0], 0, 0, 0);   \
        o[d0] = __builtin_amdgcn_mfma_f32_32x32x16_bf16(pa2, (bf16x8){l2[0], l2[1], l2[2], l2[3], h2[0], h2[1], h2[2], h2[3]}, o[d0], 0, 0, 0);   \
        o[d0] = __builtin_amdgcn_mfma_f32_32x32x16_bf16(pa3, (bf16x8){l3[0], l3[1], l3[2], l3[3], h3[0], h3[1], h3[2], h3[3]}, o[d0], 0, 0, 0); } while (0)
    PV_D0(0); PV_D0(1); PV_D0(2); PV_D0(3);
#undef PV_D0
#undef TRRD
}

struct Blk {
    const bf16_t* Q;
    const bf16_t* K; const bf16_t* V;
    const float* KB;
    int mode, P0, j_lo, j_hi, b, hb;
};
struct Seam { bf16x8 st_v0, st_v1, st_k0, st_k1; };
__device__ __forceinline__ int q_lane_off(int mode, int wid, int r32) { return mode == M_FOX ? (wid * 32 + r32) * 128 : ((r32 >> 3) * T + wid * 8 + (r32 & 7)) * 128; }
#define ROW(p, k0, rr) ((p) + (size_t)((k0) + (rr)) * D + sc)
#define VMW() asm volatile("s_waitcnt vmcnt(0)" ::: "memory")
#define VMWN(n) asm volatile("s_waitcnt vmcnt(%0)" :: "i"(n) : "memory")
#define SLOAD_H(Kp, Vp, k0) do { S.st_v0 = load8(ROW(Vp, k0, sr)); S.st_v1 = load8(ROW(Vp, k0, 32 + sr)); S.st_k0 = load8(ROW(Kp, k0, sr)); S.st_k1 = load8(ROW(Kp, k0, 32 + sr)); } while (0)
#define SWRITE_HK(bf) do { *(LAS bf16x8*)(K_lds + (bf) * SHM_K + kws) = S.st_k0; *(LAS bf16x8*)(K_lds + (bf) * SHM_K + kws + 32 * 256) = S.st_k1; } while (0)
#define SWRITE_HV(bf) do { *(LAS bf16x8*)(V_lds + (bf) * SHM_V + vst0) = S.st_v0; *(LAS bf16x8*)(V_lds + (bf) * SHM_V + vst1) = S.st_v1; } while (0)
#define SWRITE_H(bf) do { SWRITE_HV(bf); SWRITE_HK(bf); } while (0)
__device__ __forceinline__ void attn_prime(const Blk& cur, LAS char* lds, Seam& S) {
    const int tid = threadIdx.x;
    const int sr = tid >> 4, sc = (tid & 15) * 8, kws = KSWZ(sr, sc * 2); LAS char* K_lds = lds + L_K;
    const int kb0 = cur.j_lo * KVBLK;
    SLOAD_H(cur.K, cur.V, kb0); VMW(); SWRITE_HK(0);
    __syncthreads();
}
struct EpiCtx { bf16_t* AO; float* NSAO; const float* GATES; unsigned* panel_cnt; };
__device__ __forceinline__ void attn_block(const Blk& cur, const Blk& nxt, LAS char* lds, Seam& S, const EpiCtx& ec) {
    int tid = threadIdx.x; asm volatile("" : "+v"(tid));
    const int wid = __builtin_amdgcn_readfirstlane(tid >> 6), lane = tid & 63, r32 = lane & 31, hi = lane >> 5;
    const int mode = cur.mode;
    const int j_lo = cur.j_lo, NT = cur.j_hi - cur.j_lo;
    const int kbn = nxt.j_lo * KVBLK;
    const bool fox = mode == M_FOX;
    const int wlo = cur.P0 + (fox ? wid * 32 : wid * 8), whi = wlo + (fox ? 31 : 7);
    const int pos = cur.P0 + (fox ? wid * 32 + r32 : wid * 8 + (r32 & 7)), qm = pos - 4 * hi;
    const unsigned Wu = (mode == M_WIN) ? 512u : (1u << 30);
    LAS char* V_lds = lds + L_V; LAS char* K_lds = lds + L_K;
    LAS float* ws = (LAS float*)(lds + L_WS) + wid * 64; LAS float* li_l = ws; LAS float* al_l = ws + 32;
    float m_reg = -1e30f, l_reg = 0; f32x16 o[4] = {};
    const int sr = tid >> 4, sc = (tid & 15) * 8, vst0 = v_st(sr, sc), vst1 = v_st(32 + sr, sc), kws = KSWZ(sr, sc * 2);
    const int vb0 = (int)(unsigned)(uintptr_t)V_lds + v_rd_base(lane);
    const bf16_t* Kh = cur.K; const bf16_t* Vh = cur.V;
    unsigned long long sel = ~0ull;
    if (mode == M_SLC) sel = *(const LAS unsigned long long*)(lds + L_SEL + (wid * 8 + (r32 & 7)) * 8);
#define RESC(a_) do { if (__any((a_) < 1.f)) { if (hi == 0) al_l[r32] = (a_); asm volatile("s_waitcnt lgkmcnt(0)" ::: "memory");              \
                     _Pragma("unroll") for (int d_ = 0; d_ < 4; ++d_) _Pragma("unroll") for (int r = 0; r < 16; ++r) o[d_][r] *= al_l[crow(r, hi)]; } } while (0)
#define KBASE(t) ((j_lo + (t)) * KVBLK)
#define PRELOAD(P0_, P1_, t) do { if (fox) { const LAS float* kbp_ = (const LAS float*)(lds + L_KB) + KBASE(t) + 4 * hi; \
            _Pragma("unroll") for (int q_ = 0; q_ < 4; ++q_) { const f32x4 a_ = *(const LAS f32x4*)(kbp_ + 8 * q_), b_ = *(const LAS f32x4*)(kbp_ + 32 + 8 * q_); \
                P0_[4*q_] = a_[0]; P0_[4*q_+1] = a_[1]; P0_[4*q_+2] = a_[2]; P0_[4*q_+3] = a_[3]; P1_[4*q_] = b_[0]; P1_[4*q_+1] = b_[1]; P1_[4*q_+2] = b_[2]; P1_[4*q_+3] = b_[3]; } } \
        else { P0_ = f32x16{}; P1_ = f32x16{}; } } while (0)
#define MASKT(P0_, P1_, t) do { const int kb_ = KBASE(t); \
        if (kb_ + KVBLK - 1 > wlo || kb_ + (int)Wu <= whi) mask_tile(P0_, P1_, qm - kb_, Wu); } while (0)
#define ONT(t) (mode != M_SLC || ((sel >> (j_lo + (t))) & 1ull) != 0ull)
    if (wid >= 4) __builtin_amdgcn_s_setprio(1);
    f32x16 pA0, pA1, pB0, pB1; float mnA, mnB, alA, alB; bf16x8 pa0, pa1, pa2, pa3;
    LAS char* qs = lds + L_Q + wid * 8192 + lane * 16;
    if (mode != M_SLC)
    { const bf16_t* qp = cur.Q + q_lane_off(mode, wid, r32) + hi * 8; bf16x8 tq[8];
#pragma unroll
      for (int d0 = 0; d0 < 8; ++d0) tq[d0] = load8(qp + d0 * 16);
#pragma unroll
      for (int d0 = 0; d0 < 8; ++d0) *(LAS bf16x8*)(qs + d0 * 1024) = tq[d0]; }
    PRELOAD(pA0, pA1, 0);
    SWRITE_HV(0); SBAR();
    if (NT > 1) SLOAD_H(Kh, Vh, KBASE(1));
    SBAR(); qkt<0>(pA0, pA1, K_lds, r32, hi, qs);
    if (NT > 1) PRELOAD(pB0, pB1, 1); else { pB0 = f32x16{}; pB1 = f32x16{}; }
    MASKT(pA0, pA1, 0); partialSM(pA0, pA1, m_reg, mnA, alA);
    if (NT > 1) { VMW(); SWRITE_H(1); }
    __syncthreads();
#define HALF_STEP(PX0, PX1, mnX, alX, PY0, PY1, alY, t, KB_, VB_, SB_) do {                                                      \
        SBAR(); if ((t) + 1 < NT) { SLOAD_H(Kh, Vh, KBASE((t) + 1)); SBAR(); }         \
        qkt<KB_>(PX0, PX1, K_lds, r32, hi, qs);                                             \
        finishSM(PY0, PY1, alY, l_reg, pa0, pa1, pa2, pa3, ONT((t) - 1)); SBAR();                                                           \
        if ((t) + 1 < NT) { PRELOAD(PY0, PY1, (t) + 1); SBAR(); }                                               \
        pv_tile<VB_>(o, vb0, pa0, pa1, pa2, pa3); MASKT(PX0, PX1, (t)); partialSM(PX0, PX1, m_reg, mnX, alX);                                        \
        __syncthreads();                                                                                                      \
        if ((t) + 1 < NT) { VMW(); SWRITE_H(SB_); }                                                                          \
        RESC(alX); __syncthreads(); } while (0)
    for (int t = 1; t + 1 < NT; t += 2) {
        HALF_STEP(pB0, pB1, mnB, alB, pA0, pA1, alA, t, 1, 0, 0);
        HALF_STEP(pA0, pA1, mnA, alA, pB0, pB1, alB, t + 1, 0, 1, 1);
    }
    const bool even = (NT & 1) == 0;
    if (even) { SBAR(); qkt<1>(pB0, pB1, K_lds, r32, hi, qs); SBAR(); }
    SLOAD_H(nxt.K, nxt.V, kbn); SBAR();
    SBAR();
    finishSM(pA0, pA1, alA, l_reg, pa0, pa1, pa2, pa3, ONT(even ? NT - 2 : NT - 1)); SBAR();
    pv_tile<0>(o, vb0, pa0, pa1, pa2, pa3);
    if (even) { MASKT(pB0, pB1, NT - 1); partialSM(pB0, pB1, m_reg, mnB, alB); __syncthreads(); RESC(alB);
        finishSM(pB0, pB1, alB, l_reg, pa0, pa1, pa2, pa3, ONT(NT - 1)); SBAR(); pv_tile<1>(o, vb0, pa0, pa1, pa2, pa3); }
    SBAR(); VMW(); SWRITE_HK(0); SBAR();
    if (hi == 0) li_l[r32] = l_reg; asm volatile("s_waitcnt lgkmcnt(0)" ::: "memory");
    if (fox) {
        bf16_t* Ow = ec.AO + ((size_t)cur.b * T + cur.P0 + wid * QBLK) * DM + cur.hb * 128;
#pragma unroll
        for (int r = 0; r < 16; ++r) { const int orow = crow(r, hi); const float li = li_l[orow]; const float rl = li > 0.f ? __builtin_amdgcn_rcpf(li) : 0.f;
#pragma unroll
            for (int d0 = 0; d0 < 4; ++d0) { const float v = o[d0][r] * rl; const float vn = __shfl_xor(v, 1);
                if ((r32 & 1) == 0) *(GAS unsigned*)(Ow + (size_t)orow * DM + d0 * 32 + r32) = cvt_pk_bf16(v, vn); } }
    } else {
        const int br = (mode == M_WIN) ? 2 : 1;
        const size_t pvb = ((((size_t)((cur.b * 2 + (cur.hb >> 2)) * 64 + (cur.P0 >> 6)) * 8 + wid) * 16) * 64 + lane) * 4;
#pragma unroll
        for (int h8 = 0; h8 < 2; ++h8) {
            float gv[8]; float av[8][4], bv[8][4];
#pragma unroll
            for (int q = 0; q < 8; ++q) { const int rho = crow(h8 * 8 + q, hi);
                const int tok = cur.P0 + wid * 8 + (rho & 7), head = cur.hb + (rho >> 3); const size_t trow = (size_t)cur.b * T + tok;
                gv[q] = ((const GAS float*)ec.GATES)[trow * 24 + head * 3 + br];
                if (mode == M_SLC) { const GAS float* np = (const GAS float*)(ec.NSAO + pvb + (size_t)(h8 * 8 + q) * 256); const f32x4 a4 = *(const GAS f32x4*)np, b4 = *(const GAS f32x4*)(np + (ptrdiff_t)((WS_PART - WS_NSAO) / 4));
#pragma unroll
                    for (int d0 = 0; d0 < 4; ++d0) { av[q][d0] = a4[d0]; bv[q][d0] = b4[d0]; } }
                else {
#pragma unroll
                    for (int d0 = 0; d0 < 4; ++d0) { av[q][d0] = 0.f; bv[q][d0] = 0.f; } } }
#pragma unroll
            for (int q = 0; q < 8; ++q) { const int r = h8 * 8 + q; const int rho = crow(r, hi); const float li = li_l[rho]; const float rl = li > 0.f ? __builtin_amdgcn_rcpf(li) : 0.f;
                const int tok = cur.P0 + wid * 8 + (rho & 7), head = cur.hb + (rho >> 3); const size_t trow = (size_t)cur.b * T + tok;
                const float gt = gv[q] * rl;
                if (mode == M_WIN) *(GAS f32x4*)(ec.NSAO + pvb + (size_t)r * 256 + (ptrdiff_t)((WS_PART - WS_NSAO) / 4)) = (f32x4){gt * o[0][r], gt * o[1][r], gt * o[2][r], gt * o[3][r]};
#pragma unroll
                for (int d0 = 0; d0 < 4; ++d0) {
                    if (mode == M_WIN) { }
                    else { const float v = av[q][d0] + bv[q][d0] + gt * o[d0][r]; const float vn = __shfl_xor(v, 1); if ((r32 & 1) == 0) *(GAS unsigned*)(ec.AO + trow * DM + 1024 + head * 128 + d0 * 32 + r32) = cvt_pk_bf16(v, vn); } } }
            asm volatile("" ::: "memory"); }
    }
    __builtin_amdgcn_s_setprio(0);
    __syncthreads();
#undef RESC
#undef KBASE
#undef PRELOAD
#undef MASKT
#undef ONT
#undef HALF_STEP
}
#undef ROW
#undef SLOAD_H
#undef SWRITE_HK
#undef SWRITE_HV
#undef SWRITE_H

__device__ __forceinline__ bf16x8 ovfrag(int n0, int J) {
    asm volatile("" : "+v"(n0));
    unsigned w[4];
#pragma unroll
    for (int q = 0; q < 4; ++q) { unsigned lohi[2];
#pragma unroll
        for (int e = 0; e < 2; ++e) { const int dl = n0 + 2 * q + e - 4 * J; lohi[e] = (dl >= 0 && dl <= 2) ? 0x3F80u : ((dl == 3 || dl == -1) ? 0x3F00u : 0u); }
        w[q] = lohi[0] | (lohi[1] << 16); }
    u32x4 v = {w[0], w[1], w[2], w[3]}; return *reinterpret_cast<bf16x8*>(&v);
}
__device__ __forceinline__ void nsa_cmp_item(int b, int g, int qb, const bf16_t* NQ, const bf16_t* KCMP, const bf16_t* VCMP, const float* GATES, const float* mbound, float* NSAO, LAS char* lds) {
    int tid = threadIdx.x; asm volatile("" : "+v"(tid));
    const int wid = __builtin_amdgcn_readfirstlane(tid >> 6), lane = tid & 63, r32 = lane & 31, hi = lane >> 5;
    LAS char* V_lds = lds + LC_V; LAS char* K_lds = lds + LC_K;
    LAS float* ws = (LAS float*)(lds + LC_WS) + wid * 64; LAS float* li_l = ws;
    LAS float* impL = (LAS float*)(lds + LC_IMP);
    const int sr = tid >> 4, sc = (tid & 15) * 8, vst0 = v_st(sr, sc), vst1 = v_st(32 + sr, sc), kws = KSWZ(sr, sc * 2);
    const bf16_t* Kc = KCMP + (size_t)(b * 2 + g) * 256 * 128; const bf16_t* Vc = VCMP + (size_t)(b * 2 + g) * 256 * 128;
    const int ntile = ((4 * qb + 2) >> 6) + 1;
    bf16x8 qr[8];
    { const bf16_t* qp = NQ + (((size_t)b * 8 + g * 4) * T + qb * 64) * 128 + q_lane_off(M_WIN, wid, r32) + hi * 8;
#pragma unroll
      for (int d0 = 0; d0 < 8; ++d0) qr[d0] = load8(qp + d0 * 16); }
    {
        bf16x8 kk[4][2], vv[4][2];
#pragma unroll
        for (int tl = 0; tl < 4; ++tl) { kk[tl][0] = load8(Kc + (size_t)(tl * 64 + sr) * 128 + sc); kk[tl][1] = load8(Kc + (size_t)(tl * 64 + 32 + sr) * 128 + sc); }
#pragma unroll
        for (int tl = 0; tl < 4; ++tl) { vv[tl][0] = load8(Vc + (size_t)(tl * 64 + sr) * 128 + sc); vv[tl][1] = load8(Vc + (size_t)(tl * 64 + 32 + sr) * 128 + sc); }
#pragma unroll
        for (int tl = 0; tl < 4; ++tl) { *(LAS bf16x8*)(K_lds + tl * SHM_K + kws) = kk[tl][0]; *(LAS bf16x8*)(K_lds + tl * SHM_K + kws + 32 * 256) = kk[tl][1]; }
#pragma unroll
        for (int tl = 0; tl < 4; ++tl) { *(LAS bf16x8*)(V_lds + tl * SHM_V + vst0) = vv[tl][0]; *(LAS bf16x8*)(V_lds + tl * SHM_V + vst1) = vv[tl][1]; }
        asm volatile("" ::: "memory");
    }
    __syncthreads();
    const int pos = qb * 64 + wid * 8 + (r32 & 7);
    const int nmax = (pos - 31) >> 4;
    const float NEG = -__builtin_inff();
#define CMASK(P0_, P1_, tl) do { _Pragma("unroll") for (int r = 0; r < 16; ++r) { const int n_ = (tl) * 64 + crow(r, hi); if (n_ > nmax) P0_[r] = NEG; if (n_ + 32 > nmax) P1_[r] = NEG; } } while (0)
    const float mL = -(*(const GAS float*)mbound) * C2;
    float l_reg = 0.f;
    const int vb0 = (int)(unsigned)(uintptr_t)V_lds + v_rd_base(lane);
    f32x16 o[4] = {}; f32x16 io[2] = {};
#pragma nounroll
    for (int tl = 0; tl < ntile; ++tl) { f32x16 p0 = f32x16{}, p1 = f32x16{}; qkt_r<0>(p0, p1, K_lds + tl * SHM_K, r32, hi, qr); CMASK(p0, p1, tl);
        float ps = 0.f;
#pragma unroll
        for (int r = 0; r < 16; ++r) { p0[r] = __builtin_amdgcn_exp2f(fmaf(p0[r], C2, mL)); p1[r] = __builtin_amdgcn_exp2f(fmaf(p1[r], C2, mL)); ps += p0[r] + p1[r]; }
        l_reg += ps; bf16x8 pa0, pa1, pa2, pa3; PK4(p0, 0, pa0); PK4(p0, 8, pa1); PK4(p1, 0, pa2); PK4(p1, 8, pa3);
        pv_tile<0>(o, vb0 + tl * SHM_V, pa0, pa1, pa2, pa3); SBAR();
#pragma unroll
        for (int d0 = 0; d0 < 2; ++d0) { const int J = d0 * 32 + r32;
            io[d0] = __builtin_amdgcn_mfma_f32_32x32x16_bf16(pa0, ovfrag(tl * 64 + 0 + 8 * hi, J), io[d0], 0, 0, 0);
            io[d0] = __builtin_amdgcn_mfma_f32_32x32x16_bf16(pa1, ovfrag(tl * 64 + 16 + 8 * hi, J), io[d0], 0, 0, 0);
            io[d0] = __builtin_amdgcn_mfma_f32_32x32x16_bf16(pa2, ovfrag(tl * 64 + 32 + 8 * hi, J), io[d0], 0, 0, 0);
            io[d0] = __builtin_amdgcn_mfma_f32_32x32x16_bf16(pa3, ovfrag(tl * 64 + 48 + 8 * hi, J), io[d0], 0, 0, 0); } SBAR(); }
    { auto rr = __builtin_amdgcn_permlane32_swap(__float_as_uint(l_reg), __float_as_uint(l_reg), false, false); l_reg = __uint_as_float(rr[0]) + __uint_as_float(rr[1]); }
    if (hi == 0) li_l[r32] = l_reg; asm volatile("s_waitcnt lgkmcnt(0)" ::: "memory");
    {
        float gv[16];
#pragma unroll
        for (int r = 0; r < 16; ++r) { const int rho = crow(r, hi); gv[r] = ((const GAS float*)GATES)[((size_t)b * T + qb * 64 + wid * 8 + (rho & 7)) * 24 + (g * 4 + (rho >> 3)) * 3 + 0]; }
        float imps[2][4] = {};
#pragma unroll
        for (int r = 0; r < 16; ++r) { const int rho = crow(r, hi); const float li = li_l[rho]; const float rl = li > 0.f ? __builtin_amdgcn_rcpf(li) : 0.f;
            const int tok = qb * 64 + wid * 8 + (rho & 7), head = g * 4 + (rho >> 3);
            const size_t trow = (size_t)b * T + tok;
            const float gt = gv[r] * rl;
            *(GAS f32x4*)(NSAO + ((((size_t)((b * 2 + g) * 64 + qb) * 8 + wid) * 16 + r) * 64 + (r32 + 32 * hi)) * 4) = (f32x4){gt * o[0][r], gt * o[1][r], gt * o[2][r], gt * o[3][r]};
            imps[0][r & 3] += io[0][r] * rl; imps[1][r & 3] += io[1][r] * rl; }
#pragma unroll
        for (int d0 = 0; d0 < 2; ++d0)
#pragma unroll
            for (int e = 0; e < 4; ++e) impL[(wid * 8 + e + 4 * hi) * 64 + d0 * 32 + r32] = imps[d0][e];
    }
#undef CMASK
    __syncthreads();
#pragma nounroll
    for (int tk = 0; tk < 8; ++tk) { const int tl = wid * 8 + tk; const int J = lane;
        const float im = impL[tl * 64 + J];
        const bool forced = (J == 0) || (J == qb) || (J == qb - 1);
        const float v = forced ? __builtin_inff() : (J <= qb ? im : NEG);
        impL[tl * 64 + J] = v; asm volatile("s_waitcnt lgkmcnt(0)" ::: "memory");
        f32x4 uv[16];
#pragma unroll
        for (int q = 0; q < 16; ++q) uv[q] = *(const LAS f32x4*)(impL + tl * 64 + 4 * q);
        int rank = 0;
#pragma unroll
        for (int q = 0; q < 16; ++q)
#pragma unroll
            for (int e = 0; e < 4; ++e) { const float u = uv[q][e]; const int jj = 4 * q + e; rank += (u > v || (u == v && jj < J)) ? 1 : 0; }
        const unsigned long long mk = __ballot(rank < 16 && J <= qb);
        if (lane == 0) *(LAS unsigned long long*)(lds + L_SEL + tl * 8) = mk; }
    __syncthreads();
}
#undef PK4
#undef VMW
#undef VMWN

template <class P> __device__ __forceinline__ P* uptr(P* p) { const unsigned long long v = (unsigned long long)p;
    const unsigned lo = __builtin_amdgcn_readfirstlane((unsigned)v), hi = __builtin_amdgcn_readfirstlane((unsigned)(v >> 32)); return (P*)(((unsigned long long)hi << 32) | lo); }
__device__ __forceinline__ Blk make_blk(unsigned char* ws, int i, int st) {
    const int bg = i >> 6, qb = i & 63, b = bg >> 1, g = bg & 1; Blk k;
    if (st < 2) {
        k.Q = uptr((const bf16_t*)(ws + WS_NQR) + (((size_t)b * 8 + g * 4) * T + qb * 64) * 128);
        k.K = uptr((const bf16_t*)(ws + (st == 0 ? WS_KW : WS_KSL)) + (size_t)bg * T * 128); k.V = uptr((const bf16_t*)(ws + (st == 0 ? WS_VW : WS_VSL)) + (size_t)bg * T * 128);
        k.KB = nullptr; k.mode = st == 0 ? M_WIN : M_SLC; k.P0 = qb * 64; k.j_lo = (st == 0 && qb >= 8) ? qb - 8 : 0; k.j_hi = qb + 1; k.b = b; k.hb = g * 4;
    } else {
        const int bh = bg * 4 + (qb & 3), qf = 15 - (qb >> 2);
        k.Q = uptr((const bf16_t*)(ws + WS_FQ) + ((size_t)bh * T + qf * 256) * 128); k.K = uptr((const bf16_t*)(ws + WS_FK) + (size_t)bh * T * 128); k.V = uptr((const bf16_t*)(ws + WS_FV) + (size_t)bh * T * 128);
        k.KB = uptr((const float*)(ws + WS_KBIAS) + (size_t)bh * T); k.mode = M_FOX; k.P0 = qf * 256; k.j_lo = 0; k.j_hi = 4 * qf + 4; k.b = bh >> 3; k.hb = bh & 7;
    }
    k.mode = __builtin_amdgcn_readfirstlane(k.mode); k.P0 = __builtin_amdgcn_readfirstlane(k.P0); k.j_lo = __builtin_amdgcn_readfirstlane(k.j_lo); k.j_hi = __builtin_amdgcn_readfirstlane(k.j_hi);
    k.b = __builtin_amdgcn_readfirstlane(k.b); k.hb = __builtin_amdgcn_readfirstlane(k.hb);
    return k;
}
__device__ __forceinline__ void compute_kb(unsigned char* ws, int bh, LAS char* lds) {
    int tid = threadIdx.x; asm volatile("" : "+v"(tid));
    LAS double* part = (LAS double*)(lds + LC_IMP);
    const float* lf = (const float*)(ws + WS_LOGF) + (size_t)bh * T + tid * 8; float* kb = (float*)(ws + WS_KBIAS) + (size_t)bh * T + tid * 8;
    const f32x4 v0 = *(const f32x4*)lf, v1 = *(const f32x4*)(lf + 4);
    double loc[8]; double run = 0.0;
    { const float vv[8] = {v0[0], v0[1], v0[2], v0[3], v1[0], v1[1], v1[2], v1[3]};
#pragma unroll
      for (int i = 0; i < 8; ++i) { run += (double)vv[i]; loc[i] = run; } }
    const int lane = tid & 63, wv = tid >> 6; double inc = run;
#pragma unroll
    for (int o = 1; o < 64; o <<= 1) { const double up = __shfl_up(inc, o); if (lane >= o) inc += up; }
    if (lane == 63) part[wv] = inc;
    __syncthreads();
    double off = inc - run;
    for (int w = 0; w < wv; ++w) off += part[w];
    f32x4 o0, o1;
#pragma unroll
    for (int i = 0; i < 4; ++i) { o0[i] = (float)(-(off + loc[i]) * (double)(1.0f / SCALE)); o1[i] = (float)(-(off + loc[4 + i]) * (double)(1.0f / SCALE)); }
    *(f32x4*)kb = o0; *(f32x4*)(kb + 4) = o1;
    asm volatile("s_waitcnt vmcnt(0)" ::: "memory");
    __syncthreads();
}
__device__ __forceinline__ void stage_kb(const float* kbg, LAS char* lds) {
    int tid = threadIdx.x; asm volatile("" : "+v"(tid));
    const f32x4 v0 = *(const GAS f32x4*)(kbg + tid * 8), v1 = *(const GAS f32x4*)(kbg + tid * 8 + 4);
    LAS float* kl = (LAS float*)(lds + L_KB) + tid * 8;
    *(LAS f32x4*)kl = v0; *(LAS f32x4*)(kl + 4) = v1;
    __syncthreads();
}
__device__ __forceinline__ void attn_phase(const Args& a, LAS char* lds, int vcu, int G) {
    unsigned char* ws = a.ws;
    EpiCtx ec{(bf16_t*)(ws + WS_AO), (float*)(ws + WS_NSAO), (const float*)(ws + WS_GATES), (unsigned*)(ws + CTL_CNT_ATTN)};
    Seam S;
    constexpr int ST0 = (DEV_ATT == 1) ? 2 : 0, ST1 = (DEV_ATT == 2) ? 2 : 3;
    for (int i = vcu; i < 256; i += G) {
#ifndef NO_CMP
        if (DEV_ATT & 2) { const int bg = i >> 6, qb = i & 63; nsa_cmp_item(bg >> 1, bg & 1, qb, (const bf16_t*)(ws + WS_NQ), (const bf16_t*)(ws + WS_KCMP), (const bf16_t*)(ws + WS_VCMP), ec.GATES, (const float*)(ws + WS_MBOUND), ec.NSAO, lds); }
#endif
#ifndef NO_BLK
        Blk cur = make_blk(ws, i, ST0);
        attn_prime(cur, lds, S);
        for (int st = ST0; st < ST1; ++st) { const Blk nxt = make_blk(ws, i, st + 1 < ST1 ? st + 1 : st);
            if (st == 1) { const int tid_ = threadIdx.x, w_ = __builtin_amdgcn_readfirstlane(tid_ >> 6), l_ = tid_ & 63; const float* kbg = (const float*)(ws + WS_KBIAS) + (size_t)((i >> 6) * 4 + (i & 3)) * T;
#pragma unroll
                for (int h_ = 0; h_ < 2; ++h_) __builtin_amdgcn_global_load_lds((const unsigned*)(kbg + (w_ * 2 + h_) * 256 + l_ * 4), (LAS unsigned*)(lds + L_KB + (w_ * 2 + h_) * 1024), 16, 0, 0); }
            if (st == 2) { asm volatile("s_waitcnt vmcnt(0)" ::: "memory"); __syncthreads(); }
            attn_block(cur, nxt, lds, S, ec); cur = nxt; }
#endif
    }
}
#undef KSWZ
#undef SBAR
}


__device__ __forceinline__ int win_src_col(int pg) {
    const int pn = pg >> 8, p = pg & 255;
    if (pn == 12) { if (p < 8) return C_FZ + p; if (p < 32) return C_GZ + p - 8; return -1; }
    const int bj = p >> 7, q = p & 127;
    const int d = 16 * (q >> 5) + 4 * ((q >> 3) & 3) + (q & 3) + 64 * ((q >> 2) & 1);
    int base;
    if (pn < 4) base = C_FQ + pn * 256; else if (pn < 8) base = C_FK + (pn - 4) * 256; else if (pn < 12) base = C_FV + (pn - 8) * 256;
    else if (pn < 17) base = C_NQ + (pn - 13) * 256; else if (pn == 17) base = C_KC; else if (pn == 18) base = C_VC; else if (pn == 19) base = C_KSL;
    else if (pn == 20) base = C_KW; else if (pn == 21) base = C_VSL; else base = C_VW;
    return base + bj * 128 + d;
}
template <int SRC>
__device__ __forceinline__ void transpose_item(const float* W, int K, int N, bf16_t* WT, LAS float* scr, int item, int nblk, int lane) {
    const int kb = item / nblk, nb = item % nblk, k0 = 64 * kb, n0 = 32 * nb;
    int sc = n0 + (lane & 31); if (SRC == 1) sc = win_src_col(sc);
    float tv[32];
    const float* wp = W + (size_t)(k0 + (lane >> 5)) * N + (sc >= 0 ? sc : 0);
#pragma unroll
    for (int i = 0; i < 32; ++i) tv[i] = wp[(size_t)(2 * i) * N];
#pragma unroll
    for (int i = 0; i < 32; ++i) { const int kk = 2 * i + (lane >> 5); scr[kk * 33 + (lane & 31)] = sc >= 0 ? tv[i] : 0.f; }
    asm volatile("s_waitcnt lgkmcnt(0)" ::: "memory");
    const int cch = lane & 7;
#pragma unroll
    for (int j = 0; j < 4; ++j) { const int n = (lane >> 3) + 8 * j; const LAS float* s = scr + (8 * cch) * 33 + n;
        u32x4 o; o.x = cvt_pk_bf16(s[0 * 33], s[1 * 33]); o.y = cvt_pk_bf16(s[2 * 33], s[3 * 33]); o.z = cvt_pk_bf16(s[4 * 33], s[5 * 33]); o.w = cvt_pk_bf16(s[6 * 33], s[7 * 33]);
        *(u32x4*)(WT + (size_t)(n0 + n) * K + k0 + 8 * cch) = o; }
    asm volatile("s_waitcnt lgkmcnt(0)" ::: "memory");
}

__device__ __forceinline__ void p0_prologue(const Args& a, LAS unsigned char* lds, int vcu, int G) {
    int tid = threadIdx.x; asm volatile("" : "+v"(tid)); const int lane = tid & 63, wave = __builtin_amdgcn_readfirstlane(tid >> 6);
    LAS float* ca = (LAS float*)lds;
    for (int i = tid; i < 2 * DM; i += NTHR) { const float v = a.c[i]; ca[i] = v / (1.f + __expf(-v)); }
    __syncthreads();
    const int gw = vcu * NWAVES + wave, NGW = G * NWAVES;
    float* modp = (float*)(a.ws + WS_MODP);
    if (wave < 3) { const int it = vcu * 3 + wave;
        if (it < 16 * 48) { const int kc = it / 48, cq = (it % 48) * 64 + lane;
            f32x4 a0 = (f32x4){0.f, 0.f, 0.f, 0.f}, a1 = a0;
            const float* wp = a.w_ada + (size_t)(kc * 128) * (6 * DM) + 4 * cq;
#pragma unroll 16
            for (int k = 0; k < 128; ++k) { const f32x4 w = *(const f32x4*)(wp + (size_t)k * (6 * DM)); a0 += w * ca[kc * 128 + k]; a1 += w * ca[DM + kc * 128 + k]; }
            const __amdgpu_buffer_rsrc_t rsrc = __builtin_amdgcn_make_buffer_rsrc(modp, 0, 16 * 2 * 6 * DM * 4, 0x00020000);
            __builtin_amdgcn_raw_buffer_store_b128(__builtin_bit_cast(u32x4, a0), rsrc, (unsigned)((((size_t)kc * 2 + 0) * (6 * DM) + 4 * cq) * 4), 0, 16);
            __builtin_amdgcn_raw_buffer_store_b128(__builtin_bit_cast(u32x4, a1), rsrc, (unsigned)((((size_t)kc * 2 + 1) * (6 * DM) + 4 * cq) * 4), 0, 16);
            handoff_signal((unsigned*)(a.ws + CTL_CNT_ADALN), lane); } }
    LAS float* scr = (LAS float*)(lds + 16384 + wave * 16384);
    constexpr int I_IN = 32 * (NPAD / 32), I_OUT = 32 * 64, I_UP = 32 * 256, I_DN = 128 * 64, I_W1 = 64 * 8, I_W2 = 4 * 4;
    constexpr int NIT = I_IN + I_OUT + I_UP + I_DN + 2 * I_W1 + 2 * I_W2;
    const int nslot = (NIT + G - 1) / G;
    auto slot_item = [&](int m) -> int { int j; if (wave < 3) { if (m >= 6) return -1; j = wave * 6 + m; } else { j = 18 + (wave - 3) + 5 * m; }
        if (j >= nslot) return -1; const int it = vcu + G * j; return it < NIT ? it : -1; };
    struct TrIt { const float* wp; bf16_t* wt; int N, K, ok; };
    auto decode = [&](int it) -> TrIt { int r = it; const float* W; bf16_t* WT; int K, N, nblk; bool src = false;
        if (r < I_IN) { W = a.w_in; K = DM; N = DIN; WT = (bf16_t*)(a.ws + WS_WIN); nblk = NPAD / 32; src = true; }
        else if ((r -= I_IN) < I_OUT) { W = a.w_out; K = DM; N = DM; WT = (bf16_t*)(a.ws + WS_WOUT); nblk = 64; }
        else if ((r -= I_OUT) < I_UP) { W = a.w_up; K = DM; N = DFF; WT = (bf16_t*)(a.ws + WS_WUP); nblk = 256; }
        else if ((r -= I_UP) < I_DN) { W = a.w_down; K = DFF; N = DM; WT = (bf16_t*)(a.ws + WS_WDN); nblk = 64; }
        else if ((r -= I_DN) < I_W1) { W = a.cmp_w1_k; K = 4096; N = 256; WT = (bf16_t*)(a.ws + WS_W1T); nblk = 8; }
        else if ((r -= I_W1) < I_W1) { W = a.cmp_w1_v; K = 4096; N = 256; WT = (bf16_t*)(a.ws + WS_W1T) + 256 * 4096; nblk = 8; }
        else if ((r -= I_W1) < I_W2) { W = a.cmp_w2_k; K = 256; N = 128; WT = (bf16_t*)(a.ws + WS_W2T); nblk = 4; }
        else { r -= I_W2; W = a.cmp_w2_v; K = 256; N = 128; WT = (bf16_t*)(a.ws + WS_W2T) + 128 * 256; nblk = 4; }
        const int kb = r / nblk, nb = r % nblk, k0 = 64 * kb, n0 = 32 * nb; int sc = n0 + (lane & 31); if (src) sc = win_src_col(sc);
        TrIt t; t.wp = W + (size_t)(k0 + (lane >> 5)) * N + (sc >= 0 ? sc : 0); t.wt = WT + (size_t)n0 * K + k0; t.N = N; t.K = K; t.ok = sc >= 0; return t; };
    auto tr_load = [&](const TrIt& t, float (&tv)[32]) {
#pragma unroll
        for (int i = 0; i < 32; ++i) tv[i] = t.wp[(size_t)(2 * i) * t.N]; };
    auto tr_store = [&](const TrIt& t, const float (&tv)[32]) {
#pragma unroll
        for (int i = 0; i < 32; ++i) { const int kk = 2 * i + (lane >> 5); scr[kk * 33 + (lane & 31)] = t.ok ? tv[i] : 0.f; }
        asm volatile("s_waitcnt lgkmcnt(0)" ::: "memory");
        const int cch = lane & 7;
#pragma unroll
        for (int j = 0; j < 4; ++j) { const int n = (lane >> 3) + 8 * j; const LAS float* sp = scr + (8 * cch) * 33 + n;
            u32x4 o; o.x = cvt_pk_bf16(sp[0 * 33], sp[1 * 33]); o.y = cvt_pk_bf16(sp[2 * 33], sp[3 * 33]); o.z = cvt_pk_bf16(sp[4 * 33], sp[5 * 33]); o.w = cvt_pk_bf16(sp[6 * 33], sp[7 * 33]);
            *(u32x4*)(t.wt + (size_t)n * t.K + 8 * cch) = o; }
        asm volatile("s_waitcnt lgkmcnt(0)" ::: "memory"); };
    {   float tva[32], tvb[32]; TrIt ta, tb; int ia = slot_item(0), ib;
        if (ia >= 0) { ta = decode(ia); tr_load(ta, tva); }
        for (int m = 1; ia >= 0; m += 2) {
            ib = slot_item(m); if (ib >= 0) { tb = decode(ib); tr_load(tb, tvb); }
            asm volatile("" ::: "memory");
            tr_store(ta, tva);
            if (ib < 0) break;
            ia = slot_item(m + 1); if (ia >= 0) { ta = decode(ia); tr_load(ta, tva); }
            asm volatile("" ::: "memory");
            tr_store(tb, tvb);
        }
    }
    if (vcu == 255 && wave == 7) { const float gk = fmaxf(fabsf(a.cmp_k_norm[lane]), fabsf(a.cmp_k_norm[64 + lane])), gq = fmaxf(fabsf(a.nsa_q_norm[lane]), fabsf(a.nsa_q_norm[64 + lane]));
        const float mb = wave_max(gk) * wave_max(gq) * (128.f * 1.02f); if (lane == 0) *(float*)(a.ws + WS_MBOUND) = mb; }
    float* rope = (float*)(a.ws + WS_ROPE);
    for (int e = (vcu * NTHR + tid); e < T * 64; e += G * NTHR) { const int t = e >> 6, i = e & 63;
        const float inv_freq = (float)pow(10000.0, -(double)i / 64.0); const float ang = (float)t * inv_freq;
        rope[2 * e] = (float)cos((double)ang); rope[2 * e + 1] = (float)sin((double)ang); }
    float* pebp = (float*)(a.ws + WS_PEBP);
    for (int it = gw; it < 2 * 4 * 64; it += NGW) { const int kv = it >> 8, cg_ = (it >> 6) & 3, ch = it & 63, col = cg_ * 64 + lane;
        const float* pe = kv ? a.cmp_pe_v : a.cmp_pe_k; const float* w1 = kv ? a.cmp_w1_v : a.cmp_w1_k; float s = 0.f;
#pragma unroll
        for (int i = 0; i < 64; ++i) s += pe[ch * 64 + i] * w1[(size_t)(ch * 64 + i) * 256 + col];
        pebp[((size_t)kv * 64 + ch) * 256 + col] = s; }
}

template <bool FIRST>
__device__ __forceinline__ void norm_phase(const Args& a, LAS unsigned char* lds, const float* xsrc, const float* gain, int shift_off, int scale_off, int bid, int G) {
    int tid = threadIdx.x; asm volatile("" : "+v"(tid)); const int lane = tid & 63, wave = __builtin_amdgcn_readfirstlane(tid >> 6);
    LAS float* AS = (LAS float*)lds; LAS float* SH = AS + DM;
    const float* modp = (const float*)(a.ws + WS_MODP); float* mod = (float*)(a.ws + WS_MOD);
    const int rows_per = M / G, b = (bid * rows_per) / T;
    f32x4 v[4][8];
#pragma unroll
    for (int rr = 0; rr < 4; ++rr) { const f32x4* xr = (const f32x4*)(xsrc + (size_t)(bid * rows_per + wave + 8 * rr) * DM) + lane;
#pragma unroll
        for (int j = 0; j < 8; ++j) v[rr][j] = xr[64 * j]; }
    if (FIRST) handoff_wait((unsigned*)(a.ws + CTL_CNT_ADALN), 16u * 48u);
    for (int d = tid; d < DM; d += NTHR) { float sc, sh;
        if (FIRST) { sc = a.b_ada[scale_off + d]; sh = a.b_ada[shift_off + d];
#pragma unroll
            for (int kc = 0; kc < 16; ++kc) { sc += modp[((size_t)kc * 2 + b) * (6 * DM) + scale_off + d]; sh += modp[((size_t)kc * 2 + b) * (6 * DM) + shift_off + d]; } }
        else { sc = mod[b * 6 * DM + scale_off + d]; sh = mod[b * 6 * DM + shift_off + d]; }
        AS[d] = gain[d] * (1.f + sc); SH[d] = sh; }
    if (FIRST) {
        for (int e = bid * NTHR + tid; e < 2 * 6 * DM; e += G * NTHR) { const int bb = e / (6 * DM), j = e % (6 * DM); float s = a.b_ada[j];
#pragma unroll
            for (int kc = 0; kc < 16; ++kc) s += modp[((size_t)kc * 2 + bb) * (6 * DM) + j];
            mod[e] = s; }
    }
    __syncthreads();
    bf16_t* XN = (bf16_t*)(a.ws + WS_XN);
    for (int r0 = 0; r0 < rows_per; r0 += 32) {
        if (r0 > 0) {
#pragma unroll
            for (int rr = 0; rr < 4; ++rr) { const f32x4* xr = (const f32x4*)(xsrc + (size_t)(bid * rows_per + r0 + wave + 8 * rr) * DM) + lane;
#pragma unroll
                for (int j = 0; j < 8; ++j) v[rr][j] = xr[64 * j]; } }
#pragma unroll
        for (int rr = 0; rr < 4; ++rr) { const int row = bid * rows_per + r0 + wave + 8 * rr; float ss = 0.f;
#pragma unroll
            for (int j = 0; j < 8; ++j) ss += (v[rr][j][0] * v[rr][j][0] + v[rr][j][1] * v[rr][j][1]) + (v[rr][j][2] * v[rr][j][2] + v[rr][j][3] * v[rr][j][3]);
            const float rstd = 1.0f / sqrtf(wave_sum(ss) * (1.f / DM) + EPS);
            u32x2* o8 = (u32x2*)(XN + (size_t)row * DM) + lane;
#pragma unroll
            for (int j = 0; j < 8; ++j) { const f32x4 as = *(const LAS f32x4*)(AS + 4 * lane + 256 * j), sh = *(const LAS f32x4*)(SH + 4 * lane + 256 * j);
                const f32x4 h = v[rr][j] * rstd * as + sh; u32x2 w; w.x = cvt_pk_bf16(h[0], h[1]); w.y = cvt_pk_bf16(h[2], h[3]); o8[64 * j] = w; } }
    }
    __syncthreads();
}


__device__ __forceinline__ void cmp2_phase(const Args& a, LAS unsigned char* lds, int L0, int Lstride) {
    int tid = threadIdx.x; asm volatile("" : "+v"(tid)); const int lane = tid & 63, wave = __builtin_amdgcn_readfirstlane(tid >> 6);
    unsigned char* ws = a.ws;
    for (int L = L0; L < 64; L += Lstride) {
        {
            const int kv = L >> 5, bg = (L >> 3) & 3, rt = L & 7;
            LAS bf16_t* hidL = (LAS bf16_t*)lds;
            LAS float* red = (LAS float*)(lds + 32768);
            LAS float* pebL = (LAS float*)(lds + 36864);
            if (tid < 256) { const float* pebp = (const float*)(ws + WS_PEBP) + (size_t)kv * 64 * 256 + tid; float sp = 0.f;
#pragma unroll
                for (int ch = 0; ch < 64; ++ch) sp += pebp[ch * 256];
                pebL[tid] = sp; }
            __syncthreads();
            { const int row = tid >> 4, c0 = (tid & 15) * 16;
              const float* pp = (const float*)(ws + WS_PART) + ((size_t)(kv * 4 + bg) * 4) * 65536 + (size_t)(rt * 32 + row) * 256 + c0;
              const LAS float* peb = pebL + c0;
              f32x4 s0 = *(const LAS f32x4*)peb, s1 = *(const LAS f32x4*)(peb + 4), s2 = *(const LAS f32x4*)(peb + 8), s3 = *(const LAS f32x4*)(peb + 12);
#pragma unroll 4
              for (int ks = 0; ks < 4; ++ks) { const float* q = pp + (size_t)ks * 65536; s0 += *(const f32x4*)q; s1 += *(const f32x4*)(q + 4); s2 += *(const f32x4*)(q + 8); s3 += *(const f32x4*)(q + 12); }
              f32x4 sv[4] = {s0, s1, s2, s3}; unsigned w[8];
#pragma unroll
              for (int i = 0; i < 4; ++i) { f32x4 v = sv[i];
#pragma unroll
                  for (int e = 0; e < 4; ++e) v[e] = v[e] / (1.f + __expf(-v[e]));
                  w[2 * i] = cvt_pk_bf16(v[0], v[1]); w[2 * i + 1] = cvt_pk_bf16(v[2], v[3]); }
              *(LAS u32x4*)(hidL + row * 264 + c0) = (u32x4){w[0], w[1], w[2], w[3]}; *(LAS u32x4*)(hidL + row * 264 + c0 + 8) = (u32x4){w[4], w[5], w[6], w[7]}; }
            __syncthreads();
            const int fr = lane & 15, fq = lane >> 4;
            f32x4 acc[2] = {(f32x4){0.f, 0.f, 0.f, 0.f}, (f32x4){0.f, 0.f, 0.f, 0.f}};
            const bf16_t* w2 = (const bf16_t*)(ws + WS_W2T) + (size_t)kv * 128 * 256 + (size_t)(16 * wave + fr) * 256 + 8 * fq;
#pragma unroll
            for (int ks = 0; ks < 8; ++ks) { const bf16x8 bf = *(const bf16x8*)(w2 + ks * 32);
#pragma unroll
                for (int rg = 0; rg < 2; ++rg) { const bf16x8 af = *(const LAS bf16x8*)(hidL + (rg * 16 + fr) * 264 + ks * 32 + 8 * fq);
                    acc[rg] = __builtin_amdgcn_mfma_f32_16x16x32_bf16(af, bf, acc[rg], 0, 0, 0); } }
            float rstd[2][4];
            if (kv == 0) {
#pragma unroll
                for (int rg = 0; rg < 2; ++rg)
#pragma unroll
                    for (int e = 0; e < 4; ++e) { float q = acc[rg][e] * acc[rg][e]; q += __shfl_xor(q, 1); q += __shfl_xor(q, 2); q += __shfl_xor(q, 4); q += __shfl_xor(q, 8);
                        if (fr == 0) red[(rg * 16 + 4 * fq + e) * 8 + wave] = q; }
                __syncthreads();
#pragma unroll
                for (int rg = 0; rg < 2; ++rg)
#pragma unroll
                    for (int e = 0; e < 4; ++e) { const LAS float* rp = red + (rg * 16 + 4 * fq + e) * 8; const float tot = ((rp[0] + rp[1]) + (rp[2] + rp[3])) + ((rp[4] + rp[5]) + (rp[6] + rp[7]));
                        rstd[rg][e] = 1.0f / sqrtf(tot * (1.f / 128.f) + EPS) * a.cmp_k_norm[16 * wave + fr]; }
            } else {
#pragma unroll
                for (int rg = 0; rg < 2; ++rg)
#pragma unroll
                    for (int e = 0; e < 4; ++e) rstd[rg][e] = 1.f;
            }
            bf16_t* dst = (bf16_t*)(ws + (kv ? WS_VCMP : WS_KCMP)) + (size_t)bg * 256 * 128;
#pragma unroll
            for (int rg = 0; rg < 2; ++rg)
#pragma unroll
                for (int e = 0; e < 4; ++e) { const int n = rt * 32 + rg * 16 + 4 * fq + e; const float v = (n == 255) ? 0.f : acc[rg][e] * rstd[rg][e];
                    dst[(size_t)n * 128 + 16 * wave + fr] = (bf16_t)(cvt_pk_bf16(v, 0.f) & 0xffffu); }
            __syncthreads();
        }
    }
}


#define XB_TMO      128
#define XB_XCNT(j)  (256  + 64 * (j))
#define XB_XSUB(j)  (1280 + 64 * (j))
#define XB_XGEN(j)  (2304 + 64 * (j))
#define XB_TOP      3328
#define XB_TOPGEN   3392
#define XCD_BAR_WORDS 3456
#define XB_SPIN_CAP (1u << 22)
__device__ __forceinline__ unsigned xb_ld(unsigned* p)              { return __hip_atomic_load(p, __ATOMIC_RELAXED, __HIP_MEMORY_SCOPE_AGENT); }
__device__ __forceinline__ unsigned xb_add(unsigned* p, unsigned v) { return __hip_atomic_fetch_add(p, v, __ATOMIC_RELAXED, __HIP_MEMORY_SCOPE_AGENT); }
__device__ __forceinline__ unsigned xb_xcc_id() { return (unsigned)__builtin_amdgcn_s_getreg((3 << 11) | 20) & 0xFu; }
#define XB_SPIN(cond, bar) do { unsigned _sp = 0; while (cond) { __builtin_amdgcn_s_sleep(1); \
    if ((++_sp & 255u) == 0u) { if (xb_ld(&(bar)[XB_TMO])) break; if (_sp > XB_SPIN_CAP) { atomicAdd(&(bar)[XB_TMO], 1u); break; } } } } while (0)
struct XcdBarrier { unsigned* bar; unsigned x; volatile LAS unsigned* st; };
__device__ __forceinline__ XcdBarrier xcd_barrier_post(unsigned* bar, volatile LAS unsigned* st) {
    XcdBarrier b; b.bar = bar; b.x = xb_xcc_id(); b.st = st;
    if (threadIdx.x == 0) (void)xb_add(&bar[XB_XCNT(b.x)], 1u);
    return b;
}
__device__ __forceinline__ void xcd_barrier_complete(unsigned* bar, unsigned x, unsigned& nloc, unsigned& nx) {
    const unsigned G = gridDim.x * gridDim.y * gridDim.z;
    unsigned sum, cnt, mine, sp = 0u;
    for (;;) {
        sum = 0u; cnt = 0u; mine = 0u;
#pragma unroll
        for (unsigned j = 0; j < 16; ++j) { const unsigned c = xb_ld(&bar[XB_XCNT(j)]); sum += c; cnt += (c > 0u) ? 1u : 0u; mine = (j == x) ? c : mine; }
        if (sum == G) break;
        __builtin_amdgcn_s_sleep(1);
        if ((++sp & 255u) == 0u) { if (xb_ld(&bar[XB_TMO])) break; if (sp > XB_SPIN_CAP) { atomicAdd(&bar[XB_TMO], 1u); break; } }
    }
    nloc = mine > 0u ? mine : 1u; nx = cnt > 0u ? cnt : 1u;
}
__device__ __forceinline__ void xcd_barrier(const XcdBarrier& b) {
    asm volatile("s_waitcnt vmcnt(0)" ::: "memory");
    __syncthreads();
    if (threadIdx.x == 0) {
        unsigned* bar = b.bar;
        __builtin_amdgcn_s_waitcnt(0);
        unsigned nloc = b.st[0], nx = b.st[1];
        if (nloc == 0u) { xcd_barrier_complete(bar, b.x, nloc, nx); b.st[0] = nloc; b.st[1] = nx; }
        const unsigned old = xb_add(&bar[XB_XSUB(b.x)], 1u);
        const unsigned gen = old / nloc;
        if (old + 1u == (gen + 1u) * nloc) {
            __builtin_amdgcn_fence(__ATOMIC_RELEASE, "agent");
            asm volatile("s_waitcnt vmcnt(0)" ::: "memory");
            const unsigned og = xb_add(&bar[XB_TOP], 1u);
            const unsigned tg = og / nx;
            if (og + 1u == (tg + 1u) * nx) xb_add(&bar[XB_TOPGEN], 1u);
            else XB_SPIN(xb_ld(&bar[XB_TOPGEN]) == tg, bar);
            __builtin_amdgcn_fence(__ATOMIC_ACQUIRE, "agent");
            xb_add(&bar[XB_XGEN(b.x)], 1u);
            asm volatile("s_waitcnt vmcnt(0)" ::: "memory");
        } else {
            XB_SPIN(xb_ld(&bar[XB_XGEN(b.x)]) == gen, bar);
            __builtin_amdgcn_fence(__ATOMIC_ACQUIRE, "agent");
            asm volatile("s_waitcnt vmcnt(0)" ::: "memory");
        }
    }
    __syncthreads();
}

enum { PH_PRO = 0, PH_INPROJ = 1, PH_ATTN = 2, PH_OUTPROJ = 3, PH_UP = 4, PH_DOWN = 5, PH_END = 6 };

__global__ void __launch_bounds__(NTHR, 2) mega_kernel(Args a) {
    extern __shared__ __attribute__((aligned(16))) unsigned char lds_raw[];
    LAS unsigned char* lds = (LAS unsigned char*)lds_raw;
    const int G = gridDim.x, bid = blockIdx.x;
    const int vcu = (G % 8 == 0) ? (bid % 8) * (G / 8) + bid / 8 : bid;
    unsigned char* ws = a.ws;
    volatile LAS unsigned* bst = (volatile LAS unsigned*)(lds + LDS_BYTES - 64);
    if (threadIdx.x < 2) bst[threadIdx.x] = 0u;
    __syncthreads();
    const XcdBarrier gbar = xcd_barrier_post((unsigned*)(ws + WS_CTL) + 1024, bst);
#ifndef PHMASK
#define PHMASK 0xffff
#endif
#define IN(k) (((PHMASK >> (k)) & 1) && a.ph_lo <= (k) && (k) < a.ph_hi)
#ifdef PROBE_PHASE
#define STAMP(k) do { if (bid == 0 && threadIdx.x == 0) ((unsigned long long*)(ws + WS_CTL + 24576))[(k)] = __builtin_amdgcn_s_memrealtime(); } while (0)
#else
#define STAMP(k) do { } while (0)
#endif
#define SEAM(k) do { if (IN(k) && IN((k) + 1)) xcd_barrier(gbar); STAMP((k) + 1); } while (0)
    STAMP(0);
    if (IN(PH_PRO)) { p0_prologue(a, lds, vcu, G); __syncthreads(); norm_phase<true>(a, lds, a.x, a.norm1_g, 0, DM, bid, G); } SEAM(PH_PRO);
    if (IN(PH_INPROJ)) {
        pg8::StaticOrder S; S.init(M, NPAD, G, bid, ws + WS_XN, ws + WS_WIN, DM, DM); S.rm = 1;
        pg8::EpiIn E{ws, a.fox_q_norm, a.fox_k_norm, a.nsa_q_norm, a.slc_k_norm, a.win_k_norm, a.b_forget, (LAS float*)(lds + LDS_STATS), (unsigned*)(ws + CTL_CNT_KCVC), (unsigned*)(ws + CTL_CNT_GATE)};
        pg8::gemm_phase(lds, DM, DM, DM, S, E);
        if (bid >= 224) {
            handoff_wait((unsigned*)(ws + CTL_CNT_KCVC), 64u * 8u);
            pg8::CmpOrder S2{32, bid - 224, (const char*)(ws + WS_KC), (const char*)(ws + WS_VC), (const char*)(ws + WS_W1T)};
            pg8::EpiPart E2{(float*)(ws + WS_PART), (unsigned*)(ws + CTL_CNT_PART)};
            pg8::gemm_phase(lds, 2048, 4096, 1024, S2, E2);
        }
        else if ((bid & 1) == 0 && (bid >> 3) < 16) {
            handoff_wait((unsigned*)(ws + CTL_CNT_PART), 32u * 8u);
            cmp2_phase(a, lds, (bid >> 3) * 4 + ((bid & 7) >> 1), 64);
        }
        else if ((bid & 1) == 0 && (bid >> 3) < 20) {
            handoff_wait((unsigned*)(ws + CTL_CNT_GATE), 32u * 8u);
            att::compute_kb(ws, ((bid >> 3) - 16) * 4 + ((bid & 7) >> 1), (LAS char*)lds);
        }
    } SEAM(PH_INPROJ);
#ifdef PROBE_PHASE
    unsigned long long tA0 = __builtin_amdgcn_s_memrealtime();
#endif
    if (IN(PH_ATTN)) { att::attn_phase(a, (LAS char*)lds, vcu, G); }
#ifdef PROBE_PHASE
    if (threadIdx.x == 0) { const unsigned d = (unsigned)(__builtin_amdgcn_s_memrealtime() - tA0); atomicMax((unsigned*)(ws + WS_CTL + 24576 + 256), d); atomicMax((unsigned*)(ws + WS_CTL + 24576 + 260), 0xffffffffu - d); }
#endif
    SEAM(PH_ATTN);
    if (IN(PH_OUTPROJ)) {
        pg8::StaticOrder S; S.init(M, DM, G, bid, ws + WS_AO, ws + WS_WOUT, DM, DM);
        pg8::EpiResNorm E{a.x, (bf16_t*)(ws + WS_X1B), (const float*)(ws + WS_MOD), a.norm2_g, (bf16_t*)(ws + WS_XN), (float*)(ws + WS_SLOTS), (unsigned*)(ws + CTL_CNT_PANEL), (LAS float*)(lds + LDS_STATS)};
        pg8::gemm_phase(lds, DM, DM, DM, S, E);
    } SEAM(PH_OUTPROJ);
    if (IN(PH_UP)) {
        pg8::StaticOrder S; S.init(M, DFF, G, bid, ws + WS_XN, ws + WS_WUP, DM, DM);
        pg8::EpiUp E{(bf16_t*)(ws + WS_U), DFF};
        pg8::gemm_phase(lds, DM, DM, DM, S, E);
    } SEAM(PH_UP);
    if (IN(PH_DOWN)) {
        pg8::StaticOrder S; S.init(M, DM, G, bid, ws + WS_U, ws + WS_WDN, DFF, DFF);
        pg8::EpiRes E{(const bf16_t*)(ws + WS_X1B), a.out, (const float*)(ws + WS_MOD) + 5 * DM};
        pg8::gemm_phase(lds, DFF, DFF, DFF, S, E);
    }
    STAMP(PH_END);
#undef IN
#undef SEAM
}

#ifdef PROBE_PHASE
__global__ void probe_kernel(const unsigned long long* tsp, float* out) {
#if PROBE_PHASE == 98
    out[0] = (float)(((const unsigned*)tsp)[64]) * 1e-3f;
#elif PROBE_PHASE == 97
    out[0] = (float)(0xffffffffu - ((const unsigned*)tsp)[65]) * 1e-3f;
#elif PROBE_PHASE == 99
    out[0] = (float)(tsp[PH_END] - tsp[0]) * 5e-4f;
#else
    const unsigned long long t1 = tsp[PROBE_PHASE + 1], t0 = tsp[PROBE_PHASE]; out[0] = (float)(t1 - t0) * 1e-2f;
#endif
}
#endif
static void launch_phases(const Args& a0, int lo, int hi, int grid, hipStream_t stream) {
    Args a = a0; a.ph_lo = lo; a.ph_hi = hi; void* args[] = {&a};
    (void)args; hipLaunchKernelGGL(mega_kernel, dim3(grid), dim3(NTHR), LDS_BYTES, stream, a);
    hipError_t e = hipPeekAtLastError();
    if (e != hipSuccess) fprintf(stderr, "launch failed: %s (grid %d)\n", hipGetErrorString(e), grid);
}

extern "C" void kernel_launch(void* const* d_in, const int* in_sizes, int n_in, void* d_out, int out_size, void* d_ws, size_t ws_size, hipStream_t stream) {
    static int grid = 0;
    if (grid == 0) {
        int dev = 0, cus = 0, per_cu = 0; hipGetDevice(&dev); hipDeviceGetAttribute(&cus, hipDeviceAttributeMultiprocessorCount, dev);
        hipFuncSetAttribute((const void*)mega_kernel, hipFuncAttributeMaxDynamicSharedMemorySize, LDS_BYTES);
        hipOccupancyMaxActiveBlocksPerMultiprocessor(&per_cu, (const void*)mega_kernel, NTHR, LDS_BYTES);
        if (per_cu < 1) { fprintf(stderr, "occupancy query says %d blocks/CU\n", per_cu); per_cu = 1; }
        grid = 256;
        if (cus < 256) fprintf(stderr, "this kernel needs >= 256 CUs for a resident grid (device has %d)\n", cus);
        if (ws_size < WS_END + 24 * MiB) fprintf(stderr, "workspace too small: %zu\n", ws_size);
    }
    hipMemsetAsync((char*)d_ws + WS_CTL, 0, 49152, stream);
    Args a{};
    const float** ap = (const float**)&a;
    for (int i = 0; i < 23; ++i) ap[i] = (const float*)d_in[i];
    a.out = (float*)d_out; a.ws = (unsigned char*)d_ws;
    unsigned char* ws = a.ws;
    launch_phases(a, PH_PRO, PH_END, grid, stream);
#ifdef PROBE_PHASE
    probe_kernel<<<1, 1, 0, stream>>>((const unsigned long long*)(ws + WS_CTL + 24576), a.out);
#endif
}
```

```cpp
#include <hip/hip_runtime.h>
#include <hip/hip_cooperative_groups.h>
#include <stdint.h>
#include <math.h>
#include <cstdio>
namespace cg = cooperative_groups;
#define NF_IN 3

constexpr int DM = 2048, NB = 2, T = 4096, M = NB * T, HD = 128;
constexpr int DIN = 5664, DFF = 8192, NPAD = 5888;
constexpr int C_FQ = 0, C_FK = 1024, C_FV = 2048, C_FZ = 3072, C_NQ = 3080, C_KC = 4104, C_VC = 4360, C_KSL = 4616, C_VSL = 4872,
              C_KW = 5128, C_VW = 5384, C_GZ = 5640;
constexpr int NCMP = 255;
constexpr float SCALE = 0.08838834764831845f;
constexpr float EPS = 1e-6f;
constexpr int NWAVES = 8, NTHR = 512;

constexpr size_t MiB = 1u << 20;
constexpr size_t WS_CTL = 0;
constexpr size_t CTL_CNT_GATE = 21504;
constexpr size_t CTL_CNT_KCVC = 20480, CTL_CNT_PART = 20736, CTL_CNT_ADALN = 20992, CTL_CNT_PANEL = 32768, CTL_CNT_ATTN = 40960;
constexpr size_t WS_SLOTS = 64 * 1024;
constexpr size_t WS_MODP = 384 * 1024;
constexpr size_t WS_MOD = 2 * MiB;
constexpr size_t WS_ROPE = 3 * MiB;
constexpr size_t WS_PEBP = 5 * MiB;
constexpr size_t WS_PEB = 5 * MiB + 256 * 1024;
constexpr size_t WS_MBOUND = 5 * MiB + 300 * 1024;
constexpr size_t WS_LOGF = 5 * MiB + 320 * 1024;
constexpr size_t WS_KBIAS = 5 * MiB + 640 * 1024;
constexpr size_t WS_GATES = 6 * MiB;
constexpr size_t WS_W2T = 7 * MiB;
constexpr size_t WS_W1T = 8 * MiB;
constexpr size_t WS_WIN = 12 * MiB;
constexpr size_t WS_WOUT = 36 * MiB;
constexpr size_t WS_WUP = 44 * MiB;
constexpr size_t WS_WDN = 76 * MiB;
constexpr size_t WS_XN = 108 * MiB;
constexpr size_t WS_FQ = 140 * MiB, WS_FK = 156 * MiB, WS_FV = 172 * MiB, WS_NQ = 188 * MiB, WS_NQR = 204 * MiB;
constexpr size_t WS_KC = 220 * MiB, WS_VC = 224 * MiB, WS_KSL = 228 * MiB, WS_VSL = 232 * MiB, WS_KW = 236 * MiB, WS_VW = 240 * MiB;
constexpr size_t WS_KCMP = 244 * MiB, WS_VCMP = 244 * MiB + 512 * 1024;
constexpr size_t WS_PART = 245 * MiB;
constexpr size_t WS_NSAO = 277 * MiB;
constexpr size_t WS_X1B = WS_NSAO;
constexpr size_t WS_AO = 309 * MiB;
constexpr size_t WS_U = 140 * MiB;
constexpr size_t WS_END = 341 * MiB;
constexpr size_t WS_DEV_CUM = 341 * MiB;
constexpr size_t WS_DEV_XB = 342 * MiB;
constexpr size_t WS_DEV_HID = 358 * MiB;
constexpr size_t WS_DEV_KC = 360 * MiB;

constexpr int LDS_STATS = 131072;
constexpr int LDS_BYTES = 155648;

#define LAS __attribute__((address_space(3)))
#define GAS __attribute__((address_space(1)))
typedef unsigned short bf16_t;
typedef short bf16x8 __attribute__((ext_vector_type(8)));
typedef float f32x4 __attribute__((ext_vector_type(4)));
typedef float f32x2 __attribute__((ext_vector_type(2)));
typedef unsigned u32x4 __attribute__((ext_vector_type(4)));
typedef unsigned u32x2 __attribute__((ext_vector_type(2)));

typedef __bf16 bf16x2_t __attribute__((ext_vector_type(2)));
__device__ __forceinline__ unsigned cvt_pk_bf16(float lo, float hi) { f32x2 v = {lo, hi}; bf16x2_t b = __builtin_convertvector(v, bf16x2_t); return __builtin_bit_cast(unsigned, b); }
__device__ __forceinline__ float bf2f(bf16_t v) { return __uint_as_float(((unsigned)v) << 16); }
__device__ __forceinline__ float wave_sum(float v) {
#pragma unroll
    for (int o = 1; o < 64; o <<= 1) v += __shfl_xor(v, o);
    return v;
}
__device__ __forceinline__ float wave_max(float v) {
#pragma unroll
    for (int o = 1; o < 64; o <<= 1) v = fmaxf(v, __shfl_xor(v, o));
    return v;
}


__device__ __forceinline__ void handoff_signal(unsigned* cnt, int lane) {
    asm volatile("s_waitcnt vmcnt(0)" ::: "memory");
    if (lane == 0) __hip_atomic_fetch_add(cnt, 1u, __ATOMIC_RELAXED, __HIP_MEMORY_SCOPE_AGENT);
}
__device__ __forceinline__ void handoff_wait(unsigned* cnt, unsigned target) {
    if (threadIdx.x < 64) { unsigned sp = 0;
        while ((unsigned)__builtin_amdgcn_readfirstlane(__hip_atomic_load(cnt, __ATOMIC_RELAXED, __HIP_MEMORY_SCOPE_AGENT)) < target) { __builtin_amdgcn_s_sleep(4); if (++sp > (1u << 24)) break; }
        __builtin_amdgcn_fence(__ATOMIC_ACQUIRE, "agent"); asm volatile("s_waitcnt vmcnt(0)" ::: "memory"); }
    __syncthreads();
}

namespace pg8 {
constexpr int BM = 256, BK = 64, HALF = 128, HTB = HALF * BK * 2, STAGE_BYTES = 8 * HTB, NXCD = 8, WGM = 8;
__host__ __device__ __forceinline__ int lds_byte(int r, int c) { const int st = (r >> 4) * 2 + (c >> 5), rr = r & 15, cc = c & 31, ob = rr * 64 + cc * 2; return st * 1024 + (ob ^ (((ob >> 9) & 1) << 5)); }
__host__ __device__ __forceinline__ void stage_rc(int b, int& R, int& C) { const int st = b / 1024, sb = b % 1024, swz = sb ^ (((sb >> 9) & 1) << 5); R = (st >> 1) * 16 + swz / 64; C = (st & 1) * 32 + (swz % 64) / 2; }
__host__ __device__ __forceinline__ int perm32(int rho) { const int n = rho >> 4, i = rho & 15; return 8 * (i >> 2) + 4 * n + (i & 3); }

struct Unit { int pm, pn, aux; };
#define NF_ERN 3
#ifndef NF_IN
#define NF_IN 2
#endif

struct StaticOrder {
    int nM, nN, nwg, G, c; const char* A; const char* Bt; size_t tsA, tsB; int rm = 0;
    __device__ __forceinline__ void init(int M_, int N_, int G_, int c_, const void* A_, const void* Bt_, int lda, int ldb) { nM = M_ / BM; nN = N_ / BM; nwg = nM * nN; G = G_; c = c_; A = (const char*)A_; Bt = (const char*)Bt_; tsA = (size_t)BM * lda * 2; tsB = (size_t)BM * ldb * 2; }
    __device__ __forceinline__ bool next(int i, Unit& u) const {
        const long L = (long)i * G + c; if (L >= nwg) return false;
        int wgid = (int)L; { const int q = nwg / NXCD, r = nwg % NXCD, xcd = wgid % NXCD, off = wgid / NXCD; wgid = (xcd < r ? xcd * (q + 1) : r * (q + 1) + (xcd - r) * q) + off; }
        const int nig = WGM * nN, gid = wgid / nig, fm = gid * WGM, gsz = (nM - fm) < WGM ? (nM - fm) : WGM;
        u.pm = fm + ((wgid % nig) % gsz); u.pn = (wgid % nig) / gsz; u.aux = 0;
        if (rm) { const int p = u.pn; u.pn = (int)(((p < 12 ? 0x4a0e6734a418820ull : 0x5ab49ad507b251ull) >> (5 * (p < 12 ? p : p - 12))) & 31ull); }
        return true;
    }
    __device__ __forceinline__ void ptrs(const Unit& u, const char*& a, const char*& b) const { a = A + (size_t)u.pm * tsA; b = Bt + (size_t)u.pn * tsB; }
};

template <class Epi, class Sched>
__device__ __forceinline__ void gemm_phase(LAS unsigned char* lds, const int lda, const int ldb, const int K, const Sched& S, const Epi& E) {
    int tid = threadIdx.x; asm volatile("" : "+v"(tid));
    const int wid = __builtin_amdgcn_readfirstlane(tid >> 6), lane = tid & 63, wr = wid >> 2, wc = wid & 3, fr = lane & 15, fq = lane >> 4;
    const int nt = K / BK;
    unsigned voffA[2], voffB[2];
#pragma unroll
    for (int i = 0; i < 2; ++i) { int R, C; stage_rc(tid * 16 + i * 8192, R, C); const int Rb = Epi::PERM ? ((R & ~31) + perm32(R & 31)) : R;
        voffA[i] = (unsigned)(R * lda + C) * 2u; voffB[i] = (unsigned)(Rb * ldb + C) * 2u; }
    const size_t kstep = (size_t)(BK * 2);
    const size_t hsA = (size_t)HALF * lda * 2, hsB = (size_t)HALF * ldb * 2;
    const unsigned ldsw = (unsigned)wid * 1024u;
    const int aoff = lds_byte(wr * 64 + fr, fq * 8), boff = lds_byte(wc * 32 + fr, fq * 8);
#define PG8_SA(b, h) (((b) * 2 + (h)) * HTB)
#define PG8_SB(b, h) ((4 + (b) * 2 + (h)) * HTB)
#define PG8_STAGE(bufoff, gbase, voff) do { _Pragma("unroll") for (int _i = 0; _i < 2; ++_i) \
        __builtin_amdgcn_global_load_lds((const unsigned*)((const char*)(gbase) + (voff)[_i]), (LAS unsigned*)(lds + (bufoff) + ldsw + _i * 8192), 16, 0, 0); } while (0)
#define PG8_LDA(dst, b, h) do { _Pragma("unroll") for (int m = 0; m < 4; ++m) _Pragma("unroll") for (int k = 0; k < 2; ++k) dst[m][k] = *(const LAS bf16x8*)(lds + PG8_SA(b, h) + aoff + m * 2048 + k * 1024); } while (0)
#define PG8_LDB(dst, b, h) do { _Pragma("unroll") for (int n = 0; n < 2; ++n) _Pragma("unroll") for (int k = 0; k < 2; ++k) dst[n][k] = *(const LAS bf16x8*)(lds + PG8_SB(b, h) + boff + n * 2048 + k * 1024); } while (0)
#define PG8_MMA(ai, bj, At, Bt) do { __builtin_amdgcn_s_setprio(1); _Pragma("unroll") for (int m = 0; m < 4; ++m) _Pragma("unroll") for (int n = 0; n < 2; ++n) _Pragma("unroll") for (int k = 0; k < 2; ++k) \
        acc[ai][bj][m][n] = __builtin_amdgcn_mfma_f32_16x16x32_bf16(Bt[n][k], At[m][k], acc[ai][bj][m][n], 0, 0, 0); __builtin_amdgcn_s_setprio(0); } while (0)
#define PG8_WAIT_V(n) asm volatile("s_waitcnt vmcnt(" #n ")" ::: "memory")
#define PG8_WAIT_VX do { static_assert(Epi::NS == 0 || Epi::NS == 16, "unit-boundary wait count"); asm volatile("s_waitcnt vmcnt(24)" ::: "memory"); } while (0)
#define PG8_WAIT_L(n) asm volatile("s_waitcnt lgkmcnt(" #n ")" ::: "memory")
#define PG8_BAR __builtin_amdgcn_s_barrier()
#define PG8_SCHED __builtin_amdgcn_sched_barrier(0)
    Unit cur, nxt; int ui = 0; bool fresh = false;
    if (!S.next(0, cur)) return;
    f32x4 acc[2][2][4][2];
#pragma unroll
    for (int a = 0; a < 2; ++a)
#pragma unroll
        for (int b = 0; b < 2; ++b)
#pragma unroll
            for (int m = 0; m < 4; ++m)
#pragma unroll
                for (int n = 0; n < 2; ++n) acc[a][b][m][n] = (f32x4){0.f, 0.f, 0.f, 0.f};
    bf16x8 At[4][2], B0[2][2], B1[2][2];
    const char* cA; const char* cB; S.ptrs(cur, cA, cB);
    PG8_STAGE(PG8_SB(0, 0), cB, voffB); PG8_STAGE(PG8_SB(0, 1), cB + hsB, voffB); PG8_STAGE(PG8_SA(0, 0), cA, voffA); PG8_STAGE(PG8_SA(0, 1), cA + hsA, voffA);
    if (wr == 1) PG8_BAR;
    PG8_WAIT_V(2); PG8_BAR;
    PG8_STAGE(PG8_SB(1, 0), cB + kstep, voffB); PG8_STAGE(PG8_SA(1, 0), cA + kstep, voffA); PG8_STAGE(PG8_SB(1, 1), cB + hsB + kstep, voffB);
    PG8_WAIT_V(6); PG8_BAR;
    if constexpr (Epi::PREFETCH) E.prefetch(cur, lds + STAGE_BYTES, wid, lane);
    for (;;) {
        const bool has_next = S.next(ui + 1, nxt);
        const char* nA = cA; const char* nB = cB; if (has_next) S.ptrs(nxt, nA, nB);
#pragma nounroll
        for (int t = 0; t < nt; t += 2) {
            const bool last = (t == nt - 2);
            const char* a1 = cA + (size_t)(t + 1) * kstep;
            const char* a2 = last ? nA : cA + (size_t)(t + 2) * kstep; const char* b2 = last ? nB : cB + (size_t)(t + 2) * kstep;
            const char* a3 = a2 + kstep; const char* b3 = b2 + kstep;
            const bool fz = (Epi::NS > 0) && fresh && t == 0;
            PG8_LDB(B0, 0, 0); PG8_LDB(B1, 0, 1); PG8_SCHED; PG8_LDA(At, 0, 0); PG8_STAGE(PG8_SA(1, 1), a1 + hsA, voffA);
            if (fz) PG8_WAIT_VX; else PG8_WAIT_V(8);
            PG8_WAIT_L(0); PG8_BAR; PG8_MMA(0, 0, At, B0); PG8_MMA(0, 1, At, B1); PG8_BAR; PG8_SCHED;
            PG8_LDA(At, 0, 1); PG8_STAGE(PG8_SB(0, 0), b2, voffB); PG8_STAGE(PG8_SB(0, 1), b2 + hsB, voffB); PG8_STAGE(PG8_SA(0, 0), a2, voffA);
            if (fz) PG8_WAIT_VX; else PG8_WAIT_V(8);
            PG8_WAIT_L(0); PG8_BAR; PG8_MMA(1, 0, At, B0); PG8_MMA(1, 1, At, B1); PG8_BAR; PG8_SCHED;
            PG8_LDB(B0, 1, 0); PG8_LDB(B1, 1, 1); PG8_SCHED; PG8_LDA(At, 1, 0); PG8_STAGE(PG8_SA(0, 1), a2 + hsA, voffA);
            PG8_WAIT_V(8); PG8_WAIT_L(0); PG8_BAR; PG8_MMA(0, 0, At, B0); PG8_MMA(0, 1, At, B1); PG8_BAR; PG8_SCHED;
            PG8_LDA(At, 1, 1); PG8_STAGE(PG8_SB(1, 0), b3, voffB); PG8_STAGE(PG8_SB(1, 1), b3 + hsB, voffB); PG8_STAGE(PG8_SA(1, 0), a3, voffA);
            PG8_WAIT_V(8); PG8_WAIT_L(0); PG8_BAR; PG8_MMA(1, 0, At, B0); PG8_MMA(1, 1, At, B1); PG8_BAR; PG8_SCHED;
        }
        if (wr == 0) PG8_BAR;
        E(acc, cur, wr, wc, fr, fq);
        if (!has_next) break;
#pragma unroll
        for (int a = 0; a < 2; ++a)
#pragma unroll
            for (int b = 0; b < 2; ++b)
#pragma unroll
                for (int m = 0; m < 4; ++m)
#pragma unroll
                    for (int n = 0; n < 2; ++n) acc[a][b][m][n] = (f32x4){0.f, 0.f, 0.f, 0.f};
        cur = nxt; cA = nA; cB = nB; ++ui; fresh = true;
        if (wr == 1) PG8_BAR;
    }
    PG8_WAIT_V(0);
    PG8_BAR;
#undef PG8_SA
#undef PG8_SB
#undef PG8_STAGE
#undef PG8_LDA
#undef PG8_LDB
#undef PG8_MMA
#undef PG8_WAIT_V
#undef PG8_WAIT_VX
#undef PG8_WAIT_L
#undef PG8_BAR
#undef PG8_SCHED
}


struct EpiRes {
    static constexpr int NS = 0; static constexpr bool PERM = true, PREFETCH = false;
    const bf16_t* base; float* out; const float* gate;
    __device__ __forceinline__ void prefetch(const Unit&, LAS unsigned char*, int, int) const {}
    __device__ __forceinline__ void operator()(const f32x4 (&acc)[2][2][4][2], const Unit& u, int wr, int wc, int fr, int fq) const {
        const int row0 = u.pm * BM + wr * 64 + fr, col0 = u.pn * BM + wc * 32 + 8 * fq;
        const int b = (u.pm * BM) / T;
        f32x4 gv[2][2];
#pragma unroll
        for (int bj = 0; bj < 2; ++bj)
#pragma unroll
            for (int n = 0; n < 2; ++n) gv[bj][n] = *(const f32x4*)(gate + (size_t)b * 6 * DM + col0 + bj * HALF + 4 * n);
        u32x4 wv[2][4][2];
#pragma unroll
        for (int ai = 0; ai < 2; ++ai)
#pragma unroll
            for (int m = 0; m < 4; ++m)
#pragma unroll
                for (int bj = 0; bj < 2; ++bj) wv[ai][m][bj] = *(const u32x4*)(base + (size_t)(row0 + ai * HALF + m * 16) * DM + col0 + bj * HALF);
        asm volatile("" ::: "memory");
#pragma unroll
        for (int ai = 0; ai < 2; ++ai)
#pragma unroll
            for (int m = 0; m < 4; ++m) { const size_t off = (size_t)(row0 + ai * HALF + m * 16) * DM + col0;
#pragma unroll
                for (int bj = 0; bj < 2; ++bj) { const u32x4 w = wv[ai][m][bj];
                    const f32x4 b0 = (f32x4){__uint_as_float(w.x << 16), __uint_as_float(w.x & 0xffff0000u), __uint_as_float(w.y << 16), __uint_as_float(w.y & 0xffff0000u)};
                    const f32x4 b1 = (f32x4){__uint_as_float(w.z << 16), __uint_as_float(w.z & 0xffff0000u), __uint_as_float(w.w << 16), __uint_as_float(w.w & 0xffff0000u)};
                    *(f32x4*)(out + off + bj * HALF) = b0 + gv[bj][0] * acc[ai][bj][m][0];
                    *(f32x4*)(out + off + bj * HALF + 4) = b1 + gv[bj][1] * acc[ai][bj][m][1]; } }
    }
};

struct EpiResNorm {
    static constexpr int NS = 0; static constexpr bool PERM = true, PREFETCH = false;
    const float* base; bf16_t* out; const float* mod; const float* g2; bf16_t* XN; float* slots; unsigned* cnt; LAS float* tab;
    __device__ __forceinline__ void prefetch(const Unit& u, LAS unsigned char* dummy, int wid, int lane) const {
        const float* p = base + (size_t)(u.pm * BM + wid * 32) * DM + u.pn * BM + lane * 4;
#pragma unroll 8
        for (int r = 0; r < 32; ++r) __builtin_amdgcn_global_load_lds((const unsigned*)(p + (size_t)r * DM), (LAS unsigned*)(dummy + wid * 1024), 16, 0, 0);
    }
    __device__ __forceinline__ void operator()(f32x4 (&acc)[2][2][4][2], const Unit& u, int wr, int wc, int fr, int fq) const {
        const int row0 = u.pm * BM + wr * 64 + fr, col0 = u.pn * BM + wc * 32 + 8 * fq;
        const int b = (u.pm * BM) / T; const int wid = wr * 4 + wc, lane = fr + 16 * fq;
        const float* mb = mod + (size_t)b * 6 * DM;
        {   f32x4 gv[2][2];
#pragma unroll
            for (int bj = 0; bj < 2; ++bj)
#pragma unroll
                for (int n = 0; n < 2; ++n) gv[bj][n] = *(const f32x4*)(mb + 2 * DM + col0 + bj * HALF + 4 * n);
            f32x4 bs[NF_ERN][2][2];
#define ER_LD(g) do { const size_t off_ = (size_t)(row0 + ((g) >> 2) * HALF + ((g) & 3) * 16) * DM + col0; _Pragma("unroll") for (int bj = 0; bj < 2; ++bj) _Pragma("unroll") for (int n = 0; n < 2; ++n) \
            bs[(g) % NF_ERN][bj][n] = *(const f32x4*)(base + off_ + bj * HALF + 4 * n); } while (0)
            _Pragma("unroll") for (int g = 0; g < NF_ERN; ++g) ER_LD(g);
            asm volatile("" ::: "memory");
#pragma unroll
            for (int g = 0; g < 8; ++g) { const int ai = g >> 2, m = g & 3; float ss = 0.f;
#pragma unroll
                for (int bj = 0; bj < 2; ++bj)
#pragma unroll
                    for (int n = 0; n < 2; ++n) { const f32x4 v = bs[g % NF_ERN][bj][n] + gv[bj][n] * acc[ai][bj][m][n];
                        acc[ai][bj][m][n] = v; ss += (v[0] * v[0] + v[1] * v[1]) + (v[2] * v[2] + v[3] * v[3]); }
                if (g + NF_ERN < 8) ER_LD(g + NF_ERN);
                ss += __shfl_xor(ss, 16); ss += __shfl_xor(ss, 32);
                if (fq == 0) tab[(ai * HALF + wr * 64 + m * 16 + fr) * 4 + wc] = ss;
                asm volatile("" ::: "memory"); }
#undef ER_LD
        }
        asm volatile("s_waitcnt lgkmcnt(0)" ::: "memory"); __builtin_amdgcn_s_barrier(); asm volatile("" ::: "memory");
        const int prow = wid * 32 + (lane & 31);
        if (lane < 32) { const f32x4 q = *(const LAS f32x4*)(tab + prow * 4);
            __hip_atomic_store((unsigned*)slots + ((size_t)(u.pm * BM + prow) * 8 + u.pn), __float_as_uint((q[0] + q[1]) + (q[2] + q[3])), __ATOMIC_RELAXED, __HIP_MEMORY_SCOPE_AGENT); }
        asm volatile("s_waitcnt vmcnt(0)" ::: "memory");
        if (lane == 0) __hip_atomic_fetch_add(cnt + 64 * u.pm, 1u, __ATOMIC_RELAXED, __HIP_MEMORY_SCOPE_AGENT);
        f32x4 av[2][2], sv[2][2];
#pragma unroll
        for (int bj = 0; bj < 2; ++bj)
#pragma unroll
            for (int n = 0; n < 2; ++n) { const int c = col0 + bj * HALF + 4 * n; const f32x4 gg = *(const f32x4*)(g2 + c), sc = *(const f32x4*)(mb + 4 * DM + c);
                av[bj][n] = gg * (sc + 1.f); sv[bj][n] = *(const f32x4*)(mb + 3 * DM + c); }
        if (wid == 0) { unsigned sp = 0;
            while ((unsigned)__builtin_amdgcn_readfirstlane(__hip_atomic_load(cnt + 64 * u.pm, __ATOMIC_RELAXED, __HIP_MEMORY_SCOPE_AGENT)) < 64u) { __builtin_amdgcn_s_sleep(2); if (++sp > (1u << 22)) break; }
            __builtin_amdgcn_fence(__ATOMIC_ACQUIRE, "agent"); }
        asm volatile("s_waitcnt vmcnt(0) lgkmcnt(0)" ::: "memory"); __builtin_amdgcn_s_barrier(); asm volatile("" ::: "memory");
        if (lane < 32) { const unsigned* sl = (const unsigned*)slots + (size_t)(u.pm * BM + prow) * 8; float tot = 0.f;
#pragma unroll
            for (int t = 0; t < 8; ++t) tot += __uint_as_float(__hip_atomic_load(sl + t, __ATOMIC_RELAXED, __HIP_MEMORY_SCOPE_AGENT));
            tab[1024 + prow] = __builtin_amdgcn_rsqf(tot * (1.f / DM) + EPS); }
        asm volatile("s_waitcnt vmcnt(0) lgkmcnt(0)" ::: "memory"); __builtin_amdgcn_s_barrier(); asm volatile("" ::: "memory");
#pragma unroll
        for (int ai = 0; ai < 2; ++ai)
#pragma unroll
            for (int m = 0; m < 4; ++m) { const int rl = ai * HALF + wr * 64 + m * 16 + fr; const float rstd = tab[1024 + rl]; const size_t off = (size_t)(u.pm * BM + rl) * DM + col0;
#pragma unroll
                for (int bj = 0; bj < 2; ++bj) {
                    { const f32x4 x0 = acc[ai][bj][m][0], x1 = acc[ai][bj][m][1]; u32x4 xw; xw.x = cvt_pk_bf16(x0[0], x0[1]); xw.y = cvt_pk_bf16(x0[2], x0[3]); xw.z = cvt_pk_bf16(x1[0], x1[1]); xw.w = cvt_pk_bf16(x1[2], x1[3]);
                      *(u32x4*)(out + off + bj * HALF) = xw; }
                    const f32x4 h0 = acc[ai][bj][m][0] * rstd * av[bj][0] + sv[bj][0], h1 = acc[ai][bj][m][1] * rstd * av[bj][1] + sv[bj][1];
                    u32x4 w; w.x = cvt_pk_bf16(h0[0], h0[1]); w.y = cvt_pk_bf16(h0[2], h0[3]); w.z = cvt_pk_bf16(h1[0], h1[1]); w.w = cvt_pk_bf16(h1[2], h1[3]);
                    *(u32x4*)(XN + off + bj * HALF) = w; }
                asm volatile("" ::: "memory"); }
    }
};
struct EpiUp {
    static constexpr int NS = 16;   static constexpr bool PERM = true, PREFETCH = false;
    bf16_t* O; int ldc;
    __device__ __forceinline__ void operator()(const f32x4 (&acc)[2][2][4][2], const Unit& u, int wr, int wc, int fr, int fq) const {
        const int row0 = u.pm * BM + wr * 64 + fr, col0 = u.pn * BM + wc * 32 + 8 * fq;
#pragma unroll
        for (int ai = 0; ai < 2; ++ai)
#pragma unroll
            for (int m = 0; m < 4; ++m) { bf16_t* rowp = O + (size_t)(row0 + ai * HALF + m * 16) * ldc + col0;
#pragma unroll
                for (int bj = 0; bj < 2; ++bj) { f32x4 v0 = acc[ai][bj][m][0], v1 = acc[ai][bj][m][1];
                    v0 = __builtin_elementwise_max(v0, (f32x4){0.f, 0.f, 0.f, 0.f}); v1 = __builtin_elementwise_max(v1, (f32x4){0.f, 0.f, 0.f, 0.f}); v0 = v0 * v0; v1 = v1 * v1;
                    u32x4 w; w.x = cvt_pk_bf16(v0[0], v0[1]); w.y = cvt_pk_bf16(v0[2], v0[3]); w.z = cvt_pk_bf16(v1[0], v1[1]); w.w = cvt_pk_bf16(v1[2], v1[3]);
                    *(u32x4*)(rowp + bj * HALF) = w; } }
    }
};
struct EpiIn {
    static constexpr int NS = 0; static constexpr bool PERM = true, PREFETCH = false;
    unsigned char* wsb;
    const float *g_fq, *g_fk, *g_nq, *g_slc, *g_win, *b_forget; LAS float* stats; unsigned* kcvc_cnt; unsigned* gate_cnt;
    __device__ __forceinline__ void operator()(const f32x4 (&acc)[2][2][4][2], const Unit& u, int wr, int wc, int fr, int fq) const {
        const int pn = u.pn;
        unsigned char* w_ = wsb; asm volatile("" : "+s"(w_));
        GAS bf16_t* const FQ = (GAS bf16_t*)(w_ + WS_FQ); GAS bf16_t* const FK = (GAS bf16_t*)(w_ + WS_FK); GAS bf16_t* const FV = (GAS bf16_t*)(w_ + WS_FV); GAS bf16_t* const NQ = (GAS bf16_t*)(w_ + WS_NQ); GAS bf16_t* const NQR = (GAS bf16_t*)(w_ + WS_NQR);
        GAS bf16_t* const KC = (GAS bf16_t*)(w_ + WS_KC); GAS bf16_t* const VC = (GAS bf16_t*)(w_ + WS_VC); GAS bf16_t* const KSL = (GAS bf16_t*)(w_ + WS_KSL); GAS bf16_t* const VSL = (GAS bf16_t*)(w_ + WS_VSL); GAS bf16_t* const KW = (GAS bf16_t*)(w_ + WS_KW); GAS bf16_t* const VW = (GAS bf16_t*)(w_ + WS_VW);
        GAS float* const LOGF = (GAS float*)(w_ + WS_LOGF); GAS float* const GATES = (GAS float*)(w_ + WS_GATES); const GAS float* const rope = (const GAS float*)(w_ + WS_ROPE);
        const int b = u.pm >> 4, t0 = (u.pm & 15) * BM + wr * 64 + fr;
        if (pn == 12) {
            if (wc == 0) {
#pragma unroll
                for (int ai = 0; ai < 2; ++ai)
#pragma unroll
                    for (int m = 0; m < 4; ++m) { const int t = t0 + ai * HALF + m * 16;
#pragma unroll
                        for (int n = 0; n < 2; ++n)
#pragma unroll
                            for (int e = 0; e < 4; ++e) { const int p = 8 * fq + 4 * n + e; const float v = acc[ai][0][m][n][e];
                                if (p < 8) { const float z = v + b_forget[p]; __hip_atomic_store((GAS unsigned*)(LOGF + ((size_t)b * 8 + p) * T + t), __float_as_uint(fminf(z, 0.f) - __logf(1.f + __expf(-fabsf(z)))), __ATOMIC_RELAXED, __HIP_MEMORY_SCOPE_AGENT); }
                                else { GATES[((size_t)b * T + t) * 24 + (p - 8)] = 1.f / (1.f + __expf(-v)); } } }
            }
            handoff_signal(gate_cnt, fr + 16 * fq);
            return;
        }
        if (pn < 4) body<true, true, false, false>(acc, u, wr, wc, fr, fq, FQ, nullptr, g_fq, rope, 8, 2 * pn);
        else if (pn < 8) body<true, true, false, false>(acc, u, wr, wc, fr, fq, FK, nullptr, g_fk, rope, 8, 2 * (pn - 4));
        else if (pn < 12) body<false, true, false, false>(acc, u, wr, wc, fr, fq, FV, nullptr, nullptr, rope, 8, 2 * (pn - 8));
        else if (pn < 17) body<true, true, true, false>(acc, u, wr, wc, fr, fq, NQ, NQR, g_nq, rope, 8, 2 * (pn - 13));
        else if (pn < 19) body<false, true, false, true>(acc, u, wr, wc, fr, fq, pn == 17 ? KC : VC, nullptr, nullptr, rope, 2, 0);
        else if (pn < 21) body<true, false, true, false>(acc, u, wr, wc, fr, fq, nullptr, pn == 19 ? KSL : KW, pn == 19 ? g_slc : g_win, rope, 2, 0);
        else body<false, true, false, false>(acc, u, wr, wc, fr, fq, pn == 21 ? VSL : VW, nullptr, nullptr, rope, 2, 0);
    }
    template <bool NORM, bool D1, bool D2, bool WT>
    __device__ __forceinline__ void body(const f32x4 (&acc)[2][2][4][2], const Unit& u, int wr, int wc, int fr, int fq, GAS bf16_t* d1, GAS bf16_t* d2, const float* gain, const GAS float* rope, int nh, int h0) const {
        const int b = u.pm >> 4, t0 = (u.pm & 15) * BM + wr * 64 + fr;
        const int dlo = 16 * wc + 4 * fq;
        f32x4 g0 = (f32x4){1.f, 1.f, 1.f, 1.f}, g1 = g0;
        if (NORM) { g0 = *(const f32x4*)(gain + dlo); g1 = *(const f32x4*)(gain + 64 + dlo); }
        f32x4 cs[NF_IN][2];
#define EI_LD(g) do { const int tn_ = t0 + ((g) >> 2) * HALF + ((g) & 3) * 16; const GAS float* rp_ = rope + ((size_t)tn_ * 64 + dlo) * 2; cs[(g) % NF_IN][0] = *(const GAS f32x4*)rp_; cs[(g) % NF_IN][1] = *(const GAS f32x4*)(rp_ + 4); } while (0)
        if (D2) { _Pragma("unroll") for (int g = 0; g < NF_IN; ++g) EI_LD(g); }
        if (NORM) {
#pragma unroll
            for (int ai = 0; ai < 2; ++ai)
#pragma unroll
                for (int m = 0; m < 4; ++m)
#pragma unroll
                    for (int bj = 0; bj < 2; ++bj) { const f32x4 a = acc[ai][bj][m][0], c = acc[ai][bj][m][1];
                        float s = (a[0] * a[0] + a[1] * a[1]) + (a[2] * a[2] + a[3] * a[3]) + (c[0] * c[0] + c[1] * c[1]) + (c[2] * c[2] + c[3] * c[3]);
                        { const unsigned x = __float_as_uint(s); const auto r = __builtin_amdgcn_permlane32_swap(x, x, false, false); s = __uint_as_float(r[0]) + __uint_as_float(r[1]); }
                        { const unsigned x = __float_as_uint(s); const auto r = __builtin_amdgcn_permlane16_swap(x, x, false, false); s = __uint_as_float(r[0]) + __uint_as_float(r[1]); }
                        if (fq == 0) stats[(ai * HALF + wr * 64 + m * 16 + fr) * 8 + bj * 4 + wc] = s; }
            asm volatile("s_waitcnt lgkmcnt(0)" ::: "memory"); __builtin_amdgcn_s_barrier(); asm volatile("" ::: "memory");
        }
#pragma unroll
        for (int g = 0; g < 8; ++g) { const int ai = g >> 2, m = g & 3; const int t = t0 + ai * HALF + m * 16;
            float rsv[2] = {1.f, 1.f};
            if (NORM) {
#pragma unroll
                for (int bj = 0; bj < 2; ++bj) { const f32x4 q = *(const LAS f32x4*)(stats + (ai * HALF + wr * 64 + m * 16 + fr) * 8 + bj * 4);
                    rsv[bj] = __builtin_amdgcn_rsqf(((q[0] + q[1]) + (q[2] + q[3])) * (1.f / 128.f) + EPS); } }
            f32x4 c = g0, sn = g0;
            if (D2) { c = (f32x4){cs[g % NF_IN][0][0], cs[g % NF_IN][0][2], cs[g % NF_IN][1][0], cs[g % NF_IN][1][2]}; sn = (f32x4){cs[g % NF_IN][0][1], cs[g % NF_IN][0][3], cs[g % NF_IN][1][1], cs[g % NF_IN][1][3]}; }
            if (D2 && g + NF_IN < 8) EI_LD(g + NF_IN);
#pragma unroll
            for (int bj = 0; bj < 2; ++bj) { f32x4 v0 = acc[ai][bj][m][0], v1 = acc[ai][bj][m][1];
                if (NORM) { const float r = rsv[bj]; v0 = v0 * r * g0; v1 = v1 * r * g1; }
                const size_t off = (((size_t)b * nh + h0 + bj) * T + t) * 128 + dlo;
                if (D1) { u32x2 w0, w1; w0.x = cvt_pk_bf16(v0[0], v0[1]); w0.y = cvt_pk_bf16(v0[2], v0[3]); w1.x = cvt_pk_bf16(v1[0], v1[1]); w1.y = cvt_pk_bf16(v1[2], v1[3]);
                    if (WT) { __hip_atomic_store((GAS unsigned long long*)(d1 + off), ((unsigned long long)w0.y << 32) | w0.x, __ATOMIC_RELAXED, __HIP_MEMORY_SCOPE_AGENT);
                        __hip_atomic_store((GAS unsigned long long*)(d1 + off + 64), ((unsigned long long)w1.y << 32) | w1.x, __ATOMIC_RELAXED, __HIP_MEMORY_SCOPE_AGENT); }
                    else { *(GAS u32x2*)(d1 + off) = w0; *(GAS u32x2*)(d1 + off + 64) = w1; } }
                if (D2) { const f32x4 r0 = v0 * c - v1 * sn, r1 = v1 * c + v0 * sn;
                    u32x2 w0, w1; w0.x = cvt_pk_bf16(r0[0], r0[1]); w0.y = cvt_pk_bf16(r0[2], r0[3]); w1.x = cvt_pk_bf16(r1[0], r1[1]); w1.y = cvt_pk_bf16(r1[2], r1[3]);
                    *(GAS u32x2*)(d2 + off) = w0; *(GAS u32x2*)(d2 + off + 64) = w1; } }
            asm volatile("" ::: "memory"); }
#undef EI_LD
        if (WT) handoff_signal(kcvc_cnt, fr + 16 * fq);
    }
};

struct EpiPart {
    static constexpr int NS = 0; static constexpr bool PERM = true, PREFETCH = false;
    float* P; unsigned* done_cnt;
    __device__ __forceinline__ void operator()(const f32x4 (&acc)[2][2][4][2], const Unit& u, int wr, int wc, int fr, int fq) const {
        const __amdgpu_buffer_rsrc_t rsrc = __builtin_amdgcn_make_buffer_rsrc(P, 0, 128 * 65536 * 4, 0x00020000);
        const unsigned base = ((unsigned)u.aux * 65536u + (unsigned)(wr * 64 + fr) * 256u + (unsigned)(wc * 32 + 8 * fq)) * 4u;
#pragma unroll
        for (int ai = 0; ai < 2; ++ai)
#pragma unroll
            for (int m = 0; m < 4; ++m) { const unsigned rp = base + (unsigned)(ai * HALF + m * 16) * 1024u;
#pragma unroll
                for (int bj = 0; bj < 2; ++bj)
#pragma unroll
                    for (int n = 0; n < 2; ++n) __builtin_amdgcn_raw_buffer_store_b128(__builtin_bit_cast(u32x4, acc[ai][bj][m][n]), rsrc, rp + (unsigned)(bj * HALF + 4 * n) * 4u, 0, 16);
                asm volatile("" ::: "memory"); }
        handoff_signal(done_cnt, fr + 16 * fq);
    }
};
struct CmpOrder {
    int G, c; const char* KC; const char* VC; const char* W1T;
    __device__ __forceinline__ bool next(int i, Unit& u) const { const int L = i * G + c; if (L >= 32) return false; u.pm = 0; u.pn = 0; u.aux = L; return true; }
    __device__ __forceinline__ void ptrs(const Unit& u, const char*& a, const char*& b) const { const int L = u.aux, kv = L >> 4, bg = (L >> 2) & 3, ks = L & 3;
        a = (kv ? VC : KC) + ((size_t)bg * T * 128 + ks * 1024) * 2; b = W1T + ((size_t)kv * 256 * 4096 + ks * 1024) * 2; }
};
}


struct Args {
    const float *x, *c, *w_ada, *b_ada, *norm1_g, *w_in, *b_forget, *fox_q_norm, *fox_k_norm, *nsa_q_norm, *cmp_k_norm, *slc_k_norm, *win_k_norm,
        *cmp_pe_k, *cmp_w1_k, *cmp_w2_k, *cmp_pe_v, *cmp_w1_v, *cmp_w2_v, *w_out, *norm2_g, *w_up, *w_down;
    float* out; unsigned char* ws; int ph_lo, ph_hi;
};

#ifndef DEV_ATT
#define DEV_ATT 3
#endif
namespace att {
typedef float f32x16 __attribute__((ext_vector_type(16)));
typedef short s16x4 __attribute__((ext_vector_type(4)));
constexpr int NW = 8, QBLK = 32, KVBLK = 64, D = 128;
constexpr int SHM_V = KVBLK * D * 2, SHM_K = KVBLK * D * 2;
constexpr int L_V = 0, L_K = 2 * SHM_V, L_WS = 2 * SHM_V + 2 * SHM_K, L_Q = L_WS + 2048;
constexpr int LC_V = 0, LC_K = 65536, LC_WS = 131072, LC_IMP = 133120;
constexpr int L_KB = 133120;
constexpr int L_SEL = 149504;
constexpr float THR = 8.f;
constexpr float C2 = 1.4426950408889634f * SCALE;
enum { M_FOX = 0, M_WIN = 1, M_SLC = 2 };
#define KSWZ(row, colB) ((row) * 256 + ((colB) ^ (((row) & 7) << 4)))
#define SBAR() __builtin_amdgcn_sched_barrier(0)
__device__ __forceinline__ int v_st(int k, int c) { const int kk = (k & ~0xC) | ((k & 4) << 1) | ((k & 8) >> 1); return ((kk >> 3) * 4 + (c >> 5)) * 512 + ((kk & 7) * 32 + (c & 31)) * 2; }
__device__ __forceinline__ int v_rd_base(int lane) { return ((lane & 3) << 3) | (((lane >> 2) & 3) << 6) | (((lane >> 4) & 1) << 5) | (((lane >> 5) & 1) << 8); }
constexpr int v_rd_off(int d0, int ks, int half) { return d0 * 512 + ks * 4096 + half * 2048; }
__device__ __forceinline__ int crow(int r, int hi) { return (r & 3) + 8 * (r >> 2) + 4 * hi; }
__device__ __forceinline__ bf16x8 load8(const bf16_t* p) { return *(const GAS bf16x8*)p; }
__device__ __forceinline__ void mask_tile(f32x16& p0, f32x16& p1, int dq, unsigned W) {
    const float NEG = -__builtin_inff();
#pragma unroll
    for (int r = 0; r < 16; ++r) { const int c = (r & 3) + 8 * (r >> 2);
        if ((unsigned)(dq - c) >= W) p0[r] = NEG;
        if ((unsigned)(dq - c - 32) >= W) p1[r] = NEG; }
}
__device__ __forceinline__ void partialSM(f32x16& p0, f32x16& p1, float& m_reg, float& mn, float& alpha) {
    float pmax = p0[0];
#pragma unroll
    for (int r = 1; r < 16; ++r) pmax = fmaxf(pmax, p0[r]);
#pragma unroll
    for (int r = 0; r < 16; ++r) pmax = fmaxf(pmax, p1[r]);
    { auto rr = __builtin_amdgcn_permlane32_swap(__float_as_uint(pmax), __float_as_uint(pmax), false, false);
      pmax = fmaxf(__uint_as_float(rr[0]), __uint_as_float(rr[1])); }
    if (__builtin_expect(__all((pmax - m_reg) * SCALE <= THR), 1)) { mn = m_reg; alpha = 1.f; }
    else { mn = fmaxf(m_reg, pmax); alpha = __builtin_amdgcn_exp2f((m_reg - mn) * C2); m_reg = mn; }
    const float mnL = -mn * C2;
#pragma unroll
    for (int r = 0; r < 16; ++r) p0[r] = fmaf(p0[r], C2, mnL);
#pragma unroll
    for (int r = 0; r < 16; ++r) p1[r] = fmaf(p1[r], C2, mnL);
#pragma unroll
    for (int r = 0; r < 16; ++r) p0[r] = __builtin_amdgcn_exp2f(p0[r]);
}
#define PK4(P, B_, OUT) do { unsigned a0 = cvt_pk_bf16(P[B_+0], P[B_+1]), a1 = cvt_pk_bf16(P[B_+2], P[B_+3]);                          \
        unsigned b0 = cvt_pk_bf16(P[B_+4], P[B_+5]), b1 = cvt_pk_bf16(P[B_+6], P[B_+7]);                                             \
        auto r0 = __builtin_amdgcn_permlane32_swap(a0, b0, false, false); auto r1 = __builtin_amdgcn_permlane32_swap(a1, b1, false, false); \
        u32x4 w = {r0[0], r1[0], r0[1], r1[1]}; OUT = *reinterpret_cast<bf16x8*>(&w); } while (0)
__device__ __forceinline__ void finishSM(f32x16& p0, f32x16& p1, float alpha, float& l_reg, bf16x8& pa0, bf16x8& pa1, bf16x8& pa2, bf16x8& pa3, bool on = true) {
#pragma unroll
    for (int r = 0; r < 16; ++r) p1[r] = __builtin_amdgcn_exp2f(p1[r]);
    float ps = 0;
#pragma unroll
    for (int r = 0; r < 16; ++r) ps += p0[r];
#pragma unroll
    for (int r = 0; r < 16; ++r) ps += p1[r];
    { auto rr = __builtin_amdgcn_permlane32_swap(__float_as_uint(ps), __float_as_uint(ps), false, false);
      ps = __uint_as_float(rr[0]) + __uint_as_float(rr[1]); }
    l_reg = l_reg * alpha + (on ? ps : 0.f);
    PK4(p0, 0, pa0); PK4(p0, 8, pa1); PK4(p1, 0, pa2); PK4(p1, 8, pa3);
    if (!on) { const bf16x8 z = {0, 0, 0, 0, 0, 0, 0, 0}; pa0 = z; pa1 = z; pa2 = z; pa3 = z; }
}
template <int KB>
__device__ __forceinline__ void qkt(f32x16& p0, f32x16& p1, const LAS char* K_lds, int r32, int hi, const LAS char* qs) {
    const LAS char* kb[4];
#pragma unroll
    for (int dd = 0; dd < 4; ++dd) kb[dd] = K_lds + KB * SHM_K + KSWZ(r32, (dd * 16 + hi * 8) * 2);
#pragma unroll
    for (int d0 = 0; d0 < 8; ++d0) { const LAS char* a = kb[d0 & 3] + (d0 >> 2) * 128;
        const bf16x8 q = *reinterpret_cast<const LAS bf16x8*>(qs + d0 * 1024);
        bf16x8 b0 = *reinterpret_cast<const LAS bf16x8*>(a);
        bf16x8 b1 = *reinterpret_cast<const LAS bf16x8*>(a + 32 * 256);
        p0 = __builtin_amdgcn_mfma_f32_32x32x16_bf16(b0, q, p0, 0, 0, 0);
        p1 = __builtin_amdgcn_mfma_f32_32x32x16_bf16(b1, q, p1, 0, 0, 0); }
}
template <int KB>
__device__ __forceinline__ void qkt_r(f32x16& p0, f32x16& p1, const LAS char* K_lds, int r32, int hi, const bf16x8* qr) {
    const LAS char* kb[4];
#pragma unroll
    for (int dd = 0; dd < 4; ++dd) kb[dd] = K_lds + KB * SHM_K + KSWZ(r32, (dd * 16 + hi * 8) * 2);
#pragma unroll
    for (int d0 = 0; d0 < 8; ++d0) { const LAS char* a = kb[d0 & 3] + (d0 >> 2) * 128;
        bf16x8 b0 = *reinterpret_cast<const LAS bf16x8*>(a);
        bf16x8 b1 = *reinterpret_cast<const LAS bf16x8*>(a + 32 * 256);
        p0 = __builtin_amdgcn_mfma_f32_32x32x16_bf16(b0, qr[d0], p0, 0, 0, 0);
        p1 = __builtin_amdgcn_mfma_f32_32x32x16_bf16(b1, qr[d0], p1, 0, 0, 0); }
}
template <int VB>
__device__ __forceinline__ void pv_tile(f32x16* o, int vb0, bf16x8 pa0, bf16x8 pa1, bf16x8 pa2, bf16x8 pa3) {
#define TRRD(dst, off) asm volatile("ds_read_b64_tr_b16 %0, %1 offset:%2" : "=&v"(dst) : "v"(vb0), "i"(off) : "memory")
#define PV_D0(d0) do { s16x4 l0, l1, l2, l3, h0, h1, h2, h3; constexpr int b_ = VB * SHM_V + v_rd_off(d0, 0, 0); \
        TRRD(l0, b_); TRRD(h0, b_ + 2048); TRRD(l1, b_ + 4096); TRRD(h1, b_ + 6144); TRRD(l2, b_ + 8192); TRRD(h2, b_ + 10240); TRRD(l3, b_ + 12288); TRRD(h3, b_ + 14336); \
        asm volatile("s_waitcnt lgkmcnt(0)" ::: "memory"); SBAR(); \
        o[d0] = __builtin_amdgcn_mfma_f32_32x32x16_bf16(pa0, (bf16x8){l0[0], l0[1], l0[2], l0[3], h0[0], h0[1], h0[2], h0[3]}, o[d0], 0, 0, 0);   \
        o[d0] = __builtin_amdgcn_mfma_f32_32x32x16_bf16(pa1, (bf16x8){l1[0], l1[1], l1[2], l1[3], h1[0], h1[1], h1[2], h1[3]}, o[d0], 0, 0, 0);   \
        o[d0] = __builtin_amdgcn_mfma_f32_32x32x16_bf16(pa2, (bf16x8){l2[0], l2[1], l2[2], l2[3], h2[0], h2[1], h2[2], h2[3]}, o[d0], 0, 0, 0);   \
        o[d0] = __builtin_amdgcn_mfma_f32_32x32x16_bf16(pa3, (bf16x8){l3[0], l3[1], l3[2], l3[3], h3[0], h3[1], h3[2], h3[3]}, o[d0], 0, 0, 0); } while (0)
    PV_D0(0); PV_D0(1); PV_D0(2); PV_D0(3);
#undef PV_D0
#undef TRRD
}

struct Blk {
    const bf16_t* Q;
    const bf16_t* K; const bf16_t* V;
    const float* KB;
    int mode, P0, j_lo, j_hi, b, hb;
};
struct Seam { bf16x8 st_v0, st_v1, st_k0, st_k1; };
__device__ __forceinline__ int q_lane_off(int mode, int wid, int r32) { return mode == M_FOX ? (wid * 32 + r32) * 128 : ((r32 >> 3) * T + wid * 8 + (r32 & 7)) * 128; }
#define ROW(p, k0, rr) ((p) + (size_t)((k0) + (rr)) * D + sc)
#define VMW() asm volatile("s_waitcnt vmcnt(0)" ::: "memory")
#define VMWN(n) asm volatile("s_waitcnt vmcnt(%0)" :: "i"(n) : "memory")
#define SLOAD_H(Kp, Vp, k0) do { S.st_v0 = load8(ROW(Vp, k0, sr)); S.st_v1 = load8(ROW(Vp, k0, 32 + sr)); S.st_k0 = load8(ROW(Kp, k0, sr)); S.st_k1 = load8(ROW(Kp, k0, 32 + sr)); } while (0)
#define SWRITE_HK(bf) do { *(LAS bf16x8*)(K_lds + (bf) * SHM_K + kws) = S.st_k0; *(LAS bf16x8*)(K_lds + (bf) * SHM_K + kws + 32 * 256) = S.st_k1; } while (0)
#define SWRITE_HV(bf) do { *(LAS bf16x8*)(V_lds + (bf) * SHM_V + vst0) = S.st_v0; *(LAS bf16x8*)(V_lds + (bf) * SHM_V + vst1) = S.st_v1; } while (0)
#define SWRITE_H(bf) do { SWRITE_HV(bf); SWRITE_HK(bf); } while (0)
__device__ __forceinline__ void attn_prime(const Blk& cur, LAS char* lds, Seam& S) {
    const int tid = threadIdx.x;
    const int sr = tid >> 4, sc = (tid & 15) * 8, kws = KSWZ(sr, sc * 2); LAS char* K_lds = lds + L_K;
    const int kb0 = cur.j_lo * KVBLK;
    SLOAD_H(cur.K, cur.V, kb0); VMW(); SWRITE_HK(0);
    __syncthreads();
}
struct EpiCtx { bf16_t* AO; float* NSAO; const float* GATES; unsigned* panel_cnt; };
__device__ __forceinline__ void attn_block(const Blk& cur, const Blk& nxt, LAS char* lds, Seam& S, const EpiCtx& ec) {
    int tid = threadIdx.x; asm volatile("" : "+v"(tid));
    const int wid = __builtin_amdgcn_readfirstlane(tid >> 6), lane = tid & 63, r32 = lane & 31, hi = lane >> 5;
    const int mode = cur.mode;
    const int j_lo = cur.j_lo, NT = cur.j_hi - cur.j_lo;
    const int kbn = nxt.j_lo * KVBLK;
    const bool fox = mode == M_FOX;
    const int wlo = cur.P0 + (fox ? wid * 32 : wid * 8), whi = wlo + (fox ? 31 : 7);
    const int pos = cur.P0 + (fox ? wid * 32 + r32 : wid * 8 + (r32 & 7)), qm = pos - 4 * hi;
    const unsigned Wu = (mode == M_WIN) ? 512u : (1u << 30);
    LAS char* V_lds = lds + L_V; LAS char* K_lds = lds + L_K;
    LAS float* ws = (LAS float*)(lds + L_WS) + wid * 64; LAS float* li_l = ws; LAS float* al_l = ws + 32;
    float m_reg = -1e30f, l_reg = 0; f32x16 o[4] = {};
    const int sr = tid >> 4, sc = (tid & 15) * 8, vst0 = v_st(sr, sc), vst1 = v_st(32 + sr, sc), kws = KSWZ(sr, sc * 2);
    const int vb0 = (int)(unsigned)(uintptr_t)V_lds + v_rd_base(lane);
    const bf16_t* Kh = cur.K; const bf16_t* Vh = cur.V;
    unsigned long long sel = ~0ull;
    if (mode == M_SLC) sel = *(const LAS unsigned long long*)(lds + L_SEL + (wid * 8 + (r32 & 7)) * 8);
#define RESC(a_) do { if (__any((a_) < 1.f)) { if (hi == 0) al_l[r32] = (a_); asm volatile("s_waitcnt lgkmcnt(0)" ::: "memory");              \
                     _Pragma("unroll") for (int d_ = 0; d_ < 4; ++d_) _Pragma("unroll") for (int r = 0; r < 16; ++r) o[d_][r] *= al_l[crow(r, hi)]; } } while (0)
#define KBASE(t) ((j_lo + (t)) * KVBLK)
#define PRELOAD(P0_, P1_, t) do { if (fox) { const LAS float* kbp_ = (const LAS float*)(lds + L_KB) + KBASE(t) + 4 * hi; \
            _Pragma("unroll") for (int q_ = 0; q_ < 4; ++q_) { const f32x4 a_ = *(const LAS f32x4*)(kbp_ + 8 * q_), b_ = *(const LAS f32x4*)(kbp_ + 32 + 8 * q_); \
                P0_[4*q_] = a_[0]; P0_[4*q_+1] = a_[1]; P0_[4*q_+2] = a_[2]; P0_[4*q_+3] = a_[3]; P1_[4*q_] = b_[0]; P1_[4*q_+1] = b_[1]; P1_[4*q_+2] = b_[2]; P1_[4*q_+3] = b_[3]; } } \
        else { P0_ = f32x16{}; P1_ = f32x16{}; } } while (0)
#define MASKT(P0_, P1_, t) do { const int kb_ = KBASE(t); \
        if (kb_ + KVBLK - 1 > wlo || kb_ + (int)Wu <= whi) mask_tile(P0_, P1_, qm - kb_, Wu); } while (0)
#define ONT(t) (mode != M_SLC || ((sel >> (j_lo + (t))) & 1ull) != 0ull)
    if (wid >= 4) __builtin_amdgcn_s_setprio(1);
    f32x16 pA0, pA1, pB0, pB1; float mnA, mnB, alA, alB; bf16x8 pa0, pa1, pa2, pa3;
    LAS char* qs = lds + L_Q + wid * 8192 + lane * 16;
    if (mode != M_SLC)
    { const bf16_t* qp = cur.Q + q_lane_off(mode, wid, r32) + hi * 8; bf16x8 tq[8];
#pragma unroll
      for (int d0 = 0; d0 < 8; ++d0) tq[d0] = load8(qp + d0 * 16);
#pragma unroll
      for (int d0 = 0; d0 < 8; ++d0) *(LAS bf16x8*)(qs + d0 * 1024) = tq[d0]; }
    PRELOAD(pA0, pA1, 0);
    SWRITE_HV(0); SBAR();
    if (NT > 1) SLOAD_H(Kh, Vh, KBASE(1));
    SBAR(); qkt<0>(pA0, pA1, K_lds, r32, hi, qs);
    if (NT > 1) PRELOAD(pB0, pB1, 1); else { pB0 = f32x16{}; pB1 = f32x16{}; }
    MASKT(pA0, pA1, 0); partialSM(pA0, pA1, m_reg, mnA, alA);
    if (NT > 1) { VMW(); SWRITE_H(1); }
    __syncthreads();
#define HALF_STEP(PX0, PX1, mnX, alX, PY0, PY1, alY, t, KB_, VB_, SB_) do {                                                      \
        SBAR(); if ((t) + 1 < NT) { SLOAD_H(Kh, Vh, KBASE((t) + 1)); SBAR(); }         \
        qkt<KB_>(PX0, PX1, K_lds, r32, hi, qs);                                             \
        finishSM(PY0, PY1, alY, l_reg, pa0, pa1, pa2, pa3, ONT((t) - 1)); SBAR();                                                           \
        if ((t) + 1 < NT) { PRELOAD(PY0, PY1, (t) + 1); SBAR(); }                                               \
        pv_tile<VB_>(o, vb0, pa0, pa1, pa2, pa3); MASKT(PX0, PX1, (t)); partialSM(PX0, PX1, m_reg, mnX, alX);                                        \
        __syncthreads();                                                                                                      \
        if ((t) + 1 < NT) { VMW(); SWRITE_H(SB_); }                                                                          \
        RESC(alX); __syncthreads(); } while (0)
    for (int t = 1; t + 1 < NT; t += 2) {
        HALF_STEP(pB0, pB1, mnB, alB, pA0, pA1, alA, t, 1, 0, 0);
        HALF_STEP(pA0, pA1, mnA, alA, pB0, pB1, alB, t + 1, 0, 1, 1);
    }
    const bool even = (NT & 1) == 0;
    if (even) { SBAR(); qkt<1>(pB0, pB1, K_lds, r32, hi, qs); SBAR(); }
    SLOAD_H(nxt.K, nxt.V, kbn); SBAR();
    SBAR();
    finishSM(pA0, pA1, alA, l_reg, pa0, pa1, pa2, pa3, ONT(even ? NT - 2 : NT - 1)); SBAR();
    pv_tile<0>(o, vb0, pa0, pa1, pa2, pa3);
    if (even) { MASKT(pB0, pB1, NT - 1); partialSM(pB0, pB1, m_reg, mnB, alB); __syncthreads(); RESC(alB);
        finishSM(pB0, pB1, alB, l_reg, pa0, pa1, pa2, pa3, ONT(NT - 1)); SBAR(); pv_tile<1>(o, vb0, pa0, pa1, pa2, pa3); }
    SBAR(); VMW(); SWRITE_HK(0); SBAR();
    if (hi == 0) li_l[r32] = l_reg; asm volatile("s_waitcnt lgkmcnt(0)" ::: "memory");
    if (fox) {
        bf16_t* Ow = ec.AO + ((size_t)cur.b * T + cur.P0 + wid * QBLK) * DM + cur.hb * 128;
#pragma unroll
        for (int r = 0; r < 16; ++r) { const int orow = crow(r, hi); const float li = li_l[orow]; const float rl = li > 0.f ? __builtin_amdgcn_rcpf(li) : 0.f;
#pragma unroll
            for (int d0 = 0; d0 < 4; ++d0) { const float v = o[d0][r] * rl; const float vn = __shfl_xor(v, 1);
                if ((r32 & 1) == 0) *(GAS unsigned*)(Ow + (size_t)orow * DM + d0 * 32 + r32) = cvt_pk_bf16(v, vn); } }
    } else {
        const int br = (mode == M_WIN) ? 2 : 1;
        const size_t pvb = ((((size_t)((cur.b * 2 + (cur.hb >> 2)) * 64 + (cur.P0 >> 6)) * 8 + wid) * 16) * 64 + lane) * 4;
#pragma unroll
        for (int h8 = 0; h8 < 2; ++h8) {
            float gv[8]; float av[8][4], bv[8][4];
#pragma unroll
            for (int q = 0; q < 8; ++q) { const int rho = crow(h8 * 8 + q, hi);
                const int tok = cur.P0 + wid * 8 + (rho & 7), head = cur.hb + (rho >> 3); const size_t trow = (size_t)cur.b * T + tok;
                gv[q] = ((const GAS float*)ec.GATES)[trow * 24 + head * 3 + br];
                if (mode == M_SLC) { const GAS float* np = (const GAS float*)(ec.NSAO + pvb + (size_t)(h8 * 8 + q) * 256); const f32x4 a4 = *(const GAS f32x4*)np, b4 = *(const GAS f32x4*)(np + (ptrdiff_t)((WS_PART - WS_NSAO) / 4));
#pragma unroll
                    for (int d0 = 0; d0 < 4; ++d0) { av[q][d0] = a4[d0]; bv[q][d0] = b4[d0]; } }
                else {
#pragma unroll
                    for (int d0 = 0; d0 < 4; ++d0) { av[q][d0] = 0.f; bv[q][d0] = 0.f; } } }
#pragma unroll
            for (int q = 0; q < 8; ++q) { const int r = h8 * 8 + q; const int rho = crow(r, hi); const float li = li_l[rho]; const float rl = li > 0.f ? __builtin_amdgcn_rcpf(li) : 0.f;
                const int tok = cur.P0 + wid * 8 + (rho & 7), head = cur.hb + (rho >> 3); const size_t trow = (size_t)cur.b * T + tok;
                const float gt = gv[q] * rl;
                if (mode == M_WIN) *(GAS f32x4*)(ec.NSAO + pvb + (size_t)r * 256 + (ptrdiff_t)((WS_PART - WS_NSAO) / 4)) = (f32x4){gt * o[0][r], gt * o[1][r], gt * o[2][r], gt * o[3][r]};
#pragma unroll
                for (int d0 = 0; d0 < 4; ++d0) {
                    if (mode == M_WIN) { }
                    else { const float v = av[q][d0] + bv[q][d0] + gt * o[d0][r]; const float vn = __shfl_xor(v, 1); if ((r32 & 1) == 0) *(GAS unsigned*)(ec.AO + trow * DM + 1024 + head * 128 + d0 * 32 + r32) = cvt_pk_bf16(v, vn); } } }
            asm volatile("" ::: "memory"); }
    }
    __builtin_amdgcn_s_setprio(0);
    __syncthreads();
#undef RESC
#undef KBASE
#undef PRELOAD
#undef MASKT
#undef ONT
#undef HALF_STEP
}
#undef ROW
#undef SLOAD_H
#undef SWRITE_HK
#undef SWRITE_HV
#undef SWRITE_H

__device__ __forceinline__ bf16x8 ovfrag(int n0, int J) {
    asm volatile("" : "+v"(n0));
    unsigned w[4];
#pragma unroll
    for (int q = 0; q < 4; ++q) { unsigned lohi[2];
#pragma unroll
        for (int e = 0; e < 2; ++e) { const int dl = n0 + 2 * q + e - 4 * J; lohi[e] = (dl >= 0 && dl <= 2) ? 0x3F80u : ((dl == 3 || dl == -1) ? 0x3F00u : 0u); }
        w[q] = lohi[0] | (lohi[1] << 16); }
    u32x4 v = {w[0], w[1], w[2], w[3]}; return *reinterpret_cast<bf16x8*>(&v);
}
__device__ __forceinline__ void nsa_cmp_item(int b, int g, int qb, const bf16_t* NQ, const bf16_t* KCMP, const bf16_t* VCMP, const float* GATES, const float* mbound, float* NSAO, LAS char* lds) {
    int tid = threadIdx.x; asm volatile("" : "+v"(tid));
    const int wid = __builtin_amdgcn_readfirstlane(tid >> 6), lane = tid & 63, r32 = lane & 31, hi = lane >> 5;
    LAS char* V_lds = lds + LC_V; LAS char* K_lds = lds + LC_K;
    LAS float* ws = (LAS float*)(lds + LC_WS) + wid * 64; LAS float* li_l = ws;
    LAS float* impL = (LAS float*)(lds + LC_IMP);
    const int sr = tid >> 4, sc = (tid & 15) * 8, vst0 = v_st(sr, sc), vst1 = v_st(32 + sr, sc), kws = KSWZ(sr, sc * 2);
    const bf16_t* Kc = KCMP + (size_t)(b * 2 + g) * 256 * 128; const bf16_t* Vc = VCMP + (size_t)(b * 2 + g) * 256 * 128;
    const int ntile = ((4 * qb + 2) >> 6) + 1;
    bf16x8 qr[8];
    { const bf16_t* qp = NQ + (((size_t)b * 8 + g * 4) * T + qb * 64) * 128 + q_lane_off(M_WIN, wid, r32) + hi * 8;
#pragma unroll
      for (int d0 = 0; d0 < 8; ++d0) qr[d0] = load8(qp + d0 * 16); }
    {
        bf16x8 kk[4][2], vv[4][2];
#pragma unroll
        for (int tl = 0; tl < 4; ++tl) { kk[tl][0] = load8(Kc + (size_t)(tl * 64 + sr) * 128 + sc); kk[tl][1] = load8(Kc + (size_t)(tl * 64 + 32 + sr) * 128 + sc); }
#pragma unroll
        for (int tl = 0; tl < 4; ++tl) { vv[tl][0] = load8(Vc + (size_t)(tl * 64 + sr) * 128 + sc); vv[tl][1] = load8(Vc + (size_t)(tl * 64 + 32 + sr) * 128 + sc); }
#pragma unroll
        for (int tl = 0; tl < 4; ++tl) { *(LAS bf16x8*)(K_lds + tl * SHM_K + kws) = kk[tl][0]; *(LAS bf16x8*)(K_lds + tl * SHM_K + kws + 32 * 256) = kk[tl][1]; }
#pragma unroll
        for (int tl = 0; tl < 4; ++tl) { *(LAS bf16x8*)(V_lds + tl * SHM_V + vst0) = vv[tl][0]; *(LAS bf16x8*)(V_lds + tl * SHM_V + vst1) = vv[tl][1]; }
        asm volatile("" ::: "memory");
    }
    __syncthreads();
    const int pos = qb * 64 + wid * 8 + (r32 & 7);
    const int nmax = (pos - 31) >> 4;
    const float NEG = -__builtin_inff();
#define CMASK(P0_, P1_, tl) do { _Pragma("unroll") for (int r = 0; r < 16; ++r) { const int n_ = (tl) * 64 + crow(r, hi); if (n_ > nmax) P0_[r] = NEG; if (n_ + 32 > nmax) P1_[r] = NEG; } } while (0)
    const float mL = -(*(const GAS float*)mbound) * C2;
    float l_reg = 0.f;
    const int vb0 = (int)(unsigned)(uintptr_t)V_lds + v_rd_base(lane);
    f32x16 o[4] = {}; f32x16 io[2] = {};
#pragma nounroll
    for (int tl = 0; tl < ntile; ++tl) { f32x16 p0 = f32x16{}, p1 = f32x16{}; qkt_r<0>(p0, p1, K_lds + tl * SHM_K, r32, hi, qr); CMASK(p0, p1, tl);
        float ps = 0.f;
#pragma unroll
        for (int r = 0; r < 16; ++r) { p0[r] = __builtin_amdgcn_exp2f(fmaf(p0[r], C2, mL)); p1[r] = __builtin_amdgcn_exp2f(fmaf(p1[r], C2, mL)); ps += p0[r] + p1[r]; }
        l_reg += ps; bf16x8 pa0, pa1, pa2, pa3; PK4(p0, 0, pa0); PK4(p0, 8, pa1); PK4(p1, 0, pa2); PK4(p1, 8, pa3);
        pv_tile<0>(o, vb0 + tl * SHM_V, pa0, pa1, pa2, pa3); SBAR();
#pragma unroll
        for (int d0 = 0; d0 < 2; ++d0) { const int J = d0 * 32 + r32;
            io[d0] = __builtin_amdgcn_mfma_f32_32x32x16_bf16(pa0, ovfrag(tl * 64 + 0 + 8 * hi, J), io[d0], 0, 0, 0);
            io[d0] = __builtin_amdgcn_mfma_f32_32x32x16_bf16(pa1, ovfrag(tl * 64 + 16 + 8 * hi, J), io[d0], 0, 0, 0);
            io[d0] = __builtin_amdgcn_mfma_f32_32x32x16_bf16(pa2, ovfrag(tl * 64 + 32 + 8 * hi, J), io[d0], 0, 0, 0);
            io[d0] = __builtin_amdgcn_mfma_f32_32x32x16_bf16(pa3, ovfrag(tl * 64 + 48 + 8 * hi, J), io[d0], 0, 0, 0); } SBAR(); }
    { auto rr = __builtin_amdgcn_permlane32_swap(__float_as_uint(l_reg), __float_as_uint(l_reg), false, false); l_reg = __uint_as_float(rr[0]) + __uint_as_float(rr[1]); }
    if (hi == 0) li_l[r32] = l_reg; asm volatile("s_waitcnt lgkmcnt(0)" ::: "memory");
    {
        float gv[16];
#pragma unroll
        for (int r = 0; r < 16; ++r) { const int rho = crow(r, hi); gv[r] = ((const GAS float*)GATES)[((size_t)b * T + qb * 64 + wid * 8 + (rho & 7)) * 24 + (g * 4 + (rho >> 3)) * 3 + 0]; }
        float imps[2][4] = {};
#pragma unroll
        for (int r = 0; r < 16; ++r) { const int rho = crow(r, hi); const float li = li_l[rho]; const float rl = li > 0.f ? __builtin_amdgcn_rcpf(li) : 0.f;
            const int tok = qb * 64 + wid * 8 + (rho & 7), head = g * 4 + (rho >> 3);
            const size_t trow = (size_t)b * T + tok;
            const float gt = gv[r] * rl;
            *(GAS f32x4*)(NSAO + ((((size_t)((b * 2 + g) * 64 + qb) * 8 + wid) * 16 + r) * 64 + (r32 + 32 * hi)) * 4) = (f32x4){gt * o[0][r], gt * o[1][r], gt * o[2][r], gt * o[3][r]};
            imps[0][r & 3] += io[0][r] * rl; imps[1][r & 3] += io[1][r] * rl; }
#pragma unroll
        for (int d0 = 0; d0 < 2; ++d0)
#pragma unroll
            for (int e = 0; e < 4; ++e) impL[(wid * 8 + e + 4 * hi) * 64 + d0 * 32 + r32] = imps[d0][e];
    }
#undef CMASK
    __syncthreads();
#pragma nounroll
    for (int tk = 0; tk < 8; ++tk) { const int tl = wid * 8 + tk; const int J = lane;
        const float im = impL[tl * 64 + J];
        const bool forced = (J == 0) || (J == qb) || (J == qb - 1);
        const float v = forced ? __builtin_inff() : (J <= qb ? im : NEG);
        impL[tl * 64 + J] = v; asm volatile("s_waitcnt lgkmcnt(0)" ::: "memory");
        f32x4 uv[16];
#pragma unroll
        for (int q = 0; q < 16; ++q) uv[q] = *(const LAS f32x4*)(impL + tl * 64 + 4 * q);
        int rank = 0;
#pragma unroll
        for (int q = 0; q < 16; ++q)
#pragma unroll
            for (int e = 0; e < 4; ++e) { const float u = uv[q][e]; const int jj = 4 * q + e; rank += (u > v || (u == v && jj < J)) ? 1 : 0; }
        const unsigned long long mk = __ballot(rank < 16 && J <= qb);
        if (lane == 0) *(LAS unsigned long long*)(lds + L_SEL + tl * 8) = mk; }
    __syncthreads();
}
#undef PK4
#undef VMW
#undef VMWN

template <class P> __device__ __forceinline__ P* uptr(P* p) { const unsigned long long v = (unsigned long long)p;
    const unsigned lo = __builtin_amdgcn_readfirstlane((unsigned)v), hi = __builtin_amdgcn_readfirstlane((unsigned)(v >> 32)); return (P*)(((unsigned long long)hi << 32) | lo); }
__device__ __forceinline__ Blk make_blk(unsigned char* ws, int i, int st) {
    const int bg = i >> 6, qb = i & 63, b = bg >> 1, g = bg & 1; Blk k;
    if (st < 2) {
        k.Q = uptr((const bf16_t*)(ws + WS_NQR) + (((size_t)b * 8 + g * 4) * T + qb * 64) * 128);
        k.K = uptr((const bf16_t*)(ws + (st == 0 ? WS_KW : WS_KSL)) + (size_t)bg * T * 128); k.V = uptr((const bf16_t*)(ws + (st == 0 ? WS_VW : WS_VSL)) + (size_t)bg * T * 128);
        k.KB = nullptr; k.mode = st == 0 ? M_WIN : M_SLC; k.P0 = qb * 64; k.j_lo = (st == 0 && qb >= 8) ? qb - 8 : 0; k.j_hi = qb + 1; k.b = b; k.hb = g * 4;
    } else {
        const int bh = bg * 4 + (qb & 3), qf = 15 - (qb >> 2);
        k.Q = uptr((const bf16_t*)(ws + WS_FQ) + ((size_t)bh * T + qf * 256) * 128); k.K = uptr((const bf16_t*)(ws + WS_FK) + (size_t)bh * T * 128); k.V = uptr((const bf16_t*)(ws + WS_FV) + (size_t)bh * T * 128);
        k.KB = uptr((const float*)(ws + WS_KBIAS) + (size_t)bh * T); k.mode = M_FOX; k.P0 = qf * 256; k.j_lo = 0; k.j_hi = 4 * qf + 4; k.b = bh >> 3; k.hb = bh & 7;
    }
    k.mode = __builtin_amdgcn_readfirstlane(k.mode); k.P0 = __builtin_amdgcn_readfirstlane(k.P0); k.j_lo = __builtin_amdgcn_readfirstlane(k.j_lo); k.j_hi = __builtin_amdgcn_readfirstlane(k.j_hi);
    k.b = __builtin_amdgcn_readfirstlane(k.b); k.hb = __builtin_amdgcn_readfirstlane(k.hb);
    return k;
}
__device__ __forceinline__ void compute_kb(unsigned char* ws, int bh, LAS char* lds) {
    int tid = threadIdx.x; asm volatile("" : "+v"(tid));
    LAS double* part = (LAS double*)(lds + LC_IMP);
    const float* lf = (const float*)(ws + WS_LOGF) + (size_t)bh * T + tid * 8; float* kb = (float*)(ws + WS_KBIAS) + (size_t)bh * T + tid * 8;
    const f32x4 v0 = *(const f32x4*)lf, v1 = *(const f32x4*)(lf + 4);
    double loc[8]; double run = 0.0;
    { const float vv[8] = {v0[0], v0[1], v0[2], v0[3], v1[0], v1[1], v1[2], v1[3]};
#pragma unroll
      for (int i = 0; i < 8; ++i) { run += (double)vv[i]; loc[i] = run; } }
    const int lane = tid & 63, wv = tid >> 6; double inc = run;
#pragma unroll
    for (int o = 1; o < 64; o <<= 1) { const double up = __shfl_up(inc, o); if (lane >= o) inc += up; }
    if (lane == 63) part[wv] = inc;
    __syncthreads();
    double off = inc - run;
    for (int w = 0; w < wv; ++w) off += part[w];
    f32x4 o0, o1;
#pragma unroll
    for (int i = 0; i < 4; ++i) { o0[i] = (float)(-(off + loc[i]) * (double)(1.0f / SCALE)); o1[i] = (float)(-(off + loc[4 + i]) * (double)(1.0f / SCALE)); }
    *(f32x4*)kb = o0; *(f32x4*)(kb + 4) = o1;
    asm volatile("s_waitcnt vmcnt(0)" ::: "memory");
    __syncthreads();
}
__device__ __forceinline__ void stage_kb(const float* kbg, LAS char* lds) {
    int tid = threadIdx.x; asm volatile("" : "+v"(tid));
    const f32x4 v0 = *(const GAS f32x4*)(kbg + tid * 8), v1 = *(const GAS f32x4*)(kbg + tid * 8 + 4);
    LAS float* kl = (LAS float*)(lds + L_KB) + tid * 8;
    *(LAS f32x4*)kl = v0; *(LAS f32x4*)(kl + 4) = v1;
    __syncthreads();
}
__device__ __forceinline__ void attn_phase(const Args& a, LAS char* lds, int vcu, int G) {
    unsigned char* ws = a.ws;
    EpiCtx ec{(bf16_t*)(ws + WS_AO), (float*)(ws + WS_NSAO), (const float*)(ws + WS_GATES), (unsigned*)(ws + CTL_CNT_ATTN)};
    Seam S;
    constexpr int ST0 = (DEV_ATT == 1) ? 2 : 0, ST1 = (DEV_ATT == 2) ? 2 : 3;
    for (int i = vcu; i < 256; i += G) {
#ifndef NO_CMP
        if (DEV_ATT & 2) { const int bg = i >> 6, qb = i & 63; nsa_cmp_item(bg >> 1, bg & 1, qb, (const bf16_t*)(ws + WS_NQ), (const bf16_t*)(ws + WS_KCMP), (const bf16_t*)(ws + WS_VCMP), ec.GATES, (const float*)(ws + WS_MBOUND), ec.NSAO, lds); }
#endif
#ifndef NO_BLK
        Blk cur = make_blk(ws, i, ST0);
        attn_prime(cur, lds, S);
        for (int st = ST0; st < ST1; ++st) { const Blk nxt = make_blk(ws, i, st + 1 < ST1 ? st + 1 : st);
            if (st == 1) { const int tid_ = threadIdx.x, w_ = __builtin_amdgcn_readfirstlane(tid_ >> 6), l_ = tid_ & 63; const float* kbg = (const float*)(ws + WS_KBIAS) + (size_t)((i >> 6) * 4 + (i & 3)) * T;
#pragma unroll
                for (int h_ = 0; h_ < 2; ++h_) __builtin_amdgcn_global_load_lds((const unsigned*)(kbg + (w_ * 2 + h_) * 256 + l_ * 4), (LAS unsigned*)(lds + L_KB + (w_ * 2 + h_) * 1024), 16, 0, 0); }
            if (st == 2) { asm volatile("s_waitcnt vmcnt(0)" ::: "memory"); __syncthreads(); }
            attn_block(cur, nxt, lds, S, ec); cur = nxt; }
#endif
    }
}
#undef KSWZ
#undef SBAR
}


__device__ __forceinline__ int win_src_col(int pg) {
    const int pn = pg >> 8, p = pg & 255;
    if (pn == 12) { if (p < 8) return C_FZ + p; if (p < 32) return C_GZ + p - 8; return -1; }
    const int bj = p >> 7, q = p & 127;
    const int d = 16 * (q >> 5) + 4 * ((q >> 3) & 3) + (q & 3) + 64 * ((q >> 2) & 1);
    int base;
    if (pn < 4) base = C_FQ + pn * 256; else if (pn < 8) base = C_FK + (pn - 4) * 256; else if (pn < 12) base = C_FV + (pn - 8) * 256;
    else if (pn < 17) base = C_NQ + (pn - 13) * 256; else if (pn == 17) base = C_KC; else if (pn == 18) base = C_VC; else if (pn == 19) base = C_KSL;
    else if (pn == 20) base = C_KW; else if (pn == 21) base = C_VSL; else base = C_VW;
    return base + bj * 128 + d;
}
template <int SRC>
__device__ __forceinline__ void transpose_item(const float* W, int K, int N, bf16_t* WT, LAS float* scr, int item, int nblk, int lane) {
    const int kb = item / nblk, nb = item % nblk, k0 = 64 * kb, n0 = 32 * nb;
    int sc = n0 + (lane & 31); if (SRC == 1) sc = win_src_col(sc);
    float tv[32];
    const float* wp = W + (size_t)(k0 + (lane >> 5)) * N + (sc >= 0 ? sc : 0);
#pragma unroll
    for (int i = 0; i < 32; ++i) tv[i] = wp[(size_t)(2 * i) * N];
#pragma unroll
    for (int i = 0; i < 32; ++i) { const int kk = 2 * i + (lane >> 5); scr[kk * 33 + (lane & 31)] = sc >= 0 ? tv[i] : 0.f; }
    asm volatile("s_waitcnt lgkmcnt(0)" ::: "memory");
    const int cch = lane & 7;
#pragma unroll
    for (int j = 0; j < 4; ++j) { const int n = (lane >> 3) + 8 * j; const LAS float* s = scr + (8 * cch) * 33 + n;
        u32x4 o; o.x = cvt_pk_bf16(s[0 * 33], s[1 * 33]); o.y = cvt_pk_bf16(s[2 * 33], s[3 * 33]); o.z = cvt_pk_bf16(s[4 * 33], s[5 * 33]); o.w = cvt_pk_bf16(s[6 * 33], s[7 * 33]);
        *(u32x4*)(WT + (size_t)(n0 + n) * K + k0 + 8 * cch) = o; }
    asm volatile("s_waitcnt lgkmcnt(0)" ::: "memory");
}

__device__ __forceinline__ void p0_prologue(const Args& a, LAS unsigned char* lds, int vcu, int G) {
    int tid = threadIdx.x; asm volatile("" : "+v"(tid)); const int lane = tid & 63, wave = __builtin_amdgcn_readfirstlane(tid >> 6);
    LAS float* ca = (LAS float*)lds;
    for (int i = tid; i < 2 * DM; i += NTHR) { const float v = a.c[i]; ca[i] = v / (1.f + __expf(-v)); }
    __syncthreads();
    const int gw = vcu * NWAVES + wave, NGW = G * NWAVES;
    float* modp = (float*)(a.ws + WS_MODP);
    if (wave < 3) { const int it = vcu * 3 + wave;
        if (it < 16 * 48) { const int kc = it / 48, cq = (it % 48) * 64 + lane;
            f32x4 a0 = (f32x4){0.f, 0.f, 0.f, 0.f}, a1 = a0;
            const float* wp = a.w_ada + (size_t)(kc * 128) * (6 * DM) + 4 * cq;
#pragma unroll 16
            for (int k = 0; k < 128; ++k) { const f32x4 w = *(const f32x4*)(wp + (size_t)k * (6 * DM)); a0 += w * ca[kc * 128 + k]; a1 += w * ca[DM + kc * 128 + k]; }
            const __amdgpu_buffer_rsrc_t rsrc = __builtin_amdgcn_make_buffer_rsrc(modp, 0, 16 * 2 * 6 * DM * 4, 0x00020000);
            __builtin_amdgcn_raw_buffer_store_b128(__builtin_bit_cast(u32x4, a0), rsrc, (unsigned)((((size_t)kc * 2 + 0) * (6 * DM) + 4 * cq) * 4), 0, 16);
            __builtin_amdgcn_raw_buffer_store_b128(__builtin_bit_cast(u32x4, a1), rsrc, (unsigned)((((size_t)kc * 2 + 1) * (6 * DM) + 4 * cq) * 4), 0, 16);
            handoff_signal((unsigned*)(a.ws + CTL_CNT_ADALN), lane); } }
    LAS float* scr = (LAS float*)(lds + 16384 + wave * 16384);
    constexpr int I_IN = 32 * (NPAD / 32), I_OUT = 32 * 64, I_UP = 32 * 256, I_DN = 128 * 64, I_W1 = 64 * 8, I_W2 = 4 * 4;
    constexpr int NIT = I_IN + I_OUT + I_UP + I_DN + 2 * I_W1 + 2 * I_W2;
    const int nslot = (NIT + G - 1) / G;
    auto slot_item = [&](int m) -> int { int j; if (wave < 3) { if (m >= 6) return -1; j = wave * 6 + m; } else { j = 18 + (wave - 3) + 5 * m; }
        if (j >= nslot) return -1; const int it = vcu + G * j; return it < NIT ? it : -1; };
    struct TrIt { const float* wp; bf16_t* wt; int N, K, ok; };
    auto decode = [&](int it) -> TrIt { int r = it; const float* W; bf16_t* WT; int K, N, nblk; bool src = false;
        if (r < I_IN) { W = a.w_in; K = DM; N = DIN; WT = (bf16_t*)(a.ws + WS_WIN); nblk = NPAD / 32; src = true; }
        else if ((r -= I_IN) < I_OUT) { W = a.w_out; K = DM; N = DM; WT = (bf16_t*)(a.ws + WS_WOUT); nblk = 64; }
        else if ((r -= I_OUT) < I_UP) { W = a.w_up; K = DM; N = DFF; WT = (bf16_t*)(a.ws + WS_WUP); nblk = 256; }
        else if ((r -= I_UP) < I_DN) { W = a.w_down; K = DFF; N = DM; WT = (bf16_t*)(a.ws + WS_WDN); nblk = 64; }
        else if ((r -= I_DN) < I_W1) { W = a.cmp_w1_k; K = 4096; N = 256; WT = (bf16_t*)(a.ws + WS_W1T); nblk = 8; }
        else if ((r -= I_W1) < I_W1) { W = a.cmp_w1_v; K = 4096; N = 256; WT = (bf16_t*)(a.ws + WS_W1T) + 256 * 4096; nblk = 8; }
        else if ((r -= I_W1) < I_W2) { W = a.cmp_w2_k; K = 256; N = 128; WT = (bf16_t*)(a.ws + WS_W2T); nblk = 4; }
        else { r -= I_W2; W = a.cmp_w2_v; K = 256; N = 128; WT = (bf16_t*)(a.ws + WS_W2T) + 128 * 256; nblk = 4; }
        const int kb = r / nblk, nb = r % nblk, k0 = 64 * kb, n0 = 32 * nb; int sc = n0 + (lane & 31); if (src) sc = win_src_col(sc);
        TrIt t; t.wp = W + (size_t)(k0 + (lane >> 5)) * N + (sc >= 0 ? sc : 0); t.wt = WT + (size_t)n0 * K + k0; t.N = N; t.K = K; t.ok = sc >= 0; return t; };
    auto tr_load = [&](const TrIt& t, float (&tv)[32]) {
#pragma unroll
        for (int i = 0; i < 32; ++i) tv[i] = t.wp[(size_t)(2 * i) * t.N]; };
    auto tr_store = [&](const TrIt& t, const float (&tv)[32]) {
#pragma unroll
        for (int i = 0; i < 32; ++i) { const int kk = 2 * i + (lane >> 5); scr[kk * 33 + (lane & 31)] = t.ok ? tv[i] : 0.f; }
        asm volatile("s_waitcnt lgkmcnt(0)" ::: "memory");
        const int cch = lane & 7;
#pragma unroll
        for (int j = 0; j < 4; ++j) { const int n = (lane >> 3) + 8 * j; const LAS float* sp = scr + (8 * cch) * 33 + n;
            u32x4 o; o.x = cvt_pk_bf16(sp[0 * 33], sp[1 * 33]); o.y = cvt_pk_bf16(sp[2 * 33], sp[3 * 33]); o.z = cvt_pk_bf16(sp[4 * 33], sp[5 * 33]); o.w = cvt_pk_bf16(sp[6 * 33], sp[7 * 33]);
            *(u32x4*)(t.wt + (size_t)n * t.K + 8 * cch) = o; }
        asm volatile("s_waitcnt lgkmcnt(0)" ::: "memory"); };
    {   float tva[32], tvb[32]; TrIt ta, tb; int ia = slot_item(0), ib;
        if (ia >= 0) { ta = decode(ia); tr_load(ta, tva); }
        for (int m = 1; ia >= 0; m += 2) {
            ib = slot_item(m); if (ib >= 0) { tb = decode(ib); tr_load(tb, tvb); }
            asm volatile("" ::: "memory");
            tr_store(ta, tva);
            if (ib < 0) break;
            ia = slot_item(m + 1); if (ia >= 0) { ta = decode(ia); tr_load(ta, tva); }
            asm volatile("" ::: "memory");
            tr_store(tb, tvb);
        }
    }
    if (vcu == 255 && wave == 7) { const float gk = fmaxf(fabsf(a.cmp_k_norm[lane]), fabsf(a.cmp_k_norm[64 + lane])), gq = fmaxf(fabsf(a.nsa_q_norm[lane]), fabsf(a.nsa_q_norm[64 + lane]));
        const float mb = wave_max(gk) * wave_max(gq) * (128.f * 1.02f); if (lane == 0) *(float*)(a.ws + WS_MBOUND) = mb; }
    float* rope = (float*)(a.ws + WS_ROPE);
    for (int e = (vcu * NTHR + tid); e < T * 64; e += G * NTHR) { const int t = e >> 6, i = e & 63;
        const float inv_freq = (float)pow(10000.0, -(double)i / 64.0); const float ang = (float)t * inv_freq;
        rope[2 * e] = (float)cos((double)ang); rope[2 * e + 1] = (float)sin((double)ang); }
    float* pebp = (float*)(a.ws + WS_PEBP);
    for (int it = gw; it < 2 * 4 * 64; it += NGW) { const int kv = it >> 8, cg_ = (it >> 6) & 3, ch = it & 63, col = cg_ * 64 + lane;
        const float* pe = kv ? a.cmp_pe_v : a.cmp_pe_k; const float* w1 = kv ? a.cmp_w1_v : a.cmp_w1_k; float s = 0.f;
#pragma unroll
        for (int i = 0; i < 64; ++i) s += pe[ch * 64 + i] * w1[(size_t)(ch * 64 + i) * 256 + col];
        pebp[((size_t)kv * 64 + ch) * 256 + col] = s; }
}

template <bool FIRST>
__device__ __forceinline__ void norm_phase(const Args& a, LAS unsigned char* lds, const float* xsrc, const float* gain, int shift_off, int scale_off, int bid, int G) {
    int tid = threadIdx.x; asm volatile("" : "+v"(tid)); const int lane = tid & 63, wave = __builtin_amdgcn_readfirstlane(tid >> 6);
    LAS float* AS = (LAS float*)lds; LAS float* SH = AS + DM;
    const float* modp = (const float*)(a.ws + WS_MODP); float* mod = (float*)(a.ws + WS_MOD);
    const int rows_per = M / G, b = (bid * rows_per) / T;
    f32x4 v[4][8];
#pragma unroll
    for (int rr = 0; rr < 4; ++rr) { const f32x4* xr = (const f32x4*)(xsrc + (size_t)(bid * rows_per + wave + 8 * rr) * DM) + lane;
#pragma unroll
        for (int j = 0; j < 8; ++j) v[rr][j] = xr[64 * j]; }
    if (FIRST) handoff_wait((unsigned*)(a.ws + CTL_CNT_ADALN), 16u * 48u);
    for (int d = tid; d < DM; d += NTHR) { float sc, sh;
        if (FIRST) { sc = a.b_ada[scale_off + d]; sh = a.b_ada[shift_off + d];
#pragma unroll
            for (int kc = 0; kc < 16; ++kc) { sc += modp[((size_t)kc * 2 + b) * (6 * DM) + scale_off + d]; sh += modp[((size_t)kc * 2 + b) * (6 * DM) + shift_off + d]; } }
        else { sc = mod[b * 6 * DM + scale_off + d]; sh = mod[b * 6 * DM + shift_off + d]; }
        AS[d] = gain[d] * (1.f + sc); SH[d] = sh; }
    if (FIRST) {
        for (int e = bid * NTHR + tid; e < 2 * 6 * DM; e += G * NTHR) { const int bb = e / (6 * DM), j = e % (6 * DM); float s = a.b_ada[j];
#pragma unroll
            for (int kc = 0; kc < 16; ++kc) s += modp[((size_t)kc * 2 + bb) * (6 * DM) + j];
            mod[e] = s; }
    }
    __syncthreads();
    bf16_t* XN = (bf16_t*)(a.ws + WS_XN);
    for (int r0 = 0; r0 < rows_per; r0 += 32) {
        if (r0 > 0) {
#pragma unroll
            for (int rr = 0; rr < 4; ++rr) { const f32x4* xr = (const f32x4*)(xsrc + (size_t)(bid * rows_per + r0 + wave + 8 * rr) * DM) + lane;
#pragma unroll
                for (int j = 0; j < 8; ++j) v[rr][j] = xr[64 * j]; } }
#pragma unroll
        for (int rr = 0; rr < 4; ++rr) { const int row = bid * rows_per + r0 + wave + 8 * rr; float ss = 0.f;
#pragma unroll
            for (int j = 0; j < 8; ++j) ss += (v[rr][j][0] * v[rr][j][0] + v[rr][j][1] * v[rr][j][1]) + (v[rr][j][2] * v[rr][j][2] + v[rr][j][3] * v[rr][j][3]);
            const float rstd = 1.0f / sqrtf(wave_sum(ss) * (1.f / DM) + EPS);
            u32x2* o8 = (u32x2*)(XN + (size_t)row * DM) + lane;
#pragma unroll
            for (int j = 0; j < 8; ++j) { const f32x4 as = *(const LAS f32x4*)(AS + 4 * lane + 256 * j), sh = *(const LAS f32x4*)(SH + 4 * lane + 256 * j);
                const f32x4 h = v[rr][j] * rstd * as + sh; u32x2 w; w.x = cvt_pk_bf16(h[0], h[1]); w.y = cvt_pk_bf16(h[2], h[3]); o8[64 * j] = w; } }
    }
    __syncthreads();
}


__device__ __forceinline__ void cmp2_phase(const Args& a, LAS unsigned char* lds, int L0, int Lstride) {
    int tid = threadIdx.x; asm volatile("" : "+v"(tid)); const int lane = tid & 63, wave = __builtin_amdgcn_readfirstlane(tid >> 6);
    unsigned char* ws = a.ws;
    for (int L = L0; L < 64; L += Lstride) {
        {
            const int kv = L >> 5, bg = (L >> 3) & 3, rt = L & 7;
            LAS bf16_t* hidL = (LAS bf16_t*)lds;
            LAS float* red = (LAS float*)(lds + 32768);
            LAS float* pebL = (LAS float*)(lds + 36864);
            if (tid < 256) { const float* pebp = (const float*)(ws + WS_PEBP) + (size_t)kv * 64 * 256 + tid; float sp = 0.f;
#pragma unroll
                for (int ch = 0; ch < 64; ++ch) sp += pebp[ch * 256];
                pebL[tid] = sp; }
            __syncthreads();
            { const int row = tid >> 4, c0 = (tid & 15) * 16;
              const float* pp = (const float*)(ws + WS_PART) + ((size_t)(kv * 4 + bg) * 4) * 65536 + (size_t)(rt * 32 + row) * 256 + c0;
              const LAS float* peb = pebL + c0;
              f32x4 s0 = *(const LAS f32x4*)peb, s1 = *(const LAS f32x4*)(peb + 4), s2 = *(const LAS f32x4*)(peb + 8), s3 = *(const LAS f32x4*)(peb + 12);
#pragma unroll 4
              for (int ks = 0; ks < 4; ++ks) { const float* q = pp + (size_t)ks * 65536; s0 += *(const f32x4*)q; s1 += *(const f32x4*)(q + 4); s2 += *(const f32x4*)(q + 8); s3 += *(const f32x4*)(q + 12); }
              f32x4 sv[4] = {s0, s1, s2, s3}; unsigned w[8];
#pragma unroll
              for (int i = 0; i < 4; ++i) { f32x4 v = sv[i];
#pragma unroll
                  for (int e = 0; e < 4; ++e) v[e] = v[e] / (1.f + __expf(-v[e]));
                  w[2 * i] = cvt_pk_bf16(v[0], v[1]); w[2 * i + 1] = cvt_pk_bf16(v[2], v[3]); }
              *(LAS u32x4*)(hidL + row * 264 + c0) = (u32x4){w[0], w[1], w[2], w[3]}; *(LAS u32x4*)(hidL + row * 264 + c0 + 8) = (u32x4){w[4], w[5], w[6], w[7]}; }
            __syncthreads();
            const int fr = lane & 15, fq = lane >> 4;
            f32x4 acc[2] = {(f32x4){0.f, 0.f, 0.f, 0.f}, (f32x4){0.f, 0.f, 0.f, 0.f}};
            const bf16_t* w2 = (const bf16_t*)(ws + WS_W2T) + (size_t)kv * 128 * 256 + (size_t)(16 * wave + fr) * 256 + 8 * fq;
#pragma unroll
            for (int ks = 0; ks < 8; ++ks) { const bf16x8 bf = *(const bf16x8*)(w2 + ks * 32);
#pragma unroll
                for (int rg = 0; rg < 2; ++rg) { const bf16x8 af = *(const LAS bf16x8*)(hidL + (rg * 16 + fr) * 264 + ks * 32 + 8 * fq);
                    acc[rg] = __builtin_amdgcn_mfma_f32_16x16x32_bf16(af, bf, acc[rg], 0, 0, 0); } }
            float rstd[2][4];
            if (kv == 0) {
#pragma unroll
                for (int rg = 0; rg < 2; ++rg)
#pragma unroll
                    for (int e = 0; e < 4; ++e) { float q = acc[rg][e] * acc[rg][e]; q += __shfl_xor(q, 1); q += __shfl_xor(q, 2); q += __shfl_xor(q, 4); q += __shfl_xor(q, 8);
                        if (fr == 0) red[(rg * 16 + 4 * fq + e) * 8 + wave] = q; }
                __syncthreads();
#pragma unroll
                for (int rg = 0; rg < 2; ++rg)
#pragma unroll
                    for (int e = 0; e < 4; ++e) { const LAS float* rp = red + (rg * 16 + 4 * fq + e) * 8; const float tot = ((rp[0] + rp[1]) + (rp[2] + rp[3])) + ((rp[4] + rp[5]) + (rp[6] + rp[7]));
                        rstd[rg][e] = 1.0f / sqrtf(tot * (1.f / 128.f) + EPS) * a.cmp_k_norm[16 * wave + fr]; }
            } else {
#pragma unroll
                for (int rg = 0; rg < 2; ++rg)
#pragma unroll
                    for (int e = 0; e < 4; ++e) rstd[rg][e] = 1.f;
            }
            bf16_t* dst = (bf16_t*)(ws + (kv ? WS_VCMP : WS_KCMP)) + (size_t)bg * 256 * 128;
#pragma unroll
            for (int rg = 0; rg < 2; ++rg)
#pragma unroll
                for (int e = 0; e < 4; ++e) { const int n = rt * 32 + rg * 16 + 4 * fq + e; const float v = (n == 255) ? 0.f : acc[rg][e] * rstd[rg][e];
                    dst[(size_t)n * 128 + 16 * wave + fr] = (bf16_t)(cvt_pk_bf16(v, 0.f) & 0xffffu); }
            __syncthreads();
        }
    }
}


#define XB_TMO      128
#define XB_XCNT(j)  (256  + 64 * (j))
#define XB_XSUB(j)  (1280 + 64 * (j))
#define XB_XGEN(j)  (2304 + 64 * (j))
#define XB_TOP      3328
#define XB_TOPGEN   3392
#define XCD_BAR_WORDS 3456
#define XB_SPIN_CAP (1u << 22)
__device__ __forceinline__ unsigned xb_ld(unsigned* p)              { return __hip_atomic_load(p, __ATOMIC_RELAXED, __HIP_MEMORY_SCOPE_AGENT); }
__device__ __forceinline__ unsigned xb_add(unsigned* p, unsigned v) { return __hip_atomic_fetch_add(p, v, __ATOMIC_RELAXED, __HIP_MEMORY_SCOPE_AGENT); }
__device__ __forceinline__ unsigned xb_xcc_id() { return (unsigned)__builtin_amdgcn_s_getreg((3 << 11) | 20) & 0xFu; }
#define XB_SPIN(cond, bar) do { unsigned _sp = 0; while (cond) { __builtin_amdgcn_s_sleep(1); \
    if ((++_sp & 255u) == 0u) { if (xb_ld(&(bar)[XB_TMO])) break; if (_sp > XB_SPIN_CAP) { atomicAdd(&(bar)[XB_TMO], 1u); break; } } } } while (0)
struct XcdBarrier { unsigned* bar; unsigned x; volatile LAS unsigned* st; };
__device__ __forceinline__ XcdBarrier xcd_barrier_post(unsigned* bar, volatile LAS unsigned* st) {
    XcdBarrier b; b.bar = bar; b.x = xb_xcc_id(); b.st = st;
    if (threadIdx.x == 0) (void)xb_add(&bar[XB_XCNT(b.x)], 1u);
    return b;
}
__device__ __forceinline__ void xcd_barrier_complete(unsigned* bar, unsigned x, unsigned& nloc, unsigned& nx) {
    const unsigned G = gridDim.x * gridDim.y * gridDim.z;
    unsigned sum, cnt, mine, sp = 0u;
    for (;;) {
        sum = 0u; cnt = 0u; mine = 0u;
#pragma unroll
        for (unsigned j = 0; j < 16; ++j) { const unsigned c = xb_ld(&bar[XB_XCNT(j)]); sum += c; cnt += (c > 0u) ? 1u : 0u; mine = (j == x) ? c : mine; }
        if (sum == G) break;
        __builtin_amdgcn_s_sleep(1);
        if ((++sp & 255u) == 0u) { if (xb_ld(&bar[XB_TMO])) break; if (sp > XB_SPIN_CAP) { atomicAdd(&bar[XB_TMO], 1u); break; } }
    }
    nloc = mine > 0u ? mine : 1u; nx = cnt > 0u ? cnt : 1u;
}
__device__ __forceinline__ void xcd_barrier(const XcdBarrier& b) {
    asm volatile("s_waitcnt vmcnt(0)" ::: "memory");
    __syncthreads();
    if (threadIdx.x == 0) {
        unsigned* bar = b.bar;
        __builtin_amdgcn_s_waitcnt(0);
        unsigned nloc = b.st[0], nx = b.st[1];
        if (nloc == 0u) { xcd_barrier_complete(bar, b.x, nloc, nx); b.st[0] = nloc; b.st[1] = nx; }
        const unsigned old = xb_add(&bar[XB_XSUB(b.x)], 1u);
        const unsigned gen = old / nloc;
        if (old + 1u == (gen + 1u) * nloc) {
            __builtin_amdgcn_fence(__ATOMIC_RELEASE, "agent");
            asm volatile("s_waitcnt vmcnt(0)" ::: "memory");
            const unsigned og = xb_add(&bar[XB_TOP], 1u);
            const unsigned tg = og / nx;
            if (og + 1u == (tg + 1u) * nx) xb_add(&bar[XB_TOPGEN], 1u);
            else XB_SPIN(xb_ld(&bar[XB_TOPGEN]) == tg, bar);
            __builtin_amdgcn_fence(__ATOMIC_ACQUIRE, "agent");
            xb_add(&bar[XB_XGEN(b.x)], 1u);
            asm volatile("s_waitcnt vmcnt(0)" ::: "memory");
        } else {
            XB_SPIN(xb_ld(&bar[XB_XGEN(b.x)]) == gen, bar);
            __builtin_amdgcn_fence(__ATOMIC_ACQUIRE, "agent");
            asm volatile("s_waitcnt vmcnt(0)" ::: "memory");
        }
    }
    __syncthreads();
}

enum { PH_PRO = 0, PH_INPROJ = 1, PH_ATTN = 2, PH_OUTPROJ = 3, PH_UP = 4, PH_DOWN = 5, PH_END = 6 };

__global__ void __launch_bounds__(NTHR, 2) mega_kernel(Args a) {
    extern __shared__ __attribute__((aligned(16))) unsigned char lds_raw[];
    LAS unsigned char* lds = (LAS unsigned char*)lds_raw;
    const int G = gridDim.x, bid = blockIdx.x;
    const int vcu = (G % 8 == 0) ? (bid % 8) * (G / 8) + bid / 8 : bid;
    unsigned char* ws = a.ws;
    volatile LAS unsigned* bst = (volatile LAS unsigned*)(lds + LDS_BYTES - 64);
    if (threadIdx.x < 2) bst[threadIdx.x] = 0u;
    __syncthreads();
    const XcdBarrier gbar = xcd_barrier_post((unsigned*)(ws + WS_CTL) + 1024, bst);
#ifndef PHMASK
#define PHMASK 0xffff
#endif
#define IN(k) (((PHMASK >> (k)) & 1) && a.ph_lo <= (k) && (k) < a.ph_hi)
#ifdef PROBE_PHASE
#define STAMP(k) do { if (bid == 0 && threadIdx.x == 0) ((unsigned long long*)(ws + WS_CTL + 24576))[(k)] = __builtin_amdgcn_s_memrealtime(); } while (0)
#else
#define STAMP(k) do { } while (0)
#endif
#define SEAM(k) do { if (IN(k) && IN((k) + 1)) xcd_barrier(gbar); STAMP((k) + 1); } while (0)
    STAMP(0);
    if (IN(PH_PRO)) { p0_prologue(a, lds, vcu, G); __syncthreads(); norm_phase<true>(a, lds, a.x, a.norm1_g, 0, DM, bid, G); } SEAM(PH_PRO);
    if (IN(PH_INPROJ)) {
        pg8::StaticOrder S; S.init(M, NPAD, G, bid, ws + WS_XN, ws + WS_WIN, DM, DM); S.rm = 1;
        pg8::EpiIn E{ws, a.fox_q_norm, a.fox_k_norm, a.nsa_q_norm, a.slc_k_norm, a.win_k_norm, a.b_forget, (LAS float*)(lds + LDS_STATS), (unsigned*)(ws + CTL_CNT_KCVC), (unsigned*)(ws + CTL_CNT_GATE)};
        pg8::gemm_phase(lds, DM, DM, DM, S, E);
        if (bid >= 224) {
            handoff_wait((unsigned*)(ws + CTL_CNT_KCVC), 64u * 8u);
            pg8::CmpOrder S2{32, bid - 224, (const char*)(ws + WS_KC), (const char*)(ws + WS_VC), (const char*)(ws + WS_W1T)};
            pg8::EpiPart E2{(float*)(ws + WS_PART), (unsigned*)(ws + CTL_CNT_PART)};
            pg8::gemm_phase(lds, 2048, 4096, 1024, S2, E2);
        }
        else if ((bid & 1) == 0 && (bid >> 3) < 16) {
            handoff_wait((unsigned*)(ws + CTL_CNT_PART), 32u * 8u);
            cmp2_phase(a, lds, (bid >> 3) * 4 + ((bid & 7) >> 1), 64);
        }
        else if ((bid & 1) == 0 && (bid >> 3) < 20) {
            handoff_wait((unsigned*)(ws + CTL_CNT_GATE), 32u * 8u);
            att::compute_kb(ws, ((bid >> 3) - 16) * 4 + ((bid & 7) >> 1), (LAS char*)lds);
        }
    } SEAM(PH_INPROJ);
#ifdef PROBE_PHASE
    unsigned long long tA0 = __builtin_amdgcn_s_memrealtime();
#endif
    if (IN(PH_ATTN)) { att::attn_phase(a, (LAS char*)lds, vcu, G); }
#ifdef PROBE_PHASE
    if (threadIdx.x == 0) { const unsigned d = (unsigned)(__builtin_amdgcn_s_memrealtime() - tA0); atomicMax((unsigned*)(ws + WS_CTL + 24576 + 256), d); atomicMax((unsigned*)(ws + WS_CTL + 24576 + 260), 0xffffffffu - d); }
#endif
    SEAM(PH_ATTN);
    if (IN(PH_OUTPROJ)) {
        pg8::StaticOrder S; S.init(M, DM, G, bid, ws + WS_AO, ws + WS_WOUT, DM, DM);
        pg8::EpiResNorm E{a.x, (bf16_t*)(ws + WS_X1B), (const float*)(ws + WS_MOD), a.norm2_g, (bf16_t*)(ws + WS_XN), (float*)(ws + WS_SLOTS), (unsigned*)(ws + CTL_CNT_PANEL), (LAS float*)(lds + LDS_STATS)};
        pg8::gemm_phase(lds, DM, DM, DM, S, E);
    } SEAM(PH_OUTPROJ);
    if (IN(PH_UP)) {
        pg8::StaticOrder S; S.init(M, DFF, G, bid, ws + WS_XN, ws + WS_WUP, DM, DM);
        pg8::EpiUp E{(bf16_t*)(ws + WS_U), DFF};
        pg8::gemm_phase(lds, DM, DM, DM, S, E);
    } SEAM(PH_UP);
    if (IN(PH_DOWN)) {
        pg8::StaticOrder S; S.init(M, DM, G, bid, ws + WS_U, ws + WS_WDN, DFF, DFF);
        pg8::EpiRes E{(const bf16_t*)(ws + WS_X1B), a.out, (const float*)(ws + WS_MOD) + 5 * DM};
        pg8::gemm_phase(lds, DFF, DFF, DFF, S, E);
    }
    STAMP(PH_END);
#undef IN
#undef SEAM
}

#ifdef PROBE_PHASE
__global__ void probe_kernel(const unsigned long long* tsp, float* out) {
#if PROBE_PHASE == 98
    out[0] = (float)(((const unsigned*)tsp)[64]) * 1e-3f;
#elif PROBE_PHASE == 97
    out[0] = (float)(0xffffffffu - ((const unsigned*)tsp)[65]) * 1e-3f;
#elif PROBE_PHASE == 99
    out[0] = (float)(tsp[PH_END] - tsp[0]) * 5e-4f;
#else
    const unsigned long long t1 = tsp[PROBE_PHASE + 1], t0 = tsp[PROBE_PHASE]; out[0] = (float)(t1 - t0) * 1e-2f;
#endif
}
#endif
static void launch_phases(const Args& a0, int lo, int hi, int grid, hipStream_t stream) {
    Args a = a0; a.ph_lo = lo; a.ph_hi = hi; void* args[] = {&a};
    (void)args; hipLaunchKernelGGL(mega_kernel, dim3(grid), dim3(NTHR), LDS_BYTES, stream, a);
    hipError_t e = hipPeekAtLastError();
    if (e != hipSuccess) fprintf(stderr, "launch failed: %s (grid %d)\n", hipGetErrorString(e), grid);
}

extern "C" void kernel_launch(void* const* d_in, const int* in_sizes, int n_in, void* d_out, int out_size, void* d_ws, size_t ws_size, hipStream_t stream) {
    static int grid = 0;
    if (grid == 0) {
        int dev = 0, cus = 0, per_cu = 0; hipGetDevice(&dev); hipDeviceGetAttribute(&cus, hipDeviceAttributeMultiprocessorCount, dev);
        hipFuncSetAttribute((const void*)mega_kernel, hipFuncAttributeMaxDynamicSharedMemorySize, LDS_BYTES);
        hipOccupancyMaxActiveBlocksPerMultiprocessor(&per_cu, (const void*)mega_kernel, NTHR, LDS_BYTES);
        if (per_cu < 1) { fprintf(stderr, "occupancy query says %d blocks/CU\n", per_cu); per_cu = 1; }
        grid = 256;
        if (cus < 256) fprintf(stderr, "this kernel needs >= 256 CUs for a resident grid (device has %d)\n", cus);
        if (ws_size < WS_END + 24 * MiB) fprintf(stderr, "workspace too small: %zu\n", ws_size);
    }
    hipMemsetAsync((char*)d_ws + WS_CTL, 0, 49152, stream);
    Args a{};
    const float** ap = (const float**)&a;
    for (int i = 0; i < 23; ++i) ap[i] = (const float*)d_in[i];
    a.out = (float*)d_out; a.ws = (unsigned char*)d_ws;
    unsigned char* ws = a.ws;
    launch_phases(a, PH_PRO, PH_END, grid, stream);
#ifdef PROBE_PHASE
    probe_kernel<<<1, 1, 0, stream>>>((const unsigned long long*)(ws + WS_CTL + 24576), a.out);
#endif
}
```
